# Optimizing an MI355X kernel written in HIP

```python
import jax
import jax.numpy as jnp
from jax import lax
import numpy as np


D_MODEL = 1024
BATCH = 8
SEQ = 4096
DEPTH = 2

CTX_LEN = 256
GRID_W = 64
EPS = 1e-6
ROPE_THETA = 10000.0
Q_BLOCK = 128

M_HEADS = 4
M_DH = 96
M_WIDTH = M_HEADS * M_DH
M_CHUNK = 64
M_CONV = 3

A_HEADS = 6
A_KV = 2
A_DH = 64
A_WIDTH = A_HEADS * A_DH

L_HEADS = 4
L_NOPE = 64
L_ROPE = 32
L_QK = L_NOPE + L_ROPE
L_DV = 64
L_QRANK = 256
L_KVRANK = 128
L_WIDTH = L_HEADS * L_DV

MIX_WIDTH = M_WIDTH + A_WIDTH + L_WIDTH
IN_SIZES = (M_WIDTH, M_WIDTH, M_WIDTH, M_WIDTH, 4 * M_HEADS,
            A_WIDTH, A_KV * A_DH, A_KV * A_DH,
            L_QRANK, L_KVRANK, L_ROPE)
IN_WIDTH = sum(IN_SIZES)

D_FF = 3584
N_EXPERTS = 8
TOP_K = 2

F32 = jnp.float32

kernel_name = 'hybrid_mlstm_gqa_mla_prefix_dit'


def rmsnorm(x, g):
    xf = x.astype(F32)
    y = xf * lax.rsqrt(jnp.mean(xf * xf, axis=-1, keepdims=True) + EPS)
    return (y * g.astype(F32)).astype(x.dtype)


def modulate(x, g, shift, scale):
    return rmsnorm(x, g) * (1 + scale) + shift


def to_heads(a, n_heads):
    b, t, _ = a.shape
    return a.reshape(b, t, n_heads, -1).transpose(0, 2, 1, 3)


def merge_heads(o):
    b, hk, g, t, dv = o.shape
    return o.transpose(0, 3, 1, 2, 4).reshape(b, t, hk * g * dv)


def axial_rope_angles(rows, cols, rot_dim):
    nf = rot_dim // 4
    inv = ROPE_THETA ** (-jnp.arange(nf, dtype=F32) / nf)
    ar = rows[:, None] * inv
    ac = cols[:, None] * inv
    ang = jnp.concatenate([ar, ar, ac, ac], axis=-1)
    return jnp.cos(ang), jnp.sin(ang)


def apply_rope(x, cos, sin):
    half = x.shape[-1] // 2
    quarter = half // 2

    def rotate_half(u):
        return jnp.concatenate([-u[..., quarter:], u[..., :quarter]], axis=-1)

    rot = jnp.concatenate([rotate_half(x[..., :half]), rotate_half(x[..., half:])], axis=-1)
    return (x.astype(F32) * cos + rot.astype(F32) * sin).astype(x.dtype)


def centred_dwconv(x, w):
    k, ch = w.shape
    pad = k // 2
    return lax.conv_general_dilated(x, w.astype(x.dtype)[:, None, :], window_strides=(1,),
                                    padding=[(pad, pad)], dimension_numbers=('NWC', 'WIO', 'NWC'),
                                    feature_group_count=ch)


def attend_blocked(q, k, v, scale):
    b, hk, g, tq, d = q.shape
    nb = tq // Q_BLOCK
    qb = jnp.moveaxis(q.reshape(b, hk, g, nb, Q_BLOCK, d), 3, 0)

    def one_block(qi):
        s = jnp.einsum('bhgqd,bhkd->bhgqk', qi, k, preferred_element_type=F32) * scale
        p = jax.nn.softmax(s, axis=-1)
        return jnp.einsum('bhgqk,bhkd->bhgqd', p.astype(v.dtype), v)

    o = lax.map(one_block, qb)
    return jnp.moveaxis(o, 0, 3).reshape(b, hk, g, tq, v.shape[-1])


def mlstm_scan(q, k, v, log_i, log_f, state):
    b, h, t, dh = q.shape
    nc = t // M_CHUNK

    def to_chunks(a):
        a = a.reshape(b, h, nc, M_CHUNK, *a.shape[3:])
        return jnp.moveaxis(a, 2, 0)

    tril = jnp.tril(jnp.ones((M_CHUNK, M_CHUNK), dtype=bool))

    def step(carry, xs):
        c_st, n_st, m_st = carry
        qc, kc, vc, ic, fc = xs
        bcum = jnp.cumsum(fc, axis=-1)
        dmat = jnp.where(tril, bcum[..., :, None] - bcum[..., None, :] + ic[..., None, :], -jnp.inf)
        m_inter = bcum + m_st[..., None]
        m_t = jnp.maximum(m_inter, jnp.max(dmat, axis=-1))
        w = jnp.exp(dmat - m_t[..., None]) * jnp.einsum('bhtd,bhsd->bhts', qc, kc)
        a_inter = jnp.exp(m_inter - m_t)
        num = a_inter[..., None] * jnp.einsum('bhtd,bhde->bhte', qc, c_st) + jnp.einsum('bhts,bhse->bhte', w, vc)
        den = a_inter * jnp.einsum('bhtd,bhd->bht', qc, n_st) + jnp.sum(w, axis=-1)
        h_out = num / jnp.maximum(jnp.abs(den), jnp.exp(-m_t))[..., None]
        g = bcum[..., -1:] - bcum + ic
        m_new = jnp.maximum(bcum[..., -1] + m_st, jnp.max(g, axis=-1))
        decay = jnp.exp(bcum[..., -1] + m_st - m_new)
        wk = jnp.exp(g - m_new[..., None])
        c_new = decay[..., None, None] * c_st + jnp.einsum('bhs,bhsd,bhse->bhde', wk, kc, vc)
        n_new = decay[..., None] * n_st + jnp.einsum('bhs,bhsd->bhd', wk, kc)
        return (c_new, n_new, m_new), h_out

    state, hs = lax.scan(step, state, tuple(to_chunks(a) for a in (q, k, v, log_i, log_f)))
    return jnp.moveaxis(hs, 0, 2).reshape(b, h, t, dh), state


def mlstm_prep(mq, mk, mv, mg, conv_w, gate_b):
    b, t, _ = mq.shape
    qk = jax.nn.silu(centred_dwconv(jnp.concatenate([mq, mk], axis=-1), conv_w))
    q = to_heads(qk[..., :M_WIDTH], M_HEADS).astype(F32)
    k = to_heads(qk[..., M_WIDTH:], M_HEADS).astype(F32) * (M_DH ** -0.5)
    v = to_heads(mv, M_HEADS).astype(F32)
    g = (mg + gate_b).astype(F32).transpose(0, 2, 1).reshape(b, 4, M_HEADS, t)
    log_i = g[:, 0::2]
    log_f = jax.nn.log_sigmoid(g[:, 1::2])
    return q, k, v, log_i, log_f


def mlstm_bidirectional(ctx_in, lat_in):
    qc, kc, vc, ic, fc = ctx_in
    ql, kl, vl, il, fl = lat_in
    b, h, _, dh = qc.shape
    zero = (jnp.zeros((b, h, dh, dh), F32), jnp.zeros((b, h, dh), F32), jnp.zeros((b, h), F32))

    def flip(a):
        return jnp.flip(a, axis=2)

    hc_f, st_f = mlstm_scan(qc, kc, vc, ic[:, 0], fc[:, 0], zero)
    hl_f, _ = mlstm_scan(ql, kl, vl, il[:, 0], fl[:, 0], st_f)
    hc_b, st_b = mlstm_scan(flip(qc), flip(kc), flip(vc), flip(ic[:, 1]), flip(fc[:, 1]), zero)
    hl_b, _ = mlstm_scan(flip(ql), flip(kl), flip(vl), flip(il[:, 1]), flip(fl[:, 1]), st_b)
    return hc_f + flip(hc_b), hl_f + flip(hl_b)


def mlstm_out(h, o, norm_g):
    b, nh, t, dh = h.shape
    hn = rmsnorm(h.transpose(0, 2, 1, 3), norm_g.reshape(nh, dh)).reshape(b, t, nh * dh)
    return (hn * jax.nn.sigmoid(o.astype(F32))).astype(o.dtype)


def gqa_prep(aq, ak, av, qn, kn, rope):
    q = rmsnorm(to_heads(aq, A_HEADS), qn)
    k = rmsnorm(to_heads(ak, A_KV), kn)
    v = to_heads(av, A_KV)
    if rope is not None:
        q = apply_rope(q, *rope)
        k = apply_rope(k, *rope)
    b, _, t, _ = q.shape
    return q.reshape(b, A_KV, A_HEADS // A_KV, t, A_DH), k, v


def mla_prep(cq, ckv, kr, cq_norm, ckv_norm, wuq, wukv, qn, kn, rope):
    q = to_heads(rmsnorm(cq, cq_norm) @ wuq, L_HEADS)
    kv = to_heads(rmsnorm(ckv, ckv_norm) @ wukv, L_HEADS)
    k_nope = rmsnorm(kv[..., :L_NOPE], kn[:L_NOPE])
    v = kv[..., L_NOPE:]
    q_nope = rmsnorm(q[..., :L_NOPE], qn[:L_NOPE])
    q_rope = rmsnorm(q[..., L_NOPE:], qn[L_NOPE:])
    k_rope = rmsnorm(kr, kn[L_NOPE:])
    if rope is not None:
        q_rope = apply_rope(q_rope, *rope)
        k_rope = apply_rope(k_rope, *rope)
    b, h, t, _ = q.shape
    q = jnp.concatenate([q_nope, q_rope], axis=-1)
    k = jnp.concatenate([k_nope, jnp.broadcast_to(k_rope[:, None], (b, h, t, L_ROPE))], axis=-1)
    return q[:, :, None], k, v


def hybrid_mixer(h_lat, h_ctx, need_ctx, w_in, m_conv, m_gate_b, m_norm, a_qnorm, a_knorm,
                 l_cq_norm, l_ckv_norm, l_wuq, l_wukv, l_qnorm, l_knorm, w_out, rope_a, rope_l):
    split_at = np.cumsum(IN_SIZES)[:-1].tolist()
    pl = jnp.split(h_lat @ w_in, split_at, axis=-1)
    pc = jnp.split(h_ctx @ w_in, split_at, axis=-1)
    hm_ctx, hm_lat = mlstm_bidirectional(mlstm_prep(pc[0], pc[1], pc[2], pc[4], m_conv, m_gate_b),
                                         mlstm_prep(pl[0], pl[1], pl[2], pl[4], m_conv, m_gate_b))
    qa_l, ka_l, va_l = gqa_prep(pl[5], pl[6], pl[7], a_qnorm, a_knorm, rope_a)
    qa_c, ka_c, va_c = gqa_prep(pc[5], pc[6], pc[7], a_qnorm, a_knorm, None)
    oa_lat = merge_heads(attend_blocked(qa_l, jnp.concatenate([ka_c, ka_l], axis=2),
                                        jnp.concatenate([va_c, va_l], axis=2), A_DH ** -0.5))
    ql_l, kl_l, vl_l = mla_prep(pl[8], pl[9], pl[10], l_cq_norm, l_ckv_norm, l_wuq, l_wukv, l_qnorm, l_knorm, rope_l)
    ql_c, kl_c, vl_c = mla_prep(pc[8], pc[9], pc[10], l_cq_norm, l_ckv_norm, l_wuq, l_wukv, l_qnorm, l_knorm, None)
    ol_lat = merge_heads(attend_blocked(ql_l, jnp.concatenate([kl_c, kl_l], axis=2),
                                        jnp.concatenate([vl_c, vl_l], axis=2), L_QK ** -0.5))
    o_lat = jnp.concatenate([mlstm_out(hm_lat, pl[3], m_norm), oa_lat, ol_lat], axis=-1) @ w_out
    if not need_ctx:
        return o_lat, None
    oa_ctx = merge_heads(attend_blocked(qa_c, ka_c, va_c, A_DH ** -0.5))
    ol_ctx = merge_heads(attend_blocked(ql_c, kl_c, vl_c, L_QK ** -0.5))
    o_ctx = jnp.concatenate([mlstm_out(hm_ctx, pc[3], m_norm), oa_ctx, ol_ctx], axis=-1) @ w_out
    return o_lat, o_ctx


def swiglu(x, wg, wu, wd):
    return (jax.nn.silu(x @ wg) * (x @ wu)) @ wd


def moe_swiglu(x, router, wg, wu, wd):
    b, t, d = x.shape
    xt = x.reshape(b * t, d)
    logits = (xt @ router).astype(F32)
    top_val, top_idx = lax.top_k(logits, TOP_K)
    top_w = jax.nn.softmax(top_val, axis=-1)
    combine = jnp.einsum('nk,nke->ne', top_w, jax.nn.one_hot(top_idx, N_EXPERTS, dtype=F32)).astype(x.dtype)
    out = jnp.zeros_like(xt)
    for e in range(N_EXPERTS):
        out = out + combine[:, e:e + 1] * swiglu(xt, wg[e], wu[e], wd[e])
    return out.reshape(b, t, d)


def setup_inputs(seed: int = 0) -> dict:
    key = jax.random.key(seed)
    ks = iter(jax.random.split(key, 32))

    def nrm(shape, scale):
        return jax.random.normal(next(ks), shape, F32) * scale

    def gain(shape):
        return 1.0 + nrm(shape, 0.1)

    nd = (DEPTH + 1) // 2
    nm = DEPTH // 2
    d = D_MODEL
    gate_offset = jnp.tile(jnp.repeat(jnp.array([0.0, 3.0], F32), M_HEADS), 2)
    return {
        'x': nrm((BATCH, SEQ, d), 1.0),
        'c': nrm((BATCH, d), 1.0),
        'ctx': nrm((BATCH, CTX_LEN, d), 1.0),
        'c_ctx': nrm((d,), 1.0),
        'mod_w': nrm((DEPTH, d, 6 * d), 0.5 * d ** -0.5),
        'mod_b': nrm((DEPTH, 6 * d), 0.01),
        'norm_mix': gain((DEPTH, d)),
        'norm_ffn': gain((DEPTH, d)),
        'w_in': nrm((DEPTH, d, IN_WIDTH), d ** -0.5),
        'm_conv': nrm((DEPTH, M_CONV, 2 * M_WIDTH), M_CONV ** -0.5),
        'm_gate_b': gate_offset + nrm((DEPTH, 4 * M_HEADS), 0.5),
        'm_norm': gain((DEPTH, M_WIDTH)),
        'a_qnorm': gain((DEPTH, A_DH)),
        'a_knorm': gain((DEPTH, A_DH)),
        'l_cq_norm': gain((DEPTH, L_QRANK)),
        'l_ckv_norm': gain((DEPTH, L_KVRANK)),
        'l_wuq': nrm((DEPTH, L_QRANK, L_HEADS * L_QK), L_QRANK ** -0.5),
        'l_wukv': nrm((DEPTH, L_KVRANK, L_HEADS * (L_NOPE + L_DV)), L_KVRANK ** -0.5),
        'l_qnorm': gain((DEPTH, L_QK)),
        'l_knorm': gain((DEPTH, L_QK)),
        'w_out': nrm((DEPTH, MIX_WIDTH, d), MIX_WIDTH ** -0.5),
        'ffn_wg': nrm((nd, d, D_FF), d ** -0.5),
        'ffn_wu': nrm((nd, d, D_FF), d ** -0.5),
        'ffn_wd': nrm((nd, D_FF, d), D_FF ** -0.5),
        'moe_router': nrm((nm, d, N_EXPERTS), d ** -0.5),
        'moe_wg': nrm((nm, N_EXPERTS, d, D_FF), d ** -0.5),
        'moe_wu': nrm((nm, N_EXPERTS, d, D_FF), d ** -0.5),
        'moe_wd': nrm((nm, N_EXPERTS, D_FF, d), D_FF ** -0.5),
    }


def reference(x, c, ctx, c_ctx, mod_w, mod_b, norm_mix, norm_ffn, w_in, m_conv, m_gate_b, m_norm,
              a_qnorm, a_knorm, l_cq_norm, l_ckv_norm, l_wuq, l_wukv, l_qnorm, l_knorm, w_out,
              ffn_wg, ffn_wu, ffn_wd, moe_router, moe_wg, moe_wu, moe_wd):
    seq = x.shape[1]
    ROWS = seq // GRID_W
    rows = jnp.repeat(jnp.arange(ROWS, dtype=F32), GRID_W)
    cols = jnp.tile(jnp.arange(GRID_W, dtype=F32), ROWS)
    rope_a = axial_rope_angles(rows, cols, A_DH)
    rope_l = axial_rope_angles(rows, cols, L_ROPE)
    silu_c = jax.nn.silu(c)
    silu_cc = jax.nn.silu(c_ctx)
    for i in range(DEPTH):
        need_ctx = i < DEPTH - 1
        mod_lat = (silu_c @ mod_w[i] + mod_b[i])[:, None, :]
        mod_ctx = silu_cc @ mod_w[i] + mod_b[i]
        sh_a, sc_a, g_a, sh_f, sc_f, g_f = jnp.split(mod_lat, 6, axis=-1)
        csh_a, csc_a, cg_a, csh_f, csc_f, cg_f = jnp.split(mod_ctx, 6, axis=-1)
        o_lat, o_ctx = hybrid_mixer(modulate(x, norm_mix[i], sh_a, sc_a),
                                    modulate(ctx, norm_mix[i], csh_a, csc_a), need_ctx,
                                    w_in[i], m_conv[i], m_gate_b[i], m_norm[i], a_qnorm[i], a_knorm[i],
                                    l_cq_norm[i], l_ckv_norm[i], l_wuq[i], l_wukv[i], l_qnorm[i], l_knorm[i],
                                    w_out[i], rope_a, rope_l)
        x = x + g_a * o_lat
        j = i // 2
        if i % 2 == 0:
            ffn = lambda u: swiglu(u, ffn_wg[j], ffn_wu[j], ffn_wd[j])
        else:
            ffn = lambda u: moe_swiglu(u, moe_router[j], moe_wg[j], moe_wu[j], moe_wd[j])
        x = x + g_f * ffn(modulate(x, norm_ffn[i], sh_f, sc_f))
        if need_ctx:
            ctx = ctx + cg_a * o_ctx
            ctx = ctx + cg_f * ffn(modulate(ctx, norm_ffn[i], csh_f, csc_f))
    return x
```

```cpp
#ifndef EMU
#include <hip/hip_runtime.h>
#endif
#include <cstdio>
#include <cstdint>
#include <cmath>

#ifdef CFG_TINY
constexpr int D_MODEL = 256, BATCH = 2, SEQ = 512, CTX = 256, GRID_W = 16, D_FF = 512;
constexpr int MOE_PCH = 6;
#else
constexpr int D_MODEL = 1024, BATCH = 8, SEQ = 4096, CTX = 256, GRID_W = 64, D_FF = 3584;
constexpr int MOE_PCH = 88;
#endif
constexpr int TP = CTX + SEQ, M_ALL = BATCH * TP, NPAN = M_ALL / 256, PAN_B = TP / 256, NQL = SEQ / 256;
constexpr int NCH = TP / 64, NC_CTX = CTX / 64;
constexpr int PROJ_W = 2816, MIXW = 1024, NEXP = 8;
constexpr int C_MQ = 0, C_MK = 384, C_MV = 768, C_MO = 1152, C_G = 1536, C_AQ = 1552, C_AK = 1936, C_AV = 2064, C_CQ = 2192, C_CKV = 2448, C_KR = 2576, IN_W = 2608;
constexpr int NV = BATCH + 1;
constexpr int NCHAIN = BATCH * 4 * 2, NITEM = NCHAIN * NCH;
constexpr int NTOK = BATCH * SEQ, NSLOTP = NTOK * 2 + NEXP * 256;
constexpr float EPS = 1e-6f, LOG2E = 1.4426950408889634f;
constexpr float QSCALE_A = 0.125f * LOG2E, QSCALE_L = 0.10206207261596575f * LOG2E, KSCALE_M = 0.10206207261596575f;
constexpr int NTHR = 512, NWAVE = 8;

typedef unsigned short bf16;
#ifndef EMU
typedef short bf16x8 __attribute__((ext_vector_type(8)));
typedef short s16x4 __attribute__((ext_vector_type(4)));
typedef float f32x4 __attribute__((ext_vector_type(4)));
typedef float f32x2 __attribute__((ext_vector_type(2)));
typedef float f32x16 __attribute__((ext_vector_type(16)));
typedef unsigned u32x4 __attribute__((ext_vector_type(4)));
typedef unsigned u32x2 __attribute__((ext_vector_type(2)));
#define DEV __device__ __forceinline__
DEV f32x16 mfma32(bf16x8 a, bf16x8 b, f32x16 c) { return __builtin_amdgcn_mfma_f32_32x32x16_bf16(a, b, c, 0, 0, 0); }
DEV void wave_sync() { asm volatile("s_waitcnt vmcnt(0) lgkmcnt(0)" ::: "memory"); __builtin_amdgcn_wave_barrier(); }
DEV float exp2_fast(float x) { return __builtin_amdgcn_exp2f(x); }
DEV float rcp_fast(float x) { return __builtin_amdgcn_rcpf(x); }
DEV void atomic_addf(float* p, float v) { unsafeAtomicAdd(p, v); }
#define OPAQUE_V(x) asm volatile("" : "+v"(x))
DEV unsigned fau(float f) { return __float_as_uint(f); }
DEV float uaf(unsigned u) { return __uint_as_float(u); }
#else
#define DEV inline
#define OPAQUE_V(x) do {} while (0)
DEV void wave_sync() { (void)emu_shfl_u(0u, emu::B->cur & 63); }
DEV void atomic_addf(float* p, float v) { atomicAdd(p, v); }
DEV unsigned fau(float f) { unsigned u; memcpy(&u, &f, 4); return u; }
DEV float uaf(unsigned u) { float f; memcpy(&f, &u, 4); return f; }
#endif
DEV bf16 f2bf(float f) { unsigned u = fau(f); u += 0x7fffu + ((u >> 16) & 1u); return (bf16)(u >> 16); }
DEV float bf2f(bf16 h) { return uaf(((unsigned)h) << 16); }
DEV unsigned pk2(float lo, float hi) { return (unsigned)f2bf(lo) | ((unsigned)f2bf(hi) << 16); }
DEV float wave_sum(float v) {
#pragma unroll
    for (int o = 1; o < 64; o <<= 1) v += __shfl_xor(v, o);
    return v;
}
DEV float wave_max(float v) {
#pragma unroll
    for (int o = 1; o < 64; o <<= 1) v = fmaxf(v, __shfl_xor(v, o));
    return v;
}
DEV float silu_f(float x) { return x / (1.0f + __expf(-x)); }
DEV float silu_fast(float x) { return x * rcp_fast(1.0f + exp2_fast(-x * LOG2E)); }
DEV float sigmoid_f(float x) { return 1.0f / (1.0f + __expf(-x)); }
DEV float log_sigmoid_f(float x) { return x >= 0.f ? -log1pf(expf(-x)) : x - log1pf(expf(x)); }
DEV int crow(int i, int h) { return (i & 3) + 8 * (i >> 2) + 4 * h; }

constexpr size_t al256(size_t x) { return (x + 255) & ~(size_t)255; }
constexpr size_t WS_CTL = 0, CTL_BYTES = 65536;
constexpr int CW_Q = 0;
constexpr int CW_BAR = 4096;
constexpr size_t WS_MODV = WS_CTL + CTL_BYTES;
constexpr size_t WS_WIN_T = al256(WS_MODV + (size_t)2 * NV * 6 * D_MODEL * 4);
constexpr size_t WS_WOUT_T = al256(WS_WIN_T + (size_t)2 * PROJ_W * D_MODEL * 2);
constexpr size_t WS_MLA_T = al256(WS_WOUT_T + (size_t)2 * D_MODEL * MIXW * 2);
constexpr size_t WS_WGU_T = al256(WS_MLA_T + (size_t)2 * 1024 * 384 * 2);
constexpr size_t WS_WD_T = al256(WS_WGU_T + (size_t)2 * D_FF * D_MODEL * 2);
constexpr size_t WS_CX = al256(WS_WD_T + (size_t)D_MODEL * D_FF * 2);
constexpr size_t WS_GATES = al256(WS_CX + (size_t)BATCH * CTX * D_MODEL * 4);
constexpr size_t WS_NL = al256(WS_GATES + (size_t)M_ALL * 16 * 4);
constexpr size_t WS_FS = al256(WS_NL + (size_t)NITEM * 96 * 4);
constexpr size_t WS_PML = al256(WS_FS + (size_t)NITEM * 4);
constexpr size_t WS_MST = al256(WS_PML + (size_t)NITEM * 4);
constexpr size_t WS_TOPI = al256(WS_MST + (size_t)NITEM * 4);
constexpr size_t WS_TOPW = al256(WS_TOPI + (size_t)NTOK * 2 * 4);
constexpr size_t WS_CNTG = al256(WS_TOPW + (size_t)NTOK * 2 * 4);
constexpr size_t WS_STOK = al256(WS_CNTG + (size_t)1024 * 8 * 4);
constexpr size_t WS_SW = al256(WS_STOK + (size_t)NSLOTP * 4);
constexpr size_t WS_PROJ = al256(WS_SW + (size_t)NSLOTP * 4);
constexpr size_t WS_MQK = al256(WS_PROJ + (size_t)M_ALL * PROJ_W * 2);
constexpr size_t WS_MLAQ = al256(WS_MQK + (size_t)M_ALL * 768 * 2);
constexpr size_t WS_UC = al256(WS_MLAQ + (size_t)M_ALL * 1024 * 2);
constexpr size_t WS_H = al256(WS_UC + (size_t)NITEM * 9216 * 2);
constexpr size_t WS_END0 = al256(WS_H + (size_t)M_ALL * 1024 * 2);
constexpr size_t WS_ACT = WS_PROJ;
constexpr size_t WS_MOEW = WS_PROJ;
constexpr size_t MOEW_E = (size_t)3 * D_FF * D_MODEL * 2;
constexpr size_t WS_AG = al256(WS_MOEW + NEXP * MOEW_E);
constexpr size_t WS_ACT2 = al256(WS_AG + (size_t)NSLOTP * D_MODEL * 2);
#ifdef CFG_TINY
constexpr size_t WS_TOTAL = WS_END0;
#else
constexpr size_t WS_TOTAL = (size_t)512 << 20;
#endif
static_assert(WS_END0 <= WS_TOTAL, "ws map");
static_assert(WS_ACT + (size_t)M_ALL * D_FF * 2 <= WS_MLAQ, "dense ACT overlays PROJ+MQK only");
static_assert(WS_MOEW + NEXP * MOEW_E <= WS_MQK, "MoE weights overlay PROJ only");
static_assert(WS_ACT2 + (size_t)MOE_PCH * 256 * D_FF * 2 <= WS_TOTAL, "MoE ACT chunk");

constexpr int LDS_STAGE = 131072;
constexpr int LDS_MISC = LDS_STAGE;
constexpr int LDS_BYTES = LDS_STAGE + 256;

struct P {
    const float *x, *c, *ctx, *c_ctx, *mod_w, *mod_b, *norm_mix, *norm_ffn, *w_in, *m_conv, *m_gate_b, *m_norm, *a_qnorm, *a_knorm, *l_cq_norm, *l_ckv_norm,
        *l_wuq, *l_wukv, *l_qnorm, *l_knorm, *w_out, *ffn_wg, *ffn_wu, *ffn_wd, *moe_router, *moe_wg, *moe_wu, *moe_wd;
    float* out; unsigned char* ws; int ph_lo, ph_hi;
};
DEV float* resid_row(const P& p, int R) {
    const int b = R / TP, q = R % TP;
    return q < CTX ? (float*)(p.ws + WS_CX) + (size_t)(b * CTX + q) * D_MODEL : p.out + (size_t)(b * SEQ + q - CTX) * D_MODEL;
}
DEV const float* modv(const P& p, int l, int R) { const int b = R / TP, q = R % TP; return (const float*)(p.ws + WS_MODV) + (size_t)(l * NV + (q < CTX ? BATCH : b)) * 6 * D_MODEL; }

namespace pg8 {
constexpr int BM = 256, BK = 64, HALF = 128, HTB = HALF * BK * 2, STAGE_BYTES = 8 * HTB, NXCD = 8, WGM = 8;
struct Unit { int pm, pn, e; };
struct Gemm { const bf16* A; const bf16* Bt; int lda, K; size_t bstride; };
DEV int lds_byte(int r, int c) { const int st = (r >> 4) * 2 + (c >> 5), rr = r & 15, cc = c & 31, ob = rr * 64 + cc * 2; return st * 1024 + (ob ^ (((ob >> 9) & 1) << 5)); }
DEV void stage_rc(int b, int& R, int& C) { const int st = b / 1024, sb = b % 1024, swz = sb ^ (((sb >> 9) & 1) << 5); R = (st >> 1) * 16 + swz / 64; C = (st & 1) * 32 + (swz % 64) / 2; }
DEV int perm32(int rho) { const int n = rho >> 4, i = rho & 15; return 8 * (i >> 2) + 4 * n + (i & 3); }
struct Order {
    int nM, nN, nwg, G, c;
    DEV void init(int nM_, int nN_, int G_, int c_) { nM = nM_; nN = nN_; nwg = nM * nN; G = G_; c = c_; }
    DEV bool nextL(int i, int& lm, int& ln) const {
        const long L = (long)i * G + c; if (L >= nwg) return false;
        int wgid = (int)L; { const int q = nwg / NXCD, r = nwg % NXCD, xcd = wgid % NXCD, off = wgid / NXCD; wgid = (xcd < r ? xcd * (q + 1) : r * (q + 1) + (xcd - r) * q) + off; }
        const int nig = WGM * nN, gid = wgid / nig, fm = gid * WGM, gsz = (nM - fm) < WGM ? (nM - fm) : WGM;
        lm = fm + ((wgid % nig) % gsz); ln = (wgid % nig) / gsz; return true;
    }
};
#ifndef EMU
#define PG8_LAS __attribute__((address_space(3)))
DEV unsigned cvt_pk_bf16(float lo, float hi) { unsigned r; asm volatile("v_cvt_pk_bf16_f32 %0, %1, %2" : "=v"(r) : "v"(lo), "v"(hi)); return r; }
template <class Epi, class Sched>
DEV void gemm_phase(unsigned char* lds_, const int tid, const Gemm g, const Sched& S, const Epi& E) {
    PG8_LAS unsigned char* lds = (PG8_LAS unsigned char*)lds_;
    const int wid = __builtin_amdgcn_readfirstlane(tid >> 6), lane = tid & 63, wr = wid >> 2, wc = wid & 3, fr = lane & 15, fq = lane >> 4;
    const int K = g.K, nt = K / BK, lda = g.lda;
    unsigned voffA[2], voffB[2];
#pragma unroll
    for (int i = 0; i < 2; ++i) { int R, C; stage_rc(tid * 16 + i * 8192, R, C); const int Rb = Epi::PERM ? ((R & ~31) + perm32(R & 31)) : R;
        voffA[i] = (unsigned)(R * lda + C) * 2u; voffB[i] = (unsigned)(Rb * K + C) * 2u; }
    const size_t kstep = (size_t)(BK * 2);
    const size_t hstepA = (size_t)HALF * lda * 2, hstepB = (size_t)HALF * K * 2;
    const size_t tstepA = 2 * hstepA, tstepB = 2 * hstepB;
    const unsigned ldsw = (unsigned)wid * 1024u;
    const int aoff = lds_byte(wr * 64 + fr, fq * 8), boff = lds_byte(wc * 32 + fr, fq * 8);
#define PG8_SA(b, h) (((b) * 2 + (h)) * HTB)
#define PG8_SB(b, h) ((4 + (b) * 2 + (h)) * HTB)
#define PG8_STAGE(bufoff, gbase, voff) do { _Pragma("unroll") for (int _i = 0; _i < 2; ++_i) \
        __builtin_amdgcn_global_load_lds((const unsigned*)((const char*)(gbase) + (voff)[_i]), (PG8_LAS unsigned*)(lds + (bufoff) + ldsw + _i * 8192), 16, 0, 0); } while (0)
#define PG8_LDA(dst, b, h) do { _Pragma("unroll") for (int m = 0; m < 4; ++m) _Pragma("unroll") for (int k = 0; k < 2; ++k) dst[m][k] = *(const PG8_LAS bf16x8*)(lds + PG8_SA(b, h) + aoff + m * 2048 + k * 1024); } while (0)
#define PG8_LDB(dst, b, h) do { _Pragma("unroll") for (int n = 0; n < 2; ++n) _Pragma("unroll") for (int k = 0; k < 2; ++k) dst[n][k] = *(const PG8_LAS bf16x8*)(lds + PG8_SB(b, h) + boff + n * 2048 + k * 1024); } while (0)
#define PG8_MMA(ai, bj, At, Bt) do { __builtin_amdgcn_s_setprio(1); _Pragma("unroll") for (int m = 0; m < 4; ++m) _Pragma("unroll") for (int n = 0; n < 2; ++n) _Pragma("unroll") for (int k = 0; k < 2; ++k) \
        acc[ai][bj][m][n] = __builtin_amdgcn_mfma_f32_16x16x32_bf16(Bt[n][k], At[m][k], acc[ai][bj][m][n], 0, 0, 0); __builtin_amdgcn_s_setprio(0); } while (0)
#define PG8_WAIT_V(n) asm volatile("s_waitcnt vmcnt(" #n ")" ::: "memory")
#define PG8_WAIT_L(n) asm volatile("s_waitcnt lgkmcnt(" #n ")" ::: "memory")
#define PG8_BAR __builtin_amdgcn_s_barrier()
#define PG8_SCHED __builtin_amdgcn_sched_barrier(0)
    Unit cur, nxt; int ui = 0;
    if (!S.next(0, cur)) return;
    f32x4 acc[2][2][4][2];
#pragma unroll
    for (int a = 0; a < 2; ++a)
#pragma unroll
        for (int b = 0; b < 2; ++b)
#pragma unroll
            for (int m = 0; m < 4; ++m)
#pragma unroll
                for (int n = 0; n < 2; ++n) acc[a][b][m][n] = (f32x4){0.f, 0.f, 0.f, 0.f};
    bf16x8 At[4][2], B0[2][2], B1[2][2];
    const char* cA = (const char*)g.A + (size_t)cur.pm * tstepA; const char* cB = (const char*)g.Bt + (size_t)cur.e * g.bstride + (size_t)cur.pn * tstepB;
    PG8_STAGE(PG8_SB(0, 0), cB, voffB); PG8_STAGE(PG8_SB(0, 1), cB + hstepB, voffB); PG8_STAGE(PG8_SA(0, 0), cA, voffA); PG8_STAGE(PG8_SA(0, 1), cA + hstepA, voffA);
    if (wr == 1) PG8_BAR;
    PG8_WAIT_V(2); PG8_BAR;
    PG8_STAGE(PG8_SB(1, 0), cB + kstep, voffB); PG8_STAGE(PG8_SA(1, 0), cA + kstep, voffA); PG8_STAGE(PG8_SB(1, 1), cB + hstepB + kstep, voffB);
    PG8_WAIT_V(6); PG8_BAR;
    for (;;) {
        const bool has_next = S.next(ui + 1, nxt);
        const char* nA = has_next ? (const char*)g.A + (size_t)nxt.pm * tstepA : cA; const char* nB = has_next ? (const char*)g.Bt + (size_t)nxt.e * g.bstride + (size_t)nxt.pn * tstepB : cB;
#pragma unroll 1
        for (int t = 0; t < nt; t += 2) {
            const bool last = (t == nt - 2);
            const char* a1 = cA + (size_t)(t + 1) * kstep;
            const char* a2 = last ? nA : cA + (size_t)(t + 2) * kstep; const char* b2 = last ? nB : cB + (size_t)(t + 2) * kstep;
            const char* a3 = a2 + kstep; const char* b3 = b2 + kstep;
            PG8_LDB(B0, 0, 0); PG8_LDB(B1, 0, 1); PG8_SCHED; PG8_LDA(At, 0, 0); PG8_STAGE(PG8_SA(1, 1), a1 + hstepA, voffA);
            PG8_WAIT_V(8); PG8_WAIT_L(0); PG8_BAR; PG8_MMA(0, 0, At, B0); PG8_MMA(0, 1, At, B1); PG8_BAR; PG8_SCHED;
            PG8_LDA(At, 0, 1); PG8_STAGE(PG8_SB(0, 0), b2, voffB); PG8_STAGE(PG8_SB(0, 1), b2 + hstepB, voffB); PG8_STAGE(PG8_SA(0, 0), a2, voffA);
            PG8_WAIT_V(8); PG8_WAIT_L(0); PG8_BAR; PG8_MMA(1, 0, At, B0); PG8_MMA(1, 1, At, B1); PG8_BAR; PG8_SCHED;
            PG8_LDB(B0, 1, 0); PG8_LDB(B1, 1, 1); PG8_SCHED; PG8_LDA(At, 1, 0); PG8_STAGE(PG8_SA(0, 1), a2 + hstepA, voffA);
            PG8_WAIT_V(8); PG8_WAIT_L(0); PG8_BAR; PG8_MMA(0, 0, At, B0); PG8_MMA(0, 1, At, B1); PG8_BAR; PG8_SCHED;
            PG8_LDA(At, 1, 1); PG8_STAGE(PG8_SB(1, 0), b3, voffB); PG8_STAGE(PG8_SB(1, 1), b3 + hstepB, voffB); PG8_STAGE(PG8_SA(1, 0), a3, voffA);
            PG8_WAIT_V(8); PG8_WAIT_L(0); PG8_BAR; PG8_MMA(1, 0, At, B0); PG8_MMA(1, 1, At, B1); PG8_BAR; PG8_SCHED;
        }
        if (wr == 0) PG8_BAR;
        E(acc, cur, wr, wc, fr, fq);
        if (!has_next) break;
#pragma unroll
        for (int a = 0; a < 2; ++a)
#pragma unroll
            for (int b = 0; b < 2; ++b)
#pragma unroll
                for (int m = 0; m < 4; ++m)
#pragma unroll
                    for (int n = 0; n < 2; ++n) acc[a][b][m][n] = (f32x4){0.f, 0.f, 0.f, 0.f};
        cur = nxt; cA = nA; cB = nB; ++ui;
        if (wr == 1) PG8_BAR;
    }
    PG8_WAIT_V(0);
    PG8_BAR;
#undef PG8_SA
#undef PG8_SB
#undef PG8_STAGE
#undef PG8_LDA
#undef PG8_LDB
#undef PG8_MMA
#undef PG8_WAIT_V
#undef PG8_WAIT_L
#undef PG8_BAR
#undef PG8_SCHED
}
#else
DEV unsigned cvt_pk_bf16(float lo, float hi) { return pk2(lo, hi); }
template <class Epi, class Sched>
DEV void gemm_phase(unsigned char*, const int tid, const Gemm g, const Sched& S, const Epi& E) {
    const int wid = tid >> 6, lane = tid & 63, wr = wid >> 2, wc = wid & 3, fr = lane & 15, fq = lane >> 4;
    Unit u;
    for (int ui = 0; S.next(ui, u); ++ui) {
        f32x4 acc[2][2][4][2];
        const bf16* Bt = (const bf16*)((const char*)g.Bt + (size_t)u.e * g.bstride);
        for (int ai = 0; ai < 2; ++ai) for (int bj = 0; bj < 2; ++bj) for (int m = 0; m < 4; ++m) for (int n = 0; n < 2; ++n) for (int j = 0; j < 4; ++j) {
            const size_t row = (size_t)u.pm * 256 + 128 * ai + 64 * wr + 16 * m + fr;
            const size_t col = (size_t)u.pn * 256 + 128 * bj + 32 * wc + (Epi::PERM ? 8 * fq + 4 * n + j : 16 * n + 4 * fq + j);
            const bf16* a = g.A + row * g.lda; const bf16* b = Bt + col * g.K; float s = 0.f;
            for (int k = 0; k < g.K; ++k) s += bf2f(a[k]) * bf2f(b[k]);
            acc[ai][bj][m][n][j] = s; }
        E(acc, u, wr, wc, fr, fq);
    }
}
#endif
}

using pg8::Unit;
struct EpiStore {
    static constexpr bool PERM = true;
    bf16* O; int ldc; float* gates;
    DEV void operator()(const f32x4 (&acc)[2][2][4][2], const Unit& u, int wr, int wc, int fr, int fq) const {
        const int row0 = u.pm * 256 + wr * 64 + fr, col0 = u.pn * 256 + wc * 32 + 8 * fq;
        const bool dog = gates != nullptr && u.pn == C_G / 256 && wc == 0 && fq < 2;
#pragma unroll
        for (int ai = 0; ai < 2; ++ai)
#pragma unroll
            for (int m = 0; m < 4; ++m) { const int row = row0 + ai * 128 + m * 16; bf16* rowp = O + (size_t)row * ldc + col0;
#pragma unroll
                for (int bj = 0; bj < 2; ++bj) { const f32x4 v0 = acc[ai][bj][m][0], v1 = acc[ai][bj][m][1];
                    u32x4 w; w.x = pg8::cvt_pk_bf16(v0[0], v0[1]); w.y = pg8::cvt_pk_bf16(v0[2], v0[3]); w.z = pg8::cvt_pk_bf16(v1[0], v1[1]); w.w = pg8::cvt_pk_bf16(v1[2], v1[3]);
                    *(u32x4*)(rowp + bj * 128) = w;
                    if (bj == 0 && dog) { float* gp = gates + (size_t)row * 16 + 8 * fq; *(f32x4*)gp = v0; *(f32x4*)(gp + 4) = v1; } } }
    }
};
struct EpiResid {
    static constexpr bool PERM = false;
    P p; int l, goff;
    DEV void operator()(const f32x4 (&acc)[2][2][4][2], const Unit& u, int wr, int wc, int fr, int fq) const {
        const int R0 = u.pm * 256; float* xb = resid_row(p, R0); const float* gv = modv(p, l, R0) + goff;
        const int col0 = u.pn * 256 + wc * 32 + 4 * fq;
#pragma unroll
        for (int bj = 0; bj < 2; ++bj)
#pragma unroll
            for (int n = 0; n < 2; ++n) { const int col = col0 + bj * 128 + n * 16; const f32x4 g = *(const f32x4*)(gv + col);
#pragma unroll
                for (int ai = 0; ai < 2; ++ai)
#pragma unroll
                    for (int m = 0; m < 4; ++m) { f32x4* xp = (f32x4*)(xb + (size_t)(wr * 64 + fr + ai * 128 + m * 16) * D_MODEL + col); *xp = *xp + g * acc[ai][bj][m][n]; } }
    }
};
struct EpiSwiglu {
    static constexpr bool PERM = true;
    bf16* O; int pm_base;
    DEV void operator()(const f32x4 (&acc)[2][2][4][2], const Unit& u, int wr, int wc, int fr, int fq) const {
        const int row0 = (u.pm - pm_base) * 256 + wr * 64 + fr, col0 = u.pn * 128 + wc * 32 + 8 * fq;
#pragma unroll
        for (int ai = 0; ai < 2; ++ai)
#pragma unroll
            for (int m = 0; m < 4; ++m) { float r[8];
#pragma unroll
                for (int n = 0; n < 2; ++n)
#pragma unroll
                    for (int j = 0; j < 4; ++j) r[4 * n + j] = silu_fast(acc[ai][0][m][n][j]) * acc[ai][1][m][n][j];
                u32x4 w; w.x = pg8::cvt_pk_bf16(r[0], r[1]); w.y = pg8::cvt_pk_bf16(r[2], r[3]); w.z = pg8::cvt_pk_bf16(r[4], r[5]); w.w = pg8::cvt_pk_bf16(r[6], r[7]);
                *(u32x4*)(O + (size_t)(row0 + ai * 128 + m * 16) * D_FF + col0) = w; }
    }
};
struct EpiMoeDown {
    static constexpr bool PERM = false;
    P p; int pm_base;
    DEV void operator()(const f32x4 (&acc)[2][2][4][2], const Unit& u, int wr, int wc, int fr, int fq) const {
        const int* stok = (const int*)(p.ws + WS_STOK); const float* sw = (const float*)(p.ws + WS_SW);
        const int col0 = u.pn * 256 + wc * 32 + 4 * fq;
#pragma unroll
        for (int ai = 0; ai < 2; ++ai)
#pragma unroll
            for (int m = 0; m < 4; ++m) { const int slot = (pm_base + u.pm) * 256 + wr * 64 + fr + ai * 128 + m * 16; const int tok = stok[slot];
                if (tok >= 0) { const float w = sw[slot]; const int b = tok / SEQ; float* xr = p.out + (size_t)tok * D_MODEL;
                    const float* gv = (const float*)(p.ws + WS_MODV) + (size_t)(1 * NV + b) * 6 * D_MODEL + 5 * D_MODEL;
#pragma unroll
                    for (int bj = 0; bj < 2; ++bj)
#pragma unroll
                        for (int n = 0; n < 2; ++n) { const int col = col0 + bj * 128 + n * 16;
#pragma unroll
                            for (int j = 0; j < 4; ++j) atomic_addf(xr + col + j, gv[col + j] * w * acc[ai][bj][m][n][j]); } } }
    }
};
struct Sched {
    pg8::Order o; int mode, pm_base; const int* seg;
    DEV bool next(int i, Unit& u) const {
        int lm, ln; if (!o.nextL(i, lm, ln)) return false;
        u.pn = ln; u.e = 0;
        if (mode == 0) u.pm = lm;
        else if (mode == 1) u.pm = (lm / NQL) * PAN_B + 1 + lm % NQL;
        else { const int gp = pm_base + lm; int e = 0;
#pragma unroll
            for (int k = 1; k < NEXP; ++k) e += (seg[k] <= gp) ? 1 : 0;
            u.e = e; u.pm = (mode == 2) ? gp : lm; }
        return true;
    }
};

#ifndef EMU
#define XB_TMO      128
#define XB_XCNT(j)  (256  + 64 * (j))
#define XB_XSUB(j)  (1280 + 64 * (j))
#define XB_XGEN(j)  (2304 + 64 * (j))
#define XB_TOP      3328
#define XB_TOPGEN   3392
#define XCD_BAR_WORDS 3456
#define XB_SPIN_CAP (1u << 22)
#define LAS __attribute__((address_space(3)))
__device__ __forceinline__ unsigned xb_ld(unsigned* p)              { return __hip_atomic_load(p, __ATOMIC_RELAXED, __HIP_MEMORY_SCOPE_AGENT); }
__device__ __forceinline__ unsigned xb_add(unsigned* p, unsigned v) { return __hip_atomic_fetch_add(p, v, __ATOMIC_RELAXED, __HIP_MEMORY_SCOPE_AGENT); }
__device__ __forceinline__ unsigned xb_xcc_id() { return (unsigned)__builtin_amdgcn_s_getreg((3 << 11) | 20) & 0xFu; }
#define XB_SPIN(cond, bar) do { unsigned _sp = 0; while (cond) { __builtin_amdgcn_s_sleep(1); \
    if ((++_sp & 255u) == 0u) { if (xb_ld(&(bar)[XB_TMO])) break; if (_sp > XB_SPIN_CAP) { atomicAdd(&(bar)[XB_TMO], 1u); break; } } } } while (0)
struct XcdBarrier { unsigned* bar; unsigned x; volatile LAS unsigned* st; };
__device__ __forceinline__ XcdBarrier xcd_barrier_post(unsigned* bar, volatile LAS unsigned* st) {
    XcdBarrier b; b.bar = bar; b.x = xb_xcc_id(); b.st = st;
    if (threadIdx.x == 0) (void)xb_add(&bar[XB_XCNT(b.x)], 1u);
    return b;
}
__device__ __forceinline__ void xcd_barrier_complete(unsigned* bar, unsigned x, unsigned& nloc, unsigned& nx) {
    const unsigned G = gridDim.x * gridDim.y * gridDim.z;
    unsigned sum, cnt, mine, sp = 0u;
    for (;;) {
        sum = 0u; cnt = 0u; mine = 0u;
#pragma unroll
        for (unsigned j = 0; j < 16; ++j) { const unsigned c = xb_ld(&bar[XB_XCNT(j)]); sum += c; cnt += (c > 0u) ? 1u : 0u; mine = (j == x) ? c : mine; }
        if (sum == G) break;
        __builtin_amdgcn_s_sleep(1);
        if ((++sp & 255u) == 0u) { if (xb_ld(&bar[XB_TMO])) break; if (sp > XB_SPIN_CAP) { atomicAdd(&bar[XB_TMO], 1u); break; } }
    }
    nloc = mine > 0u ? mine : 1u; nx = cnt > 0u ? cnt : 1u;
}
__device__ __forceinline__ void xcd_barrier(const XcdBarrier& b) {
    asm volatile("s_waitcnt vmcnt(0)" ::: "memory");
    __syncthreads();
    if (threadIdx.x == 0) {
        unsigned* bar = b.bar;
        __builtin_amdgcn_s_waitcnt(0);
        unsigned nloc = b.st[0], nx = b.st[1];
        if (nloc == 0u) { xcd_barrier_complete(bar, b.x, nloc, nx); b.st[0] = nloc; b.st[1] = nx; }
        const unsigned old = xb_add(&bar[XB_XSUB(b.x)], 1u);
        const unsigned gen = old / nloc;
        if (old + 1u == (gen + 1u) * nloc) {
            __builtin_amdgcn_fence(__ATOMIC_RELEASE, "agent");
            asm volatile("s_waitcnt vmcnt(0)" ::: "memory");
            const unsigned og = xb_add(&bar[XB_TOP], 1u);
            const unsigned tg = og / nx;
            if (og + 1u == (tg + 1u) * nx) xb_add(&bar[XB_TOPGEN], 1u);
            else XB_SPIN(xb_ld(&bar[XB_TOPGEN]) == tg, bar);
            __builtin_amdgcn_fence(__ATOMIC_ACQUIRE, "agent");
            xb_add(&bar[XB_XGEN(b.x)], 1u);
            asm volatile("s_waitcnt vmcnt(0)" ::: "memory");
        } else {
            XB_SPIN(xb_ld(&bar[XB_XGEN(b.x)]) == gen, bar);
            __builtin_amdgcn_fence(__ATOMIC_ACQUIRE, "agent");
            asm volatile("s_waitcnt vmcnt(0)" ::: "memory");
        }
    }
    __syncthreads();
}
#endif

struct Wg { int tid, lane, wave, G, wg, gw, NGW; unsigned char* lds; unsigned* misc; };
DEV int q_next(Wg& w, unsigned* ctr) {
    if (w.tid == 0) w.misc[2] = atomicAdd(ctr, 1u);
    __syncthreads();
    const int v = (int)w.misc[2];
    __syncthreads();
    return v;
}

DEV void conv_tile(const float* src, int N, int k0, int n0, bf16* dst, int ldk, int kdst0, int rowofs, int mode, float* scr, int tid) {
#pragma unroll
    for (int i = 0; i < 8; ++i) { const int kk = i * 8 + (tid >> 6), nn = tid & 63; scr[kk * 65 + nn] = (n0 + nn < N) ? src[(size_t)(k0 + kk) * N + n0 + nn] : 0.f; }
    __syncthreads();
    { const int n = tid >> 3, c = tid & 7, ng = n0 + n; const float* s = scr + (8 * c) * 65 + n;
      const int row = rowofs + (mode == 0 ? ng : (ng / 128) * 256 + (ng % 128) + (mode == 2 ? 128 : 0));
      u32x4 o; o.x = pk2(s[0], s[65]); o.y = pk2(s[2 * 65], s[3 * 65]); o.z = pk2(s[4 * 65], s[5 * 65]); o.w = pk2(s[6 * 65], s[7 * 65]);
      *(u32x4*)(dst + (size_t)row * ldk + kdst0 + k0 + 8 * c) = o; }
    __syncthreads();
}
struct ConvJob { const float* src; int K, N, Npad; bf16* dst; int ldk, kdst0, rowofs, mode; };
DEV bool conv_job_run(const ConvJob& j, int& it, float* scr, int tid) {
    const int nkb = j.K / 64, nnb = j.Npad / 64, tot = nkb * nnb;
    if (it >= tot) { it -= tot; return false; }
    conv_tile(j.src, j.N, (it / nnb) * 64, (it % nnb) * 64, j.dst, j.ldk, j.kdst0, j.rowofs, j.mode, scr, tid);
    return true;
}
DEV void zero_rect(bf16* dst, int ld, int r0, int r1, int c0, int c1, int gtid, int gn) {
    const int cw = (c1 - c0) / 8; const long tot = (long)(r1 - r0) * cw;
    for (long i = gtid; i < tot; i += gn) { const int r = r0 + (int)(i / cw), c = c0 + 8 * (int)(i % cw); *(u32x4*)(dst + (size_t)r * ld + c) = (u32x4){0u, 0u, 0u, 0u}; }
}
DEV void phase0(const P& p, Wg& w) {
    float* scr = (float*)w.lds;
    {
        bf16* WIN = (bf16*)(p.ws + WS_WIN_T); bf16* WOUT = (bf16*)(p.ws + WS_WOUT_T); bf16* MLT = (bf16*)(p.ws + WS_MLA_T);
#define JOB_WIN(l) ConvJob{p.w_in + (size_t)(l) * D_MODEL * IN_W, D_MODEL, IN_W, PROJ_W, WIN + (size_t)(l) * PROJ_W * D_MODEL, D_MODEL, 0, 0, 0}
#define JOB_WOUT(l) ConvJob{p.w_out + (size_t)(l) * MIXW * D_MODEL, MIXW, D_MODEL, D_MODEL, WOUT + (size_t)(l) * D_MODEL * MIXW, MIXW, 0, 0, 0}
#define JOB_WUQ(l) ConvJob{p.l_wuq + (size_t)(l) * 256 * 384, 256, 384, 384, MLT + (size_t)(l) * 1024 * 384, 384, 0, 0, 0}
#define JOB_WUKV(l) ConvJob{p.l_wukv + (size_t)(l) * 128 * 512, 128, 512, 512, MLT + (size_t)(l) * 1024 * 384, 384, 256, 384, 0}
        constexpr int total = 2 * ((D_MODEL / 64) * (PROJ_W / 64) + (MIXW / 64) * (D_MODEL / 64) + 4 * 6 + 2 * 8) + 2 * (D_MODEL / 64) * (D_FF / 64) + (D_FF / 64) * (D_MODEL / 64);
        for (int it0 = w.wg; it0 < total; it0 += w.G) { int it = it0;
            if (conv_job_run(JOB_WIN(0), it, scr, w.tid)) continue;
            if (conv_job_run(JOB_WIN(1), it, scr, w.tid)) continue;
            if (conv_job_run(JOB_WOUT(0), it, scr, w.tid)) continue;
            if (conv_job_run(JOB_WOUT(1), it, scr, w.tid)) continue;
            if (conv_job_run(JOB_WUQ(0), it, scr, w.tid)) continue;
            if (conv_job_run(JOB_WUQ(1), it, scr, w.tid)) continue;
            if (conv_job_run(JOB_WUKV(0), it, scr, w.tid)) continue;
            if (conv_job_run(JOB_WUKV(1), it, scr, w.tid)) continue;
            if (conv_job_run(ConvJob{p.ffn_wg, D_MODEL, D_FF, D_FF, (bf16*)(p.ws + WS_WGU_T), D_MODEL, 0, 0, 1}, it, scr, w.tid)) continue;
            if (conv_job_run(ConvJob{p.ffn_wu, D_MODEL, D_FF, D_FF, (bf16*)(p.ws + WS_WGU_T), D_MODEL, 0, 0, 2}, it, scr, w.tid)) continue;
            conv_job_run(ConvJob{p.ffn_wd, D_FF, D_MODEL, D_MODEL, (bf16*)(p.ws + WS_WD_T), D_FF, 0, 0, 0}, it, scr, w.tid);
        }
    }
    for (int l = 0; l < 2; ++l) { bf16* mt = (bf16*)(p.ws + WS_MLA_T) + (size_t)l * 1024 * 384; const int gt = w.wg * NTHR + w.tid, gn = w.G * NTHR;
        zero_rect(mt, 384, 0, 384, 256, 384, gt, gn); zero_rect(mt, 384, 384, 896, 0, 256, gt, gn); zero_rect(mt, 384, 896, 1024, 0, 384, gt, gn); }
    {
        float* sS = (float*)w.lds;
        float* part = sS + NV * D_MODEL;
        const int nitem = 2 * (6 * D_MODEL / 64);
        bool loaded = false;
        for (int it = w.wg; it < nitem; it += w.G) {
            if (!loaded) { for (int i = w.tid; i < NV * D_MODEL; i += NTHR) { const int v = i / D_MODEL, k = i % D_MODEL; sS[i] = silu_f(v < BATCH ? p.c[v * D_MODEL + k] : p.c_ctx[k]); } loaded = true; __syncthreads(); }
            const int l = it / (6 * D_MODEL / 64), cb = it % (6 * D_MODEL / 64), col = cb * 64 + w.lane;
            float acc[NV];
#pragma unroll
            for (int v = 0; v < NV; ++v) acc[v] = 0.f;
            const float* mw = p.mod_w + (size_t)l * D_MODEL * 6 * D_MODEL + col;
            for (int k = w.wave * (D_MODEL / 8); k < (w.wave + 1) * (D_MODEL / 8); ++k) { const float wv = mw[(size_t)k * 6 * D_MODEL];
#pragma unroll
                for (int v = 0; v < NV; ++v) acc[v] += sS[v * D_MODEL + k] * wv; }
#pragma unroll
            for (int v = 0; v < NV; ++v) part[(w.wave * NV + v) * 64 + w.lane] = acc[v];
            __syncthreads();
            for (int i = w.tid; i < NV * 64; i += NTHR) { const int v = i / 64, cc = i % 64; float s = p.mod_b[(size_t)l * 6 * D_MODEL + cb * 64 + cc];
#pragma unroll
                for (int ww = 0; ww < 8; ++ww) s += part[(ww * NV + v) * 64 + cc];
                ((float*)(p.ws + WS_MODV))[(size_t)(l * NV + v) * 6 * D_MODEL + cb * 64 + cc] = s; }
            __syncthreads();
        }
    }
}
DEV void phase_moe_weights(const P& p, Wg& w) {
    float* scr = (float*)w.lds;
    const int t_gu = (D_MODEL / 64) * (D_FF / 64), t_d = (D_FF / 64) * (D_MODEL / 64), per_e = 2 * t_gu + t_d;
    for (int it0 = w.wg; it0 < NEXP * per_e; it0 += w.G) {
        const int e = it0 / per_e; int it = it0 % per_e;
        bf16* base = (bf16*)(p.ws + WS_MOEW + (size_t)e * MOEW_E);
        const ConvJob jg{p.moe_wg + (size_t)e * D_MODEL * D_FF, D_MODEL, D_FF, D_FF, base, D_MODEL, 0, 0, 1};
        const ConvJob ju{p.moe_wu + (size_t)e * D_MODEL * D_FF, D_MODEL, D_FF, D_FF, base, D_MODEL, 0, 0, 2};
        const ConvJob jd{p.moe_wd + (size_t)e * D_FF * D_MODEL, D_FF, D_MODEL, D_MODEL, base + (size_t)2 * D_FF * D_MODEL, D_FF, 0, 0, 0};
        if (conv_job_run(jg, it, scr, w.tid)) continue;
        if (conv_job_run(ju, it, scr, w.tid)) continue;
        conv_job_run(jd, it, scr, w.tid);
    }
}

DEV void phase_modulate(const P& p, Wg& w, int l, int which, bool first, bool skip_ctx, bool moe) {
    constexpr int NJ = D_MODEL / 256;
    bf16* H = (bf16*)(p.ws + WS_H);
    const float* gn = (which ? p.norm_ffn : p.norm_mix) + (size_t)l * D_MODEL;
    int cnt[NEXP];
#pragma unroll
    for (int e = 0; e < NEXP; ++e) cnt[e] = 0;
    for (int R = w.gw; R < M_ALL; R += w.NGW) {
        const int b = R / TP, q = R % TP;
        if (skip_ctx && q < CTX) continue;
        float* xr = resid_row(p, R);
        const float* src = first ? (q < CTX ? p.ctx + (size_t)(b * CTX + q) * D_MODEL : p.x + (size_t)(b * SEQ + q - CTX) * D_MODEL) : xr;
        f32x4 v[NJ]; float ss = 0.f;
#pragma unroll
        for (int j = 0; j < NJ; ++j) { v[j] = *(const f32x4*)(src + 4 * w.lane + 256 * j); ss += v[j][0] * v[j][0] + v[j][1] * v[j][1] + v[j][2] * v[j][2] + v[j][3] * v[j][3]; }
        ss = wave_sum(ss);
        const float rstd = 1.0f / sqrtf(ss * (1.0f / D_MODEL) + EPS);
        const float* mv = modv(p, l, R); const float* sh = mv + (which ? 3 : 0) * D_MODEL; const float* sc = mv + (which ? 4 : 1) * D_MODEL;
        float lg[NEXP];
#pragma unroll
        for (int e = 0; e < NEXP; ++e) lg[e] = 0.f;
#pragma unroll
        for (int j = 0; j < NJ; ++j) { const int col = 4 * w.lane + 256 * j;
            if (first) *(f32x4*)(xr + col) = v[j];
            const f32x4 g = *(const f32x4*)(gn + col), s1 = *(const f32x4*)(sc + col), s0 = *(const f32x4*)(sh + col);
            f32x4 h;
#pragma unroll
            for (int k = 0; k < 4; ++k) h[k] = v[j][k] * rstd * g[k] * (1.0f + s1[k]) + s0[k];
            u32x2 o; o.x = pk2(h[0], h[1]); o.y = pk2(h[2], h[3]);
            *(u32x2*)(H + (size_t)R * D_MODEL + col) = o;
            if (moe) {
#pragma unroll
                for (int k = 0; k < 4; ++k) { const float* rr = p.moe_router + (size_t)(col + k) * NEXP;
#pragma unroll
                    for (int e = 0; e < NEXP; ++e) lg[e] += h[k] * rr[e]; } } }
        if (moe) {
#pragma unroll
            for (int e = 0; e < NEXP; ++e) lg[e] = wave_sum(lg[e]);
            int i1 = 0; float v1 = lg[0];
#pragma unroll
            for (int e = 1; e < NEXP; ++e) if (lg[e] > v1) { v1 = lg[e]; i1 = e; }
            int i2 = -1; float v2 = -3.0e38f;
#pragma unroll
            for (int e = 0; e < NEXP; ++e) if (e != i1 && lg[e] > v2) { v2 = lg[e]; i2 = e; }
            const float w1 = 1.0f / (1.0f + expf(v2 - v1)), w2 = 1.0f - w1;
            const int tok = b * SEQ + q - CTX;
            if (w.lane == 0) { int* ti = (int*)(p.ws + WS_TOPI) + 2 * tok; float* tw = (float*)(p.ws + WS_TOPW) + 2 * tok; ti[0] = i1; ti[1] = i2; tw[0] = w1; tw[1] = w2; }
#pragma unroll
            for (int e = 0; e < NEXP; ++e) cnt[e] += (e == i1 || e == i2) ? 1 : 0;
        }
    }
    if (moe) {
        int* lc = (int*)w.lds;
        if (w.lane == 0) {
#pragma unroll
            for (int e = 0; e < NEXP; ++e) lc[w.wave * NEXP + e] = cnt[e]; }
        __syncthreads();
        if (w.tid < NEXP) { int s = 0; for (int ww = 0; ww < NWAVE; ++ww) s += lc[ww * NEXP + w.tid]; ((int*)(p.ws + WS_CNTG))[w.wg * NEXP + w.tid] = s; }
        __syncthreads();
    }
}

DEV void phase_prep(const P& p, Wg& w, int l) {
    bf16* PROJ = (bf16*)(p.ws + WS_PROJ); bf16* MQK = (bf16*)(p.ws + WS_MQK);
    const float* cw = p.m_conv + (size_t)l * 3 * 768;
    const int lane = w.lane;
    for (int R = w.gw; R < M_ALL; R += w.NGW) {
        const int q = R % TP; const bool lat = q >= CTX; const int t = q - CTX;
        bf16* pr = PROJ + (size_t)R * PROJ_W;
        const bool hp = !(q == 0 || q == CTX), hn = !(q == CTX - 1 || q == TP - 1);
#pragma unroll
        for (int j = 0; j < 3; ++j) { const int col = 4 * lane + 256 * j;
            const u32x2 c0 = *(const u32x2*)(pr + col);
            u32x2 cp = (u32x2){0u, 0u}, cn = (u32x2){0u, 0u};
            if (hp) cp = *(const u32x2*)(pr - PROJ_W + col);
            if (hn) cn = *(const u32x2*)(pr + PROJ_W + col);
            const f32x4 w0 = *(const f32x4*)(cw + col), w1 = *(const f32x4*)(cw + 768 + col), w2 = *(const f32x4*)(cw + 1536 + col);
            float o[4];
#pragma unroll
            for (int k = 0; k < 4; ++k) { const unsigned sh = (k & 1) * 16; const unsigned a = (k < 2 ? cp.x : cp.y) >> sh, c = (k < 2 ? c0.x : c0.y) >> sh, n = (k < 2 ? cn.x : cn.y) >> sh;
                const float s = bf2f((bf16)a) * w0[k] + bf2f((bf16)c) * w1[k] + bf2f((bf16)n) * w2[k]; o[k] = silu_f(s) * (col >= 384 ? KSCALE_M : 1.0f); }
            u32x2 ov; ov.x = pk2(o[0], o[1]); ov.y = pk2(o[2], o[3]);
            *(u32x2*)(MQK + (size_t)R * 768 + col) = ov; }
        float csA = 1.f, snA = 0.f, csL = 1.f, snL = 0.f;
        if (lat) { const float rowp = (float)(t / GRID_W), colp = (float)(t % GRID_W);
            { const int f = lane & 15; const float inv = exp2f(-(float)f * (13.287712379549449f / 16.0f)); const float ang = (lane < 32 ? rowp : colp) * inv; sincosf(ang, &snA, &csA); }
            { const int d = lane & 31, f = d & 7; const float inv = exp2f(-(float)f * (13.287712379549449f / 8.0f)); const float ang = (d < 16 ? rowp : colp) * inv; sincosf(ang, &snL, &csL); } }
#pragma unroll
        for (int hq = 0; hq < 8; ++hq) { const int base = hq < 6 ? C_AQ + hq * 64 : C_AK + (hq - 6) * 64;
            const float g = (hq < 6 ? p.a_qnorm : p.a_knorm)[l * 64 + lane];
            const float v = bf2f(pr[base + lane]); const float ss = wave_sum(v * v);
            float y = v * (1.0f / sqrtf(ss * (1.0f / 64.0f) + EPS)) * g;
            const float pt = __shfl_xor(y, 16);
            if (lat) y = (lane & 16) ? y * csA + pt * snA : y * csA - pt * snA;
            if (hq < 6) y *= QSCALE_A;
            pr[base + lane] = f2bf(y); }
        { const u32x2 cv = *(const u32x2*)(pr + C_CQ + 4 * lane); float x[4] = {bf2f((bf16)cv.x), bf2f((bf16)(cv.x >> 16)), bf2f((bf16)cv.y), bf2f((bf16)(cv.y >> 16))};
          const float ss = wave_sum(x[0] * x[0] + x[1] * x[1] + x[2] * x[2] + x[3] * x[3]); const float rs = 1.0f / sqrtf(ss * (1.0f / 256.0f) + EPS);
          const f32x4 g = *(const f32x4*)(p.l_cq_norm + l * 256 + 4 * lane);
          u32x2 o; o.x = pk2(x[0] * rs * g[0], x[1] * rs * g[1]); o.y = pk2(x[2] * rs * g[2], x[3] * rs * g[3]); *(u32x2*)(pr + C_CQ + 4 * lane) = o; }
        { const unsigned cv = *(const unsigned*)(pr + C_CKV + 2 * lane); const float x0 = bf2f((bf16)cv), x1 = bf2f((bf16)(cv >> 16));
          const float ss = wave_sum(x0 * x0 + x1 * x1); const float rs = 1.0f / sqrtf(ss * (1.0f / 128.0f) + EPS);
          const float g0 = p.l_ckv_norm[l * 128 + 2 * lane], g1 = p.l_ckv_norm[l * 128 + 2 * lane + 1];
          *(unsigned*)(pr + C_CKV + 2 * lane) = pk2(x0 * rs * g0, x1 * rs * g1); }
        { const float v = lane < 32 ? bf2f(pr[C_KR + lane]) : 0.f; const float ss = wave_sum(v * v);
          float y = v * (1.0f / sqrtf(ss * (1.0f / 32.0f) + EPS)) * p.l_knorm[l * 96 + 64 + (lane & 31)];
          const float pt = __shfl_xor(y, 8);
          if (lat) y = (lane & 8) ? y * csL + pt * snL : y * csL - pt * snL;
          if (lane < 32) pr[C_KR + lane] = f2bf(y); }
    }
}

DEV float scan_add(float v, int lane) {
#pragma unroll
    for (int d = 1; d < 64; d <<= 1) { const float t = __shfl(v, lane >= d ? lane - d : lane); if (lane >= d) v += t; }
    return v;
}
DEV float scan_max(float v, int lane) {
#pragma unroll
    for (int d = 1; d < 64; d <<= 1) { const float t = __shfl(v, lane >= d ? lane - d : lane); if (lane >= d) v = fmaxf(v, t); }
    return v;
}
DEV int chain_step(int dir, int cl) { return dir == 0 ? cl : (cl < NC_CTX ? NC_CTX - 1 - cl : NCH + NC_CTX - 1 - cl); }
DEV void gate_scan(const P& p, int l, int R0, int hh, int dir, int lane, float& bc, float& a) {
    const int o = dir ? 63 - lane : lane;
    const float* G = (const float*)(p.ws + WS_GATES) + (size_t)(R0 + o) * 16; const float* gb = p.m_gate_b + l * 16;
    const float gi = G[dir * 8 + hh] + gb[dir * 8 + hh], gf = G[dir * 8 + 4 + hh] + gb[dir * 8 + 4 + hh];
    bc = scan_add(log_sigmoid_f(gf), lane); a = gi - bc;
}
DEV void ml1_item(const P& p, Wg& w, int l, int item) {
    const int b = item / (4 * NCH), hh = (item / NCH) % 4, cl = item % NCH, R0 = b * TP + cl * 64;
    float* wgt = (float*)w.lds;
    bf16* Kw = (bf16*)(w.lds + 512);
    bf16* Vt = Kw + 2 * 96 * 72;
    const bf16* MQK = (const bf16*)(p.ws + WS_MQK); const bf16* PROJ = (const bf16*)(p.ws + WS_PROJ);
    bf16* UC = (bf16*)(p.ws + WS_UC); float* NL = (float*)(p.ws + WS_NL);
    const int lane = w.lane, r = lane & 31, h = lane >> 5;
    if (w.wave < 2) { const int dir = w.wave; float bc, a; gate_scan(p, l, R0, hh, dir, lane, bc, a);
        const float pml = wave_max(a), F = __shfl(bc, 63);
        wgt[dir * 64 + (dir ? 63 - lane : lane)] = __expf(a - pml);
        const int ci = ((b * 4 + hh) * 2 + dir) * NCH + chain_step(dir, cl);
        if (lane == 0) { ((float*)(p.ws + WS_FS))[ci] = F; ((float*)(p.ws + WS_PML))[ci] = pml; } }
    __syncthreads();
    for (int idx = w.tid; idx < 768; idx += NTHR) { const int s = idx / 12, c = idx % 12;
        const u32x4 kr = *(const u32x4*)(MQK + (size_t)(R0 + s) * 768 + 384 + hh * 96 + 8 * c), vr = *(const u32x4*)(PROJ + (size_t)(R0 + s) * PROJ_W + C_MV + hh * 96 + 8 * c);
        const float w0 = wgt[s], w1 = wgt[64 + s];
#pragma unroll
        for (int j = 0; j < 8; ++j) { const unsigned kw = kr[j >> 1] >> ((j & 1) * 16), vw = vr[j >> 1] >> ((j & 1) * 16); const float kv = bf2f((bf16)kw);
            Kw[(8 * c + j) * 72 + s] = f2bf(w0 * kv); Kw[(96 + 8 * c + j) * 72 + s] = f2bf(w1 * kv); Vt[(8 * c + j) * 72 + s] = (bf16)vw; } }
    __syncthreads();
    for (int task = w.wave; task < 18; task += NWAVE) { const int dir = task / 9, dt = (task % 9) / 3, et = task % 3;
        f32x16 acc;
#pragma unroll
        for (int i = 0; i < 16; ++i) acc[i] = 0.f;
#pragma unroll
        for (int ks = 0; ks < 4; ++ks) { const bf16x8 af = *(const bf16x8*)(Kw + (dir * 96 + 32 * dt + r) * 72 + 16 * ks + 8 * h), bfr = *(const bf16x8*)(Vt + (32 * et + r) * 72 + 16 * ks + 8 * h);
            acc = mfma32(af, bfr, acc); }
        const int ci = ((b * 4 + hh) * 2 + dir) * NCH + chain_step(dir, cl);
        bf16* up = UC + (size_t)ci * 9216 + (32 * et + r) * 96 + 32 * dt + 4 * h;
#pragma unroll
        for (int g = 0; g < 4; ++g) { u32x2 o; o.x = pk2(acc[4 * g], acc[4 * g + 1]); o.y = pk2(acc[4 * g + 2], acc[4 * g + 3]); *(u32x2*)(up + 8 * g) = o; } }
    if (w.tid < 192) { const int dir = w.tid / 96, d = w.tid % 96; float s = 0.f;
        for (int k = 0; k < 64; ++k) s += bf2f(Kw[(dir * 96 + d) * 72 + k]);
        NL[(size_t)(((b * 4 + hh) * 2 + dir) * NCH + chain_step(dir, cl)) * 96 + d] = s; }
    __syncthreads();
}
DEV void phase_ml2(const P& p, Wg& w) {
    constexpr int GPC = 1152 + 12;
    bf16* UC = (bf16*)(p.ws + WS_UC); float* NL = (float*)(p.ws + WS_NL);
    const float* FS = (const float*)(p.ws + WS_FS); const float* PML = (const float*)(p.ws + WS_PML); float* MST = (float*)(p.ws + WS_MST);
    for (int j = w.wg * NTHR + w.tid; j < NCHAIN * GPC; j += w.G * NTHR) {
        const int chain = j / GPC, g = j % GPC;
        float C[8], m = 0.f;
#pragma unroll
        for (int i = 0; i < 8; ++i) C[i] = 0.f;
        for (int k = 0; k < NCH; ++k) {
            const int ci = chain * NCH + k; const float F = FS[ci], pml = PML[ci], mx = fmaxf(m, pml), dec = __expf(m - mx), sc = __expf(pml - mx);
            if (g < 1152) { bf16* u = UC + (size_t)ci * 9216 + 8 * g; const u32x4 raw = *(const u32x4*)u;
                u32x4 st; st.x = pk2(C[0], C[1]); st.y = pk2(C[2], C[3]); st.z = pk2(C[4], C[5]); st.w = pk2(C[6], C[7]); *(u32x4*)u = st;
#pragma unroll
                for (int i = 0; i < 8; ++i) C[i] = dec * C[i] + sc * bf2f((bf16)(raw[i >> 1] >> ((i & 1) * 16)));
                if (g == 0) MST[ci] = m; }
            else { float* nl = NL + (size_t)ci * 96 + 8 * (g - 1152); const f32x4 r0 = *(const f32x4*)nl, r1 = *(const f32x4*)(nl + 4);
                *(f32x4*)nl = (f32x4){C[0], C[1], C[2], C[3]}; *(f32x4*)(nl + 4) = (f32x4){C[4], C[5], C[6], C[7]};
#pragma unroll
                for (int i = 0; i < 4; ++i) { C[i] = dec * C[i] + sc * r0[i]; C[4 + i] = dec * C[4 + i] + sc * r1[i]; } }
            m = F + mx;
        }
    }
}
DEV void ml3_pair(const P& p, Wg& w, int l, int pi) {
    const int lane = w.lane, r = lane & 31, h = lane >> 5, it = w.wave >> 2, dir = (w.wave >> 1) & 1, tq = w.wave & 1;
    const int item = 2 * pi + it, b = item / (4 * NCH), hh = (item / NCH) % 4, cl = item % NCH, R0 = b * TP + cl * 64;
    const int ci = ((b * 4 + hh) * 2 + dir) * NCH + chain_step(dir, cl);
    bf16* Vt = (bf16*)(w.lds + it * 40960);
    float* hx = (float*)(w.lds + it * 40960 + 13824);
    const bf16* MQK = (const bf16*)(p.ws + WS_MQK); const bf16* PROJ = (const bf16*)(p.ws + WS_PROJ);
    const bf16* UCi = (const bf16*)(p.ws + WS_UC) + (size_t)ci * 9216; const float* NLi = (const float*)(p.ws + WS_NL) + (size_t)ci * 96;
    for (int idx = (w.wave & 3) * 64 + lane; idx < 768; idx += 256) { const int s = idx / 12, c = idx % 12;
        const u32x4 vr = *(const u32x4*)(PROJ + (size_t)(R0 + s) * PROJ_W + C_MV + hh * 96 + 8 * c);
#pragma unroll
        for (int j = 0; j < 8; ++j) Vt[(8 * c + j) * 72 + s] = (bf16)(vr[j >> 1] >> ((j & 1) * 16)); }
    float bc, a; gate_scan(p, l, R0, hh, dir, lane, bc, a);
    const float pmx = scan_max(a, lane), m_st = ((const float*)(p.ws + WS_MST))[ci];
    const int t = 32 * tq + r, jt = dir ? 63 - t : t;
    const float mx_t = fmaxf(m_st, __shfl(pmx, jt)), bc_t = __shfl(bc, jt);
    float a_s[2][16];
#pragma unroll
    for (int kh = 0; kh < 2; ++kh)
#pragma unroll
        for (int i = 0; i < 16; ++i) { const int s = 32 * kh + crow(i, h); a_s[kh][i] = __shfl(a, dir ? 63 - s : s); }
    __syncthreads();
    bf16x8 qf[6]; float qn = 0.f;
#pragma unroll
    for (int ks = 0; ks < 6; ++ks) { qf[ks] = *(const bf16x8*)(MQK + (size_t)(R0 + t) * 768 + hh * 96 + 16 * ks + 8 * h);
        const f32x4 n0 = *(const f32x4*)(NLi + 16 * ks + 8 * h), n1 = *(const f32x4*)(NLi + 16 * ks + 8 * h + 4);
#pragma unroll
        for (int j = 0; j < 4; ++j) { qn += bf2f((bf16)qf[ks][j]) * n0[j]; qn += bf2f((bf16)qf[ks][4 + j]) * n1[j]; } }
    qn += __shfl_xor(qn, 32);
    f32x16 pw[2]; float rs = 0.f;
#pragma unroll
    for (int kh = 0; kh < 2; ++kh) {
        const bool skip = dir ? (kh < tq) : (kh > tq);
#pragma unroll
        for (int i = 0; i < 16; ++i) pw[kh][i] = 0.f;
        if (!skip) {
#pragma unroll
            for (int ks = 0; ks < 6; ++ks) { const bf16x8 kf = *(const bf16x8*)(MQK + (size_t)(R0 + 32 * kh + r) * 768 + 384 + hh * 96 + 16 * ks + 8 * h); pw[kh] = mfma32(kf, qf[ks], pw[kh]); }
#pragma unroll
            for (int i = 0; i < 16; ++i) { const int s = 32 * kh + crow(i, h); const bool ok = dir ? (s >= t) : (s <= t);
                const float wv = ok ? __expf(a_s[kh][i] - mx_t) * pw[kh][i] : 0.f; pw[kh][i] = wv; rs += wv; } }
    }
    rs += __shfl_xor(rs, 32);
    const float a_int = __expf(m_st - mx_t), den = a_int * qn + rs, inv = 1.0f / fmaxf(fabsf(den), __expf(-(bc_t + mx_t)));
    bf16x8 pb[2][2];
#pragma unroll
    for (int kh = 0; kh < 2; ++kh)
#pragma unroll
        for (int sp = 0; sp < 2; ++sp) { u32x4 u; u.x = pk2(pw[kh][8 * sp], pw[kh][8 * sp + 1]); u.y = pk2(pw[kh][8 * sp + 2], pw[kh][8 * sp + 3]); u.z = pk2(pw[kh][8 * sp + 4], pw[kh][8 * sp + 5]); u.w = pk2(pw[kh][8 * sp + 6], pw[kh][8 * sp + 7]);
            pb[kh][sp] = __builtin_bit_cast(bf16x8, u); }
    float hv[3][16];
#pragma unroll
    for (int et = 0; et < 3; ++et) { f32x16 o, oi;
#pragma unroll
        for (int i = 0; i < 16; ++i) { o[i] = 0.f; oi[i] = 0.f; }
#pragma unroll
        for (int kh = 0; kh < 2; ++kh)
#pragma unroll
            for (int sp = 0; sp < 2; ++sp) { const int base = 32 * kh + 16 * sp + 4 * h; const bf16* vp = Vt + (32 * et + r) * 72 + base;
                const s16x4 lo = *(const s16x4*)vp, hi = *(const s16x4*)(vp + 8);
                const bf16x8 vf = (bf16x8){lo[0], lo[1], lo[2], lo[3], hi[0], hi[1], hi[2], hi[3]};
                o = mfma32(vf, pb[kh][sp], o); }
#pragma unroll
        for (int ks = 0; ks < 6; ++ks) { const bf16x8 cf = *(const bf16x8*)(UCi + (32 * et + r) * 96 + 16 * ks + 8 * h); oi = mfma32(cf, qf[ks], oi); }
#pragma unroll
        for (int i = 0; i < 16; ++i) hv[et][i] = (a_int * oi[i] + o[i]) * inv; }
    if (dir == 1) {
#pragma unroll
        for (int et = 0; et < 3; ++et)
#pragma unroll
            for (int i = 0; i < 16; ++i) hx[t * 97 + 32 * et + crow(i, h)] = hv[et][i]; }
    __syncthreads();
    if (dir == 0) { float ss = 0.f;
#pragma unroll
        for (int et = 0; et < 3; ++et)
#pragma unroll
            for (int i = 0; i < 16; ++i) { hv[et][i] += hx[t * 97 + 32 * et + crow(i, h)]; ss += hv[et][i] * hv[et][i]; }
        ss += __shfl_xor(ss, 32);
        const float rstd = 1.0f / sqrtf(ss * (1.0f / 96.0f) + EPS);
        bf16* MIX = (bf16*)(p.ws + WS_H);
#pragma unroll
        for (int et = 0; et < 3; ++et)
#pragma unroll
            for (int g = 0; g < 4; ++g) { const int e = 32 * et + 8 * g + 4 * h;
                const u32x2 og = *(const u32x2*)(PROJ + (size_t)(R0 + t) * PROJ_W + C_MO + hh * 96 + e); const f32x4 mn = *(const f32x4*)(p.m_norm + l * 384 + hh * 96 + e);
                float o4[4];
#pragma unroll
                for (int j = 0; j < 4; ++j) { const float gate = bf2f((bf16)((j < 2 ? og.x : og.y) >> ((j & 1) * 16))); o4[j] = hv[et][4 * g + j] * rstd * mn[j] * sigmoid_f(gate); }
                u32x2 ov; ov.x = pk2(o4[0], o4[1]); ov.y = pk2(o4[2], o4[3]);
                *(u32x2*)(MIX + (size_t)(R0 + t) * MIXW + hh * 96 + e) = ov; } }
    __syncthreads();
}

DEV void phase_mla_post(const P& p, Wg& w, int l) {
    bf16* MLAQ = (bf16*)(p.ws + WS_MLAQ); const bf16* PROJ = (const bf16*)(p.ws + WS_PROJ);
    const int lane = w.lane;
    for (int R = w.gw; R < M_ALL; R += w.NGW) {
        const int q = R % TP; const bool lat = q >= CTX; const int t = q - CTX;
        bf16* row = MLAQ + (size_t)R * 1024;
        const u32x4 ra = *(const u32x4*)(row + 8 * lane), rb = *(const u32x4*)(row + 512 + 8 * lane);
        u32x4 kr = (u32x4){0u, 0u, 0u, 0u};
        if (lane >= 48) kr = *(const u32x4*)(PROJ + (size_t)R * PROJ_W + C_KR + 8 * ((lane - 48) & 3));
        float xa[8], xb[8];
#pragma unroll
        for (int j = 0; j < 8; ++j) { xa[j] = bf2f((bf16)(ra[j >> 1] >> ((j & 1) * 16))); xb[j] = bf2f((bf16)(rb[j >> 1] >> ((j & 1) * 16))); }
        int baseA, nA, dstA; bool normA = true, ropeA = false; const float* gA;
        if (lane < 48) { const int hh = lane / 12, o = lane % 12;
            if (o < 8) { baseA = 12 * hh; nA = 8; gA = p.l_qnorm + l * 96 + 8 * o; }
            else { baseA = 12 * hh + 8; nA = 4; gA = p.l_qnorm + l * 96 + 64 + 8 * (o - 8); ropeA = true; }
            dstA = 8 * lane; }
        else { const int o = lane - 48;
            if (o < 8) { baseA = 48; nA = 8; gA = p.l_knorm + l * 96 + 8 * o; dstA = 384 + 8 * o; }
            else { baseA = 48; nA = 8; gA = p.l_knorm; normA = false; dstA = 768 + 8 * (o - 8); } }
        float ssA = 0.f, ssB = 0.f;
#pragma unroll
        for (int j = 0; j < 8; ++j) { ssA += xa[j] * xa[j]; ssB += xb[j] * xb[j]; }
        float sA = 0.f;
#pragma unroll
        for (int i = 0; i < 8; ++i) { const float v = __shfl(ssA, (baseA + i) & 63); if (i < nA) sA += v; }
        const int hb = 1 + lane / 16, ob = lane % 16; const bool validB = lane < 48, normB = ob < 8;
        const int baseB = 16 * (lane / 16) & 63;
        float sB = 0.f;
#pragma unroll
        for (int i = 0; i < 8; ++i) sB += __shfl(ssB, (baseB + i) & 63);
        const int dstB = normB ? 384 + 96 * hb + 8 * ob : 768 + 64 * hb + 8 * (ob - 8);
        const float* gB = p.l_knorm + l * 96 + 8 * (ob & 7);
        float ya[8], yb[8];
        { const float rsA = normA ? 1.0f / sqrtf(sA / (float)(8 * nA) + EPS) : 1.0f;
#pragma unroll
          for (int j = 0; j < 8; ++j) ya[j] = normA ? xa[j] * rsA * gA[j] : xa[j]; }
        { const float rsB = normB ? 1.0f / sqrtf(sB * (1.0f / 64.0f) + EPS) : 1.0f;
#pragma unroll
          for (int j = 0; j < 8; ++j) yb[j] = normB ? xb[j] * rsB * gB[j] : xb[j]; }
        { const int cidx = (lane % 12) - 8; const float pos = lat ? ((cidx & 3) < 2 ? (float)(t / GRID_W) : (float)(t % GRID_W)) : 0.f;
#pragma unroll
          for (int j = 0; j < 8; ++j) { const float pt = __shfl_xor(ya[j], 1);
              if (ropeA && lat) { float sn, cs; sincosf(pos * exp2f(-(float)j * (13.287712379549449f / 8.0f)), &sn, &cs); ya[j] = (cidx & 1) ? ya[j] * cs + pt * sn : ya[j] * cs - pt * sn; } } }
        if (lane < 48) {
#pragma unroll
            for (int j = 0; j < 8; ++j) ya[j] *= QSCALE_L; }
        wave_sync();
        { u32x4 o; o.x = pk2(ya[0], ya[1]); o.y = pk2(ya[2], ya[3]); o.z = pk2(ya[4], ya[5]); o.w = pk2(ya[6], ya[7]); *(u32x4*)(row + dstA) = o; }
        if (validB) { u32x4 o; o.x = pk2(yb[0], yb[1]); o.y = pk2(yb[2], yb[3]); o.z = pk2(yb[4], yb[5]); o.w = pk2(yb[6], yb[7]); *(u32x4*)(row + dstB) = o; }
        else { const int i = lane - 48; *(u32x4*)(row + 384 + 96 * (i >> 2) + 64 + 8 * (i & 3)) = kr; }
        wave_sync();
    }
}

template <int DQK>
DEV void attn_unit(const bf16* Q, int ldq, const bf16* K, int ldk, const bf16* V, int ldv, bf16* O, int ldo, int nkeys, Wg& w) {
    constexpr int KS = DQK + 8, NKD = DQK / 16, CPR = DQK / 8, NKC = 64 * CPR;
    bf16* Ks = (bf16*)w.lds;
    bf16* Vt = (bf16*)(w.lds + 2 * 64 * KS * 2);
    const int tid = w.tid, lane = w.lane, r = lane & 31, h = lane >> 5;
    bf16x8 qr[NKD];
    { const bf16* qp = Q + (size_t)(w.wave * 32 + r) * ldq + 8 * h;
#pragma unroll
      for (int d0 = 0; d0 < NKD; ++d0) qr[d0] = *(const bf16x8*)(qp + 16 * d0); }
    const int kr0 = tid / CPR, kc0 = tid % CPR, kr1 = (tid + NTHR) / CPR, kc1 = (tid + NTHR) % CPR; const bool k1 = (tid + NTHR) < NKC;
    const int vr = tid >> 3, vc = tid & 7;
    u32x4 rk0, rk1 = (u32x4){0u, 0u, 0u, 0u}, rv;
    const int NT = nkeys / 64;
#define AT_LOAD(kt) do { rk0 = *(const u32x4*)(K + (size_t)((kt) * 64 + kr0) * ldk + 8 * kc0); if (k1) rk1 = *(const u32x4*)(K + (size_t)((kt) * 64 + kr1) * ldk + 8 * kc1); \
        rv = *(const u32x4*)(V + (size_t)((kt) * 64 + vr) * ldv + 8 * vc); } while (0)
#define AT_STORE(buf) do { *(u32x4*)(Ks + ((buf) * 64 + kr0) * KS + 8 * kc0) = rk0; if (k1) *(u32x4*)(Ks + ((buf) * 64 + kr1) * KS + 8 * kc1) = rk1; \
        _Pragma("unroll") for (int j = 0; j < 8; ++j) Vt[((buf) * 64 + 8 * vc + j) * 72 + vr] = (bf16)(rv[j >> 1] >> ((j & 1) * 16)); } while (0)
    AT_LOAD(0); AT_STORE(0);
    __syncthreads();
    float m_run = -1.0e30f, l_run = 0.f; f32x16 o[2];
#pragma unroll
    for (int i = 0; i < 16; ++i) { o[0][i] = 0.f; o[1][i] = 0.f; }
    for (int kt = 0; kt < NT; ++kt) {
        const int buf = kt & 1;
        if (kt + 1 < NT) AT_LOAD(kt + 1);
        f32x16 pt[2];
#pragma unroll
        for (int kh = 0; kh < 2; ++kh) {
#pragma unroll
            for (int i = 0; i < 16; ++i) pt[kh][i] = 0.f;
#pragma unroll
            for (int d0 = 0; d0 < NKD; ++d0) { const bf16x8 kf = *(const bf16x8*)(Ks + (buf * 64 + 32 * kh + r) * KS + 16 * d0 + 8 * h); pt[kh] = mfma32(kf, qr[d0], pt[kh]); } }
        float mt = pt[0][0];
#pragma unroll
        for (int i = 0; i < 16; ++i) { mt = fmaxf(mt, pt[0][i]); mt = fmaxf(mt, pt[1][i]); }
        mt = fmaxf(mt, __shfl_xor(mt, 32));
        const float mn = fmaxf(m_run, mt), alpha = exp2_fast(m_run - mn); m_run = mn;
        float rs = 0.f;
#pragma unroll
        for (int kh = 0; kh < 2; ++kh)
#pragma unroll
            for (int i = 0; i < 16; ++i) { const float e = exp2_fast(pt[kh][i] - mn); pt[kh][i] = e; rs += e; }
        l_run = l_run * alpha + rs;
#pragma unroll
        for (int i = 0; i < 16; ++i) { o[0][i] *= alpha; o[1][i] *= alpha; }
        bf16x8 pb[2][2];
#pragma unroll
        for (int kh = 0; kh < 2; ++kh)
#pragma unroll
            for (int sp = 0; sp < 2; ++sp) { u32x4 u; u.x = pk2(pt[kh][8 * sp], pt[kh][8 * sp + 1]); u.y = pk2(pt[kh][8 * sp + 2], pt[kh][8 * sp + 3]); u.z = pk2(pt[kh][8 * sp + 4], pt[kh][8 * sp + 5]); u.w = pk2(pt[kh][8 * sp + 6], pt[kh][8 * sp + 7]);
                pb[kh][sp] = __builtin_bit_cast(bf16x8, u); }
#pragma unroll
        for (int et = 0; et < 2; ++et)
#pragma unroll
            for (int kh = 0; kh < 2; ++kh)
#pragma unroll
                for (int sp = 0; sp < 2; ++sp) { const bf16* vp = Vt + (buf * 64 + 32 * et + r) * 72 + 32 * kh + 16 * sp + 4 * h;
                    const s16x4 lo = *(const s16x4*)vp, hi = *(const s16x4*)(vp + 8);
                    const bf16x8 vf = (bf16x8){lo[0], lo[1], lo[2], lo[3], hi[0], hi[1], hi[2], hi[3]};
                    o[et] = mfma32(vf, pb[kh][sp], o[et]); }
        if (kt + 1 < NT) AT_STORE(buf ^ 1);
        __syncthreads();
    }
#undef AT_LOAD
#undef AT_STORE
    l_run += __shfl_xor(l_run, 32);
    const float inv = 1.0f / l_run;
    bf16* op = O + (size_t)(w.wave * 32 + r) * ldo + 4 * h;
#pragma unroll
    for (int et = 0; et < 2; ++et)
#pragma unroll
        for (int g = 0; g < 4; ++g) { u32x2 ov; ov.x = pk2(o[et][4 * g] * inv, o[et][4 * g + 1] * inv); ov.y = pk2(o[et][4 * g + 2] * inv, o[et][4 * g + 3] * inv); *(u32x2*)(op + 32 * et + 8 * g) = ov; }
}
DEV void phase_mix(const P& p, Wg& w, int l) {
    const bf16* PROJ = (const bf16*)(p.ws + WS_PROJ); const bf16* MLAQ = (const bf16*)(p.ws + WS_MLAQ); bf16* MIX = (bf16*)(p.ws + WS_H);
    unsigned* ctr = (unsigned*)(p.ws + WS_CTL) + CW_Q + 128 * l;
    const int n_mla = BATCH * 4 * NQL, n_gqa = BATCH * 6 * NQL, n_ml3 = BATCH * 4 * NCH / 2, n_ctx = (l == 0) ? BATCH * 10 : 0, n_att = n_mla + n_gqa + n_ctx;
    for (;;) {
        int idx = q_next(w, ctr);
        if (idx >= n_att) break;
        int b, head, qb, nkeys; bool mla;
        if (idx < n_mla) { b = idx / (4 * NQL); head = (idx / NQL) % 4; qb = 1 + idx % NQL; nkeys = TP; mla = true; }
        else if ((idx -= n_mla) < n_gqa) { b = idx / (6 * NQL); const int rem = idx % (6 * NQL); head = (rem / (3 * NQL)) * 3 + rem % 3; qb = 1 + (rem % (3 * NQL)) / 3; nkeys = TP; mla = false; }
        else { idx -= n_gqa; b = idx / 10; const int hd = idx % 10; mla = hd >= 6; head = mla ? hd - 6 : hd; qb = 0; nkeys = CTX; }
        const size_t Rq = (size_t)b * TP + qb * 256, Rk = (size_t)b * TP;
        if (mla) attn_unit<96>(MLAQ + Rq * 1024 + head * 96, 1024, MLAQ + Rk * 1024 + 384 + head * 96, 1024, MLAQ + Rk * 1024 + 768 + head * 64, 1024, MIX + Rq * MIXW + 768 + head * 64, MIXW, nkeys, w);
        else attn_unit<64>(PROJ + Rq * PROJ_W + C_AQ + head * 64, PROJ_W, PROJ + Rk * PROJ_W + C_AK + (head / 3) * 64, PROJ_W, PROJ + Rk * PROJ_W + C_AV + (head / 3) * 64, PROJ_W, MIX + Rq * MIXW + 384 + head * 64, MIXW, nkeys, w);
    }
    for (;;) {
        const int idx = q_next(w, ctr + 64);
        if (idx >= n_ml3) break;
        ml3_pair(p, w, l, idx);
    }
}

DEV void moe_seg_table(const P& p, Wg& w) {
    const int* cntg = (const int*)(p.ws + WS_CNTG);
    if (w.tid < NEXP) { int tot = 0, pre = 0; for (int g = 0; g < w.G; ++g) { const int c = cntg[g * NEXP + w.tid]; tot += c; pre += (g < w.wg) ? c : 0; } w.misc[32 + w.tid] = (unsigned)tot; w.misc[48 + w.tid] = (unsigned)pre; }
    __syncthreads();
    if (w.tid == 0) { int s = 0; for (int e = 0; e < NEXP; ++e) { w.misc[16 + e] = (unsigned)s; s += ((int)w.misc[32 + e] + 255) / 256; } w.misc[16 + NEXP] = (unsigned)s; }
    __syncthreads();
}
DEV void phase_gather(const P& p, Wg& w) {
    moe_seg_table(p, w);
    const int* topi = (const int*)(p.ws + WS_TOPI); const float* topw = (const float*)(p.ws + WS_TOPW);
    int* stok = (int*)(p.ws + WS_STOK); float* sw = (float*)(p.ws + WS_SW);
    const bf16* H = (const bf16*)(p.ws + WS_H); bf16* AG = (bf16*)(p.ws + WS_AG);
    int* lc = (int*)w.lds;
    if (w.lane == 0) { for (int e = 0; e < NEXP; ++e) lc[w.wave * NEXP + e] = 0;
        for (int R = w.gw; R < M_ALL; R += w.NGW) { const int q = R % TP; if (q < CTX) continue; const int tok = (R / TP) * SEQ + q - CTX; lc[w.wave * NEXP + topi[2 * tok]]++; lc[w.wave * NEXP + topi[2 * tok + 1]]++; } }
    __syncthreads();
    if (w.tid < NEXP) { int s = (int)w.misc[16 + w.tid] * 256 + (int)w.misc[48 + w.tid]; for (int ww = 0; ww < NWAVE; ++ww) { const int c = lc[ww * NEXP + w.tid]; lc[ww * NEXP + w.tid] = s; s += c; } }
    __syncthreads();
    for (int R = w.gw; R < M_ALL; R += w.NGW) { const int q = R % TP; if (q < CTX) continue; const int tok = (R / TP) * SEQ + q - CTX;
        int s0 = 0, s1 = 0;
        if (w.lane == 0) { const int e0 = topi[2 * tok], e1 = topi[2 * tok + 1]; s0 = lc[w.wave * NEXP + e0]; lc[w.wave * NEXP + e0] = s0 + 1; s1 = lc[w.wave * NEXP + e1]; lc[w.wave * NEXP + e1] = s1 + 1;
            stok[s0] = tok; stok[s1] = tok; sw[s0] = topw[2 * tok]; sw[s1] = topw[2 * tok + 1]; }
        s0 = __shfl(s0, 0); s1 = __shfl(s1, 0);
#pragma unroll
        for (int j = 0; j < D_MODEL / 512; ++j) { const u32x4 v = *(const u32x4*)(H + (size_t)R * D_MODEL + 8 * w.lane + 512 * j);
            *(u32x4*)(AG + (size_t)s0 * D_MODEL + 8 * w.lane + 512 * j) = v; *(u32x4*)(AG + (size_t)s1 * D_MODEL + 8 * w.lane + 512 * j) = v; }
        if (D_MODEL % 512) { if (w.lane < (D_MODEL % 512) / 8) { const int c = (D_MODEL / 512) * 512 + 8 * w.lane; const u32x4 v = *(const u32x4*)(H + (size_t)R * D_MODEL + c);
            *(u32x4*)(AG + (size_t)s0 * D_MODEL + c) = v; *(u32x4*)(AG + (size_t)s1 * D_MODEL + c) = v; } } }
    for (int e = w.wg; e < NEXP; e += w.G) { const int lo = (int)w.misc[16 + e] * 256 + (int)w.misc[32 + e], hi = (int)w.misc[16 + e + 1] * 256;
        for (int s = lo + w.wave; s < hi; s += NWAVE) { if (w.lane == 0) { stok[s] = -1; sw[s] = 0.f; }
            for (int c = 8 * w.lane; c < D_MODEL; c += 512) *(u32x4*)(AG + (size_t)s * D_MODEL + c) = (u32x4){0u, 0u, 0u, 0u}; } }
}

constexpr int PH_L = 16;
constexpr int N_PHASES = 1 + 2 * PH_L;
#ifdef EMU
#define GRID_BAR() do {} while (0)
#define DYN_LDS() unsigned char* lds = EMU_DYN_LDS()
#else
#define GRID_BAR() xcd_barrier(bar)
#define DYN_LDS() extern __shared__ __attribute__((aligned(16))) unsigned char lds[]
#endif
__global__ void __launch_bounds__(NTHR, 2) fwd(P p) {
    DYN_LDS();
    Wg w; w.tid = threadIdx.x; w.lane = w.tid & 63;
#ifndef EMU
    w.wave = __builtin_amdgcn_readfirstlane(w.tid >> 6);
#else
    w.wave = w.tid >> 6;
#endif
    w.G = gridDim.x; w.wg = blockIdx.x; w.gw = w.wg * NWAVE + w.wave; w.NGW = w.G * NWAVE; w.lds = lds; w.misc = (unsigned*)(lds + LDS_MISC);
    if (w.tid < 64) w.misc[w.tid] = 0u;
    __syncthreads();
#ifndef EMU
    XcdBarrier bar = xcd_barrier_post((unsigned*)(p.ws + WS_CTL) + CW_BAR, (volatile LAS unsigned*)(w.misc));
#endif
    const int lo = p.ph_lo, hi = p.ph_hi;
#ifndef PH_MASK
#define PH_MASK 0xffffffffu
#endif
#ifndef EMU
#define WAVE_OF(t) __builtin_amdgcn_readfirstlane((t) >> 6)
#else
#define WAVE_OF(t) ((t) >> 6)
#endif
#define PH_BEGIN(k) if (((PH_MASK >> ((k) - pb_)) & 1u) && lo <= (k) && (k) < hi) { { int t_ = threadIdx.x; OPAQUE_V(t_); w.tid = t_; w.lane = t_ & 63; w.wave = WAVE_OF(t_); w.gw = w.wg * NWAVE + w.wave; }
#define PH_END(k) if ((k) + 1 < hi) GRID_BAR(); }
    { const int pb_ = -31; PH_BEGIN(0) phase0(p, w); PH_END(0) }
    for (int l = 0; l < 2; ++l) {
        const int pb = 1 + PH_L * l, pb_ = pb;
        PH_BEGIN(pb + 0) phase_modulate(p, w, l, 0, l == 0, false, false); PH_END(pb + 0)
        PH_BEGIN(pb + 1) {
            pg8::Gemm g{(const bf16*)(p.ws + WS_H), (const bf16*)(p.ws + WS_WIN_T) + (size_t)l * PROJ_W * D_MODEL, D_MODEL, D_MODEL, 0};
            Sched S; S.o.init(NPAN, PROJ_W / 256, w.G, w.wg); S.mode = 0; S.pm_base = 0; S.seg = nullptr;
            EpiStore E{(bf16*)(p.ws + WS_PROJ), PROJ_W, (float*)(p.ws + WS_GATES)};
            pg8::gemm_phase<EpiStore, Sched>(w.lds, w.tid, g, S, E); } PH_END(pb + 1)
        PH_BEGIN(pb + 2) phase_prep(p, w, l); PH_END(pb + 2)
        PH_BEGIN(pb + 3) {
            pg8::Gemm g{(const bf16*)(p.ws + WS_PROJ) + C_CQ, (const bf16*)(p.ws + WS_MLA_T) + (size_t)l * 1024 * 384, PROJ_W, 384, 0};
            Sched S; S.o.init(NPAN, 4, w.G, w.wg); S.mode = 0; S.pm_base = 0; S.seg = nullptr;
            EpiStore E{(bf16*)(p.ws + WS_MLAQ), 1024, nullptr};
            pg8::gemm_phase<EpiStore, Sched>(w.lds, w.tid, g, S, E);
            __syncthreads();
#ifndef NO_ML1
            for (int it = w.wg; it < BATCH * 4 * NCH; it += w.G) ml1_item(p, w, l, it);
#endif
            } PH_END(pb + 3)
        PH_BEGIN(pb + 4) phase_mla_post(p, w, l); phase_ml2(p, w); PH_END(pb + 4)
        PH_BEGIN(pb + 5) phase_mix(p, w, l); PH_END(pb + 5)
        PH_BEGIN(pb + 6) {
            pg8::Gemm g{(const bf16*)(p.ws + WS_H), (const bf16*)(p.ws + WS_WOUT_T) + (size_t)l * D_MODEL * MIXW, MIXW, MIXW, 0};
            Sched S; S.o.init(l == 0 ? NPAN : BATCH * NQL, D_MODEL / 256, w.G, w.wg); S.mode = (l == 0) ? 0 : 1; S.pm_base = 0; S.seg = nullptr;
            EpiResid E{p, l, 2 * D_MODEL};
            pg8::gemm_phase<EpiResid, Sched>(w.lds, w.tid, g, S, E); } PH_END(pb + 6)
        if (l == 0) {
            PH_BEGIN(pb + 7) phase_modulate(p, w, 0, 1, false, false, false); PH_END(pb + 7)
            PH_BEGIN(pb + 8) {
                pg8::Gemm g{(const bf16*)(p.ws + WS_H), (const bf16*)(p.ws + WS_WGU_T), D_MODEL, D_MODEL, 0};
                Sched S; S.o.init(NPAN, 2 * D_FF / 256, w.G, w.wg); S.mode = 0; S.pm_base = 0; S.seg = nullptr;
                EpiSwiglu E{(bf16*)(p.ws + WS_ACT), 0};
                pg8::gemm_phase<EpiSwiglu, Sched>(w.lds, w.tid, g, S, E); } PH_END(pb + 8)
            PH_BEGIN(pb + 9) {
                pg8::Gemm g{(const bf16*)(p.ws + WS_ACT), (const bf16*)(p.ws + WS_WD_T), D_FF, D_FF, 0};
                Sched S; S.o.init(NPAN, D_MODEL / 256, w.G, w.wg); S.mode = 0; S.pm_base = 0; S.seg = nullptr;
                EpiResid E{p, 0, 5 * D_MODEL};
                pg8::gemm_phase<EpiResid, Sched>(w.lds, w.tid, g, S, E); } PH_END(pb + 9)
        } else {
            PH_BEGIN(pb + 7) phase_modulate(p, w, 1, 1, false, true, true); phase_moe_weights(p, w); PH_END(pb + 7)
            PH_BEGIN(pb + 8) phase_gather(p, w); PH_END(pb + 8)
            for (int c = 0; c < 3; ++c) {
                PH_BEGIN(pb + 9 + 2 * c) {
                    moe_seg_table(p, w);
                    const int ptot = (int)w.misc[16 + NEXP], nch = (ptot + MOE_PCH - 1) / MOE_PCH, pch = (ptot + nch - 1) / nch, pm0 = c * pch, np = (ptot - pm0) < pch ? (ptot - pm0) : pch;
                    if (c < nch && np > 0) {
                        pg8::Gemm g{(const bf16*)(p.ws + WS_AG), (const bf16*)(p.ws + WS_MOEW), D_MODEL, D_MODEL, MOEW_E};
                        Sched S; S.o.init(np, 2 * D_FF / 256, w.G, w.wg); S.mode = 2; S.pm_base = pm0; S.seg = (const int*)(w.misc + 16);
                        EpiSwiglu E{(bf16*)(p.ws + WS_ACT2), pm0};
                        pg8::gemm_phase<EpiSwiglu, Sched>(w.lds, w.tid, g, S, E); } } PH_END(pb + 9 + 2 * c)
                PH_BEGIN(pb + 10 + 2 * c) {
                    moe_seg_table(p, w);
                    const int ptot = (int)w.misc[16 + NEXP], nch = (ptot + MOE_PCH - 1) / MOE_PCH, pch = (ptot + nch - 1) / nch, pm0 = c * pch, np = (ptot - pm0) < pch ? (ptot - pm0) : pch;
                    if (c < nch && np > 0) {
                        pg8::Gemm g{(const bf16*)(p.ws + WS_ACT2), (const bf16*)(p.ws + WS_MOEW) + (size_t)2 * D_FF * D_MODEL, D_FF, D_FF, MOEW_E};
                        Sched S; S.o.init(np, D_MODEL / 256, w.G, w.wg); S.mode = 3; S.pm_base = pm0; S.seg = (const int*)(w.misc + 16);
                        EpiMoeDown E{p, pm0};
                        pg8::gemm_phase<EpiMoeDown, Sched>(w.lds, w.tid, g, S, E); } } PH_END(pb + 10 + 2 * c)
            }
        }
    }
}

#ifndef MK_PER_PHASE
#define MK_PER_PHASE 1
#endif
extern "C" void kernel_launch(void* const* d_in, const int* in_sizes, int n_in, void* d_out, int out_size, void* d_ws, size_t ws_size, hipStream_t stream) {
    static int grid = 0;
    if (grid == 0) {
        if (n_in != 28 || in_sizes[0] != BATCH * SEQ * D_MODEL || out_size != BATCH * SEQ * D_MODEL || ws_size < WS_TOTAL) {
            fprintf(stderr, "kernel_launch: unexpected problem (n_in %d, x %d, out %d, ws %zu < %zu)\n", n_in, n_in > 0 ? in_sizes[0] : -1, out_size, ws_size, (size_t)WS_TOTAL); grid = -1; return; }
#ifndef EMU
        int dev = 0, cus = 0;
        if (hipGetDevice(&dev) != hipSuccess || hipDeviceGetAttribute(&cus, hipDeviceAttributeMultiprocessorCount, dev) != hipSuccess) { grid = -1; return; }
        if (hipFuncSetAttribute((const void*)fwd, hipFuncAttributeMaxDynamicSharedMemorySize, LDS_BYTES) != hipSuccess) { fprintf(stderr, "kernel_launch: hipFuncSetAttribute failed\n"); grid = -1; return; }
        int per_cu = 0;
        if (hipOccupancyMaxActiveBlocksPerMultiprocessor(&per_cu, (const void*)fwd, NTHR, LDS_BYTES) != hipSuccess || per_cu < 1) { fprintf(stderr, "kernel_launch: occupancy query says %d\n", per_cu); (void)hipGetLastError(); }
        grid = cus;
#else
        grid = 8;
#endif
    }
    if (grid < 0) return;
    (void)hipMemsetAsync((char*)d_ws + WS_CTL, 0, CTL_BYTES, stream);
    P p{};
    const float** pp = (const float**)&p;
    for (int i = 0; i < 28; ++i) pp[i] = (const float*)d_in[i];
    p.out = (float*)d_out; p.ws = (unsigned char*)d_ws;
#if MK_PER_PHASE
    for (int k = 0; k < N_PHASES; ++k) {
        if (k >= 1 + 10 && k < 1 + PH_L) continue;
        if (k >= 1 + PH_L + 15) continue;
        p.ph_lo = k; p.ph_hi = k + 1;
        hipLaunchKernelGGL(fwd, dim3(grid), dim3(NTHR), LDS_BYTES, stream, p);
    }
#else
    p.ph_lo = 0; p.ph_hi = N_PHASES;
    hipLaunchKernelGGL(fwd, dim3(grid), dim3(NTHR), LDS_BYTES, stream, p);
#endif
}
```

```cpp
#ifndef EMU
#include <hip/hip_runtime.h>
#endif
#include <cstdio>
#include <cstdint>
#include <cmath>

#ifdef CFG_TINY
constexpr int D_MODEL = 256, BATCH = 2, SEQ = 512, CTX = 256, GRID_W = 16, D_FF = 512;
constexpr int MOE_PCH = 6;
#else
constexpr int D_MODEL = 1024, BATCH = 8, SEQ = 4096, CTX = 256, GRID_W = 64, D_FF = 3584;
constexpr int MOE_PCH = 88;
#endif
constexpr int TP = CTX + SEQ, M_ALL = BATCH * TP, NPAN = M_ALL / 256, PAN_B = TP / 256, NQL = SEQ / 256;
constexpr int NCH = TP / 64, NC_CTX = CTX / 64;
constexpr int PROJ_W = 2816, MIXW = 1024, NEXP = 8;
constexpr int C_MQ = 0, C_MK = 384, C_MV = 768, C_MO = 1152, C_G = 1536, C_AQ = 1552, C_AK = 1936, C_AV = 2064, C_CQ = 2192, C_CKV = 2448, C_KR = 2576, IN_W = 2608;
constexpr int NV = BATCH + 1;
constexpr int NCHAIN = BATCH * 4 * 2, NITEM = NCHAIN * NCH;
constexpr int NTOK = BATCH * SEQ, NSLOTP = NTOK * 2 + NEXP * 256;
constexpr float EPS = 1e-6f, LOG2E = 1.4426950408889634f;
constexpr float QSCALE_A = 0.125f * LOG2E, QSCALE_L = 0.10206207261596575f * LOG2E, KSCALE_M = 0.10206207261596575f;
constexpr int NTHR = 512, NWAVE = 8;

typedef unsigned short bf16;
#ifndef EMU
typedef short bf16x8 __attribute__((ext_vector_type(8)));
typedef short s16x4 __attribute__((ext_vector_type(4)));
typedef float f32x4 __attribute__((ext_vector_type(4)));
typedef float f32x2 __attribute__((ext_vector_type(2)));
typedef float f32x16 __attribute__((ext_vector_type(16)));
typedef unsigned u32x4 __attribute__((ext_vector_type(4)));
typedef unsigned u32x2 __attribute__((ext_vector_type(2)));
#define DEV __device__ __forceinline__
DEV f32x16 mfma32(bf16x8 a, bf16x8 b, f32x16 c) { return __builtin_amdgcn_mfma_f32_32x32x16_bf16(a, b, c, 0, 0, 0); }
DEV void wave_sync() { asm volatile("s_waitcnt vmcnt(0) lgkmcnt(0)" ::: "memory"); __builtin_amdgcn_wave_barrier(); }
DEV float exp2_fast(float x) { return __builtin_amdgcn_exp2f(x); }
DEV float rcp_fast(float x) { return __builtin_amdgcn_rcpf(x); }
DEV void atomic_addf(float* p, float v) { unsafeAtomicAdd(p, v); }
#define OPAQUE_V(x) asm volatile("" : "+v"(x))
DEV unsigned fau(float f) { return __float_as_uint(f); }
DEV float uaf(unsigned u) { return __uint_as_float(u); }
#else
#define DEV inline
#define OPAQUE_V(x) do {} while (0)
DEV void wave_sync() { (void)emu_shfl_u(0u, emu::B->cur & 63); }
DEV void atomic_addf(float* p, float v) { atomicAdd(p, v); }
DEV unsigned fau(float f) { unsigned u; memcpy(&u, &f, 4); return u; }
DEV float uaf(unsigned u) { float f; memcpy(&f, &u, 4); return f; }
#endif
DEV bf16 f2bf(float f) { unsigned u = fau(f); u += 0x7fffu + ((u >> 16) & 1u); return (bf16)(u >> 16); }
DEV float bf2f(bf16 h) { return uaf(((unsigned)h) << 16); }
DEV unsigned pk2(float lo, float hi) { return (unsigned)f2bf(lo) | ((unsigned)f2bf(hi) << 16); }
DEV float wave_sum(float v) {
#pragma unroll
    for (int o = 1; o < 64; o <<= 1) v += __shfl_xor(v, o);
    return v;
}
DEV float wave_max(float v) {
#pragma unroll
    for (int o = 1; o < 64; o <<= 1) v = fmaxf(v, __shfl_xor(v, o));
    return v;
}
DEV float silu_f(float x) { return x / (1.0f + __expf(-x)); }
DEV float silu_fast(float x) { return x * rcp_fast(1.0f + exp2_fast(-x * LOG2E)); }
DEV float sigmoid_f(float x) { return 1.0f / (1.0f + __expf(-x)); }
DEV float log_sigmoid_f(float x) { return x >= 0.f ? -log1pf(expf(-x)) : x - log1pf(expf(x)); }
DEV int crow(int i, int h) { return (i & 3) + 8 * (i >> 2) + 4 * h; }

constexpr size_t al256(size_t x) { return (x + 255) & ~(size_t)255; }
constexpr size_t WS_CTL = 0, CTL_BYTES = 65536;
constexpr int CW_Q = 0;
constexpr int CW_BAR = 4096;
constexpr size_t WS_MODV = WS_CTL + CTL_BYTES;
constexpr size_t WS_WIN_T = al256(WS_MODV + (size_t)2 * NV * 6 * D_MODEL * 4);
constexpr size_t WS_WOUT_T = al256(WS_WIN_T + (size_t)2 * PROJ_W * D_MODEL * 2);
constexpr size_t WS_MLA_T = al256(WS_WOUT_T + (size_t)2 * D_MODEL * MIXW * 2);
constexpr size_t WS_WGU_T = al256(WS_MLA_T + (size_t)2 * 1024 * 384 * 2);
constexpr size_t WS_WD_T = al256(WS_WGU_T + (size_t)2 * D_FF * D_MODEL * 2);
constexpr size_t WS_CX = al256(WS_WD_T + (size_t)D_MODEL * D_FF * 2);
constexpr size_t WS_GATES = al256(WS_CX + (size_t)BATCH * CTX * D_MODEL * 4);
constexpr size_t WS_NL = al256(WS_GATES + (size_t)M_ALL * 16 * 4);
constexpr size_t WS_FS = al256(WS_NL + (size_t)NITEM * 96 * 4);
constexpr size_t WS_PML = al256(WS_FS + (size_t)NITEM * 4);
constexpr size_t WS_MST = al256(WS_PML + (size_t)NITEM * 4);
constexpr size_t WS_TOPI = al256(WS_MST + (size_t)NITEM * 4);
constexpr size_t WS_TOPW = al256(WS_TOPI + (size_t)NTOK * 2 * 4);
constexpr size_t WS_CNTG = al256(WS_TOPW + (size_t)NTOK * 2 * 4);
constexpr size_t WS_STOK = al256(WS_CNTG + (size_t)1024 * 8 * 4);
constexpr size_t WS_SW = al256(WS_STOK + (size_t)NSLOTP * 4);
constexpr size_t WS_PROJ = al256(WS_SW + (size_t)NSLOTP * 4);
constexpr size_t WS_MQK = al256(WS_PROJ + (size_t)M_ALL * PROJ_W * 2);
constexpr size_t WS_MLAQ = al256(WS_MQK + (size_t)M_ALL * 768 * 2);
constexpr size_t WS_UC = al256(WS_MLAQ + (size_t)M_ALL * 1024 * 2);
constexpr size_t WS_H = al256(WS_UC + (size_t)NITEM * 9216 * 2);
constexpr size_t WS_END0 = al256(WS_H + (size_t)M_ALL * 1024 * 2);
constexpr size_t WS_ACT = WS_PROJ;
constexpr size_t WS_MOEW = WS_PROJ;
constexpr size_t MOEW_E = (size_t)3 * D_FF * D_MODEL * 2;
constexpr size_t WS_AG = al256(WS_MOEW + NEXP * MOEW_E);
constexpr size_t WS_ACT2 = al256(WS_AG + (size_t)NSLOTP * D_MODEL * 2);
#ifdef CFG_TINY
constexpr size_t WS_TOTAL = WS_END0;
#else
constexpr size_t WS_TOTAL = (size_t)512 << 20;
#endif
static_assert(WS_END0 <= WS_TOTAL, "ws map");
static_assert(WS_ACT + (size_t)M_ALL * D_FF * 2 <= WS_MLAQ, "dense ACT overlays PROJ+MQK only");
static_assert(WS_MOEW + NEXP * MOEW_E <= WS_MQK, "MoE weights overlay PROJ only");
static_assert(WS_ACT2 + (size_t)MOE_PCH * 256 * D_FF * 2 <= WS_TOTAL, "MoE ACT chunk");

constexpr int LDS_STAGE = 131072;
constexpr int LDS_MISC = LDS_STAGE;
constexpr int LDS_BYTES = LDS_STAGE + 256;

struct P {
    const float *x, *c, *ctx, *c_ctx, *mod_w, *mod_b, *norm_mix, *norm_ffn, *w_in, *m_conv, *m_gate_b, *m_norm, *a_qnorm, *a_knorm, *l_cq_norm, *l_ckv_norm,
        *l_wuq, *l_wukv, *l_qnorm, *l_knorm, *w_out, *ffn_wg, *ffn_wu, *ffn_wd, *moe_router, *moe_wg, *moe_wu, *moe_wd;
    float* out; unsigned char* ws; int ph_lo, ph_hi;
};
DEV float* resid_row(const P& p, int R) {
    const int b = R / TP, q = R % TP;
    return q < CTX ? (float*)(p.ws + WS_CX) + (size_t)(b * CTX + q) * D_MODEL : p.out + (size_t)(b * SEQ + q - CTX) * D_MODEL;
}
DEV const float* modv(const P& p, int l, int R) { const int b = R / TP, q = R % TP; return (const float*)(p.ws + WS_MODV) + (size_t)(l * NV + (q < CTX ? BATCH : b)) * 6 * D_MODEL; }

namespace pg8 {
constexpr int BM = 256, BK = 64, HALF = 128, HTB = HALF * BK * 2, STAGE_BYTES = 8 * HTB, NXCD = 8, WGM = 8;
struct Unit { int pm, pn, e; };
struct Gemm { const bf16* A; const bf16* Bt; int lda, K; size_t bstride; };
DEV int lds_byte(int r, int c) { const int st = (r >> 4) * 2 + (c >> 5), rr = r & 15, cc = c & 31, ob = rr * 64 + cc * 2; return st * 1024 + (ob ^ (((ob >> 9) & 1) << 5)); }
DEV void stage_rc(int b, int& R, int& C) { const int st = b / 1024, sb = b % 1024, swz = sb ^ (((sb >> 9) & 1) << 5); R = (st >> 1) * 16 + swz / 64; C = (st & 1) * 32 + (swz % 64) / 2; }
DEV int perm32(int rho) { const int n = rho >> 4, i = rho & 15; return 8 * (i >> 2) + 4 * n + (i & 3); }
struct Order {
    int nM, nN, nwg, G, c;
    DEV void init(int nM_, int nN_, int G_, int c_) { nM = nM_; nN = nN_; nwg = nM * nN; G = G_; c = c_; }
    DEV bool nextL(int i, int& lm, int& ln) const {
        const long L = (long)i * G + c; if (L >= nwg) return false;
        int wgid = (int)L; { const int q = nwg / NXCD, r = nwg % NXCD, xcd = wgid % NXCD, off = wgid / NXCD; wgid = (xcd < r ? xcd * (q + 1) : r * (q + 1) + (xcd - r) * q) + off; }
        const int nig = WGM * nN, gid = wgid / nig, fm = gid * WGM, gsz = (nM - fm) < WGM ? (nM - fm) : WGM;
        lm = fm + ((wgid % nig) % gsz); ln = (wgid % nig) / gsz; return true;
    }
};
#ifndef EMU
#define PG8_LAS __attribute__((address_space(3)))
DEV unsigned cvt_pk_bf16(float lo, float hi) { unsigned r; asm volatile("v_cvt_pk_bf16_f32 %0, %1, %2" : "=v"(r) : "v"(lo), "v"(hi)); return r; }
template <class Epi, class Sched>
DEV void gemm_phase(unsigned char* lds_, const int tid, const Gemm g, const Sched& S, const Epi& E) {
    PG8_LAS unsigned char* lds = (PG8_LAS unsigned char*)lds_;
    const int wid = __builtin_amdgcn_readfirstlane(tid >> 6), lane = tid & 63, wr = wid >> 2, wc = wid & 3, fr = lane & 15, fq = lane >> 4;
    const int K = g.K, nt = K / BK, lda = g.lda;
    unsigned voffA[2], voffB[2];
#pragma unroll
    for (int i = 0; i < 2; ++i) { int R, C; stage_rc(tid * 16 + i * 8192, R, C); const int Rb = Epi::PERM ? ((R & ~31) + perm32(R & 31)) : R;
        voffA[i] = (unsigned)(R * lda + C) * 2u; voffB[i] = (unsigned)(Rb * K + C) * 2u; }
    const size_t kstep = (size_t)(BK * 2);
    const size_t hstepA = (size_t)HALF * lda * 2, hstepB = (size_t)HALF * K * 2;
    const size_t tstepA = 2 * hstepA, tstepB = 2 * hstepB;
    const unsigned ldsw = (unsigned)wid * 1024u;
    const int aoff = lds_byte(wr * 64 + fr, fq * 8), boff = lds_byte(wc * 32 + fr, fq * 8);
#define PG8_SA(b, h) (((b) * 2 + (h)) * HTB)
#define PG8_SB(b, h) ((4 + (b) * 2 + (h)) * HTB)
#define PG8_STAGE(bufoff, gbase, voff) do { _Pragma("unroll") for (int _i = 0; _i < 2; ++_i) \
        __builtin_amdgcn_global_load_lds((const unsigned*)((const char*)(gbase) + (voff)[_i]), (PG8_LAS unsigned*)(lds + (bufoff) + ldsw + _i * 8192), 16, 0, 0); } while (0)
#define PG8_LDA(dst, b, h) do { _Pragma("unroll") for (int m = 0; m < 4; ++m) _Pragma("unroll") for (int k = 0; k < 2; ++k) dst[m][k] = *(const PG8_LAS bf16x8*)(lds + PG8_SA(b, h) + aoff + m * 2048 + k * 1024); } while (0)
#define PG8_LDB(dst, b, h) do { _Pragma("unroll") for (int n = 0; n < 2; ++n) _Pragma("unroll") for (int k = 0; k < 2; ++k) dst[n][k] = *(const PG8_LAS bf16x8*)(lds + PG8_SB(b, h) + boff + n * 2048 + k * 1024); } while (0)
#define PG8_MMA(ai, bj, At, Bt) do { __builtin_amdgcn_s_setprio(1); _Pragma("unroll") for (int m = 0; m < 4; ++m) _Pragma("unroll") for (int n = 0; n < 2; ++n) _Pragma("unroll") for (int k = 0; k < 2; ++k) \
        acc[ai][bj][m][n] = __builtin_amdgcn_mfma_f32_16x16x32_bf16(Bt[n][k], At[m][k], acc[ai][bj][m][n], 0, 0, 0); __builtin_amdgcn_s_setprio(0); } while (0)
#define PG8_WAIT_V(n) asm volatile("s_waitcnt vmcnt(" #n ")" ::: "memory")
#define PG8_WAIT_L(n) asm volatile("s_waitcnt lgkmcnt(" #n ")" ::: "memory")
#define PG8_BAR __builtin_amdgcn_s_barrier()
#define PG8_SCHED __builtin_amdgcn_sched_barrier(0)
    Unit cur, nxt; int ui = 0;
    if (!S.next(0, cur)) return;
    f32x4 acc[2][2][4][2];
#pragma unroll
    for (int a = 0; a < 2; ++a)
#pragma unroll
        for (int b = 0; b < 2; ++b)
#pragma unroll
            for (int m = 0; m < 4; ++m)
#pragma unroll
                for (int n = 0; n < 2; ++n) acc[a][b][m][n] = (f32x4){0.f, 0.f, 0.f, 0.f};
    bf16x8 At[4][2], B0[2][2], B1[2][2];
    const char* cA = (const char*)g.A + (size_t)cur.pm * tstepA; const char* cB = (const char*)g.Bt + (size_t)cur.e * g.bstride + (size_t)cur.pn * tstepB;
    PG8_STAGE(PG8_SB(0, 0), cB, voffB); PG8_STAGE(PG8_SB(0, 1), cB + hstepB, voffB); PG8_STAGE(PG8_SA(0, 0), cA, voffA); PG8_STAGE(PG8_SA(0, 1), cA + hstepA, voffA);
    if (wr == 1) PG8_BAR;
    PG8_WAIT_V(2); PG8_BAR;
    PG8_STAGE(PG8_SB(1, 0), cB + kstep, voffB); PG8_STAGE(PG8_SA(1, 0), cA + kstep, voffA); PG8_STAGE(PG8_SB(1, 1), cB + hstepB + kstep, voffB);
    PG8_WAIT_V(6); PG8_BAR;
    for (;;) {
        const bool has_next = S.next(ui + 1, nxt);
        const char* nA = has_next ? (const char*)g.A + (size_t)nxt.pm * tstepA : cA; const char* nB = has_next ? (const char*)g.Bt + (size_t)nxt.e * g.bstride + (size_t)nxt.pn * tstepB : cB;
#pragma unroll 1
        for (int t = 0; t < nt; t += 2) {
            const bool last = (t == nt - 2);
            const char* a1 = cA + (size_t)(t + 1) * kstep;
            const char* a2 = last ? nA : cA + (size_t)(t + 2) * kstep; const char* b2 = last ? nB : cB + (size_t)(t + 2) * kstep;
            const char* a3 = a2 + kstep; const char* b3 = b2 + kstep;
            PG8_LDB(B0, 0, 0); PG8_LDB(B1, 0, 1); PG8_SCHED; PG8_LDA(At, 0, 0); PG8_STAGE(PG8_SA(1, 1), a1 + hstepA, voffA);
            PG8_WAIT_V(8); PG8_WAIT_L(0); PG8_BAR; PG8_MMA(0, 0, At, B0); PG8_MMA(0, 1, At, B1); PG8_BAR; PG8_SCHED;
            PG8_LDA(At, 0, 1); PG8_STAGE(PG8_SB(0, 0), b2, voffB); PG8_STAGE(PG8_SB(0, 1), b2 + hstepB, voffB); PG8_STAGE(PG8_SA(0, 0), a2, voffA);
            PG8_WAIT_V(8); PG8_WAIT_L(0); PG8_BAR; PG8_MMA(1, 0, At, B0); PG8_MMA(1, 1, At, B1); PG8_BAR; PG8_SCHED;
            PG8_LDB(B0, 1, 0); PG8_LDB(B1, 1, 1); PG8_SCHED; PG8_LDA(At, 1, 0); PG8_STAGE(PG8_SA(0, 1), a2 + hstepA, voffA);
            PG8_WAIT_V(8); PG8_WAIT_L(0); PG8_BAR; PG8_MMA(0, 0, At, B0); PG8_MMA(0, 1, At, B1); PG8_BAR; PG8_SCHED;
            PG8_LDA(At, 1, 1); PG8_STAGE(PG8_SB(1, 0), b3, voffB); PG8_STAGE(PG8_SB(1, 1), b3 + hstepB, voffB); PG8_STAGE(PG8_SA(1, 0), a3, voffA);
            PG8_WAIT_V(8); PG8_WAIT_L(0); PG8_BAR; PG8_MMA(1, 0, At, B0); PG8_MMA(1, 1, At, B1); PG8_BAR; PG8_SCHED;
        }
        if (wr == 0) PG8_BAR;
        E(acc, cur, wr, wc, fr, fq);
        if (!has_next) break;
#pragma unroll
        for (int a = 0; a < 2; ++a)
#pragma unroll
            for (int b = 0; b < 2; ++b)
#pragma unroll
                for (int m = 0; m < 4; ++m)
#pragma unroll
                    for (int n = 0; n < 2; ++n) acc[a][b][m][n] = (f32x4){0.f, 0.f, 0.f, 0.f};
        cur = nxt; cA = nA; cB = nB; ++ui;
        if (wr == 1) PG8_BAR;
    }
    PG8_WAIT_V(0);
    PG8_BAR;
#undef PG8_SA
#undef PG8_SB
#undef PG8_STAGE
#undef PG8_LDA
#undef PG8_LDB
#undef PG8_MMA
#undef PG8_WAIT_V
#undef PG8_WAIT_L
#undef PG8_BAR
#undef PG8_SCHED
}
#else
DEV unsigned cvt_pk_bf16(float lo, float hi) { return pk2(lo, hi); }
template <class Epi, class Sched>
DEV void gemm_phase(unsigned char*, const int tid, const Gemm g, const Sched& S, const Epi& E) {
    const int wid = tid >> 6, lane = tid & 63, wr = wid >> 2, wc = wid & 3, fr = lane & 15, fq = lane >> 4;
    Unit u;
    for (int ui = 0; S.next(ui, u); ++ui) {
        f32x4 acc[2][2][4][2];
        const bf16* Bt = (const bf16*)((const char*)g.Bt + (size_t)u.e * g.bstride);
        for (int ai = 0; ai < 2; ++ai) for (int bj = 0; bj < 2; ++bj) for (int m = 0; m < 4; ++m) for (int n = 0; n < 2; ++n) for (int j = 0; j < 4; ++j) {
            const size_t row = (size_t)u.pm * 256 + 128 * ai + 64 * wr + 16 * m + fr;
            const size_t col = (size_t)u.pn * 256 + 128 * bj + 32 * wc + (Epi::PERM ? 8 * fq + 4 * n + j : 16 * n + 4 * fq + j);
            const bf16* a = g.A + row * g.lda; const bf16* b = Bt + col * g.K; float s = 0.f;
            for (int k = 0; k < g.K; ++k) s += bf2f(a[k]) * bf2f(b[k]);
            acc[ai][bj][m][n][j] = s; }
        E(acc, u, wr, wc, fr, fq);
    }
}
#endif
}

using pg8::Unit;
struct EpiStore {
    static constexpr bool PERM = true;
    bf16* O; int ldc; float* gates;
    DEV void operator()(const f32x4 (&acc)[2][2][4][2], const Unit& u, int wr, int wc, int fr, int fq) const {
        const int row0 = u.pm * 256 + wr * 64 + fr, col0 = u.pn * 256 + wc * 32 + 8 * fq;
        const bool dog = gates != nullptr && u.pn == C_G / 256 && wc == 0 && fq < 2;
#pragma unroll
        for (int ai = 0; ai < 2; ++ai)
#pragma unroll
            for (int m = 0; m < 4; ++m) { const int row = row0 + ai * 128 + m * 16; bf16* rowp = O + (size_t)row * ldc + col0;
#pragma unroll
                for (int bj = 0; bj < 2; ++bj) { const f32x4 v0 = acc[ai][bj][m][0], v1 = acc[ai][bj][m][1];
                    u32x4 w; w.x = pg8::cvt_pk_bf16(v0[0], v0[1]); w.y = pg8::cvt_pk_bf16(v0[2], v0[3]); w.z = pg8::cvt_pk_bf16(v1[0], v1[1]); w.w = pg8::cvt_pk_bf16(v1[2], v1[3]);
                    *(u32x4*)(rowp + bj * 128) = w;
                    if (bj == 0 && dog) { float* gp = gates + (size_t)row * 16 + 8 * fq; *(f32x4*)gp = v0; *(f32x4*)(gp + 4) = v1; } } }
    }
};
struct EpiResid {
    static constexpr bool PERM = false;
    P p; int l, goff;
    DEV void operator()(const f32x4 (&acc)[2][2][4][2], const Unit& u, int wr, int wc, int fr, int fq) const {
        const int R0 = u.pm * 256; float* xb = resid_row(p, R0); const float* gv = modv(p, l, R0) + goff;
        const int col0 = u.pn * 256 + wc * 32 + 4 * fq;
#pragma unroll
        for (int bj = 0; bj < 2; ++bj)
#pragma unroll
            for (int n = 0; n < 2; ++n) { const int col = col0 + bj * 128 + n * 16; const f32x4 g = *(const f32x4*)(gv + col);
#pragma unroll
                for (int ai = 0; ai < 2; ++ai)
#pragma unroll
                    for (int m = 0; m < 4; ++m) { f32x4* xp = (f32x4*)(xb + (size_t)(wr * 64 + fr + ai * 128 + m * 16) * D_MODEL + col); *xp = *xp + g * acc[ai][bj][m][n]; } }
    }
};
struct EpiSwiglu {
    static constexpr bool PERM = true;
    bf16* O; int pm_base;
    DEV void operator()(const f32x4 (&acc)[2][2][4][2], const Unit& u, int wr, int wc, int fr, int fq) const {
        const int row0 = (u.pm - pm_base) * 256 + wr * 64 + fr, col0 = u.pn * 128 + wc * 32 + 8 * fq;
#pragma unroll
        for (int ai = 0; ai < 2; ++ai)
#pragma unroll
            for (int m = 0; m < 4; ++m) { float r[8];
#pragma unroll
                for (int n = 0; n < 2; ++n)
#pragma unroll
                    for (int j = 0; j < 4; ++j) r[4 * n + j] = silu_fast(acc[ai][0][m][n][j]) * acc[ai][1][m][n][j];
                u32x4 w; w.x = pg8::cvt_pk_bf16(r[0], r[1]); w.y = pg8::cvt_pk_bf16(r[2], r[3]); w.z = pg8::cvt_pk_bf16(r[4], r[5]); w.w = pg8::cvt_pk_bf16(r[6], r[7]);
                *(u32x4*)(O + (size_t)(row0 + ai * 128 + m * 16) * D_FF + col0) = w; }
    }
};
struct EpiMoeDown {
    static constexpr bool PERM = false;
    P p; int pm_base;
    DEV void operator()(const f32x4 (&acc)[2][2][4][2], const Unit& u, int wr, int wc, int fr, int fq) const {
        const int* stok = (const int*)(p.ws + WS_STOK); const float* sw = (const float*)(p.ws + WS_SW);
        const int col0 = u.pn * 256 + wc * 32 + 4 * fq;
#pragma unroll
        for (int ai = 0; ai < 2; ++ai)
#pragma unroll
            for (int m = 0; m < 4; ++m) { const int slot = (pm_base + u.pm) * 256 + wr * 64 + fr + ai * 128 + m * 16; const int tok = stok[slot];
                if (tok >= 0) { const float w = sw[slot]; const int b = tok / SEQ; float* xr = p.out + (size_t)tok * D_MODEL;
                    const float* gv = (const float*)(p.ws + WS_MODV) + (size_t)(1 * NV + b) * 6 * D_MODEL + 5 * D_MODEL;
#pragma unroll
                    for (int bj = 0; bj < 2; ++bj)
#pragma unroll
                        for (int n = 0; n < 2; ++n) { const int col = col0 + bj * 128 + n * 16;
#pragma unroll
                            for (int j = 0; j < 4; ++j) atomic_addf(xr + col + j, gv[col + j] * w * acc[ai][bj][m][n][j]); } } }
    }
};
struct Sched {
    pg8::Order o; int mode, pm_base; const int* seg;
    DEV bool next(int i, Unit& u) const {
        int lm, ln; if (!o.nextL(i, lm, ln)) return false;
        u.pn = ln; u.e = 0;
        if (mode == 0) u.pm = lm;
        else if (mode == 1) u.pm = (lm / NQL) * PAN_B + 1 + lm % NQL;
        else { const int gp = pm_base + lm; int e = 0;
#pragma unroll
            for (int k = 1; k < NEXP; ++k) e += (seg[k] <= gp) ? 1 : 0;
            u.e = e; u.pm = (mode == 2) ? gp : lm; }
        return true;
    }
};

#ifndef EMU
#define XB_TMO      128
#define XB_XCNT(j)  (256  + 64 * (j))
#define XB_XSUB(j)  (1280 + 64 * (j))
#define XB_XGEN(j)  (2304 + 64 * (j))
#define XB_TOP      3328
#define XB_TOPGEN   3392
#define XCD_BAR_WORDS 3456
#define XB_SPIN_CAP (1u << 22)
#define LAS __attribute__((address_space(3)))
__device__ __forceinline__ unsigned xb_ld(unsigned* p)              { return __hip_atomic_load(p, __ATOMIC_RELAXED, __HIP_MEMORY_SCOPE_AGENT); }
__device__ __forceinline__ unsigned xb_add(unsigned* p, unsigned v) { return __hip_atomic_fetch_add(p, v, __ATOMIC_RELAXED, __HIP_MEMORY_SCOPE_AGENT); }
__device__ __forceinline__ unsigned xb_xcc_id() { return (unsigned)__builtin_amdgcn_s_getreg((3 << 11) | 20) & 0xFu; }
#define XB_SPIN(cond, bar) do { unsigned _sp = 0; while (cond) { __builtin_amdgcn_s_sleep(1); \
    if ((++_sp & 255u) == 0u) { if (xb_ld(&(bar)[XB_TMO])) break; if (_sp > XB_SPIN_CAP) { atomicAdd(&(bar)[XB_TMO], 1u); break; } } } } while (0)
struct XcdBarrier { unsigned* bar; unsigned x; volatile LAS unsigned* st; };
__device__ __forceinline__ XcdBarrier xcd_barrier_post(unsigned* bar, volatile LAS unsigned* st) {
    XcdBarrier b; b.bar = bar; b.x = xb_xcc_id(); b.st = st;
    if (threadIdx.x == 0) (void)xb_add(&bar[XB_XCNT(b.x)], 1u);
    return b;
}
__device__ __forceinline__ void xcd_barrier_complete(unsigned* bar, unsigned x, unsigned& nloc, unsigned& nx) {
    const unsigned G = gridDim.x * gridDim.y * gridDim.z;
    unsigned sum, cnt, mine, sp = 0u;
    for (;;) {
        sum = 0u; cnt = 0u; mine = 0u;
#pragma unroll
        for (unsigned j = 0; j < 16; ++j) { const unsigned c = xb_ld(&bar[XB_XCNT(j)]); sum += c; cnt += (c > 0u) ? 1u : 0u; mine = (j == x) ? c : mine; }
        if (sum == G) break;
        __builtin_amdgcn_s_sleep(1);
        if ((++sp & 255u) == 0u) { if (xb_ld(&bar[XB_TMO])) break; if (sp > XB_SPIN_CAP) { atomicAdd(&bar[XB_TMO], 1u); break; } }
    }
    nloc = mine > 0u ? mine : 1u; nx = cnt > 0u ? cnt : 1u;
}
__device__ __forceinline__ void xcd_barrier(const XcdBarrier& b) {
    asm volatile("s_waitcnt vmcnt(0)" ::: "memory");
    __syncthreads();
    if (threadIdx.x == 0) {
        unsigned* bar = b.bar;
        __builtin_amdgcn_s_waitcnt(0);
        unsigned nloc = b.st[0], nx = b.st[1];
        if (nloc == 0u) { xcd_barrier_complete(bar, b.x, nloc, nx); b.st[0] = nloc; b.st[1] = nx; }
        const unsigned old = xb_add(&bar[XB_XSUB(b.x)], 1u);
        const unsigned gen = old / nloc;
        if (old + 1u == (gen + 1u) * nloc) {
            __builtin_amdgcn_fence(__ATOMIC_RELEASE, "agent");
            asm volatile("s_waitcnt vmcnt(0)" ::: "memory");
            const unsigned og = xb_add(&bar[XB_TOP], 1u);
            const unsigned tg = og / nx;
            if (og + 1u == (tg + 1u) * nx) xb_add(&bar[XB_TOPGEN], 1u);
            else XB_SPIN(xb_ld(&bar[XB_TOPGEN]) == tg, bar);
            __builtin_amdgcn_fence(__ATOMIC_ACQUIRE, "agent");
            xb_add(&bar[XB_XGEN(b.x)], 1u);
            asm volatile("s_waitcnt vmcnt(0)" ::: "memory");
        } else {
            XB_SPIN(xb_ld(&bar[XB_XGEN(b.x)]) == gen, bar);
            __builtin_amdgcn_fence(__ATOMIC_ACQUIRE, "agent");
            asm volatile("s_waitcnt vmcnt(0)" ::: "memory");
        }
    }
    __syncthreads();
}
#endif

struct Wg { int tid, lane, wave, G, wg, gw, NGW; unsigned char* lds; unsigned* misc; };
DEV int q_next(Wg& w, unsigned* ctr) {
    if (w.tid == 0) w.misc[2] = atomicAdd(ctr, 1u);
    __syncthreads();
    const int v = (int)w.misc[2];
    __syncthreads();
    return v;
}

DEV void conv_tile(const float* src, int N, int k0, int n0, bf16* dst, int ldk, int kdst0, int rowofs, int mode, float* scr, int tid) {
#pragma unroll
    for (int i = 0; i < 8; ++i) { const int kk = i * 8 + (tid >> 6), nn = tid & 63; scr[kk * 65 + nn] = (n0 + nn < N) ? src[(size_t)(k0 + kk) * N + n0 + nn] : 0.f; }
    __syncthreads();
    { const int n = tid >> 3, c = tid & 7, ng = n0 + n; const float* s = scr + (8 * c) * 65 + n;
      const int row = rowofs + (mode == 0 ? ng : (ng / 128) * 256 + (ng % 128) + (mode == 2 ? 128 : 0));
      u32x4 o; o.x = pk2(s[0], s[65]); o.y = pk2(s[2 * 65], s[3 * 65]); o.z = pk2(s[4 * 65], s[5 * 65]); o.w = pk2(s[6 * 65], s[7 * 65]);
      *(u32x4*)(dst + (size_t)row * ldk + kdst0 + k0 + 8 * c) = o; }
    __syncthreads();
}
struct ConvJob { const float* src; int K, N, Npad; bf16* dst; int ldk, kdst0, rowofs, mode; };
DEV bool conv_job_run(const ConvJob& j, int& it, float* scr, int tid) {
    const int nkb = j.K / 64, nnb = j.Npad / 64, tot = nkb * nnb;
    if (it >= tot) { it -= tot; return false; }
    conv_tile(j.src, j.N, (it / nnb) * 64, (it % nnb) * 64, j.dst, j.ldk, j.kdst0, j.rowofs, j.mode, scr, tid);
    return true;
}
DEV void zero_rect(bf16* dst, int ld, int r0, int r1, int c0, int c1, int gtid, int gn) {
    const int cw = (c1 - c0) / 8; const long tot = (long)(r1 - r0) * cw;
    for (long i = gtid; i < tot; i += gn) { const int r = r0 + (int)(i / cw), c = c0 + 8 * (int)(i % cw); *(u32x4*)(dst + (size_t)r * ld + c) = (u32x4){0u, 0u, 0u, 0u}; }
}
DEV void phase0(const P& p, Wg& w) {
    float* scr = (float*)w.lds;
    {
        bf16* WIN = (bf16*)(p.ws + WS_WIN_T); bf16* WOUT = (bf16*)(p.ws + WS_WOUT_T); bf16* MLT = (bf16*)(p.ws + WS_MLA_T);
#define JOB_WIN(l) ConvJob{p.w_in + (size_t)(l) * D_MODEL * IN_W, D_MODEL, IN_W, PROJ_W, WIN + (size_t)(l) * PROJ_W * D_MODEL, D_MODEL, 0, 0, 0}
#define JOB_WOUT(l) ConvJob{p.w_out + (size_t)(l) * MIXW * D_MODEL, MIXW, D_MODEL, D_MODEL, WOUT + (size_t)(l) * D_MODEL * MIXW, MIXW, 0, 0, 0}
#define JOB_WUQ(l) ConvJob{p.l_wuq + (size_t)(l) * 256 * 384, 256, 384, 384, MLT + (size_t)(l) * 1024 * 384, 384, 0, 0, 0}
#define JOB_WUKV(l) ConvJob{p.l_wukv + (size_t)(l) * 128 * 512, 128, 512, 512, MLT + (size_t)(l) * 1024 * 384, 384, 256, 384, 0}
        constexpr int total = 2 * ((D_MODEL / 64) * (PROJ_W / 64) + (MIXW / 64) * (D_MODEL / 64) + 4 * 6 + 2 * 8) + 2 * (D_MODEL / 64) * (D_FF / 64) + (D_FF / 64) * (D_MODEL / 64);
        for (int it0 = w.wg; it0 < total; it0 += w.G) { int it = it0;
            if (conv_job_run(JOB_WIN(0), it, scr, w.tid)) continue;
            if (conv_job_run(JOB_WIN(1), it, scr, w.tid)) continue;
            if (conv_job_run(JOB_WOUT(0), it, scr, w.tid)) continue;
            if (conv_job_run(JOB_WOUT(1), it, scr, w.tid)) continue;
            if (conv_job_run(JOB_WUQ(0), it, scr, w.tid)) continue;
            if (conv_job_run(JOB_WUQ(1), it, scr, w.tid)) continue;
            if (conv_job_run(JOB_WUKV(0), it, scr, w.tid)) continue;
            if (conv_job_run(JOB_WUKV(1), it, scr, w.tid)) continue;
            if (conv_job_run(ConvJob{p.ffn_wg, D_MODEL, D_FF, D_FF, (bf16*)(p.ws + WS_WGU_T), D_MODEL, 0, 0, 1}, it, scr, w.tid)) continue;
            if (conv_job_run(ConvJob{p.ffn_wu, D_MODEL, D_FF, D_FF, (bf16*)(p.ws + WS_WGU_T), D_MODEL, 0, 0, 2}, it, scr, w.tid)) continue;
            conv_job_run(ConvJob{p.ffn_wd, D_FF, D_MODEL, D_MODEL, (bf16*)(p.ws + WS_WD_T), D_FF, 0, 0, 0}, it, scr, w.tid);
        }
    }
    for (int l = 0; l < 2; ++l) { bf16* mt = (bf16*)(p.ws + WS_MLA_T) + (size_t)l * 1024 * 384; const int gt = w.wg * NTHR + w.tid, gn = w.G * NTHR;
        zero_rect(mt, 384, 0, 384, 256, 384, gt, gn); zero_rect(mt, 384, 384, 896, 0, 256, gt, gn); zero_rect(mt, 384, 896, 1024, 0, 384, gt, gn); }
    {
        float* sS = (float*)w.lds;
        float* part = sS + NV * D_MODEL;
        const int nitem = 2 * (6 * D_MODEL / 64);
        bool loaded = false;
        for (int it = w.wg; it < nitem; it += w.G) {
            if (!loaded) { for (int i = w.tid; i < NV * D_MODEL; i += NTHR) { const int v = i / D_MODEL, k = i % D_MODEL; sS[i] = silu_f(v < BATCH ? p.c[v * D_MODEL + k] : p.c_ctx[k]); } loaded = true; __syncthreads(); }
            const int l = it / (6 * D_MODEL / 64), cb = it % (6 * D_MODEL / 64), col = cb * 64 + w.lane;
            float acc[NV];
#pragma unroll
            for (int v = 0; v < NV; ++v) acc[v] = 0.f;
            const float* mw = p.mod_w + (size_t)l * D_MODEL * 6 * D_MODEL + col;
            for (int k = w.wave * (D_MODEL / 8); k < (w.wave + 1) * (D_MODEL / 8); ++k) { const float wv = mw[(size_t)k * 6 * D_MODEL];
#pragma unroll
                for (int v = 0; v < NV; ++v) acc[v] += sS[v * D_MODEL + k] * wv; }
#pragma unroll
            for (int v = 0; v < NV; ++v) part[(w.wave * NV + v) * 64 + w.lane] = acc[v];
            __syncthreads();
            for (int i = w.tid; i < NV * 64; i += NTHR) { const int v = i / 64, cc = i % 64; float s = p.mod_b[(size_t)l * 6 * D_MODEL + cb * 64 + cc];
#pragma unroll
                for (int ww = 0; ww < 8; ++ww) s += part[(ww * NV + v) * 64 + cc];
                ((float*)(p.ws + WS_MODV))[(size_t)(l * NV + v) * 6 * D_MODEL + cb * 64 + cc] = s; }
            __syncthreads();
        }
    }
}
DEV void phase_moe_weights(const P& p, Wg& w) {
    float* scr = (float*)w.lds;
    const int t_gu = (D_MODEL / 64) * (D_FF / 64), t_d = (D_FF / 64) * (D_MODEL / 64), per_e = 2 * t_gu + t_d;
    for (int it0 = w.wg; it0 < NEXP * per_e; it0 += w.G) {
        const int e = it0 / per_e; int it = it0 % per_e;
        bf16* base = (bf16*)(p.ws + WS_MOEW + (size_t)e * MOEW_E);
        const ConvJob jg{p.moe_wg + (size_t)e * D_MODEL * D_FF, D_MODEL, D_FF, D_FF, base, D_MODEL, 0, 0, 1};
        const ConvJob ju{p.moe_wu + (size_t)e * D_MODEL * D_FF, D_MODEL, D_FF, D_FF, base, D_MODEL, 0, 0, 2};
        const ConvJob jd{p.moe_wd + (size_t)e * D_FF * D_MODEL, D_FF, D_MODEL, D_MODEL, base + (size_t)2 * D_FF * D_MODEL, D_FF, 0, 0, 0};
        if (conv_job_run(jg, it, scr, w.tid)) continue;
        if (conv_job_run(ju, it, scr, w.tid)) continue;
        conv_job_run(jd, it, scr, w.tid);
    }
}

DEV void phase_modulate(const P& p, Wg& w, int l, int which, bool first, bool skip_ctx, bool moe) {
    constexpr int NJ = D_MODEL / 256;
    bf16* H = (bf16*)(p.ws + WS_H);
    const float* gn = (which ? p.norm_ffn : p.norm_mix) + (size_t)l * D_MODEL;
    int cnt[NEXP];
#pragma unroll
    for (int e = 0; e < NEXP; ++e) cnt[e] = 0;
    for (int R = w.gw; R < M_ALL; R += w.NGW) {
        const int b = R / TP, q = R % TP;
        if (skip_ctx && q < CTX) continue;
        float* xr = resid_row(p, R);
        const float* src = first ? (q < CTX ? p.ctx + (size_t)(b * CTX + q) * D_MODEL : p.x + (size_t)(b * SEQ + q - CTX) * D_MODEL) : xr;
        f32x4 v[NJ]; float ss = 0.f;
#pragma unroll
        for (int j = 0; j < NJ; ++j) { v[j] = *(const f32x4*)(src + 4 * w.lane + 256 * j); ss += v[j][0] * v[j][0] + v[j][1] * v[j][1] + v[j][2] * v[j][2] + v[j][3] * v[j][3]; }
        ss = wave_sum(ss);
        const float rstd = 1.0f / sqrtf(ss * (1.0f / D_MODEL) + EPS);
        const float* mv = modv(p, l, R); const float* sh = mv + (which ? 3 : 0) * D_MODEL; const float* sc = mv + (which ? 4 : 1) * D_MODEL;
        float lg[NEXP];
#pragma unroll
        for (int e = 0; e < NEXP; ++e) lg[e] = 0.f;
#pragma unroll
        for (int j = 0; j < NJ; ++j) { const int col = 4 * w.lane + 256 * j;
            if (first) *(f32x4*)(xr + col) = v[j];
            const f32x4 g = *(const f32x4*)(gn + col), s1 = *(const f32x4*)(sc + col), s0 = *(const f32x4*)(sh + col);
            f32x4 h;
#pragma unroll
            for (int k = 0; k < 4; ++k) h[k] = v[j][k] * rstd * g[k] * (1.0f + s1[k]) + s0[k];
            u32x2 o; o.x = pk2(h[0], h[1]); o.y = pk2(h[2], h[3]);
            *(u32x2*)(H + (size_t)R * D_MODEL + col) = o;
            if (moe) {
#pragma unroll
                for (int k = 0; k < 4; ++k) { const float* rr = p.moe_router + (size_t)(col + k) * NEXP;
#pragma unroll
                    for (int e = 0; e < NEXP; ++e) lg[e] += h[k] * rr[e]; } } }
        if (moe) {
#pragma unroll
            for (int e = 0; e < NEXP; ++e) lg[e] = wave_sum(lg[e]);
            int i1 = 0; float v1 = lg[0];
#pragma unroll
            for (int e = 1; e < NEXP; ++e) if (lg[e] > v1) { v1 = lg[e]; i1 = e; }
            int i2 = -1; float v2 = -3.0e38f;
#pragma unroll
            for (int e = 0; e < NEXP; ++e) if (e != i1 && lg[e] > v2) { v2 = lg[e]; i2 = e; }
            const float w1 = 1.0f / (1.0f + expf(v2 - v1)), w2 = 1.0f - w1;
            const int tok = b * SEQ + q - CTX;
            if (w.lane == 0) { int* ti = (int*)(p.ws + WS_TOPI) + 2 * tok; float* tw = (float*)(p.ws + WS_TOPW) + 2 * tok; ti[0] = i1; ti[1] = i2; tw[0] = w1; tw[1] = w2; }
#pragma unroll
            for (int e = 0; e < NEXP; ++e) cnt[e] += (e == i1 || e == i2) ? 1 : 0;
        }
    }
    if (moe) {
        int* lc = (int*)w.lds;
        if (w.lane == 0) {
#pragma unroll
            for (int e = 0; e < NEXP; ++e) lc[w.wave * NEXP + e] = cnt[e]; }
        __syncthreads();
        if (w.tid < NEXP) { int s = 0; for (int ww = 0; ww < NWAVE; ++ww) s += lc[ww * NEXP + w.tid]; ((int*)(p.ws + WS_CNTG))[w.wg * NEXP + w.tid] = s; }
        __syncthreads();
    }
}

DEV void phase_prep(const P& p, Wg& w, int l) {
    bf16* PROJ = (bf16*)(p.ws + WS_PROJ); bf16* MQK = (bf16*)(p.ws + WS_MQK);
    const float* cw = p.m_conv + (size_t)l * 3 * 768;
    const int lane = w.lane;
    for (int R = w.gw; R < M_ALL; R += w.NGW) {
        const int q = R % TP; const bool lat = q >= CTX; const int t = q - CTX;
        bf16* pr = PROJ + (size_t)R * PROJ_W;
        const bool hp = !(q == 0 || q == CTX), hn = !(q == CTX - 1 || q == TP - 1);
#pragma unroll
        for (int j = 0; j < 3; ++j) { const int col = 4 * lane + 256 * j;
            const u32x2 c0 = *(const u32x2*)(pr + col);
            u32x2 cp = (u32x2){0u, 0u}, cn = (u32x2){0u, 0u};
            if (hp) cp = *(const u32x2*)(pr - PROJ_W + col);
            if (hn) cn = *(const u32x2*)(pr + PROJ_W + col);
            const f32x4 w0 = *(const f32x4*)(cw + col), w1 = *(const f32x4*)(cw + 768 + col), w2 = *(const f32x4*)(cw + 1536 + col);
            float o[4];
#pragma unroll
            for (int k = 0; k < 4; ++k) { const unsigned sh = (k & 1) * 16; const unsigned a = (k < 2 ? cp.x : cp.y) >> sh, c = (k < 2 ? c0.x : c0.y) >> sh, n = (k < 2 ? cn.x : cn.y) >> sh;
                const float s = bf2f((bf16)a) * w0[k] + bf2f((bf16)c) * w1[k] + bf2f((bf16)n) * w2[k]; o[k] = silu_f(s) * (col >= 384 ? KSCALE_M : 1.0f); }
            u32x2 ov; ov.x = pk2(o[0], o[1]); ov.y = pk2(o[2], o[3]);
            *(u32x2*)(MQK + (size_t)R * 768 + col) = ov; }
        float csA = 1.f, snA = 0.f, csL = 1.f, snL = 0.f;
        if (lat) { const float rowp = (float)(t / GRID_W), colp = (float)(t % GRID_W);
            { const int f = lane & 15; const float inv = exp2f(-(float)f * (13.287712379549449f / 16.0f)); const float ang = (lane < 32 ? rowp : colp) * inv; sincosf(ang, &snA, &csA); }
            { const int d = lane & 31, f = d & 7; const float inv = exp2f(-(float)f * (13.287712379549449f / 8.0f)); const float ang = (d < 16 ? rowp : colp) * inv; sincosf(ang, &snL, &csL); } }
#pragma unroll
        for (int hq = 0; hq < 8; ++hq) { const int base = hq < 6 ? C_AQ + hq * 64 : C_AK + (hq - 6) * 64;
            const float g = (hq < 6 ? p.a_qnorm : p.a_knorm)[l * 64 + lane];
            const float v = bf2f(pr[base + lane]); const float ss = wave_sum(v * v);
            float y = v * (1.0f / sqrtf(ss * (1.0f / 64.0f) + EPS)) * g;
            const float pt = __shfl_xor(y, 16);
            if (lat) y = (lane & 16) ? y * csA + pt * snA : y * csA - pt * snA;
            if (hq < 6) y *= QSCALE_A;
            pr[base + lane] = f2bf(y); }
        { const u32x2 cv = *(const u32x2*)(pr + C_CQ + 4 * lane); float x[4] = {bf2f((bf16)cv.x), bf2f((bf16)(cv.x >> 16)), bf2f((bf16)cv.y), bf2f((bf16)(cv.y >> 16))};
          const float ss = wave_sum(x[0] * x[0] + x[1] * x[1] + x[2] * x[2] + x[3] * x[3]); const float rs = 1.0f / sqrtf(ss * (1.0f / 256.0f) + EPS);
          const f32x4 g = *(const f32x4*)(p.l_cq_norm + l * 256 + 4 * lane);
          u32x2 o; o.x = pk2(x[0] * rs * g[0], x[1] * rs * g[1]); o.y = pk2(x[2] * rs * g[2], x[3] * rs * g[3]); *(u32x2*)(pr + C_CQ + 4 * lane) = o; }
        { const unsigned cv = *(const unsigned*)(pr + C_CKV + 2 * lane); const float x0 = bf2f((bf16)cv), x1 = bf2f((bf16)(cv >> 16));
          const float ss = wave_sum(x0 * x0 + x1 * x1); const float rs = 1.0f / sqrtf(ss * (1.0f / 128.0f) + EPS);
          const float g0 = p.l_ckv_norm[l * 128 + 2 * lane], g1 = p.l_ckv_norm[l * 128 + 2 * lane + 1];
          *(unsigned*)(pr + C_CKV + 2 * lane) = pk2(x0 * rs * g0, x1 * rs * g1); }
        { const float v = lane < 32 ? bf2f(pr[C_KR + lane]) : 0.f; const float ss = wave_sum(v * v);
          float y = v * (1.0f / sqrtf(ss * (1.0f / 32.0f) + EPS)) * p.l_knorm[l * 96 + 64 + (lane & 31)];
          const float pt = __shfl_xor(y, 8);
          if (lat) y = (lane & 8) ? y * csL + pt * snL : y * csL - pt * snL;
          if (lane < 32) pr[C_KR + lane] = f2bf(y); }
    }
}

DEV float scan_add(float v, int lane) {
#pragma unroll
    for (int d = 1; d < 64; d <<= 1) { const float t = __shfl(v, lane >= d ? lane - d : lane); if (lane >= d) v += t; }
    return v;
}
DEV float scan_max(float v, int lane) {
#pragma unroll
    for (int d = 1; d < 64; d <<= 1) { const float t = __shfl(v, lane >= d ? lane - d : lane); if (lane >= d) v = fmaxf(v, t); }
    return v;
}
DEV int chain_step(int dir, int cl) { return dir == 0 ? cl : (cl < NC_CTX ? NC_CTX - 1 - cl : NCH + NC_CTX - 1 - cl); }
DEV void gate_scan(const P& p, int l, int R0, int hh, int dir, int lane, float& bc, float& a) {
    const int o = dir ? 63 - lane : lane;
    const float* G = (const float*)(p.ws + WS_GATES) + (size_t)(R0 + o) * 16; const float* gb = p.m_gate_b + l * 16;
    const float gi = G[dir * 8 + hh] + gb[dir * 8 + hh], gf = G[dir * 8 + 4 + hh] + gb[dir * 8 + 4 + hh];
    bc = scan_add(log_sigmoid_f(gf), lane); a = gi - bc;
}
DEV void ml1_item(const P& p, Wg& w, int l, int item) {
    const int b = item / (4 * NCH), hh = (item / NCH) % 4, cl = item % NCH, R0 = b * TP + cl * 64;
    float* wgt = (float*)w.lds;
    bf16* Kw = (bf16*)(w.lds + 512);
    bf16* Vt = Kw + 2 * 96 * 72;
    const bf16* MQK = (const bf16*)(p.ws + WS_MQK); const bf16* PROJ = (const bf16*)(p.ws + WS_PROJ);
    bf16* UC = (bf16*)(p.ws + WS_UC); float* NL = (float*)(p.ws + WS_NL);
    const int lane = w.lane, r = lane & 31, h = lane >> 5;
    if (w.wave < 2) { const int dir = w.wave; float bc, a; gate_scan(p, l, R0, hh, dir, lane, bc, a);
        const float pml = wave_max(a), F = __shfl(bc, 63);
        wgt[dir * 64 + (dir ? 63 - lane : lane)] = __expf(a - pml);
        const int ci = ((b * 4 + hh) * 2 + dir) * NCH + chain_step(dir, cl);
        if (lane == 0) { ((float*)(p.ws + WS_FS))[ci] = F; ((float*)(p.ws + WS_PML))[ci] = pml; } }
    __syncthreads();
    for (int idx = w.tid; idx < 768; idx += NTHR) { const int s = idx / 12, c = idx % 12;
        const u32x4 kr = *(const u32x4*)(MQK + (size_t)(R0 + s) * 768 + 384 + hh * 96 + 8 * c), vr = *(const u32x4*)(PROJ + (size_t)(R0 + s) * PROJ_W + C_MV + hh * 96 + 8 * c);
        const float w0 = wgt[s], w1 = wgt[64 + s];
#pragma unroll
        for (int j = 0; j < 8; ++j) { const unsigned kw = kr[j >> 1] >> ((j & 1) * 16), vw = vr[j >> 1] >> ((j & 1) * 16); const float kv = bf2f((bf16)kw);
            Kw[(8 * c + j) * 72 + s] = f2bf(w0 * kv); Kw[(96 + 8 * c + j) * 72 + s] = f2bf(w1 * kv); Vt[(8 * c + j) * 72 + s] = (bf16)vw; } }
    __syncthreads();
    for (int task = w.wave; task < 18; task += NWAVE) { const int dir = task / 9, dt = (task % 9) / 3, et = task % 3;
        f32x16 acc;
#pragma unroll
        for (int i = 0; i < 16; ++i) acc[i] = 0.f;
#pragma unroll
        for (int ks = 0; ks < 4; ++ks) { const bf16x8 af = *(const bf16x8*)(Kw + (dir * 96 + 32 * dt + r) * 72 + 16 * ks + 8 * h), bfr = *(const bf16x8*)(Vt + (32 * et + r) * 72 + 16 * ks + 8 * h);
            acc = mfma32(af, bfr, acc); }
        const int ci = ((b * 4 + hh) * 2 + dir) * NCH + chain_step(dir, cl);
        bf16* up = UC + (size_t)ci * 9216 + (32 * et + r) * 96 + 32 * dt + 4 * h;
#pragma unroll
        for (int g = 0; g < 4; ++g) { u32x2 o; o.x = pk2(acc[4 * g], acc[4 * g + 1]); o.y = pk2(acc[4 * g + 2], acc[4 * g + 3]); *(u32x2*)(up + 8 * g) = o; } }
    if (w.tid < 192) { const int dir = w.tid / 96, d = w.tid % 96; float s = 0.f;
        for (int k = 0; k < 64; ++k) s += bf2f(Kw[(dir * 96 + d) * 72 + k]);
        NL[(size_t)(((b * 4 + hh) * 2 + dir) * NCH + chain_step(dir, cl)) * 96 + d] = s; }
    __syncthreads();
}
DEV void phase_ml2(const P& p, Wg& w) {
    constexpr int GPC = 1152 + 12;
    bf16* UC = (bf16*)(p.ws + WS_UC); float* NL = (float*)(p.ws + WS_NL);
    const float* FS = (const float*)(p.ws + WS_FS); const float* PML = (const float*)(p.ws + WS_PML); float* MST = (float*)(p.ws + WS_MST);
    for (int j = w.wg * NTHR + w.tid; j < NCHAIN * GPC; j += w.G * NTHR) {
        const int chain = j / GPC, g = j % GPC;
        float C[8], m = 0.f;
#pragma unroll
        for (int i = 0; i < 8; ++i) C[i] = 0.f;
        for (int k = 0; k < NCH; ++k) {
            const int ci = chain * NCH + k; const float F = FS[ci], pml = PML[ci], mx = fmaxf(m, pml), dec = __expf(m - mx), sc = __expf(pml - mx);
            if (g < 1152) { bf16* u = UC + (size_t)ci * 9216 + 8 * g; const u32x4 raw = *(const u32x4*)u;
                u32x4 st; st.x = pk2(C[0], C[1]); st.y = pk2(C[2], C[3]); st.z = pk2(C[4], C[5]); st.w = pk2(C[6], C[7]); *(u32x4*)u = st;
#pragma unroll
                for (int i = 0; i < 8; ++i) C[i] = dec * C[i] + sc * bf2f((bf16)(raw[i >> 1] >> ((i & 1) * 16)));
                if (g == 0) MST[ci] = m; }
            else { float* nl = NL + (size_t)ci * 96 + 8 * (g - 1152); const f32x4 r0 = *(const f32x4*)nl, r1 = *(const f32x4*)(nl + 4);
                *(f32x4*)nl = (f32x4){C[0], C[1], C[2], C[3]}; *(f32x4*)(nl + 4) = (f32x4){C[4], C[5], C[6], C[7]};
#pragma unroll
                for (int i = 0; i < 4; ++i) { C[i] = dec * C[i] + sc * r0[i]; C[4 + i] = dec * C[4 + i] + sc * r1[i]; } }
            m = F + mx;
        }
    }
}
DEV void ml3_pair(const P& p, Wg& w, int l, int pi) {
    const int lane = w.lane, r = lane & 31, h = lane >> 5, it = w.wave >> 2, dir = (w.wave >> 1) & 1, tq = w.wave & 1;
    const int item = 2 * pi + it, b = item / (4 * NCH), hh = (item / NCH) % 4, cl = item % NCH, R0 = b * TP + cl * 64;
    const int ci = ((b * 4 + hh) * 2 + dir) * NCH + chain_step(dir, cl);
    bf16* Vt = (bf16*)(w.lds + it * 40960);
    float* hx = (float*)(w.lds + it * 40960 + 13824);
    const bf16* MQK = (const bf16*)(p.ws + WS_MQK); const bf16* PROJ = (const bf16*)(p.ws + WS_PROJ);
    const bf16* UCi = (const bf16*)(p.ws + WS_UC) + (size_t)ci * 9216; const float* NLi = (const float*)(p.ws + WS_NL) + (size_t)ci * 96;
    for (int idx = (w.wave & 3) * 64 + lane; idx < 768; idx += 256) { const int s = idx / 12, c = idx % 12;
        const u32x4 vr = *(const u32x4*)(PROJ + (size_t)(R0 + s) * PROJ_W + C_MV + hh * 96 + 8 * c);
#pragma unroll
        for (int j = 0; j < 8; ++j) Vt[(8 * c + j) * 72 + s] = (bf16)(vr[j >> 1] >> ((j & 1) * 16)); }
    float bc, a; gate_scan(p, l, R0, hh, dir, lane, bc, a);
    const float pmx = scan_max(a, lane), m_st = ((const float*)(p.ws + WS_MST))[ci];
    const int t = 32 * tq + r, jt = dir ? 63 - t : t;
    const float mx_t = fmaxf(m_st, __shfl(pmx, jt)), bc_t = __shfl(bc, jt);
    float a_s[2][16];
#pragma unroll
    for (int kh = 0; kh < 2; ++kh)
#pragma unroll
        for (int i = 0; i < 16; ++i) { const int s = 32 * kh + crow(i, h); a_s[kh][i] = __shfl(a, dir ? 63 - s : s); }
    __syncthreads();
    bf16x8 qf[6]; float qn = 0.f;
#pragma unroll
    for (int ks = 0; ks < 6; ++ks) { qf[ks] = *(const bf16x8*)(MQK + (size_t)(R0 + t) * 768 + hh * 96 + 16 * ks + 8 * h);
        const f32x4 n0 = *(const f32x4*)(NLi + 16 * ks + 8 * h), n1 = *(const f32x4*)(NLi + 16 * ks + 8 * h + 4);
#pragma unroll
        for (int j = 0; j < 4; ++j) { qn += bf2f((bf16)qf[ks][j]) * n0[j]; qn += bf2f((bf16)qf[ks][4 + j]) * n1[j]; } }
    qn += __shfl_xor(qn, 32);
    f32x16 pw[2]; float rs = 0.f;
#pragma unroll
    for (int kh = 0; kh < 2; ++kh) {
        const bool skip = dir ? (kh < tq) : (kh > tq);
#pragma unroll
        for (int i = 0; i < 16; ++i) pw[kh][i] = 0.f;
        if (!skip) {
#pragma unroll
            for (int ks = 0; ks < 6; ++ks) { const bf16x8 kf = *(const bf16x8*)(MQK + (size_t)(R0 + 32 * kh + r) * 768 + 384 + hh * 96 + 16 * ks + 8 * h); pw[kh] = mfma32(kf, qf[ks], pw[kh]); }
#pragma unroll
            for (int i = 0; i < 16; ++i) { const int s = 32 * kh + crow(i, h); const bool ok = dir ? (s >= t) : (s <= t);
                const float wv = ok ? __expf(a_s[kh][i] - mx_t) * pw[kh][i] : 0.f; pw[kh][i] = wv; rs += wv; } }
    }
    rs += __shfl_xor(rs, 32);
    const float a_int = __expf(m_st - mx_t), den = a_int * qn + rs, inv = 1.0f / fmaxf(fabsf(den), __expf(-(bc_t + mx_t)));
    bf16x8 pb[2][2];
#pragma unroll
    for (int kh = 0; kh < 2; ++kh)
#pragma unroll
        for (int sp = 0; sp < 2; ++sp) { u32x4 u; u.x = pk2(pw[kh][8 * sp], pw[kh][8 * sp + 1]); u.y = pk2(pw[kh][8 * sp + 2], pw[kh][8 * sp + 3]); u.z = pk2(pw[kh][8 * sp + 4], pw[kh][8 * sp + 5]); u.w = pk2(pw[kh][8 * sp + 6], pw[kh][8 * sp + 7]);
            pb[kh][sp] = __builtin_bit_cast(bf16x8, u); }
    float hv[3][16];
#pragma unroll
    for (int et = 0; et < 3; ++et) { f32x16 o, oi;
#pragma unroll
        for (int i = 0; i < 16; ++i) { o[i] = 0.f; oi[i] = 0.f; }
#pragma unroll
        for (int kh = 0; kh < 2; ++kh)
#pragma unroll
            for (int sp = 0; sp < 2; ++sp) { const int base = 32 * kh + 16 * sp + 4 * h; const bf16* vp = Vt + (32 * et + r) * 72 + base;
                const s16x4 lo = *(const s16x4*)vp, hi = *(const s16x4*)(vp + 8);
                const bf16x8 vf = (bf16x8){lo[0], lo[1], lo[2], lo[3], hi[0], hi[1], hi[2], hi[3]};
                o = mfma32(vf, pb[kh][sp], o); }
#pragma unroll
        for (int ks = 0; ks < 6; ++ks) { const bf16x8 cf = *(const bf16x8*)(UCi + (32 * et + r) * 96 + 16 * ks + 8 * h); oi = mfma32(cf, qf[ks], oi); }
#pragma unroll
        for (int i = 0; i < 16; ++i) hv[et][i] = (a_int * oi[i] + o[i]) * inv; }
    if (dir == 1) {
#pragma unroll
        for (int et = 0; et < 3; ++et)
#pragma unroll
            for (int i = 0; i < 16; ++i) hx[t * 97 + 32 * et + crow(i, h)] = hv[et][i]; }
    __syncthreads();
    if (dir == 0) { float ss = 0.f;
#pragma unroll
        for (int et = 0; et < 3; ++et)
#pragma unroll
            for (int i = 0; i < 16; ++i) { hv[et][i] += hx[t * 97 + 32 * et + crow(i, h)]; ss += hv[et][i] * hv[et][i]; }
        ss += __shfl_xor(ss, 32);
        const float rstd = 1.0f / sqrtf(ss * (1.0f / 96.0f) + EPS);
        bf16* MIX = (bf16*)(p.ws + WS_H);
#pragma unroll
        for (int et = 0; et < 3; ++et)
#pragma unroll
            for (int g = 0; g < 4; ++g) { const int e = 32 * et + 8 * g + 4 * h;
                const u32x2 og = *(const u32x2*)(PROJ + (size_t)(R0 + t) * PROJ_W + C_MO + hh * 96 + e); const f32x4 mn = *(const f32x4*)(p.m_norm + l * 384 + hh * 96 + e);
                float o4[4];
#pragma unroll
                for (int j = 0; j < 4; ++j) { const float gate = bf2f((bf16)((j < 2 ? og.x : og.y) >> ((j & 1) * 16))); o4[j] = hv[et][4 * g + j] * rstd * mn[j] * sigmoid_f(gate); }
                u32x2 ov; ov.x = pk2(o4[0], o4[1]); ov.y = pk2(o4[2], o4[3]);
                *(u32x2*)(MIX + (size_t)(R0 + t) * MIXW + hh * 96 + e) = ov; } }
    __syncthreads();
}

DEV void phase_mla_post(const P& p, Wg& w, int l) {
    bf16* MLAQ = (bf16*)(p.ws + WS_MLAQ); const bf16* PROJ = (const bf16*)(p.ws + WS_PROJ);
    const int lane = w.lane;
    for (int R = w.gw; R < M_ALL; R += w.NGW) {
        const int q = R % TP; const bool lat = q >= CTX; const int t = q - CTX;
        bf16* row = MLAQ + (size_t)R * 1024;
        const u32x4 ra = *(const u32x4*)(row + 8 * lane), rb = *(const u32x4*)(row + 512 + 8 * lane);
        u32x4 kr = (u32x4){0u, 0u, 0u, 0u};
        if (lane >= 48) kr = *(const u32x4*)(PROJ + (size_t)R * PROJ_W + C_KR + 8 * ((lane - 48) & 3));
        float xa[8], xb[8];
#pragma unroll
        for (int j = 0; j < 8; ++j) { xa[j] = bf2f((bf16)(ra[j >> 1] >> ((j & 1) * 16))); xb[j] = bf2f((bf16)(rb[j >> 1] >> ((j & 1) * 16))); }
        int baseA, nA, dstA; bool normA = true, ropeA = false; const float* gA;
        if (lane < 48) { const int hh = lane / 12, o = lane % 12;
            if (o < 8) { baseA = 12 * hh; nA = 8; gA = p.l_qnorm + l * 96 + 8 * o; }
            else { baseA = 12 * hh + 8; nA = 4; gA = p.l_qnorm + l * 96 + 64 + 8 * (o - 8); ropeA = true; }
            dstA = 8 * lane; }
        else { const int o = lane - 48;
            if (o < 8) { baseA = 48; nA = 8; gA = p.l_knorm + l * 96 + 8 * o; dstA = 384 + 8 * o; }
            else { baseA = 48; nA = 8; gA = p.l_knorm; normA = false; dstA = 768 + 8 * (o - 8); } }
        float ssA = 0.f, ssB = 0.f;
#pragma unroll
        for (int j = 0; j < 8; ++j) { ssA += xa[j] * xa[j]; ssB += xb[j] * xb[j]; }
        float sA = 0.f;
#pragma unroll
        for (int i = 0; i < 8; ++i) { const float v = __shfl(ssA, (baseA + i) & 63); if (i < nA) sA += v; }
        const int hb = 1 + lane / 16, ob = lane % 16; const bool validB = lane < 48, normB = ob < 8;
        const int baseB = 16 * (lane / 16) & 63;
        float sB = 0.f;
#pragma unroll
        for (int i = 0; i < 8; ++i) sB += __shfl(ssB, (baseB + i) & 63);
        const int dstB = normB ? 384 + 96 * hb + 8 * ob : 768 + 64 * hb + 8 * (ob - 8);
        const float* gB = p.l_knorm + l * 96 + 8 * (ob & 7);
        float ya[8], yb[8];
        { const float rsA = normA ? 1.0f / sqrtf(sA / (float)(8 * nA) + EPS) : 1.0f;
#pragma unroll
          for (int j = 0; j < 8; ++j) ya[j] = normA ? xa[j] * rsA * gA[j] : xa[j]; }
        { const float rsB = normB ? 1.0f / sqrtf(sB * (1.0f / 64.0f) + EPS) : 1.0f;
#pragma unroll
          for (int j = 0; j < 8; ++j) yb[j] = normB ? xb[j] * rsB * gB[j] : xb[j]; }
        { const int cidx = (lane % 12) - 8; const float pos = lat ? ((cidx & 3) < 2 ? (float)(t / GRID_W) : (float)(t % GRID_W)) : 0.f;
#pragma unroll
          for (int j = 0; j < 8; ++j) { const float pt = __shfl_xor(ya[j], 1);
              if (ropeA && lat) { float sn, cs; sincosf(pos * exp2f(-(float)j * (13.287712379549449f / 8.0f)), &sn, &cs); ya[j] = (cidx & 1) ? ya[j] * cs + pt * sn : ya[j] * cs - pt * sn; } } }
        if (lane < 48) {
#pragma unroll
            for (int j = 0; j < 8; ++j) ya[j] *= QSCALE_L; }
        wave_sync();
        { u32x4 o; o.x = pk2(ya[0], ya[1]); o.y = pk2(ya[2], ya[3]); o.z = pk2(ya[4], ya[5]); o.w = pk2(ya[6], ya[7]); *(u32x4*)(row + dstA) = o; }
        if (validB) { u32x4 o; o.x = pk2(yb[0], yb[1]); o.y = pk2(yb[2], yb[3]); o.z = pk2(yb[4], yb[5]); o.w = pk2(yb[6], yb[7]); *(u32x4*)(row + dstB) = o; }
        else { const int i = lane - 48; *(u32x4*)(row + 384 + 96 * (i >> 2) + 64 + 8 * (i & 3)) = kr; }
        wave_sync();
    }
}

template <int DQK>
DEV void attn_unit(const bf16* Q, int ldq, const bf16* K, int ldk, const bf16* V, int ldv, bf16* O, int ldo, int nkeys, Wg& w) {
    constexpr int KS = DQK + 8, NKD = DQK / 16, CPR = DQK / 8, NKC = 64 * CPR;
    bf16* Ks = (bf16*)w.lds;
    bf16* Vt = (bf16*)(w.lds + 2 * 64 * KS * 2);
    const int tid = w.tid, lane = w.lane, r = lane & 31, h = lane >> 5;
    bf16x8 qr[NKD];
    { const bf16* qp = Q + (size_t)(w.wave * 32 + r) * ldq + 8 * h;
#pragma unroll
      for (int d0 = 0; d0 < NKD; ++d0) qr[d0] = *(const bf16x8*)(qp + 16 * d0); }
    const int kr0 = tid / CPR, kc0 = tid % CPR, kr1 = (tid + NTHR) / CPR, kc1 = (tid + NTHR) % CPR; const bool k1 = (tid + NTHR) < NKC;
    const int vr = tid >> 3, vc = tid & 7;
    u32x4 rk0, rk1 = (u32x4){0u, 0u, 0u, 0u}, rv;
    const int NT = nkeys / 64;
#define AT_LOAD(kt) do { rk0 = *(const u32x4*)(K + (size_t)((kt) * 64 + kr0) * ldk + 8 * kc0); if (k1) rk1 = *(const u32x4*)(K + (size_t)((kt) * 64 + kr1) * ldk + 8 * kc1); \
        rv = *(const u32x4*)(V + (size_t)((kt) * 64 + vr) * ldv + 8 * vc); } while (0)
#define AT_STORE(buf) do { *(u32x4*)(Ks + ((buf) * 64 + kr0) * KS + 8 * kc0) = rk0; if (k1) *(u32x4*)(Ks + ((buf) * 64 + kr1) * KS + 8 * kc1) = rk1; \
        _Pragma("unroll") for (int j = 0; j < 8; ++j) Vt[((buf) * 64 + 8 * vc + j) * 72 + vr] = (bf16)(rv[j >> 1] >> ((j & 1) * 16)); } while (0)
    AT_LOAD(0); AT_STORE(0);
    __syncthreads();
    float m_run = -1.0e30f, l_run = 0.f; f32x16 o[2];
#pragma unroll
    for (int i = 0; i < 16; ++i) { o[0][i] = 0.f; o[1][i] = 0.f; }
    for (int kt = 0; kt < NT; ++kt) {
        const int buf = kt & 1;
        if (kt + 1 < NT) AT_LOAD(kt + 1);
        f32x16 pt[2];
#pragma unroll
        for (int kh = 0; kh < 2; ++kh) {
#pragma unroll
            for (int i = 0; i < 16; ++i) pt[kh][i] = 0.f;
#pragma unroll
            for (int d0 = 0; d0 < NKD; ++d0) { const bf16x8 kf = *(const bf16x8*)(Ks + (buf * 64 + 32 * kh + r) * KS + 16 * d0 + 8 * h); pt[kh] = mfma32(kf, qr[d0], pt[kh]); } }
        float mt = pt[0][0];
#pragma unroll
        for (int i = 0; i < 16; ++i) { mt = fmaxf(mt, pt[0][i]); mt = fmaxf(mt, pt[1][i]); }
        mt = fmaxf(mt, __shfl_xor(mt, 32));
        const float mn = fmaxf(m_run, mt), alpha = exp2_fast(m_run - mn); m_run = mn;
        float rs = 0.f;
#pragma unroll
        for (int kh = 0; kh < 2; ++kh)
#pragma unroll
            for (int i = 0; i < 16; ++i) { const float e = exp2_fast(pt[kh][i] - mn); pt[kh][i] = e; rs += e; }
        l_run = l_run * alpha + rs;
#pragma unroll
        for (int i = 0; i < 16; ++i) { o[0][i] *= alpha; o[1][i] *= alpha; }
        bf16x8 pb[2][2];
#pragma unroll
        for (int kh = 0; kh < 2; ++kh)
#pragma unroll
            for (int sp = 0; sp < 2; ++sp) { u32x4 u; u.x = pk2(pt[kh][8 * sp], pt[kh][8 * sp + 1]); u.y = pk2(pt[kh][8 * sp + 2], pt[kh][8 * sp + 3]); u.z = pk2(pt[kh][8 * sp + 4], pt[kh][8 * sp + 5]); u.w = pk2(pt[kh][8 * sp + 6], pt[kh][8 * sp + 7]);
                pb[kh][sp] = __builtin_bit_cast(bf16x8, u); }
#pragma unroll
        for (int et = 0; et < 2; ++et)
#pragma unroll
            for (int kh = 0; kh < 2; ++kh)
#pragma unroll
                for (int sp = 0; sp < 2; ++sp) { const bf16* vp = Vt + (buf * 64 + 32 * et + r) * 72 + 32 * kh + 16 * sp + 4 * h;
                    const s16x4 lo = *(const s16x4*)vp, hi = *(const s16x4*)(vp + 8);
                    const bf16x8 vf = (bf16x8){lo[0], lo[1], lo[2], lo[3], hi[0], hi[1], hi[2], hi[3]};
                    o[et] = mfma32(vf, pb[kh][sp], o[et]); }
        if (kt + 1 < NT) AT_STORE(buf ^ 1);
        __syncthreads();
    }
#undef AT_LOAD
#undef AT_STORE
    l_run += __shfl_xor(l_run, 32);
    const float inv = 1.0f / l_run;
    bf16* op = O + (size_t)(w.wave * 32 + r) * ldo + 4 * h;
#pragma unroll
    for (int et = 0; et < 2; ++et)
#pragma unroll
        for (int g = 0; g < 4; ++g) { u32x2 ov; ov.x = pk2(o[et][4 * g] * inv, o[et][4 * g + 1] * inv); ov.y = pk2(o[et][4 * g + 2] * inv, o[et][4 * g + 3] * inv); *(u32x2*)(op + 32 * et + 8 * g) = ov; }
}
DEV void phase_mix(const P& p, Wg& w, int l) {
    const bf16* PROJ = (const bf16*)(p.ws + WS_PROJ); const bf16* MLAQ = (const bf16*)(p.ws + WS_MLAQ); bf16* MIX = (bf16*)(p.ws + WS_H);
    unsigned* ctr = (unsigned*)(p.ws + WS_CTL) + CW_Q + 128 * l;
    const int n_mla = BATCH * 4 * NQL, n_gqa = BATCH * 6 * NQL, n_ml3 = BATCH * 4 * NCH / 2, n_ctx = (l == 0) ? BATCH * 10 : 0, n_att = n_mla + n_gqa + n_ctx;
    for (;;) {
        int idx = q_next(w, ctr);
        if (idx >= n_att) break;
        int b, head, qb, nkeys; bool mla;
        if (idx < n_mla) { b = idx / (4 * NQL); head = (idx / NQL) % 4; qb = 1 + idx % NQL; nkeys = TP; mla = true; }
        else if ((idx -= n_mla) < n_gqa) { b = idx / (6 * NQL); const int rem = idx % (6 * NQL); head = (rem / (3 * NQL)) * 3 + rem % 3; qb = 1 + (rem % (3 * NQL)) / 3; nkeys = TP; mla = false; }
        else { idx -= n_gqa; b = idx / 10; const int hd = idx % 10; mla = hd >= 6; head = mla ? hd - 6 : hd; qb = 0; nkeys = CTX; }
        const size_t Rq = (size_t)b * TP + qb * 256, Rk = (size_t)b * TP;
        if (mla) attn_unit<96>(MLAQ + Rq * 1024 + head * 96, 1024, MLAQ + Rk * 1024 + 384 + head * 96, 1024, MLAQ + Rk * 1024 + 768 + head * 64, 1024, MIX + Rq * MIXW + 768 + head * 64, MIXW, nkeys, w);
        else attn_unit<64>(PROJ + Rq * PROJ_W + C_AQ + head * 64, PROJ_W, PROJ + Rk * PROJ_W + C_AK + (head / 3) * 64, PROJ_W, PROJ + Rk * PROJ_W + C_AV + (head / 3) * 64, PROJ_W, MIX + Rq * MIXW + 384 + head * 64, MIXW, nkeys, w);
    }
    for (;;) {
        const int idx = q_next(w, ctr + 64);
        if (idx >= n_ml3) break;
        ml3_pair(p, w, l, idx);
    }
}

DEV void moe_seg_table(const P& p, Wg& w) {
    const int* cntg = (const int*)(p.ws + WS_CNTG);
    if (w.tid < NEXP) { int tot = 0, pre = 0; for (int g = 0; g < w.G; ++g) { const int c = cntg[g * NEXP + w.tid]; tot += c; pre += (g < w.wg) ? c : 0; } w.misc[32 + w.tid] = (unsigned)tot; w.misc[48 + w.tid] = (unsigned)pre; }
    __syncthreads();
    if (w.tid == 0) { int s = 0; for (int e = 0; e < NEXP; ++e) { w.misc[16 + e] = (unsigned)s; s += ((int)w.misc[32 + e] + 255) / 256; } w.misc[16 + NEXP] = (unsigned)s; }
    __syncthreads();
}
DEV void phase_gather(const P& p, Wg& w) {
    moe_seg_table(p, w);
    const int* topi = (const int*)(p.ws + WS_TOPI); const float* topw = (const float*)(p.ws + WS_TOPW);
    int* stok = (int*)(p.ws + WS_STOK); float* sw = (float*)(p.ws + WS_SW);
    const bf16* H = (const bf16*)(p.ws + WS_H); bf16* AG = (bf16*)(p.ws + WS_AG);
    int* lc = (int*)w.lds;
    if (w.lane == 0) { for (int e = 0; e < NEXP; ++e) lc[w.wave * NEXP + e] = 0;
        for (int R = w.gw; R < M_ALL; R += w.NGW) { const int q = R % TP; if (q < CTX) continue; const int tok = (R / TP) * SEQ + q - CTX; lc[w.wave * NEXP + topi[2 * tok]]++; lc[w.wave * NEXP + topi[2 * tok + 1]]++; } }
    __syncthreads();
    if (w.tid < NEXP) { int s = (int)w.misc[16 + w.tid] * 256 + (int)w.misc[48 + w.tid]; for (int ww = 0; ww < NWAVE; ++ww) { const int c = lc[ww * NEXP + w.tid]; lc[ww * NEXP + w.tid] = s; s += c; } }
    __syncthreads();
    for (int R = w.gw; R < M_ALL; R += w.NGW) { const int q = R % TP; if (q < CTX) continue; const int tok = (R / TP) * SEQ + q - CTX;
        int s0 = 0, s1 = 0;
        if (w.lane == 0) { const int e0 = topi[2 * tok], e1 = topi[2 * tok + 1]; s0 = lc[w.wave * NEXP + e0]; lc[w.wave * NEXP + e0] = s0 + 1; s1 = lc[w.wave * NEXP + e1]; lc[w.wave * NEXP + e1] = s1 + 1;
            stok[s0] = tok; stok[s1] = tok; sw[s0] = topw[2 * tok]; sw[s1] = topw[2 * tok + 1]; }
        s0 = __shfl(s0, 0); s1 = __shfl(s1, 0);
#pragma unroll
        for (int j = 0; j < D_MODEL / 512; ++j) { const u32x4 v = *(const u32x4*)(H + (size_t)R * D_MODEL + 8 * w.lane + 512 * j);
            *(u32x4*)(AG + (size_t)s0 * D_MODEL + 8 * w.lane + 512 * j) = v; *(u32x4*)(AG + (size_t)s1 * D_MODEL + 8 * w.lane + 512 * j) = v; }
        if (D_MODEL % 512) { if (w.lane < (D_MODEL % 512) / 8) { const int c = (D_MODEL / 512) * 512 + 8 * w.lane; const u32x4 v = *(const u32x4*)(H + (size_t)R * D_MODEL + c);
            *(u32x4*)(AG + (size_t)s0 * D_MODEL + c) = v; *(u32x4*)(AG + (size_t)s1 * D_MODEL + c) = v; } } }
    for (int e = w.wg; e < NEXP; e += w.G) { const int lo = (int)w.misc[16 + e] * 256 + (int)w.misc[32 + e], hi = (int)w.misc[16 + e + 1] * 256;
        for (int s = lo + w.wave; s < hi; s += NWAVE) { if (w.lane == 0) { stok[s] = -1; sw[s] = 0.f; }
            for (int c = 8 * w.lane; c < D_MODEL; c += 512) *(u32x4*)(AG + (size_t)s * D_MODEL + c) = (u32x4){0u, 0u, 0u, 0u}; } }
}

constexpr int PH_L = 16;
constexpr int N_PHASES = 1 + 2 * PH_L;
#ifdef EMU
#define GRID_BAR() do {} while (0)
#define DYN_LDS() unsigned char* lds = EMU_DYN_LDS()
#else
#define GRID_BAR() xcd_barrier(bar)
#define DYN_LDS() extern __shared__ __attribute__((aligned(16))) unsigned char lds[]
#endif
__global__ void __launch_bounds__(NTHR, 2) fwd(P p) {
    DYN_LDS();
    Wg w; w.tid = threadIdx.x; w.lane = w.tid & 63;
#ifndef EMU
    w.wave = __builtin_amdgcn_readfirstlane(w.tid >> 6);
#else
    w.wave = w.tid >> 6;
#endif
    w.G = gridDim.x; w.wg = blockIdx.x; w.gw = w.wg * NWAVE + w.wave; w.NGW = w.G * NWAVE; w.lds = lds; w.misc = (unsigned*)(lds + LDS_MISC);
    if (w.tid < 64) w.misc[w.tid] = 0u;
    __syncthreads();
#ifndef EMU
    XcdBarrier bar = xcd_barrier_post((unsigned*)(p.ws + WS_CTL) + CW_BAR, (volatile LAS unsigned*)(w.misc));
#endif
    const int lo = p.ph_lo, hi = p.ph_hi;
#ifndef PH_MASK
#define PH_MASK 0xffffffffu
#endif
#ifndef EMU
#define WAVE_OF(t) __builtin_amdgcn_readfirstlane((t) >> 6)
#else
#define WAVE_OF(t) ((t) >> 6)
#endif
#define PH_BEGIN(k) if (((PH_MASK >> ((k) - pb_)) & 1u) && lo <= (k) && (k) < hi) { { int t_ = threadIdx.x; OPAQUE_V(t_); w.tid = t_; w.lane = t_ & 63; w.wave = WAVE_OF(t_); w.gw = w.wg * NWAVE + w.wave; }
#define PH_END(k) if ((k) + 1 < hi) GRID_BAR(); }
    { const int pb_ = -31; PH_BEGIN(0) phase0(p, w); PH_END(0) }
    for (int l = 0; l < 2; ++l) {
        const int pb = 1 + PH_L * l, pb_ = pb;
        PH_BEGIN(pb + 0) phase_modulate(p, w, l, 0, l == 0, false, false); PH_END(pb + 0)
        PH_BEGIN(pb + 1) {
            pg8::Gemm g{(const bf16*)(p.ws + WS_H), (const bf16*)(p.ws + WS_WIN_T) + (size_t)l * PROJ_W * D_MODEL, D_MODEL, D_MODEL, 0};
            Sched S; S.o.init(NPAN, PROJ_W / 256, w.G, w.wg); S.mode = 0; S.pm_base = 0; S.seg = nullptr;
            EpiStore E{(bf16*)(p.ws + WS_PROJ), PROJ_W, (float*)(p.ws + WS_GATES)};
            pg8::gemm_phase<EpiStore, Sched>(w.lds, w.tid, g, S, E); } PH_END(pb + 1)
        PH_BEGIN(pb + 2) phase_prep(p, w, l); PH_END(pb + 2)
        PH_BEGIN(pb + 3) {
            pg8::Gemm g{(const bf16*)(p.ws + WS_PROJ) + C_CQ, (const bf16*)(p.ws + WS_MLA_T) + (size_t)l * 1024 * 384, PROJ_W, 384, 0};
            Sched S; S.o.init(NPAN, 4, w.G, w.wg); S.mode = 0; S.pm_base = 0; S.seg = nullptr;
            EpiStore E{(bf16*)(p.ws + WS_MLAQ), 1024, nullptr};
            pg8::gemm_phase<EpiStore, Sched>(w.lds, w.tid, g, S, E);
            __syncthreads();
#ifndef NO_ML1
            for (int it = w.wg; it < BATCH * 4 * NCH; it += w.G) ml1_item(p, w, l, it);
#endif
            } PH_END(pb + 3)
        PH_BEGIN(pb + 4) phase_mla_post(p, w, l); phase_ml2(p, w); PH_END(pb + 4)
        PH_BEGIN(pb + 5) phase_mix(p, w, l); PH_END(pb + 5)
        PH_BEGIN(pb + 6) {
            pg8::Gemm g{(const bf16*)(p.ws + WS_H), (const bf16*)(p.ws + WS_WOUT_T) + (size_t)l * D_MODEL * MIXW, MIXW, MIXW, 0};
            Sched S; S.o.init(l == 0 ? NPAN : BATCH * NQL, D_MODEL / 256, w.G, w.wg); S.mode = (l == 0) ? 0 : 1; S.pm_base = 0; S.seg = nullptr;
            EpiResid E{p, l, 2 * D_MODEL};
            pg8::gemm_phase<EpiResid, Sched>(w.lds, w.tid, g, S, E); } PH_END(pb + 6)
        if (l == 0) {
            PH_BEGIN(pb + 7) phase_modulate(p, w, 0, 1, false, false, false); PH_END(pb + 7)
            PH_BEGIN(pb + 8) {
                pg8::Gemm g{(const bf16*)(p.ws + WS_H), (const bf16*)(p.ws + WS_WGU_T), D_MODEL, D_MODEL, 0};
                Sched S; S.o.init(NPAN, 2 * D_FF / 256, w.G, w.wg); S.mode = 0; S.pm_base = 0; S.seg = nullptr;
                EpiSwiglu E{(bf16*)(p.ws + WS_ACT), 0};
                pg8::gemm_phase<EpiSwiglu, Sched>(w.lds, w.tid, g, S, E); } PH_END(pb + 8)
            PH_BEGIN(pb + 9) {
                pg8::Gemm g{(const bf16*)(p.ws + WS_ACT), (const bf16*)(p.ws + WS_WD_T), D_FF, D_FF, 0};
                Sched S; S.o.init(NPAN, D_MODEL / 256, w.G, w.wg); S.mode = 0; S.pm_base = 0; S.seg = nullptr;
                EpiResid E{p, 0, 5 * D_MODEL};
                pg8::gemm_phase<EpiResid, Sched>(w.lds, w.tid, g, S, E); } PH_END(pb + 9)
        } else {
            PH_BEGIN(pb + 7) phase_modulate(p, w, 1, 1, false, true, true); phase_moe_weights(p, w); PH_END(pb + 7)
            PH_BEGIN(pb + 8) phase_gather(p, w); PH_END(pb + 8)
            for (int c = 0; c < 3; ++c) {
                PH_BEGIN(pb + 9 + 2 * c) {
                    moe_seg_table(p, w);
                    const int ptot = (int)w.misc[16 + NEXP], nch = (ptot + MOE_PCH - 1) / MOE_PCH, pch = (ptot + nch - 1) / nch, pm0 = c * pch, np = (ptot - pm0) < pch ? (ptot - pm0) : pch;
                    if (c < nch && np > 0) {
                        pg8::Gemm g{(const bf16*)(p.ws + WS_AG), (const bf16*)(p.ws + WS_MOEW), D_MODEL, D_MODEL, MOEW_E};
                        Sched S; S.o.init(np, 2 * D_FF / 256, w.G, w.wg); S.mode = 2; S.pm_base = pm0; S.seg = (const int*)(w.misc + 16);
                        EpiSwiglu E{(bf16*)(p.ws + WS_ACT2), pm0};
                        pg8::gemm_phase<EpiSwiglu, Sched>(w.lds, w.tid, g, S, E); } } PH_END(pb + 9 + 2 * c)
                PH_BEGIN(pb + 10 + 2 * c) {
                    moe_seg_table(p, w);
                    const int ptot = (int)w.misc[16 + NEXP], nch = (ptot + MOE_PCH - 1) / MOE_PCH, pch = (ptot + nch - 1) / nch, pm0 = c * pch, np = (ptot - pm0) < pch ? (ptot - pm0) : pch;
                    if (c < nch && np > 0) {
                        pg8::Gemm g{(const bf16*)(p.ws + WS_ACT2), (const bf16*)(p.ws + WS_MOEW) + (size_t)2 * D_FF * D_MODEL, D_FF, D_FF, MOEW_E};
                        Sched S; S.o.init(np, D_MODEL / 256, w.G, w.wg); S.mode = 3; S.pm_base = pm0; S.seg = (const int*)(w.misc + 16);
                        EpiMoeDown E{p, pm0};
                        pg8::gemm_phase<EpiMoeDown, Sched>(w.lds, w.tid, g, S, E); } } PH_END(pb + 10 + 2 * c)
            }
        }
    }
}

#ifndef MK_PER_PHASE
#define MK_PER_PHASE 0
#endif
extern "C" void kernel_launch(void* const* d_in, const int* in_sizes, int n_in, void* d_out, int out_size, void* d_ws, size_t ws_size, hipStream_t stream) {
    static int grid = 0;
    if (grid == 0) {
        if (n_in != 28 || in_sizes[0] != BATCH * SEQ * D_MODEL || out_size != BATCH * SEQ * D_MODEL || ws_size < WS_TOTAL) {
            fprintf(stderr, "kernel_launch: unexpected problem (n_in %d, x %d, out %d, ws %zu < %zu)\n", n_in, n_in > 0 ? in_sizes[0] : -1, out_size, ws_size, (size_t)WS_TOTAL); grid = -1; return; }
#ifndef EMU
        int dev = 0, cus = 0;
        if (hipGetDevice(&dev) != hipSuccess || hipDeviceGetAttribute(&cus, hipDeviceAttributeMultiprocessorCount, dev) != hipSuccess) { grid = -1; return; }
        if (hipFuncSetAttribute((const void*)fwd, hipFuncAttributeMaxDynamicSharedMemorySize, LDS_BYTES) != hipSuccess) { fprintf(stderr, "kernel_launch: hipFuncSetAttribute failed\n"); grid = -1; return; }
        int per_cu = 0;
        if (hipOccupancyMaxActiveBlocksPerMultiprocessor(&per_cu, (const void*)fwd, NTHR, LDS_BYTES) != hipSuccess || per_cu < 1) { fprintf(stderr, "kernel_launch: occupancy query says %d\n", per_cu); (void)hipGetLastError(); }
        grid = cus;
#else
        grid = 8;
#endif
    }
    if (grid < 0) return;
    (void)hipMemsetAsync((char*)d_ws + WS_CTL, 0, CTL_BYTES, stream);
    P p{};
    const float** pp = (const float**)&p;
    for (int i = 0; i < 28; ++i) pp[i] = (const float*)d_in[i];
    p.out = (float*)d_out; p.ws = (unsigned char*)d_ws;
#if MK_PER_PHASE
    for (int k = 0; k < N_PHASES; ++k) {
        if (k >= 1 + 10 && k < 1 + PH_L) continue;
        if (k >= 1 + PH_L + 15) continue;
        p.ph_lo = k; p.ph_hi = k + 1;
        hipLaunchKernelGGL(fwd, dim3(grid), dim3(NTHR), LDS_BYTES, stream, p);
    }
#else
    p.ph_lo = 0; p.ph_hi = N_PHASES;
    hipLaunchKernelGGL(fwd, dim3(grid), dim3(NTHR), LDS_BYTES, stream, p);
#endif
}
```

```cpp
#ifndef EMU
#include <hip/hip_runtime.h>
#endif
#include <cstdio>
#include <cstdint>
#include <cmath>

#ifdef CFG_TINY
constexpr int D_MODEL = 256, BATCH = 2, SEQ = 512, CTX = 256, GRID_W = 16, D_FF = 512;
constexpr int MOE_PCH = 4, NSPLIT = 2;
#else
constexpr int D_MODEL = 1024, BATCH = 8, SEQ = 4096, CTX = 256, GRID_W = 64, D_FF = 3584;
constexpr int MOE_PCH = 64, NSPLIT = 7;
#endif
constexpr int TP = CTX + SEQ, M_ALL = BATCH * TP, NPAN = M_ALL / 256, PAN_B = TP / 256, NQL = SEQ / 256;
constexpr int MCH = 128;
constexpr int NCH = TP / MCH, NC_CTX = CTX / MCH, NQB = MCH / 32;
constexpr int PROJ_W = 2816, MIXW = 1024, NEXP = 8;
constexpr int C_MQ = 0, C_MK = 384, C_MV = 768, C_MO = 1152, C_G = 1536, C_AQ = 1552, C_AK = 1936, C_AV = 2064, C_CQ = 2192, C_CKV = 2448, C_KR = 2576, IN_W = 2608;
constexpr int NV = BATCH + 1;
constexpr int NCHAIN = BATCH * 4 * 2, NITEM = NCHAIN * NCH;
constexpr int NTOK = BATCH * SEQ, NSLOTP = NTOK * 2 + NEXP * 256;
constexpr int MOE_NCH = (NSLOTP / 256 + MOE_PCH - 1) / MOE_PCH;
constexpr float EPS = 1e-6f, LOG2E = 1.4426950408889634f;
constexpr float QSCALE_A = 0.125f * LOG2E, QSCALE_L = 0.10206207261596575f * LOG2E, KSCALE_M = 0.10206207261596575f;
constexpr int NTHR = 512, NWAVE = 8;
constexpr int KSPLIT = D_FF / NSPLIT;
static_assert(KSPLIT % 128 == 0 && KSPLIT >= 256 && NSPLIT * BATCH * 256 * D_MODEL * 2 <= M_ALL * 1024 * 2, "split-K geometry");
constexpr int NPOS = (SEQ / GRID_W > GRID_W) ? SEQ / GRID_W : GRID_W;

typedef unsigned short bf16;
#ifndef EMU
typedef short bf16x8 __attribute__((ext_vector_type(8)));
typedef short s16x4 __attribute__((ext_vector_type(4)));
typedef float f32x4 __attribute__((ext_vector_type(4)));
typedef float f32x2 __attribute__((ext_vector_type(2)));
typedef float f32x16 __attribute__((ext_vector_type(16)));
typedef unsigned u32x4 __attribute__((ext_vector_type(4)));
typedef unsigned u32x2 __attribute__((ext_vector_type(2)));
#define DEV __device__ __forceinline__
DEV f32x16 mfma32(bf16x8 a, bf16x8 b, f32x16 c) { return __builtin_amdgcn_mfma_f32_32x32x16_bf16(a, b, c, 0, 0, 0); }
DEV void wave_sync() { asm volatile("s_waitcnt vmcnt(0) lgkmcnt(0)" ::: "memory"); __builtin_amdgcn_wave_barrier(); }
typedef __bf16 bf16x2_hw __attribute__((ext_vector_type(2)));
typedef short v4i16_t __attribute__((ext_vector_type(4)));
DEV unsigned pk2_hw(float lo, float hi) { f32x2 v = {lo, hi}; bf16x2_hw b = __builtin_convertvector(v, bf16x2_hw); return __builtin_bit_cast(unsigned, b); }
DEV s16x4 lds_tr_read(const unsigned short* a) { return __builtin_bit_cast(s16x4, __builtin_amdgcn_ds_read_tr16_b64_v4i16((__attribute__((address_space(3))) v4i16_t*)(a))); }
DEV float exp2_fast(float x) { return __builtin_amdgcn_exp2f(x); }
DEV float rcp_fast(float x) { return __builtin_amdgcn_rcpf(x); }
DEV float rsqrt_fast(float x) { return __builtin_amdgcn_rsqf(x); }
DEV void atomic_addf(float* p, float v) { unsafeAtomicAdd(p, v); }
#define OPAQUE_V(x) asm volatile("" : "+v"(x))
#define SCHED_FENCE() __builtin_amdgcn_sched_barrier(0)
#define UNIFORM_I(x) __builtin_amdgcn_readfirstlane(x)
DEV unsigned fau(float f) { return __float_as_uint(f); }
DEV float uaf(unsigned u) { return __uint_as_float(u); }
DEV float my_shfl_xor(float v, int m, int lane) { return __int_as_float(__builtin_amdgcn_ds_bpermute((lane ^ m) << 2, __float_as_int(v))); }
#define SHX(v, m, lane) my_shfl_xor((v), (m), (lane))
DEV float my_shfl(float v, int src) { return __int_as_float(__builtin_amdgcn_ds_bpermute((src & 63) << 2, __float_as_int(v))); }
DEV int my_shfl(int v, int src) { return __builtin_amdgcn_ds_bpermute((src & 63) << 2, v); }
#define __shfl my_shfl
DEV int lane_fresh() { int l_; asm volatile("v_mbcnt_lo_u32_b32 %0, -1, 0\n\tv_mbcnt_hi_u32_b32 %0, -1, %0" : "=v"(l_)); return l_; }
#else
#define DEV inline
#define OPAQUE_V(x) do {} while (0)
#define SCHED_FENCE() do {} while (0)
#define UNIFORM_I(x) (x)
#define SHX(v, m, lane) __shfl_xor((v), (m))
DEV void wave_sync() { (void)emu_shfl_u(0u, emu::B->cur & 63); }
DEV void atomic_addf(float* p, float v) { atomicAdd(p, v); }
DEV float rsqrt_fast(float x) { return 1.0f / sqrtf(x); }
DEV unsigned fau(float f) { unsigned u; memcpy(&u, &f, 4); return u; }
DEV float uaf(unsigned u) { float f; memcpy(&f, &u, 4); return f; }
#endif
DEV bf16 f2bf(float f) { unsigned u = fau(f); u += 0x7fffu + ((u >> 16) & 1u); return (bf16)(u >> 16); }
DEV float bf2f(bf16 h) { return uaf(((unsigned)h) << 16); }
#ifndef EMU
DEV unsigned pk2(float lo, float hi) { return pk2_hw(lo, hi); }
#else
DEV unsigned pk2(float lo, float hi) { return (unsigned)f2bf(lo) | ((unsigned)f2bf(hi) << 16); }
#endif
DEV float wave_sum(float v, int lane) {
#pragma unroll
    for (int o = 1; o < 64; o <<= 1) v += SHX(v, o, lane);
    return v;
}
DEV float wave_max(float v, int lane) {
#pragma unroll
    for (int o = 1; o < 64; o <<= 1) v = fmaxf(v, SHX(v, o, lane));
    return v;
}
DEV float silu_f(float x) { return x / (1.0f + __expf(-x)); }
DEV float silu_fast(float x) { return x * rcp_fast(1.0f + exp2_fast(-x * LOG2E)); }
DEV float sigmoid_f(float x) { return rcp_fast(1.0f + exp2_fast(-x * LOG2E)); }
DEV float log_sigmoid_f(float x) { return x >= 0.f ? -log1pf(expf(-x)) : x - log1pf(expf(x)); }
DEV int crow(int i, int h) { return (i & 3) + 8 * (i >> 2) + 4 * h; }

constexpr size_t al256(size_t x) { return (x + 255) & ~(size_t)255; }
constexpr size_t WS_CTL = 0, CTL_BYTES = 65536;
constexpr int CW_Q = 0;
constexpr int CW_BAR = 4096;
constexpr size_t WS_MODV = WS_CTL + CTL_BYTES;
constexpr size_t WS_WIN_T = al256(WS_MODV + (size_t)2 * NV * 6 * D_MODEL * 4);
constexpr size_t WS_WOUT_T = al256(WS_WIN_T + (size_t)2 * PROJ_W * D_MODEL * 2);
constexpr size_t WS_MLA_T = al256(WS_WOUT_T + (size_t)2 * D_MODEL * MIXW * 2);
constexpr size_t WS_WGU_T = al256(WS_MLA_T + (size_t)2 * 1024 * 512 * 2);
constexpr size_t WS_WD_T = al256(WS_WGU_T + (size_t)2 * D_FF * D_MODEL * 2);
constexpr size_t WS_CX = al256(WS_WD_T + (size_t)D_MODEL * D_FF * 2);
constexpr size_t WS_GATES = al256(WS_CX + (size_t)BATCH * CTX * D_MODEL * 4);
constexpr size_t WS_NL = al256(WS_GATES + (size_t)M_ALL * 16 * 4);
constexpr size_t WS_FS = al256(WS_NL + (size_t)NITEM * 96 * 4);
constexpr size_t WS_PML = al256(WS_FS + (size_t)NITEM * 4);
constexpr size_t WS_MST = al256(WS_PML + (size_t)NITEM * 4);
constexpr size_t WS_TOPI = al256(WS_MST + (size_t)NITEM * 4);
constexpr size_t WS_TOPW = al256(WS_TOPI + (size_t)NTOK * 2 * 4);
constexpr size_t WS_CNTG = al256(WS_TOPW + (size_t)NTOK * 2 * 4);
constexpr size_t WS_STOK = al256(WS_CNTG + (size_t)1024 * 8 * 4);
constexpr size_t WS_SW = al256(WS_STOK + (size_t)NSLOTP * 4);
constexpr size_t WS_TSL = al256(WS_SW + (size_t)NSLOTP * 4);
constexpr size_t WS_ROPE = al256(WS_TSL + (size_t)NTOK * 2 * 4);
constexpr size_t WS_PROJ = al256(WS_ROPE + (size_t)NPOS * 24 * 2 * 4);
constexpr size_t WS_MQK = al256(WS_PROJ + (size_t)M_ALL * PROJ_W * 2);
constexpr size_t WS_MLAQ = al256(WS_MQK + (size_t)M_ALL * 768 * 2);
constexpr size_t WS_UC = al256(WS_MLAQ + (size_t)M_ALL * 1024 * 2);
constexpr size_t WS_H = al256(WS_UC + (size_t)NITEM * 9216 * 2);
constexpr size_t WS_END0 = al256(WS_H + (size_t)M_ALL * 1024 * 2);
constexpr size_t WS_ACT = WS_PROJ;
constexpr size_t WS_MOEW = WS_PROJ;
constexpr size_t MOEW_E = (size_t)3 * D_FF * D_MODEL * 2;
constexpr size_t WS_AG = al256(WS_MOEW + NEXP * MOEW_E);
constexpr size_t WS_ACT2 = al256(WS_AG + (size_t)NSLOTP * D_MODEL * 2);
constexpr size_t WS_YC = al256(WS_ACT2 + (size_t)MOE_PCH * 256 * D_FF * 2);
#ifdef CFG_TINY
constexpr size_t WS_TOTAL = WS_END0 + (4u << 20);
#else
constexpr size_t WS_TOTAL = (size_t)512 << 20;
#endif
static_assert(WS_END0 <= WS_TOTAL, "ws map");
constexpr int ML2_U = (NCH % 17 == 0) ? 17 : ((NCH % 4 == 0) ? 4 : 2);
static_assert(NCH % ML2_U == 0, "ML2 unroll");
static_assert(WS_ACT + (size_t)M_ALL * D_FF * 2 <= WS_MLAQ, "dense ACT overlays PROJ+MQK only");
static_assert(WS_MOEW + NEXP * MOEW_E <= WS_MQK, "MoE weights overlay PROJ only");
static_assert(WS_YC + (size_t)MOE_PCH * 256 * D_MODEL * 2 <= WS_TOTAL, "MoE chunk buffers");

constexpr int LDS_STAGE = 131072;
constexpr int LDS_MISC = LDS_STAGE;
constexpr int LDS_BYTES = LDS_STAGE + 4096;

struct P {
    const float *x, *c, *ctx, *c_ctx, *mod_w, *mod_b, *norm_mix, *norm_ffn, *w_in, *m_conv, *m_gate_b, *m_norm, *a_qnorm, *a_knorm, *l_cq_norm, *l_ckv_norm,
        *l_wuq, *l_wukv, *l_qnorm, *l_knorm, *w_out, *ffn_wg, *ffn_wu, *ffn_wd, *moe_router, *moe_wg, *moe_wu, *moe_wd;
    float* out; unsigned char* ws; int ph_lo, ph_hi;
};
constexpr int RPITCH = 2 * D_MODEL;
DEV bf16* resid_row(const P& p, int R) {
    const int b = R / TP, q = R % TP;
    return q < CTX ? (bf16*)(p.ws + WS_CX) + (size_t)(b * CTX + q) * RPITCH : (bf16*)(p.out + (size_t)(b * SEQ + q - CTX) * D_MODEL);
}
DEV const float* modv(const P& p, int l, int R) { const int b = R / TP, q = R % TP; return (const float*)(p.ws + WS_MODV) + (size_t)(l * NV + (q < CTX ? BATCH : b)) * 6 * D_MODEL; }

namespace pg8 {
constexpr int BM = 256, BK = 64, HALF = 128, HTB = HALF * BK * 2, STAGE_BYTES = 8 * HTB, NXCD = 8, WGM = 8;
struct Unit { int pm, pn, e, k0, po; };
struct Gemm { const bf16* A; const bf16* Bt; int lda, ldb, K; size_t bstride; };
DEV int lds_byte(int r, int c) { const int st = (r >> 4) * 2 + (c >> 5), rr = r & 15, cc = c & 31, ob = rr * 64 + cc * 2; return st * 1024 + (ob ^ (((ob >> 9) & 1) << 5)); }
DEV void stage_rc(int b, int& R, int& C) { const int st = b / 1024, sb = b % 1024, swz = sb ^ (((sb >> 9) & 1) << 5); R = (st >> 1) * 16 + swz / 64; C = (st & 1) * 32 + (swz % 64) / 2; }
DEV int perm32(int rho) { const int n = rho >> 4, i = rho & 15; return 8 * (i >> 2) + 4 * n + (i & 3); }
struct Order {
    int nM, nN, nwg, G, c, wgm;
    DEV void init(int nM_, int nN_, int G_, int c_, int wgm_ = WGM) { nM = nM_; nN = nN_; nwg = nM * nN; G = G_; c = c_; wgm = wgm_; }
    DEV bool nextL(int i, int& lm, int& ln) const {
        const long L = (long)i * G + c; if (L >= nwg) return false;
        int wgid = (int)L; { const int q = nwg / NXCD, r = nwg % NXCD, xcd = wgid % NXCD, off = wgid / NXCD; wgid = (xcd < r ? xcd * (q + 1) : r * (q + 1) + (xcd - r) * q) + off; }
        const int nig = wgm * nN, gid = wgid / nig, fm = gid * wgm, gsz = (nM - fm) < wgm ? (nM - fm) : wgm;
        lm = fm + ((wgid % nig) % gsz); ln = (wgid % nig) / gsz; return true;
    }
};
#ifndef EMU
#define PG8_LAS __attribute__((address_space(3)))
DEV unsigned cvt_pk_bf16(float lo, float hi) { unsigned r; asm volatile("v_cvt_pk_bf16_f32 %0, %1, %2" : "=v"(r) : "v"(lo), "v"(hi)); return r; }
template <class Epi, class Sched>
DEV void gemm_phase(unsigned char* lds_, const int tid, const Gemm g, const Sched& S, const Epi& E) {
    PG8_LAS unsigned char* lds = (PG8_LAS unsigned char*)lds_;
    const int wid = __builtin_amdgcn_readfirstlane(tid >> 6), lane = tid & 63, wr = wid >> 2, wc = wid & 3, fr = lane & 15, fq = lane >> 4;
    const int K = g.K, nt = K / BK, lda = g.lda, ldb = g.ldb;
    unsigned voffA[2], voffB[2];
#pragma unroll
    for (int i = 0; i < 2; ++i) { int R, C; stage_rc(tid * 16 + i * 8192, R, C); const int Rb = Epi::PERM ? ((R & ~31) + perm32(R & 31)) : R;
        voffA[i] = (unsigned)(R * lda + C) * 2u; voffB[i] = (unsigned)(Rb * ldb + C) * 2u; }
    const size_t kstep = (size_t)(BK * 2);
    const size_t hstepA = (size_t)HALF * lda * 2, hstepB = (size_t)HALF * ldb * 2;
    const size_t tstepA = 2 * hstepA, tstepB = 2 * hstepB;
    const unsigned ldsw = (unsigned)wid * 1024u;
    const int aoff = lds_byte(wr * 64 + fr, fq * 8), boff = lds_byte(wc * 32 + fr, fq * 8);
#define PG8_SA(b, h) (((b) * 2 + (h)) * HTB)
#define PG8_SB(b, h) ((4 + (b) * 2 + (h)) * HTB)
#define PG8_STAGE(bufoff, gbase, voff) do { _Pragma("unroll") for (int _i = 0; _i < 2; ++_i) \
        __builtin_amdgcn_global_load_lds((const unsigned*)((const char*)(gbase) + (voff)[_i]), (PG8_LAS unsigned*)(lds + (bufoff) + ldsw + _i * 8192), 16, 0, 0); } while (0)
#define PG8_LDA(dst, b, h) do { _Pragma("unroll") for (int m = 0; m < 4; ++m) _Pragma("unroll") for (int k = 0; k < 2; ++k) dst[m][k] = *(const PG8_LAS bf16x8*)(lds + PG8_SA(b, h) + aoff + m * 2048 + k * 1024); } while (0)
#define PG8_LDB(dst, b, h) do { _Pragma("unroll") for (int n = 0; n < 2; ++n) _Pragma("unroll") for (int k = 0; k < 2; ++k) dst[n][k] = *(const PG8_LAS bf16x8*)(lds + PG8_SB(b, h) + boff + n * 2048 + k * 1024); } while (0)
#define PG8_MMA(ai, bj, At, Bt) do { __builtin_amdgcn_s_setprio(1); _Pragma("unroll") for (int m = 0; m < 4; ++m) _Pragma("unroll") for (int n = 0; n < 2; ++n) _Pragma("unroll") for (int k = 0; k < 2; ++k) \
        acc[ai][bj][m][n] = __builtin_amdgcn_mfma_f32_16x16x32_bf16(Bt[n][k], At[m][k], acc[ai][bj][m][n], 0, 0, 0); __builtin_amdgcn_s_setprio(0); } while (0)
#define PG8_WAIT_V(n) asm volatile("s_waitcnt vmcnt(" #n ")" ::: "memory")
#define PG8_WAIT_L(n) asm volatile("s_waitcnt lgkmcnt(" #n ")" ::: "memory")
#define PG8_BAR __builtin_amdgcn_s_barrier()
#define PG8_SCHED __builtin_amdgcn_sched_barrier(0)
    Unit cur, nxt; int ui = 0;
    if (!S.next(0, cur)) return;
    f32x4 acc[2][2][4][2];
#pragma unroll
    for (int a = 0; a < 2; ++a)
#pragma unroll
        for (int b = 0; b < 2; ++b)
#pragma unroll
            for (int m = 0; m < 4; ++m)
#pragma unroll
                for (int n = 0; n < 2; ++n) acc[a][b][m][n] = (f32x4){0.f, 0.f, 0.f, 0.f};
    bf16x8 At[4][2], B0[2][2], B1[2][2];
    const char* cA = (const char*)g.A + (size_t)cur.pm * tstepA + (size_t)cur.k0 * 2; const char* cB = (const char*)g.Bt + (size_t)cur.e * g.bstride + (size_t)cur.pn * tstepB + (size_t)cur.k0 * 2;
    PG8_STAGE(PG8_SB(0, 0), cB, voffB); PG8_STAGE(PG8_SB(0, 1), cB + hstepB, voffB); PG8_STAGE(PG8_SA(0, 0), cA, voffA); PG8_STAGE(PG8_SA(0, 1), cA + hstepA, voffA);
    if (wr == 1) PG8_BAR;
    PG8_WAIT_V(2); PG8_BAR;
    PG8_STAGE(PG8_SB(1, 0), cB + kstep, voffB); PG8_STAGE(PG8_SA(1, 0), cA + kstep, voffA); PG8_STAGE(PG8_SB(1, 1), cB + hstepB + kstep, voffB);
    PG8_WAIT_V(6); PG8_BAR;
    for (;;) {
        const bool has_next = S.next(ui + 1, nxt);
        const char* nA = has_next ? (const char*)g.A + (size_t)nxt.pm * tstepA + (size_t)nxt.k0 * 2 : cA; const char* nB = has_next ? (const char*)g.Bt + (size_t)nxt.e * g.bstride + (size_t)nxt.pn * tstepB + (size_t)nxt.k0 * 2 : cB;
#pragma unroll 1
        for (int t = 0; t < nt; t += 2) {
            const bool last = (t == nt - 2);
            const char* a1 = cA + (size_t)(t + 1) * kstep;
            const char* a2 = last ? nA : cA + (size_t)(t + 2) * kstep; const char* b2 = last ? nB : cB + (size_t)(t + 2) * kstep;
            const char* a3 = a2 + kstep; const char* b3 = b2 + kstep;
            PG8_LDB(B0, 0, 0); PG8_LDB(B1, 0, 1); PG8_SCHED; PG8_LDA(At, 0, 0); PG8_STAGE(PG8_SA(1, 1), a1 + hstepA, voffA);
            PG8_WAIT_V(8); PG8_WAIT_L(0); PG8_BAR; PG8_MMA(0, 0, At, B0); PG8_MMA(0, 1, At, B1); PG8_BAR; PG8_SCHED;
            PG8_LDA(At, 0, 1); PG8_STAGE(PG8_SB(0, 0), b2, voffB); PG8_STAGE(PG8_SB(0, 1), b2 + hstepB, voffB); PG8_STAGE(PG8_SA(0, 0), a2, voffA);
            PG8_WAIT_V(8); PG8_WAIT_L(0); PG8_BAR; PG8_MMA(1, 0, At, B0); PG8_MMA(1, 1, At, B1); PG8_BAR; PG8_SCHED;
            PG8_LDB(B0, 1, 0); PG8_LDB(B1, 1, 1); PG8_SCHED; PG8_LDA(At, 1, 0); PG8_STAGE(PG8_SA(0, 1), a2 + hstepA, voffA);
            PG8_WAIT_V(8); PG8_WAIT_L(0); PG8_BAR; PG8_MMA(0, 0, At, B0); PG8_MMA(0, 1, At, B1); PG8_BAR; PG8_SCHED;
            PG8_LDA(At, 1, 1); PG8_STAGE(PG8_SB(1, 0), b3, voffB); PG8_STAGE(PG8_SB(1, 1), b3 + hstepB, voffB); PG8_STAGE(PG8_SA(1, 0), a3, voffA);
            PG8_WAIT_V(8); PG8_WAIT_L(0); PG8_BAR; PG8_MMA(1, 0, At, B0); PG8_MMA(1, 1, At, B1); PG8_BAR; PG8_SCHED;
        }
        if (wr == 0) PG8_BAR;
        E(acc, cur, wr, wc, fr, fq);
        if (!has_next) break;
#pragma unroll
        for (int a = 0; a < 2; ++a)
#pragma unroll
            for (int b = 0; b < 2; ++b)
#pragma unroll
                for (int m = 0; m < 4; ++m)
#pragma unroll
                    for (int n = 0; n < 2; ++n) acc[a][b][m][n] = (f32x4){0.f, 0.f, 0.f, 0.f};
        cur = nxt; cA = nA; cB = nB; ++ui;
        if (wr == 1) PG8_BAR;
    }
    PG8_WAIT_V(0);
    PG8_BAR;
#undef PG8_SA
#undef PG8_SB
#undef PG8_STAGE
#undef PG8_LDA
#undef PG8_LDB
#undef PG8_MMA
#undef PG8_WAIT_V
#undef PG8_WAIT_L
#undef PG8_BAR
#undef PG8_SCHED
}
#else
DEV unsigned cvt_pk_bf16(float lo, float hi) { return pk2(lo, hi); }
template <class Epi, class Sched>
DEV void gemm_phase(unsigned char*, const int tid, const Gemm g, const Sched& S, const Epi& E) {
    const int wid = tid >> 6, lane = tid & 63, wr = wid >> 2, wc = wid & 3, fr = lane & 15, fq = lane >> 4;
    Unit u;
    for (int ui = 0; S.next(ui, u); ++ui) {
        f32x4 acc[2][2][4][2];
        const bf16* Bt = (const bf16*)((const char*)g.Bt + (size_t)u.e * g.bstride);
        for (int ai = 0; ai < 2; ++ai) for (int bj = 0; bj < 2; ++bj) for (int m = 0; m < 4; ++m) for (int n = 0; n < 2; ++n) for (int j = 0; j < 4; ++j) {
            const size_t row = (size_t)u.pm * 256 + 128 * ai + 64 * wr + 16 * m + fr;
            const size_t col = (size_t)u.pn * 256 + 128 * bj + 32 * wc + (Epi::PERM ? 8 * fq + 4 * n + j : 16 * n + 4 * fq + j);
            const bf16* a = g.A + row * g.lda + u.k0; const bf16* b = Bt + col * g.ldb + u.k0; float s = 0.f;
            for (int k = 0; k < g.K; ++k) s += bf2f(a[k]) * bf2f(b[k]);
            acc[ai][bj][m][n][j] = s; }
        E(acc, u, wr, wc, fr, fq);
    }
}
#endif
}

using pg8::Unit;
struct EpiStore {
    static constexpr bool PERM = true;
    bf16* O; int ldc; float* gates;
    DEV void operator()(const f32x4 (&acc)[2][2][4][2], const Unit& u, int wr, int wc, int fr, int fq) const {
        const int row0 = u.pm * 256 + wr * 64 + fr, col0 = u.pn * 256 + wc * 32 + 8 * fq;
        const bool dog = gates != nullptr && u.pn == C_G / 256 && wc == 0 && fq < 2;
#pragma unroll
        for (int ai = 0; ai < 2; ++ai)
#pragma unroll
            for (int m = 0; m < 4; ++m) { const int row = row0 + ai * 128 + m * 16; bf16* rowp = O + (size_t)row * ldc + col0;
#pragma unroll
                for (int bj = 0; bj < 2; ++bj) { const f32x4 v0 = acc[ai][bj][m][0], v1 = acc[ai][bj][m][1];
                    u32x4 w; w.x = pg8::cvt_pk_bf16(v0[0], v0[1]); w.y = pg8::cvt_pk_bf16(v0[2], v0[3]); w.z = pg8::cvt_pk_bf16(v1[0], v1[1]); w.w = pg8::cvt_pk_bf16(v1[2], v1[3]);
                    *(u32x4*)(rowp + bj * 128) = w;
                    if (bj == 0 && dog) { float* gp = gates + (size_t)row * 16 + 8 * fq; *(f32x4*)gp = v0; *(f32x4*)(gp + 4) = v1; } } }
    }
};
template <bool from_input> struct EpiResid {
    static constexpr bool PERM = true;
    P p; int l, goff;
    DEV void operator()(const f32x4 (&acc)[2][2][4][2], const Unit& u, int wr, int wc, int fr, int fq) const {
        const int R0 = u.pm * 256, bb = R0 / TP, q0 = R0 % TP; const bool isctx = q0 < CTX;
        bf16* xb = resid_row(p, R0); constexpr size_t rs = RPITCH;
        const float* xin = isctx ? p.ctx + (size_t)(bb * CTX + q0) * D_MODEL : p.x + (size_t)(bb * SEQ + q0 - CTX) * D_MODEL;
        const float* gv = modv(p, l, R0) + goff;
        const int col0 = u.pn * 256 + wc * 32 + 8 * fq;
        constexpr int MB = from_input ? 2 : 4;
#pragma unroll
        for (int bj = 0; bj < 2; ++bj) { const int col = col0 + bj * 128; const f32x4 g0 = *(const f32x4*)(gv + col), g1 = *(const f32x4*)(gv + col + 4);
#pragma unroll
            for (int ai = 0; ai < 2; ++ai)
#pragma unroll
                for (int mb = 0; mb < 4; mb += MB) { f32x4 a0[MB], a1[MB];
#pragma unroll
                    for (int mm = 0; mm < MB; ++mm) { const size_t rl = (size_t)(wr * 64 + fr + ai * 128 + (mb + mm) * 16);
                        if (from_input) { a0[mm] = *(const f32x4*)(xin + rl * D_MODEL + col); a1[mm] = *(const f32x4*)(xin + rl * D_MODEL + col + 4); }
                        else { const u32x4 t = *(const u32x4*)(xb + rl * rs + col);
                            a0[mm] = (f32x4){bf2f((bf16)t.x), bf2f((bf16)(t.x >> 16)), bf2f((bf16)t.y), bf2f((bf16)(t.y >> 16))}; a1[mm] = (f32x4){bf2f((bf16)t.z), bf2f((bf16)(t.z >> 16)), bf2f((bf16)t.w), bf2f((bf16)(t.w >> 16))}; } }
#pragma unroll
                    for (int mm = 0; mm < MB; ++mm) { const size_t rl = (size_t)(wr * 64 + fr + ai * 128 + (mb + mm) * 16);
                        const f32x4 o0 = a0[mm] + g0 * acc[ai][bj][mb + mm][0], o1 = a1[mm] + g1 * acc[ai][bj][mb + mm][1];
                        u32x4 wv; wv.x = pg8::cvt_pk_bf16(o0[0], o0[1]); wv.y = pg8::cvt_pk_bf16(o0[2], o0[3]); wv.z = pg8::cvt_pk_bf16(o1[0], o1[1]); wv.w = pg8::cvt_pk_bf16(o1[2], o1[3]);
                        *(u32x4*)(xb + rl * rs + col) = wv; } } }
    }
};
struct EpiSwiglu {
    static constexpr bool PERM = true;
    bf16* O; int pm_base;
    DEV void operator()(const f32x4 (&acc)[2][2][4][2], const Unit& u, int wr, int wc, int fr, int fq) const {
        const int row0 = u.po * 256 + wr * 64 + fr, col0 = u.pn * 128 + wc * 32 + 8 * fq;
#pragma unroll
        for (int ai = 0; ai < 2; ++ai)
#pragma unroll
            for (int m = 0; m < 4; ++m) { float r[8];
#pragma unroll
                for (int n = 0; n < 2; ++n)
#pragma unroll
                    for (int j = 0; j < 4; ++j) r[4 * n + j] = silu_fast(acc[ai][0][m][n][j]) * acc[ai][1][m][n][j];
                u32x4 w; w.x = pg8::cvt_pk_bf16(r[0], r[1]); w.y = pg8::cvt_pk_bf16(r[2], r[3]); w.z = pg8::cvt_pk_bf16(r[4], r[5]); w.w = pg8::cvt_pk_bf16(r[6], r[7]);
                *(u32x4*)(O + (size_t)(row0 + ai * 128 + m * 16) * D_FF + col0) = w; }
    }
};
struct EpiStoreRel {
    static constexpr bool PERM = true;
    bf16* O; int ldc, pm_base;
    DEV void operator()(const f32x4 (&acc)[2][2][4][2], const Unit& u, int wr, int wc, int fr, int fq) const {
        const int row0 = u.po * 256 + wr * 64 + fr, col0 = u.pn * 256 + wc * 32 + 8 * fq;
#pragma unroll
        for (int ai = 0; ai < 2; ++ai)
#pragma unroll
            for (int m = 0; m < 4; ++m) { bf16* rowp = O + (size_t)(row0 + ai * 128 + m * 16) * ldc + col0;
#pragma unroll
                for (int bj = 0; bj < 2; ++bj) { const f32x4 v0 = acc[ai][bj][m][0], v1 = acc[ai][bj][m][1];
                    u32x4 w; w.x = pg8::cvt_pk_bf16(v0[0], v0[1]); w.y = pg8::cvt_pk_bf16(v0[2], v0[3]); w.z = pg8::cvt_pk_bf16(v1[0], v1[1]); w.w = pg8::cvt_pk_bf16(v1[2], v1[3]);
                    *(u32x4*)(rowp + bj * 128) = w; } }
    }
};
template <int mode> struct Sched {
    pg8::Order o; int pm_base; const int* seg; int nNc, kper;
    DEV bool next(int i, Unit& u) const {
        int lm, ln; if (!o.nextL(i, lm, ln)) return false;
        u.pn = ln; u.e = 0; u.k0 = 0; u.po = lm;
        if (mode == 0) u.pm = lm;
        else if (mode == 1) u.pm = (lm / NQL) * PAN_B + 1 + lm % NQL;
        else if (mode == 6) { u.pm = lm; u.k0 = (ln >= 2) ? 256 : 0; }
        else if (mode == 4) { u.pm = lm * PAN_B; u.pn = ln % nNc; u.k0 = (ln / nNc) * kper; u.po = (ln / nNc) * o.nM + lm; }
        else { const int gp = pm_base + lm; int e = 0;
#pragma unroll
            for (int k = 1; k < NEXP; ++k) e += (seg[k] <= gp) ? 1 : 0;
            u.e = e; u.pm = (mode == 2) ? gp : lm;
            if (mode == 5) { u.pn = ln % nNc; u.k0 = (ln / nNc) * kper; u.po = (ln / nNc) * o.nM + lm; } }
        return true;
    }
};

#ifndef WGM_MASK
#define WGM_MASK 0x01f
#endif
#define SITE_WGM(k) (((WGM_MASK >> (k)) & 1) ? 4 : 8)
struct TabSched {
    const int* tab; int n;
    DEV bool next(int i, Unit& u) const {
        if (i >= n) return false;
        u.pm = UNIFORM_I(tab[5 * i]); u.pn = UNIFORM_I(tab[5 * i + 1]); u.e = UNIFORM_I(tab[5 * i + 2]); u.k0 = UNIFORM_I(tab[5 * i + 3]); u.po = UNIFORM_I(tab[5 * i + 4]);
        return true;
    }
};
constexpr int MAX_UNITS = 150;
template <class S> DEV TabSched build_units(unsigned* misc, int tid, const S& sch) {
    int* tab = (int*)(misc + 256);
    __syncthreads();
    if (tid < MAX_UNITS) { Unit u; if (sch.next(tid, u)) { tab[5 * tid] = u.pm; tab[5 * tid + 1] = u.pn; tab[5 * tid + 2] = u.e; tab[5 * tid + 3] = u.k0; tab[5 * tid + 4] = u.po; } }
    __syncthreads();
    const int nwg = sch.o.nwg, c = sch.o.c, G = sch.o.G;
    TabSched t; t.tab = tab; t.n = (c < nwg) ? (nwg - c + G - 1) / G : 0;
    return t;
}

#ifndef EMU
#define XB_TMO      128
#define XB_XCNT(j)  (256  + 64 * (j))
#define XB_XSUB(j)  (1280 + 64 * (j))
#define XB_XGEN(j)  (2304 + 64 * (j))
#define XB_TOP      3328
#define XB_TOPGEN   3392
#define XCD_BAR_WORDS 3456
#define XB_SPIN_CAP (1u << 22)
#define LAS __attribute__((address_space(3)))
__device__ __forceinline__ unsigned xb_ld(unsigned* p)              { return __hip_atomic_load(p, __ATOMIC_RELAXED, __HIP_MEMORY_SCOPE_AGENT); }
__device__ __forceinline__ unsigned xb_add(unsigned* p, unsigned v) { return __hip_atomic_fetch_add(p, v, __ATOMIC_RELAXED, __HIP_MEMORY_SCOPE_AGENT); }
__device__ __forceinline__ unsigned xb_xcc_id() { return (unsigned)__builtin_amdgcn_s_getreg((3 << 11) | 20) & 0xFu; }
#define XB_SPIN(cond, bar) do { unsigned _sp = 0; while (cond) { __builtin_amdgcn_s_sleep(1); \
    if ((++_sp & 255u) == 0u) { if (xb_ld(&(bar)[XB_TMO])) break; if (_sp > XB_SPIN_CAP) { atomicAdd(&(bar)[XB_TMO], 1u); break; } } } } while (0)
struct XcdBarrier { unsigned* bar; unsigned x; volatile LAS unsigned* st; };
__device__ __forceinline__ XcdBarrier xcd_barrier_post(unsigned* bar, volatile LAS unsigned* st) {
    XcdBarrier b; b.bar = bar; b.x = xb_xcc_id(); b.st = st;
    if (threadIdx.x == 0) (void)xb_add(&bar[XB_XCNT(b.x)], 1u);
    return b;
}
__device__ __forceinline__ void xcd_barrier_complete(unsigned* bar, unsigned x, unsigned& nloc, unsigned& nx) {
    const unsigned G = gridDim.x * gridDim.y * gridDim.z;
    unsigned sum, cnt, mine, sp = 0u;
    for (;;) {
        sum = 0u; cnt = 0u; mine = 0u;
#pragma unroll
        for (unsigned j = 0; j < 16; ++j) { const unsigned c = xb_ld(&bar[XB_XCNT(j)]); sum += c; cnt += (c > 0u) ? 1u : 0u; mine = (j == x) ? c : mine; }
        if (sum == G) break;
        __builtin_amdgcn_s_sleep(1);
        if ((++sp & 255u) == 0u) { if (xb_ld(&bar[XB_TMO])) break; if (sp > XB_SPIN_CAP) { atomicAdd(&bar[XB_TMO], 1u); break; } }
    }
    nloc = mine > 0u ? mine : 1u; nx = cnt > 0u ? cnt : 1u;
}
__device__ __forceinline__ void xcd_barrier(const XcdBarrier& b) {
    asm volatile("s_waitcnt vmcnt(0)" ::: "memory");
    __syncthreads();
    if (threadIdx.x == 0) {
        unsigned* bar = b.bar;
        __builtin_amdgcn_s_waitcnt(0);
        unsigned nloc = b.st[0], nx = b.st[1];
        if (nloc == 0u) { xcd_barrier_complete(bar, b.x, nloc, nx); b.st[0] = nloc; b.st[1] = nx; }
        const unsigned old = xb_add(&bar[XB_XSUB(b.x)], 1u);
        const unsigned gen = old / nloc;
        if (old + 1u == (gen + 1u) * nloc) {
            __builtin_amdgcn_fence(__ATOMIC_RELEASE, "agent");
            asm volatile("s_waitcnt vmcnt(0)" ::: "memory");
            const unsigned og = xb_add(&bar[XB_TOP], 1u);
            const unsigned tg = og / nx;
            if (og + 1u == (tg + 1u) * nx) xb_add(&bar[XB_TOPGEN], 1u);
            else XB_SPIN(xb_ld(&bar[XB_TOPGEN]) == tg, bar);
            __builtin_amdgcn_fence(__ATOMIC_ACQUIRE, "agent");
            xb_add(&bar[XB_XGEN(b.x)], 1u);
            asm volatile("s_waitcnt vmcnt(0)" ::: "memory");
        } else {
            XB_SPIN(xb_ld(&bar[XB_XGEN(b.x)]) == gen, bar);
            __builtin_amdgcn_fence(__ATOMIC_ACQUIRE, "agent");
            asm volatile("s_waitcnt vmcnt(0)" ::: "memory");
        }
    }
    __syncthreads();
}
#endif

struct Wg { int tid, lane, wave, G, wg, gw, NGW; unsigned char* lds; unsigned* misc; };
DEV int q_next(Wg& w, unsigned* ctr) {
    if (w.tid == 0) w.misc[2] = atomicAdd(ctr, 1u);
    __syncthreads();
    const int v = (int)w.misc[2];
    __syncthreads();
    return v;
}

struct ConvJob { const float* src; int K, N, Npad; bf16* dst; int ldk, kdst0, rowofs, mode; };
struct ConvTile { const float* src; int N, k0, n0; bf16* dst; int ldk, kdst0, rowofs, mode; bool valid; };
DEV bool conv_job_pick(const ConvJob& j, int& it, ConvTile& t) {
    const int nkb = j.K / 64, nnb = j.Npad / 128, tot = nkb * nnb;
    if (it >= tot) { it -= tot; return false; }
    t.src = j.src; t.N = j.N; t.k0 = (it / nnb) * 64; t.n0 = (it % nnb) * 128; t.dst = j.dst; t.ldk = j.ldk; t.kdst0 = j.kdst0; t.rowofs = j.rowofs; t.mode = j.mode; t.valid = true;
    return true;
}
DEV void conv_load(const ConvTile& t, f32x4 (&v)[4], int tid) {
#pragma unroll
    for (int i = 0; i < 4; ++i) { const int kk = i * 16 + (tid >> 5), c4 = tid & 31; v[i] = (t.valid && t.n0 + 4 * c4 < t.N) ? *(const f32x4*)(t.src + (size_t)(t.k0 + kk) * t.N + t.n0 + 4 * c4) : (f32x4){0.f, 0.f, 0.f, 0.f}; }
}
DEV void conv_store(const ConvTile& t, const f32x4 (&v)[4], float* scr, int tid) {
#pragma unroll
    for (int i = 0; i < 4; ++i) { const int kk = i * 16 + (tid >> 5), c4 = tid & 31; *(f32x4*)(scr + kk * 132 + 4 * c4) = v[i]; }
    __syncthreads();
#pragma unroll
    for (int i = 0; i < 2; ++i) { const int idx = tid + NTHR * i, n = idx >> 3, c = idx & 7, ng = t.n0 + n; const float* s = scr + (8 * c) * 132 + n;
      const int row = t.rowofs + (t.mode == 0 ? ng : (ng / 128) * 256 + (ng % 128) + (t.mode == 2 ? 128 : 0));
      u32x4 o; o.x = pk2(s[0], s[132]); o.y = pk2(s[2 * 132], s[3 * 132]); o.z = pk2(s[4 * 132], s[5 * 132]); o.w = pk2(s[6 * 132], s[7 * 132]);
      *(u32x4*)(t.dst + (size_t)row * t.ldk + t.kdst0 + t.k0 + 8 * c) = o; }
    __syncthreads();
}
DEV void zero_rect(bf16* dst, int ld, int r0, int r1, int c0, int c1, int gtid, int gn) {
    const int cw = (c1 - c0) / 8; const long tot = (long)(r1 - r0) * cw;
    for (long i = gtid; i < tot; i += gn) { const int r = r0 + (int)(i / cw), c = c0 + 8 * (int)(i % cw); *(u32x4*)(dst + (size_t)r * ld + c) = (u32x4){0u, 0u, 0u, 0u}; }
}
DEV void phase0(const P& p, Wg& w) {
    float* scr = (float*)w.lds;
    {
        bf16* WIN = (bf16*)(p.ws + WS_WIN_T); bf16* WOUT = (bf16*)(p.ws + WS_WOUT_T); bf16* MLT = (bf16*)(p.ws + WS_MLA_T);
#define JOB_WIN(l) ConvJob{p.w_in + (size_t)(l) * D_MODEL * IN_W, D_MODEL, IN_W, PROJ_W, WIN + (size_t)(l) * PROJ_W * D_MODEL, D_MODEL, 0, 0, 0}
#define JOB_WOUT(l) ConvJob{p.w_out + (size_t)(l) * MIXW * D_MODEL, MIXW, D_MODEL, D_MODEL, WOUT + (size_t)(l) * D_MODEL * MIXW, MIXW, 0, 0, 0}
#define JOB_WUQ(l) ConvJob{p.l_wuq + (size_t)(l) * 256 * 384, 256, 384, 384, MLT + (size_t)(l) * 1024 * 512, 512, 0, 0, 0}
#define JOB_WUKV(l) ConvJob{p.l_wukv + (size_t)(l) * 128 * 512, 128, 512, 512, MLT + (size_t)(l) * 1024 * 512, 512, 256, 512, 0}
        constexpr int total = 2 * ((D_MODEL / 64) * (PROJ_W / 128) + (MIXW / 64) * (D_MODEL / 128) + 4 * 3 + 2 * 4) + 2 * (D_MODEL / 64) * (D_FF / 128) + (D_FF / 64) * (D_MODEL / 128);
        ConvTile cur, nxt; f32x4 vc[4], vn[4]; cur.valid = false;
#define PICK0(it0_, T) do { int it = (it0_); T.valid = false; if ((it0_) < total) { \
            if (!conv_job_pick(JOB_WIN(0), it, T)) if (!conv_job_pick(JOB_WIN(1), it, T)) if (!conv_job_pick(JOB_WOUT(0), it, T)) if (!conv_job_pick(JOB_WOUT(1), it, T)) \
            if (!conv_job_pick(JOB_WUQ(0), it, T)) if (!conv_job_pick(JOB_WUQ(1), it, T)) if (!conv_job_pick(JOB_WUKV(0), it, T)) if (!conv_job_pick(JOB_WUKV(1), it, T)) \
            if (!conv_job_pick(ConvJob{p.ffn_wg, D_MODEL, D_FF, D_FF, (bf16*)(p.ws + WS_WGU_T), D_MODEL, 0, 0, 1}, it, T)) \
            if (!conv_job_pick(ConvJob{p.ffn_wu, D_MODEL, D_FF, D_FF, (bf16*)(p.ws + WS_WGU_T), D_MODEL, 0, 0, 2}, it, T)) \
            conv_job_pick(ConvJob{p.ffn_wd, D_FF, D_MODEL, D_MODEL, (bf16*)(p.ws + WS_WD_T), D_FF, 0, 0, 0}, it, T); } } while (0)
        PICK0(w.wg, cur); if (cur.valid) conv_load(cur, vc, w.tid);
        for (int it0 = w.wg; it0 < total; it0 += w.G) {
            PICK0(it0 + w.G, nxt); if (nxt.valid) conv_load(nxt, vn, w.tid);
            conv_store(cur, vc, scr, w.tid);
            cur = nxt;
#pragma unroll
            for (int i = 0; i < 4; ++i) vc[i] = vn[i];
        }
#undef PICK0
    }
    for (int l = 0; l < 2; ++l) { bf16* mt = (bf16*)(p.ws + WS_MLA_T) + (size_t)l * 1024 * 512; const int gt = w.wg * NTHR + w.tid, gn = w.G * NTHR;
        zero_rect(mt, 512, 384, 512, 0, 256, gt, gn); zero_rect(mt, 512, 512, 1024, 384, 512, gt, gn); }
    if (w.wg == w.G - 1) for (int i = w.tid; i < NPOS * 24; i += NTHR) { const int pos = i / 24, f = i % 24;
        const float inv = f < 16 ? exp2f(-(float)f * (13.287712379549449f / 16.0f)) : exp2f(-(float)(f - 16) * (13.287712379549449f / 8.0f));
        float sn, cs; sincosf((float)pos * inv, &sn, &cs); float* rt = (float*)(p.ws + WS_ROPE) + 2 * i; rt[0] = cs; rt[1] = sn; }
    {
        float* sS = (float*)w.lds;
        float* part = sS + NV * D_MODEL;
        const int nitem = 2 * (6 * D_MODEL / 64);
        bool loaded = false;
        for (int it = w.wg; it < nitem; it += w.G) {
            if (!loaded) { for (int i = w.tid; i < NV * D_MODEL; i += NTHR) { const int v = i / D_MODEL, k = i % D_MODEL; sS[i] = silu_f(v < BATCH ? p.c[v * D_MODEL + k] : p.c_ctx[k]); } loaded = true; __syncthreads(); }
            const int l = it / (6 * D_MODEL / 64), cb = it % (6 * D_MODEL / 64), col = cb * 64 + w.lane;
            float acc[NV];
#pragma unroll
            for (int v = 0; v < NV; ++v) acc[v] = 0.f;
            const float* mw = p.mod_w + (size_t)l * D_MODEL * 6 * D_MODEL + col;
            for (int k0 = w.wave * (D_MODEL / 8); k0 < (w.wave + 1) * (D_MODEL / 8); k0 += 16) { float wv[16];
#pragma unroll
                for (int kk = 0; kk < 16; ++kk) wv[kk] = mw[(size_t)(k0 + kk) * 6 * D_MODEL];
#pragma unroll
                for (int kk = 0; kk < 16; ++kk)
#pragma unroll
                    for (int v = 0; v < NV; ++v) acc[v] += sS[v * D_MODEL + k0 + kk] * wv[kk]; }
#pragma unroll
            for (int v = 0; v < NV; ++v) part[(w.wave * NV + v) * 64 + w.lane] = acc[v];
            __syncthreads();
            for (int i = w.tid; i < NV * 64; i += NTHR) { const int v = i / 64, cc = i % 64; float s = p.mod_b[(size_t)l * 6 * D_MODEL + cb * 64 + cc];
#pragma unroll
                for (int ww = 0; ww < 8; ++ww) s += part[(ww * NV + v) * 64 + cc];
                ((float*)(p.ws + WS_MODV))[(size_t)(l * NV + v) * 6 * D_MODEL + cb * 64 + cc] = s; }
            __syncthreads();
        }
    }
}
DEV void phase_moe_weights(const P& p, Wg& w) {
    float* scr = (float*)w.lds;
    const int t_gu = (D_MODEL / 64) * (D_FF / 128), t_d = (D_FF / 64) * (D_MODEL / 128), per_e = 2 * t_gu + t_d;
    ConvTile cur, nxt; f32x4 vc[4], vn[4];
#define PICKM(it0_, T) do { T.valid = false; if ((it0_) < NEXP * per_e) { const int e = (it0_) / per_e; int it = (it0_) % per_e; bf16* base = (bf16*)(p.ws + WS_MOEW + (size_t)e * MOEW_E); \
        if (!conv_job_pick(ConvJob{p.moe_wg + (size_t)e * D_MODEL * D_FF, D_MODEL, D_FF, D_FF, base, D_MODEL, 0, 0, 1}, it, T)) \
        if (!conv_job_pick(ConvJob{p.moe_wu + (size_t)e * D_MODEL * D_FF, D_MODEL, D_FF, D_FF, base, D_MODEL, 0, 0, 2}, it, T)) \
        conv_job_pick(ConvJob{p.moe_wd + (size_t)e * D_FF * D_MODEL, D_FF, D_MODEL, D_MODEL, base + (size_t)2 * D_FF * D_MODEL, D_FF, 0, 0, 0}, it, T); } } while (0)
    PICKM(w.wg, cur); if (cur.valid) conv_load(cur, vc, w.tid);
    for (int it0 = w.wg; it0 < NEXP * per_e; it0 += w.G) {
        PICKM(it0 + w.G, nxt); if (nxt.valid) conv_load(nxt, vn, w.tid);
        conv_store(cur, vc, scr, w.tid);
        cur = nxt;
#pragma unroll
        for (int i = 0; i < 4; ++i) vc[i] = vn[i];
    }
#undef PICKM
}

template <int NB> DEV void phase_modulate(const P& p, Wg& w, int l, int which, bool first, bool skip_ctx, bool moe, bool ctx_part) {
    constexpr int NJ = D_MODEL / 256;
    bf16* H = (bf16*)(p.ws + WS_H);
    const float* gn = (which ? p.norm_ffn : p.norm_mix) + (size_t)l * D_MODEL;
    int cnt[NEXP];
#pragma unroll
    for (int e = 0; e < NEXP; ++e) cnt[e] = 0;
    f32x4 rw[NJ * 4][2];
    if (moe) {
#pragma unroll
        for (int j = 0; j < NJ; ++j)
#pragma unroll
            for (int k = 0; k < 4; ++k) { const float* rr = p.moe_router + (size_t)(4 * w.lane + 256 * j + k) * NEXP; rw[4 * j + k][0] = *(const f32x4*)rr; rw[4 * j + k][1] = *(const f32x4*)(rr + 4); } }
    f32x4 gnv[NJ];
#pragma unroll
    for (int j = 0; j < NJ; ++j) gnv[j] = *(const f32x4*)(gn + 4 * w.lane + 256 * j);
    for (int Rb = w.gw; Rb < M_ALL; Rb += NB * w.NGW) {
        f32x4 vv[NB][NJ]; bool okr[NB];
#pragma unroll
        for (int qq = 0; qq < NB; ++qq) { const int R = Rb + qq * w.NGW; okr[qq] = R < M_ALL && !(skip_ctx && (R % TP) < CTX); const int Rr = okr[qq] ? R : Rb;
            const int b = Rr / TP, q = Rr % TP; const bf16* xr = resid_row(p, Rr);
            const float* src = q < CTX ? p.ctx + (size_t)(b * CTX + q) * D_MODEL : p.x + (size_t)(b * SEQ + q - CTX) * D_MODEL;
#pragma unroll
            for (int j = 0; j < NJ; ++j) { const int col = 4 * w.lane + 256 * j;
                if (first) vv[qq][j] = *(const f32x4*)(src + col);
                else { const u32x2 t = *(const u32x2*)(xr + col); vv[qq][j] = (f32x4){bf2f((bf16)t.x), bf2f((bf16)(t.x >> 16)), bf2f((bf16)t.y), bf2f((bf16)(t.y >> 16))}; } } }
#pragma unroll
        for (int qq = 0; qq < NB; ++qq) { if (!okr[qq]) continue;
        const int R = Rb + qq * w.NGW; const int b = R / TP, q = R % TP;
        bf16* xr = resid_row(p, R);
        f32x4 v[NJ]; float ss = 0.f;
#pragma unroll
        for (int j = 0; j < NJ; ++j) { v[j] = vv[qq][j]; ss += v[j][0] * v[j][0] + v[j][1] * v[j][1] + v[j][2] * v[j][2] + v[j][3] * v[j][3]; }
        if (ctx_part && q < CTX) {
            const bf16* cp = (const bf16*)(p.ws + WS_MLAQ) + (size_t)(b * CTX + q) * D_MODEL; const float* gf = (const float*)(p.ws + WS_MODV) + (size_t)((l - 1) * NV + BATCH) * 6 * D_MODEL + 5 * D_MODEL;
            ss = 0.f;
#pragma unroll
            for (int j = 0; j < NJ; ++j) { const int col = 4 * w.lane + 256 * j; f32x4 a = (f32x4){0.f, 0.f, 0.f, 0.f};
                for (int ks = 0; ks < NSPLIT; ++ks) { const u32x2 t = *(const u32x2*)(cp + (size_t)ks * BATCH * CTX * D_MODEL + col);
                    a[0] += bf2f((bf16)t.x); a[1] += bf2f((bf16)(t.x >> 16)); a[2] += bf2f((bf16)t.y); a[3] += bf2f((bf16)(t.y >> 16)); }
                const f32x4 g = *(const f32x4*)(gf + col); v[j] = v[j] + g * a; { u32x2 wb; wb.x = pk2(v[j][0], v[j][1]); wb.y = pk2(v[j][2], v[j][3]); *(u32x2*)(xr + col) = wb; }
                ss += v[j][0] * v[j][0] + v[j][1] * v[j][1] + v[j][2] * v[j][2] + v[j][3] * v[j][3]; } }
        ss = wave_sum(ss, w.lane);
        const float rstd = rsqrt_fast(ss * (1.0f / D_MODEL) + EPS);
        const float* mv = modv(p, l, R); const float* sh = mv + (which ? 3 : 0) * D_MODEL; const float* sc = mv + (which ? 4 : 1) * D_MODEL;
        float lg[NEXP];
#pragma unroll
        for (int e = 0; e < NEXP; ++e) lg[e] = 0.f;
#pragma unroll
        for (int j = 0; j < NJ; ++j) { const int col = 4 * w.lane + 256 * j;
            const f32x4 g = gnv[j], s1 = *(const f32x4*)(sc + col), s0 = *(const f32x4*)(sh + col);
            f32x4 h;
#pragma unroll
            for (int k = 0; k < 4; ++k) h[k] = v[j][k] * rstd * g[k] * (1.0f + s1[k]) + s0[k];
            u32x2 o; o.x = pk2(h[0], h[1]); o.y = pk2(h[2], h[3]);
            *(u32x2*)(H + (size_t)R * D_MODEL + col) = o;
            if (moe) {
#pragma unroll
                for (int k = 0; k < 4; ++k) {
#pragma unroll
                    for (int e = 0; e < NEXP; ++e) lg[e] += h[k] * rw[4 * j + k][e >> 2][e & 3]; } } }
        if (moe) {
#pragma unroll
            for (int e = 0; e < NEXP; ++e) lg[e] = wave_sum(lg[e], w.lane);
            int i1 = 0; float v1 = lg[0];
#pragma unroll
            for (int e = 1; e < NEXP; ++e) if (lg[e] > v1) { v1 = lg[e]; i1 = e; }
            int i2 = -1; float v2 = -3.0e38f;
#pragma unroll
            for (int e = 0; e < NEXP; ++e) if (e != i1 && lg[e] > v2) { v2 = lg[e]; i2 = e; }
            const float w1 = 1.0f / (1.0f + expf(v2 - v1)), w2 = 1.0f - w1;
            const int tok = b * SEQ + q - CTX;
            if (w.lane == 0) { int* ti = (int*)(p.ws + WS_TOPI) + 2 * tok; float* tw = (float*)(p.ws + WS_TOPW) + 2 * tok; ti[0] = i1; ti[1] = i2; tw[0] = w1; tw[1] = w2; }
#pragma unroll
            for (int e = 0; e < NEXP; ++e) cnt[e] += (e == i1 || e == i2) ? 1 : 0;
        }
        }
    }
    if (moe) {
        int* lc = (int*)w.lds;
        if (w.lane == 0) {
#pragma unroll
            for (int e = 0; e < NEXP; ++e) lc[w.wave * NEXP + e] = cnt[e]; }
        __syncthreads();
        if (w.tid < NEXP) { int s = 0; for (int ww = 0; ww < NWAVE; ++ww) s += lc[ww * NEXP + w.tid]; ((int*)(p.ws + WS_CNTG))[w.wg * NEXP + w.tid] = s; }
        __syncthreads();
    }
}

DEV void phase_prep(const P& p, Wg& w, int l) {
    bf16* PROJ = (bf16*)(p.ws + WS_PROJ); bf16* MQK = (bf16*)(p.ws + WS_MQK);
    const float* cw = p.m_conv + (size_t)l * 3 * 768;
    const int lane = w.lane;
    const float gkr = p.l_knorm[l * 96 + 64 + (lane & 31)];
    const f32x4 gcq = *(const f32x4*)(p.l_cq_norm + l * 256 + 4 * lane); const float gkv0 = p.l_ckv_norm[l * 128 + 2 * lane], gkv1 = p.l_ckv_norm[l * 128 + 2 * lane + 1];
    const int hq = lane >> 3, hi8 = lane & 7, hbase = (hq < 6 ? C_AQ + hq * 64 : C_AK + (hq - 6) * 64) + 8 * hi8;
    f32x4 cwv[3][3];
#pragma unroll
    for (int j = 0; j < 3; ++j)
#pragma unroll
        for (int tp = 0; tp < 3; ++tp) cwv[j][tp] = *(const f32x4*)(cw + tp * 768 + 4 * lane + 256 * j);
    float gh[8];
    { const float* gp = (hq < 6 ? p.a_qnorm : p.a_knorm) + l * 64 + 8 * hi8;
#pragma unroll
      for (int j = 0; j < 8; ++j) gh[j] = gp[j] * (hq < 6 ? QSCALE_A : 1.0f); }
    const float* rtab = (const float*)(p.ws + WS_ROPE);
    constexpr int NB = 4;
    const int RPW = (M_ALL + w.NGW - 1) / w.NGW, Rend = ((w.gw + 1) * RPW < M_ALL) ? (w.gw + 1) * RPW : M_ALL;
    for (int R0 = w.gw * RPW; R0 < Rend; R0 += NB) {
        u32x2 c0[NB][3], cp[NB][3], cn[NB][3], cprev[3], cnext[3]; u32x4 hraw[NB]; u32x2 cqv[NB]; unsigned ckvv[NB]; bf16 krv[NB]; bool ok[NB];
        { const bool hpv = R0 > 0, hnv = R0 + NB < M_ALL;
#pragma unroll
          for (int j = 0; j < 3; ++j) { const int col = 4 * lane + 256 * j;
              cprev[j] = hpv ? *(const u32x2*)(PROJ + (size_t)(R0 - 1) * PROJ_W + col) : (u32x2){0u, 0u}; cnext[j] = hnv ? *(const u32x2*)(PROJ + (size_t)(R0 + NB) * PROJ_W + col) : (u32x2){0u, 0u}; } }
#pragma unroll
        for (int q = 0; q < NB; ++q) { const int R = R0 + q; ok[q] = R < Rend; const int Rr = R < M_ALL ? R : R0;
            const bf16* pr = PROJ + (size_t)Rr * PROJ_W;
#pragma unroll
            for (int j = 0; j < 3; ++j) c0[q][j] = *(const u32x2*)(pr + 4 * lane + 256 * j);
            hraw[q] = *(const u32x4*)(pr + hbase); cqv[q] = *(const u32x2*)(pr + C_CQ + 4 * lane); ckvv[q] = *(const unsigned*)(pr + C_CKV + 2 * lane); krv[q] = pr[C_KR + (lane & 31)]; }
#pragma unroll
        for (int q = 0; q < NB; ++q) { const int qq = (R0 + q) % TP; const bool hp = !(qq == 0 || qq == CTX), hn = !(qq == CTX - 1 || qq == TP - 1);
#pragma unroll
            for (int j = 0; j < 3; ++j) { const u32x2 a = (q == 0) ? cprev[j] : c0[q > 0 ? q - 1 : 0][j], n = (q == NB - 1) ? cnext[j] : c0[q < NB - 1 ? q + 1 : 0][j];
                cp[q][j] = hp ? a : (u32x2){0u, 0u}; cn[q][j] = hn ? n : (u32x2){0u, 0u}; } }
#pragma unroll
        for (int q = 0; q < NB; ++q) { const int Rr = (R0 + q < M_ALL) ? R0 + q : R0; const int qq = Rr % TP; const bool lat = qq >= CTX; const int t = qq - CTX;
            bf16* pr = PROJ + (size_t)Rr * PROJ_W;
            u32x2 ov[3];
#pragma unroll
            for (int j = 0; j < 3; ++j) { const int col = 4 * lane + 256 * j; float o[4];
#pragma unroll
                for (int k = 0; k < 4; ++k) { const unsigned sh = (k & 1) * 16; const unsigned a = (k < 2 ? cp[q][j].x : cp[q][j].y) >> sh, c = (k < 2 ? c0[q][j].x : c0[q][j].y) >> sh, n = (k < 2 ? cn[q][j].x : cn[q][j].y) >> sh;
                    const float sv = bf2f((bf16)a) * cwv[j][0][k] + bf2f((bf16)c) * cwv[j][1][k] + bf2f((bf16)n) * cwv[j][2][k]; o[k] = silu_fast(sv) * (col >= 384 ? KSCALE_M : 1.0f); }
                ov[j].x = pk2(o[0], o[1]); ov[j].y = pk2(o[2], o[3]); }
            u32x4 oh;
            { float x[8], ss = 0.f;
#pragma unroll
              for (int j = 0; j < 8; ++j) { x[j] = bf2f((bf16)(hraw[q][j >> 1] >> ((j & 1) * 16))); ss += x[j] * x[j]; }
              ss += SHX(ss, 1, lane); ss += SHX(ss, 2, lane); ss += SHX(ss, 4, lane);
              const float rs = rsqrt_fast(ss * (1.0f / 64.0f) + EPS);
#pragma unroll
              for (int j = 0; j < 8; ++j) x[j] *= rs * gh[j];
              const float* ct = rtab + ((size_t)(lat ? (hi8 < 4 ? t / GRID_W : t % GRID_W) : 0) * 24 + 8 * (hi8 & 1)) * 2;
              const f32x4 t0 = *(const f32x4*)ct, t1 = *(const f32x4*)(ct + 4), t2 = *(const f32x4*)(ct + 8), t3 = *(const f32x4*)(ct + 12);
              const float csv[8] = {t0[0], t0[2], t1[0], t1[2], t2[0], t2[2], t3[0], t3[2]}, snv[8] = {t0[1], t0[3], t1[1], t1[3], t2[1], t2[3], t3[1], t3[3]};
#pragma unroll
              for (int j = 0; j < 8; ++j) { const float pt = SHX(x[j], 2, lane);
                  if (lat) x[j] = (hi8 & 2) ? x[j] * csv[j] + pt * snv[j] : x[j] * csv[j] - pt * snv[j]; }
              oh.x = pk2(x[0], x[1]); oh.y = pk2(x[2], x[3]); oh.z = pk2(x[4], x[5]); oh.w = pk2(x[6], x[7]); }
            float csL = 1.f, snL = 0.f;
            if (lat) { const int d = lane & 31; const float* ct = rtab + ((size_t)(d < 16 ? t / GRID_W : t % GRID_W) * 24 + 16 + (d & 7)) * 2; csL = ct[0]; snL = ct[1]; }
            u32x2 ocq; unsigned ockv; float ykr;
            { float x[4] = {bf2f((bf16)cqv[q].x), bf2f((bf16)(cqv[q].x >> 16)), bf2f((bf16)cqv[q].y), bf2f((bf16)(cqv[q].y >> 16))};
              const float x0 = bf2f((bf16)ckvv[q]), x1 = bf2f((bf16)(ckvv[q] >> 16)); const float vk = lane < 32 ? bf2f(krv[q]) : 0.f;
              float s1 = x[0] * x[0] + x[1] * x[1] + x[2] * x[2] + x[3] * x[3], s2 = x0 * x0 + x1 * x1, s3 = vk * vk;
#pragma unroll
              for (int o = 1; o < 64; o <<= 1) { s1 += SHX(s1, o, lane); s2 += SHX(s2, o, lane); s3 += SHX(s3, o, lane); }
              const float r1 = rsqrt_fast(s1 * (1.0f / 256.0f) + EPS), r2 = rsqrt_fast(s2 * (1.0f / 128.0f) + EPS), r3 = rsqrt_fast(s3 * (1.0f / 32.0f) + EPS);
              ocq.x = pk2(x[0] * r1 * gcq[0], x[1] * r1 * gcq[1]); ocq.y = pk2(x[2] * r1 * gcq[2], x[3] * r1 * gcq[3]);
              ockv = pk2(x0 * r2 * gkv0, x1 * r2 * gkv1);
              float y = vk * r3 * gkr; const float pt = SHX(y, 8, lane);
              if (lat) y = (lane & 8) ? y * csL + pt * snL : y * csL - pt * snL;
              ykr = y; }
            if (ok[q]) {
#pragma unroll
                for (int j = 0; j < 3; ++j) *(u32x2*)(MQK + (size_t)Rr * 768 + 4 * lane + 256 * j) = ov[j];
                *(u32x4*)(pr + hbase) = oh;
                *(u32x2*)(pr + C_CQ + 4 * lane) = ocq; *(unsigned*)(pr + C_CKV + 2 * lane) = ockv;
                if (lane < 32) pr[C_KR + lane] = f2bf(ykr); }
        }
    }
}

DEV float scan_add(float v, int lane) {
#pragma unroll
    for (int d = 1; d < 64; d <<= 1) { const float t = __shfl(v, lane >= d ? lane - d : lane); if (lane >= d) v += t; }
    return v;
}
DEV float scan_max(float v, int lane) {
#pragma unroll
    for (int d = 1; d < 64; d <<= 1) { const float t = __shfl(v, lane >= d ? lane - d : lane); if (lane >= d) v = fmaxf(v, t); }
    return v;
}
DEV int chain_step(int dir, int cl) { return dir == 0 ? cl : (cl < NC_CTX ? NC_CTX - 1 - cl : NCH + NC_CTX - 1 - cl); }
DEV void gate_scan2(const P& p, int l, int R0, int hh, int dir, int lane, float* al, float* pm, float* bcl, float& F, float& pml) {
    static_assert(MCH == 128, "two positions per lane");
    const float* gb = p.m_gate_b + l * 16; float bc[2], a[2], px[2];
    float carry = 0.f, pcar = -3.0e38f;
#pragma unroll
    for (int hf = 0; hf < 2; ++hf) { const int j = lane + 64 * hf, o = dir ? MCH - 1 - j : j;
        const float* G = (const float*)(p.ws + WS_GATES) + (size_t)(R0 + o) * 16;
        const float gi = G[dir * 8 + hh] + gb[dir * 8 + hh], gf = G[dir * 8 + 4 + hh] + gb[dir * 8 + 4 + hh];
        bc[hf] = scan_add(log_sigmoid_f(gf), lane) + carry; a[hf] = gi - bc[hf]; px[hf] = fmaxf(scan_max(a[hf], lane), pcar);
        carry = __shfl(bc[hf], 63); pcar = __shfl(px[hf], 63);
        al[o] = a[hf]; pm[o] = px[hf]; bcl[o] = bc[hf]; }
    F = carry; pml = pcar;
}
DEV void ml1_item(const P& p, Wg& w, int l, int item) {
    const int b = item / (4 * NCH), hh = (item / NCH) % 4, cl = item % NCH, R0 = b * TP + cl * MCH;
    float* wgt = (float*)w.lds;
    float* scr = wgt + 2 * MCH;
    bf16* Ks = (bf16*)(w.lds + 4096);
    bf16* Vw = Ks + MCH * 104;
    const bf16* MQK = (const bf16*)(p.ws + WS_MQK); const bf16* PROJ = (const bf16*)(p.ws + WS_PROJ);
    bf16* UC = (bf16*)(p.ws + WS_UC); float* NL = (float*)(p.ws + WS_NL);
    const int lane = w.lane, r = lane & 31, h = lane >> 5;
    if (w.wave < 2) { const int dir = w.wave; float F, pml; float* sc = scr + dir * 3 * MCH;
        gate_scan2(p, l, R0, hh, dir, lane, sc, sc + MCH, sc + 2 * MCH, F, pml);
        wave_sync();
#pragma unroll
        for (int hf = 0; hf < 2; ++hf) wgt[dir * MCH + lane + 64 * hf] = __expf(sc[lane + 64 * hf] - pml);
        const int ci = ((b * 4 + hh) * 2 + dir) * NCH + chain_step(dir, cl);
        if (lane == 0) { ((float*)(p.ws + WS_FS))[ci] = F; ((float*)(p.ws + WS_PML))[ci] = pml; } }
    __syncthreads();
    for (int idx = w.tid; idx < MCH * 12; idx += NTHR) { const int s = idx / 12, c = idx % 12;
        const u32x4 kr = *(const u32x4*)(MQK + (size_t)(R0 + s) * 768 + 384 + hh * 96 + 8 * c), vr = *(const u32x4*)(PROJ + (size_t)(R0 + s) * PROJ_W + C_MV + hh * 96 + 8 * c);
        *(u32x4*)(Ks + s * 104 + 8 * c) = kr;
#pragma unroll
        for (int dir = 0; dir < 2; ++dir) { const float wd = wgt[dir * MCH + s]; u32x4 o;
            o.x = pk2(wd * bf2f((bf16)vr.x), wd * bf2f((bf16)(vr.x >> 16))); o.y = pk2(wd * bf2f((bf16)vr.y), wd * bf2f((bf16)(vr.y >> 16)));
            o.z = pk2(wd * bf2f((bf16)vr.z), wd * bf2f((bf16)(vr.z >> 16))); o.w = pk2(wd * bf2f((bf16)vr.w), wd * bf2f((bf16)(vr.w >> 16)));
            *(u32x4*)(Vw + (dir * MCH + s) * 104 + 8 * c) = o; } }
    __syncthreads();
    const int toff = (8 * h + ((lane & 15) >> 2)) * 104 + 16 * ((lane >> 4) & 1) + 4 * (lane & 3);
    for (int task = w.wave; task < 18; task += NWAVE) { const int dir = task / 9, dt = (task % 9) / 3, et = task % 3;
        f32x16 acc;
#pragma unroll
        for (int i = 0; i < 16; ++i) acc[i] = 0.f;
#pragma unroll
        for (int ks = 0; ks < MCH / 16; ++ks) { const bf16* ap = Ks + (16 * ks) * 104 + 32 * dt + toff; const bf16* bp = Vw + (dir * MCH + 16 * ks) * 104 + 32 * et + toff;
            const s16x4 al = lds_tr_read(ap), ah = lds_tr_read(ap + 4 * 104), bl = lds_tr_read(bp), bh = lds_tr_read(bp + 4 * 104);
            const bf16x8 af = (bf16x8){al[0], al[1], al[2], al[3], ah[0], ah[1], ah[2], ah[3]}, bfr = (bf16x8){bl[0], bl[1], bl[2], bl[3], bh[0], bh[1], bh[2], bh[3]};
            acc = mfma32(af, bfr, acc); }
        const int ci = ((b * 4 + hh) * 2 + dir) * NCH + chain_step(dir, cl);
        bf16* up = UC + (size_t)ci * 9216 + (32 * et + r) * 96 + 32 * dt + 4 * h;
#pragma unroll
        for (int g = 0; g < 4; ++g) { u32x2 o; o.x = pk2(acc[4 * g], acc[4 * g + 1]); o.y = pk2(acc[4 * g + 2], acc[4 * g + 3]); *(u32x2*)(up + 8 * g) = o; } }
    if (w.tid < 192) { const int dir = w.tid / 96, d = w.tid % 96; float sum = 0.f;
        for (int k = 0; k < MCH; ++k) sum += wgt[dir * MCH + k] * bf2f(Ks[k * 104 + d]);
        NL[(size_t)(((b * 4 + hh) * 2 + dir) * NCH + chain_step(dir, cl)) * 96 + d] = sum; }
    __syncthreads();
}
DEV void phase_ml2(const P& p, Wg& w) {
    constexpr int GPC = 1152 + 12;
    bf16* UC = (bf16*)(p.ws + WS_UC); float* NL = (float*)(p.ws + WS_NL);
    const float* FS = (const float*)(p.ws + WS_FS); const float* PML = (const float*)(p.ws + WS_PML); float* MST = (float*)(p.ws + WS_MST);
    for (int j = w.wg * NTHR + w.tid; j < NCHAIN * GPC; j += w.G * NTHR) {
        const int chain = j / GPC, g = j % GPC;
        float C[8], m = 0.f;
#pragma unroll
        for (int i = 0; i < 8; ++i) C[i] = 0.f;
        for (int k0 = 0; k0 < NCH; k0 += ML2_U) {
            float Fv[ML2_U], pv[ML2_U];
#pragma unroll
            for (int q = 0; q < ML2_U; ++q) { Fv[q] = FS[chain * NCH + k0 + q]; pv[q] = PML[chain * NCH + k0 + q]; }
            if (g < 1152) { u32x4 raw[ML2_U];
#pragma unroll
                for (int q = 0; q < ML2_U; ++q) raw[q] = *(const u32x4*)(UC + (size_t)(chain * NCH + k0 + q) * 9216 + 8 * g);
#pragma unroll
                for (int q = 0; q < ML2_U; ++q) { const int ci = chain * NCH + k0 + q; const float mx = fmaxf(m, pv[q]), dec = __expf(m - mx), sc = __expf(pv[q] - mx);
                    u32x4 st; st.x = pk2(C[0], C[1]); st.y = pk2(C[2], C[3]); st.z = pk2(C[4], C[5]); st.w = pk2(C[6], C[7]); *(u32x4*)(UC + (size_t)ci * 9216 + 8 * g) = st;
#pragma unroll
                    for (int i = 0; i < 8; ++i) C[i] = dec * C[i] + sc * bf2f((bf16)(raw[q][i >> 1] >> ((i & 1) * 16)));
                    if (g == 0) MST[ci] = m;
                    m = Fv[q] + mx; } }
            else {
                for (int q = 0; q < ML2_U; ++q) { float* nl = NL + (size_t)(chain * NCH + k0 + q) * 96 + 8 * (g - 1152); const f32x4 r0 = *(const f32x4*)nl, r1 = *(const f32x4*)(nl + 4);
                    const float mx = fmaxf(m, pv[q]), dec = __expf(m - mx), sc = __expf(pv[q] - mx);
                    *(f32x4*)nl = (f32x4){C[0], C[1], C[2], C[3]}; *(f32x4*)(nl + 4) = (f32x4){C[4], C[5], C[6], C[7]};
#pragma unroll
                    for (int i = 0; i < 4; ++i) { C[i] = dec * C[i] + sc * r0[i]; C[4 + i] = dec * C[4 + i] + sc * r1[i]; }
                    m = Fv[q] + mx; } }
        }
    }
}
DEV void ml3_item(const P& p, Wg& w, int l, int item) {
    const int lane = w.lane, r = lane & 31, h = lane >> 5, dir = w.wave >> 2, tq = w.wave & 3;
    const int b = item / (4 * NCH), hh = (item / NCH) % 4, cl = item % NCH, R0 = b * TP + cl * MCH;
    const int ci = ((b * 4 + hh) * 2 + dir) * NCH + chain_step(dir, cl);
    bf16* Qs = (bf16*)w.lds;
    bf16* Ksm = Qs + MCH * 104;
    bf16* Vs = Ksm + MCH * 104;
    float* nls = (float*)(w.lds + 3 * MCH * 104 * 2);
    float* scn = nls + 192;
    float* hx = (float*)w.lds;
    const bf16* MQK = (const bf16*)(p.ws + WS_MQK); const bf16* PROJ = (const bf16*)(p.ws + WS_PROJ);
    const bf16* UCi = (const bf16*)(p.ws + WS_UC) + (size_t)ci * 9216;
    for (int idx = w.tid; idx < MCH * 12; idx += NTHR) { const int s = idx / 12, c = idx % 12;
        const u32x4 qv = *(const u32x4*)(MQK + (size_t)(R0 + s) * 768 + hh * 96 + 8 * c), kv = *(const u32x4*)(MQK + (size_t)(R0 + s) * 768 + 384 + hh * 96 + 8 * c),
                    vv = *(const u32x4*)(PROJ + (size_t)(R0 + s) * PROJ_W + C_MV + hh * 96 + 8 * c);
        *(u32x4*)(Qs + s * 104 + 8 * c) = qv; *(u32x4*)(Ksm + s * 104 + 8 * c) = kv; *(u32x4*)(Vs + s * 104 + 8 * c) = vv; }
    if (w.tid < 192) { const int dd = w.tid / 96; nls[w.tid] = ((const float*)(p.ws + WS_NL))[(size_t)(((b * 4 + hh) * 2 + dd) * NCH + chain_step(dd, cl)) * 96 + w.tid % 96]; }
    if (tq == 0) { float F, pml; float* sc = scn + dir * 3 * MCH; gate_scan2(p, l, R0, hh, dir, lane, sc, sc + MCH, sc + 2 * MCH, F, pml); }
    const float m_st = ((const float*)(p.ws + WS_MST))[ci];
    __syncthreads();
    const float* al = scn + dir * 3 * MCH; const float* pmv = al + MCH; const float* bcl = al + 2 * MCH;
    const int t = 32 * tq + r;
    const float mx_t = fmaxf(m_st, pmv[t]), bc_t = bcl[t];
    bf16x8 qf[6]; float qn = 0.f;
#pragma unroll
    for (int ks = 0; ks < 6; ++ks) { qf[ks] = *(const bf16x8*)(Qs + t * 104 + 16 * ks + 8 * h);
        const f32x4 n0 = *(const f32x4*)(nls + dir * 96 + 16 * ks + 8 * h), n1 = *(const f32x4*)(nls + dir * 96 + 16 * ks + 8 * h + 4);
#pragma unroll
        for (int j = 0; j < 4; ++j) { qn += bf2f((bf16)qf[ks][j]) * n0[j]; qn += bf2f((bf16)qf[ks][4 + j]) * n1[j]; } }
    qn += SHX(qn, 32, lane);
    f32x16 o[3]; float rs = 0.f;
#pragma unroll
    for (int et = 0; et < 3; ++et)
#pragma unroll
        for (int i = 0; i < 16; ++i) o[et][i] = 0.f;
    for (int kb = dir ? tq : 0; kb < (dir ? NQB : tq + 1); ++kb) {
        f32x16 pw;
#pragma unroll
        for (int i = 0; i < 16; ++i) pw[i] = 0.f;
#pragma unroll
        for (int ks = 0; ks < 6; ++ks) { const bf16x8 kf = *(const bf16x8*)(Ksm + (32 * kb + r) * 104 + 16 * ks + 8 * h); pw = mfma32(kf, qf[ks], pw); }
#pragma unroll
        for (int g = 0; g < 4; ++g) { const int s0 = 32 * kb + 8 * g + 4 * h; const f32x4 av = *(const f32x4*)(al + s0);
#pragma unroll
            for (int j = 0; j < 4; ++j) { const int sidx = s0 + j; const bool okk = dir ? (sidx >= t) : (sidx <= t);
                const float wv = okk ? __expf(av[j] - mx_t) * pw[4 * g + j] : 0.f; pw[4 * g + j] = wv; rs += wv; } }
        bf16x8 pb[2];
#pragma unroll
        for (int sp = 0; sp < 2; ++sp) { u32x4 u; u.x = pk2(pw[8 * sp], pw[8 * sp + 1]); u.y = pk2(pw[8 * sp + 2], pw[8 * sp + 3]); u.z = pk2(pw[8 * sp + 4], pw[8 * sp + 5]); u.w = pk2(pw[8 * sp + 6], pw[8 * sp + 7]);
            pb[sp] = __builtin_bit_cast(bf16x8, u); }
#pragma unroll
        for (int et = 0; et < 3; ++et)
#pragma unroll
            for (int sp = 0; sp < 2; ++sp) { const bf16* vp = Vs + (32 * kb + 16 * sp + 4 * h + ((lane & 15) >> 2)) * 104 + 32 * et + 16 * ((lane >> 4) & 1) + 4 * (lane & 3);
                const s16x4 lo = lds_tr_read(vp), hi = lds_tr_read(vp + 8 * 104);
                const bf16x8 vf = (bf16x8){lo[0], lo[1], lo[2], lo[3], hi[0], hi[1], hi[2], hi[3]};
                o[et] = mfma32(vf, pb[sp], o[et]); }
    }
    rs += SHX(rs, 32, lane);
    const float a_int = __expf(m_st - mx_t), den = a_int * qn + rs, inv = 1.0f / fmaxf(fabsf(den), __expf(-(bc_t + mx_t)));
#pragma unroll
    for (int et = 0; et < 3; ++et) { f32x16 oi;
#pragma unroll
        for (int i = 0; i < 16; ++i) oi[i] = 0.f;
#pragma unroll
        for (int ks = 0; ks < 6; ++ks) { const bf16x8 cf = *(const bf16x8*)(UCi + (32 * et + r) * 96 + 16 * ks + 8 * h); oi = mfma32(cf, qf[ks], oi); }
#pragma unroll
        for (int i = 0; i < 16; ++i) o[et][i] = (a_int * oi[i] + o[et][i]) * inv; }
    __syncthreads();
    if (dir == 1) {
#pragma unroll
        for (int et = 0; et < 3; ++et)
#pragma unroll
            for (int i = 0; i < 16; ++i) hx[t * 97 + 32 * et + crow(i, h)] = o[et][i]; }
    __syncthreads();
    if (dir == 0) { float ss = 0.f;
#pragma unroll
        for (int et = 0; et < 3; ++et)
#pragma unroll
            for (int i = 0; i < 16; ++i) { o[et][i] += hx[t * 97 + 32 * et + crow(i, h)]; ss += o[et][i] * o[et][i]; }
        ss += SHX(ss, 32, lane);
        const float rstd = rsqrt_fast(ss * (1.0f / 96.0f) + EPS);
        bf16* MIX = (bf16*)(p.ws + WS_H);
#pragma unroll
        for (int et = 0; et < 3; ++et)
#pragma unroll
            for (int g = 0; g < 4; ++g) { const int e = 32 * et + 8 * g + 4 * h;
                const u32x2 og = *(const u32x2*)(PROJ + (size_t)(R0 + t) * PROJ_W + C_MO + hh * 96 + e); const f32x4 mn = *(const f32x4*)(p.m_norm + l * 384 + hh * 96 + e);
                float o4[4];
#pragma unroll
                for (int j = 0; j < 4; ++j) { const float gate = bf2f((bf16)((j < 2 ? og.x : og.y) >> ((j & 1) * 16))); o4[j] = o[et][4 * g + j] * rstd * mn[j] * sigmoid_f(gate); }
                u32x2 ov; ov.x = pk2(o4[0], o4[1]); ov.y = pk2(o4[2], o4[3]);
                *(u32x2*)(MIX + (size_t)(R0 + t) * MIXW + hh * 96 + e) = ov; } }
    __syncthreads();
}

DEV void phase_mla_post(const P& p, Wg& w, int l) {
    bf16* MLAQ = (bf16*)(p.ws + WS_MLAQ); const bf16* PROJ = (const bf16*)(p.ws + WS_PROJ);
    const int lane = w.lane;
    int baseA = 0, nA = 8, dstA = 8 * lane; bool normA = true, ropeA = false; const float* gA = p.l_qnorm + l * 96;
    if (lane < 48) { const int hh = lane / 12, o = lane % 12;
        if (o < 8) { baseA = 12 * hh; nA = 8; gA = p.l_qnorm + l * 96 + 8 * o; }
        else { baseA = 12 * hh + 8; nA = 4; gA = p.l_qnorm + l * 96 + 64 + 8 * (o - 8); ropeA = true; } }
    else { normA = false; }
    const int hb = lane / 16, ob = lane % 16; const bool normB = ob < 8;
    const int baseB = (16 * (lane / 16)) & 63;
    const int dstB = normB ? 384 + 96 * hb + 8 * ob : 768 + 64 * hb + 8 * (ob - 8);
    const float* gB = p.l_knorm + l * 96 + 8 * (ob & 7);
    float gAv[8], gBv[8];
#pragma unroll
    for (int j = 0; j < 8; ++j) { gAv[j] = gA[j]; gBv[j] = gB[j]; }
    const int cidx = (lane % 12) - 8;
    constexpr int NB = 2;
    for (int R0 = w.gw; R0 < M_ALL; R0 += NB * w.NGW) {
        u32x4 ra[NB], rb[NB], kr[NB]; bool ok[NB];
#pragma unroll
        for (int q = 0; q < NB; ++q) { const int R = R0 + q * w.NGW; ok[q] = R < M_ALL; const int Rr = ok[q] ? R : R0; const bf16* row = MLAQ + (size_t)Rr * 1024;
            ra[q] = *(const u32x4*)(row + 8 * lane); rb[q] = *(const u32x4*)(row + 512 + 8 * lane);
            kr[q] = (lane >= 48) ? *(const u32x4*)(PROJ + (size_t)Rr * PROJ_W + C_KR + 8 * ((lane - 48) & 3)) : (u32x4){0u, 0u, 0u, 0u}; }
        u32x4 oa[NB], obv[NB];
#pragma unroll
        for (int q = 0; q < NB; ++q) { const int Rr = ok[q] ? R0 + q * w.NGW : R0; const int qq = Rr % TP; const bool lat = qq >= CTX; const int t = qq - CTX;
            float xa[8], xb[8], ssA = 0.f, ssB = 0.f;
#pragma unroll
            for (int j = 0; j < 8; ++j) { xa[j] = bf2f((bf16)(ra[q][j >> 1] >> ((j & 1) * 16))); xb[j] = bf2f((bf16)(rb[q][j >> 1] >> ((j & 1) * 16))); ssA += xa[j] * xa[j]; ssB += xb[j] * xb[j]; }
            float sA = 0.f, sB = 0.f;
#pragma unroll
            for (int i = 0; i < 8; ++i) { const float v = __shfl(ssA, (baseA + i) & 63); if (i < nA) sA += v; sB += __shfl(ssB, (baseB + i) & 63); }
            const float rsA = normA ? rsqrt_fast(sA / (float)(8 * nA) + EPS) : 1.0f, rsB = normB ? rsqrt_fast(sB * (1.0f / 64.0f) + EPS) : 1.0f;
#pragma unroll
            for (int j = 0; j < 8; ++j) { xa[j] = normA ? xa[j] * rsA * gAv[j] : xa[j]; xb[j] = normB ? xb[j] * rsB * gBv[j] : xb[j]; }
            const float* ct = (const float*)(p.ws + WS_ROPE) + ((size_t)(lat ? ((cidx & 3) < 2 ? t / GRID_W : t % GRID_W) : 0) * 24 + 16) * 2;
            const f32x4 t0 = *(const f32x4*)ct, t1 = *(const f32x4*)(ct + 4), t2 = *(const f32x4*)(ct + 8), t3 = *(const f32x4*)(ct + 12);
            const float csv[8] = {t0[0], t0[2], t1[0], t1[2], t2[0], t2[2], t3[0], t3[2]}, snv[8] = {t0[1], t0[3], t1[1], t1[3], t2[1], t2[3], t3[1], t3[3]};
#pragma unroll
            for (int j = 0; j < 8; ++j) { const float pt = SHX(xa[j], 1, lane);
                if (ropeA && lat) xa[j] = (cidx & 1) ? xa[j] * csv[j] + pt * snv[j] : xa[j] * csv[j] - pt * snv[j]; }
            if (lane < 48) {
#pragma unroll
                for (int j = 0; j < 8; ++j) xa[j] *= QSCALE_L; }
            oa[q].x = pk2(xa[0], xa[1]); oa[q].y = pk2(xa[2], xa[3]); oa[q].z = pk2(xa[4], xa[5]); oa[q].w = pk2(xa[6], xa[7]);
            obv[q].x = pk2(xb[0], xb[1]); obv[q].y = pk2(xb[2], xb[3]); obv[q].z = pk2(xb[4], xb[5]); obv[q].w = pk2(xb[6], xb[7]); }
        wave_sync();
#pragma unroll
        for (int q = 0; q < NB; ++q) if (ok[q]) { bf16* row = MLAQ + (size_t)(R0 + q * w.NGW) * 1024;
            if (lane < 48) *(u32x4*)(row + dstA) = oa[q];
            else { const int i = lane - 48; *(u32x4*)(row + 384 + 96 * (i >> 2) + 64 + 8 * (i & 3)) = kr[q]; }
            *(u32x4*)(row + dstB) = obv[q]; }
        wave_sync();
    }
}

template <int DQK>
DEV void attn_unit(const bf16* Q, int ldq, const bf16* K, int ldk, const bf16* V, int ldv, bf16* O, int ldo, int nkeys, Wg& w) {
    constexpr int KS = DQK + 8, NKD = DQK / 16, CPR = DQK / 8, NKC = 64 * CPR, VS = 72;
    bf16* Ks = (bf16*)w.lds;
    bf16* Vs = (bf16*)(w.lds + 2 * 64 * KS * 2);
    const int tid = w.tid, lane = w.lane, r = lane & 31, h = lane >> 5;
    bf16x8 qr[NKD];
    { const bf16* qp = Q + (size_t)(w.wave * 32 + r) * ldq + 8 * h;
#pragma unroll
      for (int d0 = 0; d0 < NKD; ++d0) qr[d0] = *(const bf16x8*)(qp + 16 * d0); }
    const int kr0 = tid / CPR, kc0 = tid % CPR, kr1 = (tid + NTHR) / CPR, kc1 = (tid + NTHR) % CPR; const bool k1 = (tid + NTHR) < NKC;
    const int vr = tid >> 3, vc = tid & 7;
    u32x4 rk0, rk1 = (u32x4){0u, 0u, 0u, 0u}, rv;
    const int NT = nkeys / 64;
    const int vtr_off = (4 * h + ((lane & 15) >> 2)) * VS + 16 * ((lane >> 4) & 1) + 4 * (lane & 3);
#define AT_LOAD(kt) do { rk0 = *(const u32x4*)(K + (size_t)((kt) * 64 + kr0) * ldk + 8 * kc0); if (k1) rk1 = *(const u32x4*)(K + (size_t)((kt) * 64 + kr1) * ldk + 8 * kc1); \
        rv = *(const u32x4*)(V + (size_t)((kt) * 64 + vr) * ldv + 8 * vc); } while (0)
#define AT_STORE(buf) do { *(u32x4*)(Ks + ((buf) * 64 + kr0) * KS + 8 * kc0) = rk0; if (k1) *(u32x4*)(Ks + ((buf) * 64 + kr1) * KS + 8 * kc1) = rk1; \
        *(u32x4*)(Vs + ((buf) * 64 + vr) * VS + 8 * vc) = rv; } while (0)
    AT_LOAD(0); AT_STORE(0);
    __syncthreads();
    float m_run = 0.f, l_run = 0.f; f32x16 o[2], negm;
#pragma unroll
    for (int i = 0; i < 16; ++i) { o[0][i] = 0.f; o[1][i] = 0.f; negm[i] = 0.f; }
    for (int kt = 0; kt < NT; ++kt) {
        const int buf = kt & 1;
        if (kt + 1 < NT) AT_LOAD(kt + 1);
        f32x16 pt[2];
        { bf16x8 kf[2][NKD];
#pragma unroll
          for (int kh = 0; kh < 2; ++kh)
#pragma unroll
              for (int d0 = 0; d0 < NKD; ++d0) kf[kh][d0] = *(const bf16x8*)(Ks + (buf * 64 + 32 * kh + r) * KS + 16 * d0 + 8 * h);
          SCHED_FENCE();
          pt[0] = negm; pt[1] = negm;
#pragma unroll
          for (int d0 = 0; d0 < NKD; ++d0) { pt[0] = mfma32(kf[0][d0], qr[d0], pt[0]); pt[1] = mfma32(kf[1][d0], qr[d0], pt[1]); } }
        bf16x8 vf[2][2][2];
#pragma unroll
        for (int et = 0; et < 2; ++et)
#pragma unroll
            for (int kh = 0; kh < 2; ++kh)
#pragma unroll
                for (int sp = 0; sp < 2; ++sp) { const bf16* vp = Vs + (buf * 64 + 32 * kh + 16 * sp) * VS + 32 * et + vtr_off;
                    const s16x4 lo = lds_tr_read(vp), hi = lds_tr_read(vp + 8 * VS);
                    vf[et][kh][sp] = (bf16x8){lo[0], lo[1], lo[2], lo[3], hi[0], hi[1], hi[2], hi[3]}; }
        SCHED_FENCE();
        float mq[4];
#pragma unroll
        for (int c = 0; c < 4; ++c) mq[c] = fmaxf(pt[0][c], pt[1][c]);
#pragma unroll
        for (int i = 4; i < 16; ++i) mq[i & 3] = fmaxf(mq[i & 3], fmaxf(pt[0][i], pt[1][i]));
        float mt = fmaxf(fmaxf(mq[0], mq[1]), fmaxf(mq[2], mq[3]));
        if (__any(kt == 0 || mt > 8.0f)) {
            mt = fmaxf(mt, SHX(mt, 32, lane));
            const float dl = (kt == 0) ? mt : fmaxf(mt, 0.f), alpha = exp2_fast(-dl);
            m_run += dl; l_run *= alpha;
#pragma unroll
            for (int i = 0; i < 16; ++i) { pt[0][i] -= dl; pt[1][i] -= dl; o[0][i] *= alpha; o[1][i] *= alpha; negm[i] = -m_run; }
        }
        float rq[4] = {0.f, 0.f, 0.f, 0.f};
#pragma unroll
        for (int kh = 0; kh < 2; ++kh)
#pragma unroll
            for (int i = 0; i < 16; ++i) { const float e = exp2_fast(pt[kh][i]); pt[kh][i] = e; rq[i & 3] += e; }
        l_run += (rq[0] + rq[1]) + (rq[2] + rq[3]);
        bf16x8 pb[2][2];
#pragma unroll
        for (int kh = 0; kh < 2; ++kh)
#pragma unroll
            for (int sp = 0; sp < 2; ++sp) { u32x4 u; u.x = pk2(pt[kh][8 * sp], pt[kh][8 * sp + 1]); u.y = pk2(pt[kh][8 * sp + 2], pt[kh][8 * sp + 3]); u.z = pk2(pt[kh][8 * sp + 4], pt[kh][8 * sp + 5]); u.w = pk2(pt[kh][8 * sp + 6], pt[kh][8 * sp + 7]);
                pb[kh][sp] = __builtin_bit_cast(bf16x8, u); }
        SCHED_FENCE();
#pragma unroll
        for (int kh = 0; kh < 2; ++kh)
#pragma unroll
            for (int sp = 0; sp < 2; ++sp)
#pragma unroll
                for (int et = 0; et < 2; ++et) o[et] = mfma32(vf[et][kh][sp], pb[kh][sp], o[et]);
        if (kt + 1 < NT) AT_STORE(buf ^ 1);
        __syncthreads();
    }
#undef AT_LOAD
#undef AT_STORE
    l_run += SHX(l_run, 32, lane);
    const float inv = 1.0f / l_run;
    bf16* op = O + (size_t)(w.wave * 32 + r) * ldo + 4 * h;
#pragma unroll
    for (int et = 0; et < 2; ++et)
#pragma unroll
        for (int g = 0; g < 4; ++g) { u32x2 ov; ov.x = pk2(o[et][4 * g] * inv, o[et][4 * g + 1] * inv); ov.y = pk2(o[et][4 * g + 2] * inv, o[et][4 * g + 3] * inv); *(u32x2*)(op + 32 * et + 8 * g) = ov; }
}
#ifndef REP_ATT
#define REP_ATT 1
#endif
#ifndef REP_ML3
#define REP_ML3 1
#endif
DEV void relaunder(Wg& w) { int t_ = w.tid; OPAQUE_V(t_); w.tid = t_; w.lane = t_ & 63; }
DEV void phase_mix(const P& p, Wg& w, int l) {
    const bf16* PROJ = (const bf16*)(p.ws + WS_PROJ); const bf16* MLAQ = (const bf16*)(p.ws + WS_MLAQ); bf16* MIX = (bf16*)(p.ws + WS_H);
    unsigned* ctr = (unsigned*)(p.ws + WS_CTL) + CW_Q + 1024 * l;
    const int n_ml3 = BATCH * 4 * NCH;
    for (int rep = 0; rep < REP_ATT; ++rep) {
        { const int n_lat = BATCH * 4 * NQL, n_all = n_lat + ((l == 0) ? BATCH * 4 : 0);
          for (;;) {
            int idx = q_next(w, ctr + 64 * rep);
            if (idx >= n_all) break;
            int b, head, qb, nkeys;
            if (idx < n_lat) { b = idx / (4 * NQL); head = (idx / NQL) % 4; qb = 1 + idx % NQL; nkeys = TP; }
            else { idx -= n_lat; b = idx / 4; head = idx % 4; qb = 0; nkeys = CTX; }
            const size_t Rq = (size_t)b * TP + qb * 256, Rk = (size_t)b * TP;
            attn_unit<96>(MLAQ + Rq * 1024 + head * 96, 1024, MLAQ + Rk * 1024 + 384 + head * 96, 1024, MLAQ + Rk * 1024 + 768 + head * 64, 1024, MIX + Rq * MIXW + 768 + head * 64, MIXW, nkeys, w);
          } }
        relaunder(w);
        { const int n_lat = BATCH * 6 * NQL, n_all = n_lat + ((l == 0) ? BATCH * 6 : 0);
          for (;;) {
            int idx = q_next(w, ctr + 256 + 64 * rep);
            if (idx >= n_all) break;
            int b, head, qb, nkeys;
            if (idx < n_lat) { b = idx / (6 * NQL); const int rem = idx % (6 * NQL); head = (rem / (3 * NQL)) * 3 + rem % 3; qb = 1 + (rem % (3 * NQL)) / 3; nkeys = TP; }
            else { idx -= n_lat; b = idx / 6; head = idx % 6; qb = 0; nkeys = CTX; }
            const size_t Rq = (size_t)b * TP + qb * 256, Rk = (size_t)b * TP;
            attn_unit<64>(PROJ + Rq * PROJ_W + C_AQ + head * 64, PROJ_W, PROJ + Rk * PROJ_W + C_AK + (head / 3) * 64, PROJ_W, PROJ + Rk * PROJ_W + C_AV + (head / 3) * 64, PROJ_W, MIX + Rq * MIXW + 384 + head * 64, MIXW, nkeys, w);
          } }
        relaunder(w);
    }
    for (int rep = 0; rep < REP_ML3; ++rep)
    for (;;) {
        const int idx = q_next(w, ctr + 512 + 64 * rep);
        if (idx >= n_ml3) break;
        if (l == 1 && idx % NCH < NC_CTX) continue;
        ml3_item(p, w, l, idx);
    }
}

DEV void moe_seg_table(const P& p, Wg& w) {
    const int* cntg = (const int*)(p.ws + WS_CNTG); int* part = (int*)w.lds;
    { const int e = w.tid & 7; int tot = 0, pre = 0;
      for (int g = w.tid >> 3; g < w.G; g += NTHR / 8) { const int c = cntg[g * NEXP + e]; tot += c; pre += (g < w.wg) ? c : 0; }
      part[2 * w.tid] = tot; part[2 * w.tid + 1] = pre; }
    __syncthreads();
    if (w.tid < NEXP) { int tot = 0, pre = 0; for (int i = 0; i < NTHR / 8; ++i) { tot += part[2 * (8 * i + w.tid)]; pre += part[2 * (8 * i + w.tid) + 1]; } w.misc[32 + w.tid] = (unsigned)tot; w.misc[48 + w.tid] = (unsigned)pre; }
    __syncthreads();
    if (w.tid == 0) { int s = 0; for (int e = 0; e < NEXP; ++e) { w.misc[16 + e] = (unsigned)s; s += ((int)w.misc[32 + e] + 255) / 256; } w.misc[16 + NEXP] = (unsigned)s; }
    __syncthreads();
}
DEV void phase_gather(const P& p, Wg& w) {
    moe_seg_table(p, w);
    const int* topi = (const int*)(p.ws + WS_TOPI); const float* topw = (const float*)(p.ws + WS_TOPW);
    int* stok = (int*)(p.ws + WS_STOK); float* sw = (float*)(p.ws + WS_SW);
    const bf16* H = (const bf16*)(p.ws + WS_H); bf16* AG = (bf16*)(p.ws + WS_AG);
    int* lc = (int*)w.lds;
    if (w.lane == 0) { for (int e = 0; e < NEXP; ++e) lc[w.wave * NEXP + e] = 0;
        for (int R = w.gw; R < M_ALL; R += w.NGW) { const int q = R % TP; if (q < CTX) continue; const int tok = (R / TP) * SEQ + q - CTX; lc[w.wave * NEXP + topi[2 * tok]]++; lc[w.wave * NEXP + topi[2 * tok + 1]]++; } }
    __syncthreads();
    if (w.tid < NEXP) { int s = (int)w.misc[16 + w.tid] * 256 + (int)w.misc[48 + w.tid]; for (int ww = 0; ww < NWAVE; ++ww) { const int c = lc[ww * NEXP + w.tid]; lc[ww * NEXP + w.tid] = s; s += c; } }
    __syncthreads();
    constexpr int NJ8 = (D_MODEL + 511) / 512;
    for (int R0 = w.gw; R0 < M_ALL; R0 += 4 * w.NGW) {
        int s0[4], s1[4]; bool ok[4];
#pragma unroll
        for (int qq = 0; qq < 4; ++qq) { const int R = R0 + qq * w.NGW; const int q = R % TP; ok[qq] = R < M_ALL && q >= CTX; const int tok = (R / TP) * SEQ + q - CTX;
            int a0 = 0, a1 = 0;
            if (w.lane == 0 && ok[qq]) { const int e0 = topi[2 * tok], e1 = topi[2 * tok + 1]; a0 = lc[w.wave * NEXP + e0]; lc[w.wave * NEXP + e0] = a0 + 1; a1 = lc[w.wave * NEXP + e1]; lc[w.wave * NEXP + e1] = a1 + 1;
                stok[a0] = tok; stok[a1] = tok; sw[a0] = topw[2 * tok]; sw[a1] = topw[2 * tok + 1]; int* tsl = (int*)(p.ws + WS_TSL) + 2 * tok; tsl[0] = a0; tsl[1] = a1; }
            s0[qq] = __shfl(a0, 0); s1[qq] = __shfl(a1, 0); }
        u32x4 v[4][NJ8];
#pragma unroll
        for (int qq = 0; qq < 4; ++qq)
#pragma unroll
            for (int j = 0; j < NJ8; ++j) { const int c = 8 * w.lane + 512 * j; if (ok[qq] && c < D_MODEL) v[qq][j] = *(const u32x4*)(H + (size_t)(R0 + qq * w.NGW) * D_MODEL + c); }
#pragma unroll
        for (int qq = 0; qq < 4; ++qq)
#pragma unroll
            for (int j = 0; j < NJ8; ++j) { const int c = 8 * w.lane + 512 * j; if (ok[qq] && c < D_MODEL) { *(u32x4*)(AG + (size_t)s0[qq] * D_MODEL + c) = v[qq][j]; *(u32x4*)(AG + (size_t)s1[qq] * D_MODEL + c) = v[qq][j]; } }
    }
    for (int e = w.wg; e < NEXP; e += w.G) { const int lo = (int)w.misc[16 + e] * 256 + (int)w.misc[32 + e], hi = (int)w.misc[16 + e + 1] * 256;
        for (int s = lo + w.wave; s < hi; s += NWAVE) { if (w.lane == 0) { stok[s] = -1; sw[s] = 0.f; }
            for (int c = 8 * w.lane; c < D_MODEL; c += 512) *(u32x4*)(AG + (size_t)s * D_MODEL + c) = (u32x4){0u, 0u, 0u, 0u}; } }
}

DEV void phase_moe_combine(const P& p, Wg& w, int c) {
    const int* tsl = (const int*)(p.ws + WS_TSL); const float* topw = (const float*)(p.ws + WS_TOPW); const bf16* YC = (const bf16*)(p.ws + WS_YC);
    const int lo = c * MOE_PCH * 256, hi = lo + MOE_PCH * 256;
    const int ptot = (int)w.misc[16 + NEXP], np = (ptot - c * MOE_PCH) < MOE_PCH ? (ptot - c * MOE_PCH) : MOE_PCH;
    if (np <= 0) return;
    const int nsp = (np * NSPLIT > MOE_PCH) ? 1 : NSPLIT; const size_t pstr = (size_t)np * 256 * D_MODEL;
    constexpr int CB = 2;
    for (int tok0 = w.gw; tok0 < NTOK; tok0 += CB * w.NGW) {
        const bf16* y0[CB]; const bf16* y1[CB]; float w0[CB], w1[CB]; bool act[CB]; bf16* xr[CB]; const float* gv[CB];
#pragma unroll
        for (int q = 0; q < CB; ++q) { const int tok = tok0 + q * w.NGW; const bool ok = tok < NTOK; const int tk = ok ? tok : 0;
            const int s0 = tsl[2 * tk], s1 = tsl[2 * tk + 1]; const bool in0 = ok && s0 >= lo && s0 < hi, in1 = ok && s1 >= lo && s1 < hi;
            act[q] = in0 || in1; w0[q] = in0 ? topw[2 * tk] : 0.f; w1[q] = in1 ? topw[2 * tk + 1] : 0.f;
            y0[q] = YC + (size_t)(in0 ? s0 - lo : 0) * D_MODEL; y1[q] = YC + (size_t)(in1 ? s1 - lo : 0) * D_MODEL;
            xr[q] = (bf16*)(p.out + (size_t)tk * D_MODEL); gv[q] = (const float*)(p.ws + WS_MODV) + (size_t)(1 * NV + tk / SEQ) * 6 * D_MODEL + 5 * D_MODEL; }
#pragma unroll
        for (int j = 0; j < D_MODEL / 256; ++j) { const int col = 4 * w.lane + 256 * j;
            f32x4 ya[CB], g[CB]; u32x2 x[CB];
#pragma unroll
            for (int q = 0; q < CB; ++q) if (act[q]) { g[q] = *(const f32x4*)(gv[q] + col); x[q] = *(const u32x2*)(xr[q] + col); ya[q] = (f32x4){0.f, 0.f, 0.f, 0.f};
                for (int ks = 0; ks < nsp; ++ks) { const u32x2 a = *(const u32x2*)(y0[q] + ks * pstr + col), bq = *(const u32x2*)(y1[q] + ks * pstr + col);
                    ya[q][0] += w0[q] * bf2f((bf16)a.x) + w1[q] * bf2f((bf16)bq.x); ya[q][1] += w0[q] * bf2f((bf16)(a.x >> 16)) + w1[q] * bf2f((bf16)(bq.x >> 16));
                    ya[q][2] += w0[q] * bf2f((bf16)a.y) + w1[q] * bf2f((bf16)bq.y); ya[q][3] += w0[q] * bf2f((bf16)(a.y >> 16)) + w1[q] * bf2f((bf16)(bq.y >> 16)); } }
#pragma unroll
            for (int q = 0; q < CB; ++q) if (act[q]) { u32x2 o;
                o.x = pk2(bf2f((bf16)x[q].x) + g[q][0] * ya[q][0], bf2f((bf16)(x[q].x >> 16)) + g[q][1] * ya[q][1]); o.y = pk2(bf2f((bf16)x[q].y) + g[q][2] * ya[q][2], bf2f((bf16)(x[q].y >> 16)) + g[q][3] * ya[q][3]);
                *(u32x2*)(xr[q] + col) = o; } }
    }
}
DEV void phase_moe_final(const P& p, Wg& w) {
    constexpr int c = MOE_NCH - 1, NJ = D_MODEL / 256;
    const int* tsl = (const int*)(p.ws + WS_TSL); const float* topw = (const float*)(p.ws + WS_TOPW); const bf16* YC = (const bf16*)(p.ws + WS_YC);
    const int lo = c * MOE_PCH * 256, hi = lo + MOE_PCH * 256;
    const int ptot = (int)w.misc[16 + NEXP], np = (ptot - c * MOE_PCH) < MOE_PCH ? (ptot - c * MOE_PCH) : MOE_PCH;
    const int nsp = (np * NSPLIT > MOE_PCH) ? 1 : NSPLIT; const size_t pstr = (size_t)(np > 0 ? np : 0) * 256 * D_MODEL;
    for (int tok0 = w.gw; tok0 < NTOK; tok0 += 2 * w.NGW) {
        f32x4 xo[2][NJ]; bool ok[2];
#pragma unroll
        for (int q = 0; q < 2; ++q) { const int tok = tok0 + q * w.NGW; ok[q] = tok < NTOK; const int tk = ok[q] ? tok : 0;
            const int s0 = tsl[2 * tk], s1 = tsl[2 * tk + 1]; const bool in0 = np > 0 && s0 >= lo && s0 < hi, in1 = np > 0 && s1 >= lo && s1 < hi;
            const float w0 = in0 ? topw[2 * tk] : 0.f, w1 = in1 ? topw[2 * tk + 1] : 0.f;
            const bf16* y0 = YC + (size_t)(in0 ? s0 - lo : 0) * D_MODEL; const bf16* y1 = YC + (size_t)(in1 ? s1 - lo : 0) * D_MODEL;
            const bf16* xr = (const bf16*)(p.out + (size_t)tk * D_MODEL); const float* gv = (const float*)(p.ws + WS_MODV) + (size_t)(1 * NV + tk / SEQ) * 6 * D_MODEL + 5 * D_MODEL;
#pragma unroll
            for (int j = 0; j < NJ; ++j) { const int col = 4 * w.lane + 256 * j; const u32x2 t = *(const u32x2*)(xr + col);
                xo[q][j] = (f32x4){bf2f((bf16)t.x), bf2f((bf16)(t.x >> 16)), bf2f((bf16)t.y), bf2f((bf16)(t.y >> 16))};
                if (in0 || in1) { f32x4 ya = (f32x4){0.f, 0.f, 0.f, 0.f};
                    for (int ks = 0; ks < nsp; ++ks) { const u32x2 a = *(const u32x2*)(y0 + ks * pstr + col), bq = *(const u32x2*)(y1 + ks * pstr + col);
                        ya[0] += w0 * bf2f((bf16)a.x) + w1 * bf2f((bf16)bq.x); ya[1] += w0 * bf2f((bf16)(a.x >> 16)) + w1 * bf2f((bf16)(bq.x >> 16));
                        ya[2] += w0 * bf2f((bf16)a.y) + w1 * bf2f((bf16)bq.y); ya[3] += w0 * bf2f((bf16)(a.y >> 16)) + w1 * bf2f((bf16)(bq.y >> 16)); }
                    xo[q][j] = xo[q][j] + *(const f32x4*)(gv + col) * ya; } } }
        wave_sync();
#pragma unroll
        for (int q = 0; q < 2; ++q) if (ok[q]) { float* orow = p.out + (size_t)(tok0 + q * w.NGW) * D_MODEL;
#pragma unroll
            for (int j = 0; j < NJ; ++j) *(f32x4*)(orow + 4 * w.lane + 256 * j) = xo[q][j]; }
    }
}

constexpr int PH_L = 24;
constexpr int N_PHASES = 1 + 2 * PH_L;
#ifndef PROBE_MUL
#define PROBE_MUL 1
#endif
#ifdef EMU
#define GRID_BAR() do {} while (0)
#define DYN_LDS() unsigned char* lds = EMU_DYN_LDS()
#else
#define GRID_BAR() xcd_barrier(bar)
#define DYN_LDS() extern __shared__ __attribute__((aligned(16))) unsigned char lds[]
#endif
__global__ void __launch_bounds__(NTHR, 2) fwd(P p_in) {
    DYN_LDS();
    Wg w; w.tid = threadIdx.x; w.lane = w.tid & 63;
#ifndef EMU
    w.wave = __builtin_amdgcn_readfirstlane(w.tid >> 6);
#else
    w.wave = w.tid >> 6;
#endif
    w.G = gridDim.x; w.wg = blockIdx.x; w.gw = w.wg * NWAVE + w.wave; w.NGW = w.G * NWAVE; w.lds = lds; w.misc = (unsigned*)(lds + LDS_MISC);
    if (w.tid < 64) w.misc[w.tid] = 0u;
    __syncthreads();
#ifndef EMU
    XcdBarrier bar = xcd_barrier_post((unsigned*)(p_in.ws + WS_CTL) + CW_BAR, (volatile LAS unsigned*)(w.misc));
#endif
    const int lo = p_in.ph_lo, hi = p_in.ph_hi; const int wave_s = w.wave; (void)wave_s;
#ifndef PH_MASK
#define PH_MASK 0xffffffffu
#endif
#if defined(PROBE_SET) && !defined(EMU)
#define PROBE_T0(k) if (blockIdx.x == 0 && threadIdx.x == 0) { ((unsigned*)(lds + LDS_MISC))[64 + 2 * (k)] = (unsigned)wall_clock64(); }
#define PROBE_T1(k) if (blockIdx.x == 0 && threadIdx.x == 0) { ((unsigned*)(lds + LDS_MISC))[65 + 2 * (k)] = (unsigned)wall_clock64(); }
#define PROBE_SPLIT(k, vk) { GRID_BAR(); if (blockIdx.x == 0 && threadIdx.x == 0) { unsigned* m_ = (unsigned*)(lds + LDS_MISC); m_[64 + 2 * (vk)] = m_[64 + 2 * (k)]; m_[65 + 2 * (vk)] = (unsigned)wall_clock64(); } }
#else
#define PROBE_T0(k)
#define PROBE_T1(k)
#define PROBE_SPLIT(k, vk)
#endif
#ifndef EMU
#define TID_NOW() (wave_s * 64 + lane_fresh())
#define WAVE_OF(t) __builtin_amdgcn_readfirstlane((t) >> 6)
#else
#define TID_NOW() ((int)threadIdx.x)
#define WAVE_OF(t) ((t) >> 6)
#endif
#ifndef EMU
#define LOAD_P() const __attribute__((address_space(4))) P* pq_ = (const __attribute__((address_space(4))) P*)__builtin_amdgcn_kernarg_segment_ptr(); asm volatile("" : "+s"(pq_)); const P p = *(const P*)pq_;
#else
#define LOAD_P() const P& p = p_in;
#endif
#define PH_BEGIN(k) if (((PH_MASK >> ((k) - pb_)) & 1u) && lo <= (k) && (k) < hi) { LOAD_P() { int t_ = TID_NOW(); OPAQUE_V(t_); w.tid = t_; w.lane = t_ & 63; w.wave = WAVE_OF(t_); w.gw = w.wg * NWAVE + w.wave; } PROBE_T0(k)
#define PH_END(k) if ((k) + 1 < hi) GRID_BAR(); PROBE_T1(k) }
    { const int pb_ = -31; PH_BEGIN(0) phase0(p, w); PH_END(0) }
    for (int l = 0; l < 2; ++l) {
        const int pb = 1 + PH_L * l, pb_ = pb;
        PH_BEGIN(pb + 0) phase_modulate<4>(p, w, l, 0, l == 0, false, false, l == 1); PH_END(pb + 0)
        PH_BEGIN(pb + 1) {
            pg8::Gemm g{(const bf16*)(p.ws + WS_H), (const bf16*)(p.ws + WS_WIN_T) + (size_t)l * PROJ_W * D_MODEL, D_MODEL, D_MODEL, D_MODEL, 0};
            Sched<0> S; S.o.init(NPAN, PROJ_W / 256, w.G, w.wg, SITE_WGM(0)); S.pm_base = 0; S.seg = nullptr; S.nNc = 0; S.kper = 0;
            EpiStore E{(bf16*)(p.ws + WS_PROJ), PROJ_W, (float*)(p.ws + WS_GATES)};
            { const TabSched T_ = build_units(w.misc, w.tid, S); pg8::gemm_phase<EpiStore, TabSched>(w.lds, w.tid, g, T_, E); } } PH_END(pb + 1)
        PH_BEGIN(pb + 2) phase_prep(p, w, l); PH_END(pb + 2)
        PH_BEGIN(pb + 3) {
            pg8::Gemm g{(const bf16*)(p.ws + WS_PROJ) + C_CQ, (const bf16*)(p.ws + WS_MLA_T) + (size_t)l * 1024 * 512, PROJ_W, 512, 256, 0};
            Sched<6> S; S.o.init(NPAN, 4, w.G, w.wg, SITE_WGM(1)); S.pm_base = 0; S.seg = nullptr; S.nNc = 0; S.kper = 0;
            EpiStore E{(bf16*)(p.ws + WS_MLAQ), 1024, nullptr};
            { const TabSched T_ = build_units(w.misc, w.tid, S); pg8::gemm_phase<EpiStore, TabSched>(w.lds, w.tid, g, T_, E); }
            __syncthreads();
            PROBE_SPLIT(pb + 3, 49 + 3 * l)
#ifndef NO_ML1
            for (int it = w.wg; it < BATCH * 4 * NCH; it += w.G) ml1_item(p, w, l, it);
#endif
            } PH_END(pb + 3)
        PH_BEGIN(pb + 4) phase_mla_post(p, w, l); PROBE_SPLIT(pb + 4, 50 + 3 * l) phase_ml2(p, w); PH_END(pb + 4)
        PH_BEGIN(pb + 5) phase_mix(p, w, l); PH_END(pb + 5)
        PH_BEGIN(pb + 6) {
            pg8::Gemm g{(const bf16*)(p.ws + WS_H), (const bf16*)(p.ws + WS_WOUT_T) + (size_t)l * D_MODEL * MIXW, MIXW, MIXW, MIXW, 0};
            Sched<0> S0; Sched<1> S1; S0.o.init(NPAN, D_MODEL / 256, w.G, w.wg, SITE_WGM(2)); S1.o.init(BATCH * NQL, D_MODEL / 256, w.G, w.wg, SITE_WGM(3)); S0.pm_base = 0; S0.seg = nullptr; S0.nNc = 0; S0.kper = 0; S1.pm_base = 0; S1.seg = nullptr; S1.nNc = 0; S1.kper = 0;
            if (l == 0) { EpiResid<true> E{p, l, 2 * D_MODEL}; const TabSched T_ = build_units(w.misc, w.tid, S0); pg8::gemm_phase<EpiResid<true>, TabSched>(w.lds, w.tid, g, T_, E); }
            else { EpiResid<false> E{p, l, 2 * D_MODEL}; const TabSched T_ = build_units(w.misc, w.tid, S1); pg8::gemm_phase<EpiResid<false>, TabSched>(w.lds, w.tid, g, T_, E); } } PH_END(pb + 6)
        if (l == 0) {
            PH_BEGIN(pb + 7) phase_modulate<4>(p, w, 0, 1, false, false, false, false); PH_END(pb + 7)
            PH_BEGIN(pb + 8) {
                pg8::Gemm g{(const bf16*)(p.ws + WS_H), (const bf16*)(p.ws + WS_WGU_T), D_MODEL, D_MODEL, D_MODEL, 0};
                Sched<0> S; S.o.init(NPAN, 2 * D_FF / 256, w.G, w.wg, SITE_WGM(4)); S.pm_base = 0; S.seg = nullptr; S.nNc = 0; S.kper = 0;
                EpiSwiglu E{(bf16*)(p.ws + WS_ACT), 0};
                { const TabSched T_ = build_units(w.misc, w.tid, S); pg8::gemm_phase<EpiSwiglu, TabSched>(w.lds, w.tid, g, T_, E); } } PH_END(pb + 8)
            PH_BEGIN(pb + 9) {
                { pg8::Gemm g{(const bf16*)(p.ws + WS_ACT), (const bf16*)(p.ws + WS_WD_T), D_FF, D_FF, D_FF, 0};
                  Sched<1> S; S.o.init(BATCH * NQL, D_MODEL / 256, w.G, w.wg, SITE_WGM(5)); S.pm_base = 0; S.seg = nullptr; S.nNc = 0; S.kper = 0;
                  EpiResid<false> E{p, 0, 5 * D_MODEL};
                  { const TabSched T_ = build_units(w.misc, w.tid, S); pg8::gemm_phase<EpiResid<false>, TabSched>(w.lds, w.tid, g, T_, E); } }
                __syncthreads();
                { pg8::Gemm g{(const bf16*)(p.ws + WS_ACT), (const bf16*)(p.ws + WS_WD_T), D_FF, D_FF, KSPLIT, 0};
                  Sched<4> S; S.o.init(BATCH, (D_MODEL / 256) * NSPLIT, w.G, w.wg, SITE_WGM(6)); S.pm_base = 0; S.seg = nullptr; S.nNc = D_MODEL / 256; S.kper = KSPLIT;
                  EpiStoreRel E{(bf16*)(p.ws + WS_MLAQ), D_MODEL, 0};
                  { const TabSched T_ = build_units(w.misc, w.tid, S); pg8::gemm_phase<EpiStoreRel, TabSched>(w.lds, w.tid, g, T_, E); } } } PH_END(pb + 9)
        } else {
            PH_BEGIN(pb + 7) phase_modulate<1>(p, w, 1, 1, false, true, true, false); PROBE_SPLIT(pb + 7, 51 + 3 * l) phase_moe_weights(p, w); PH_END(pb + 7)
            PH_BEGIN(pb + 8) phase_gather(p, w); PH_END(pb + 8)
            for (int c = 0; c < MOE_NCH; ++c) {
                PH_BEGIN(pb + 9 + 2 * c) {
                    moe_seg_table(p, w);
                    const int ptot = (int)w.misc[16 + NEXP], pm0 = c * MOE_PCH, np = (ptot - pm0) < MOE_PCH ? (ptot - pm0) : MOE_PCH;
                    if (c > 0 && (w.wg & 1)) phase_moe_combine(p, w, c - 1);
                    if (np > 0) {
                        pg8::Gemm g{(const bf16*)(p.ws + WS_AG), (const bf16*)(p.ws + WS_MOEW), D_MODEL, D_MODEL, D_MODEL, MOEW_E};
                        Sched<2> S; S.o.init(np, 2 * D_FF / 256, w.G, w.wg, SITE_WGM(7)); S.pm_base = pm0; S.seg = (const int*)(w.misc + 16); S.nNc = 0; S.kper = 0;
                        EpiSwiglu E{(bf16*)(p.ws + WS_ACT2), pm0};
                        { const TabSched T_ = build_units(w.misc, w.tid, S); pg8::gemm_phase<EpiSwiglu, TabSched>(w.lds, w.tid, g, T_, E); } }
                    if (c > 0 && !(w.wg & 1)) phase_moe_combine(p, w, c - 1); } PH_END(pb + 9 + 2 * c)
                PH_BEGIN(pb + 10 + 2 * c) {
                    moe_seg_table(p, w);
                    const int ptot = (int)w.misc[16 + NEXP], pm0 = c * MOE_PCH, np = (ptot - pm0) < MOE_PCH ? (ptot - pm0) : MOE_PCH;
                    if (np > 0 && np * NSPLIT > MOE_PCH) {
                        pg8::Gemm g{(const bf16*)(p.ws + WS_ACT2), (const bf16*)(p.ws + WS_MOEW) + (size_t)2 * D_FF * D_MODEL, D_FF, D_FF, D_FF, MOEW_E};
                        Sched<3> S; S.o.init(np, D_MODEL / 256, w.G, w.wg, SITE_WGM(8)); S.pm_base = pm0; S.seg = (const int*)(w.misc + 16); S.nNc = 0; S.kper = 0;
                        EpiStoreRel E{(bf16*)(p.ws + WS_YC), D_MODEL, 0};
                        { const TabSched T_ = build_units(w.misc, w.tid, S); pg8::gemm_phase<EpiStoreRel, TabSched>(w.lds, w.tid, g, T_, E); } }
                    else if (np > 0) {
                        pg8::Gemm g{(const bf16*)(p.ws + WS_ACT2), (const bf16*)(p.ws + WS_MOEW) + (size_t)2 * D_FF * D_MODEL, D_FF, D_FF, KSPLIT, MOEW_E};
                        Sched<5> S; S.o.init(np, (D_MODEL / 256) * NSPLIT, w.G, w.wg, SITE_WGM(9)); S.pm_base = pm0; S.seg = (const int*)(w.misc + 16); S.nNc = D_MODEL / 256; S.kper = KSPLIT;
                        EpiStoreRel E{(bf16*)(p.ws + WS_YC), D_MODEL, 0};
                        { const TabSched T_ = build_units(w.misc, w.tid, S); pg8::gemm_phase<EpiStoreRel, TabSched>(w.lds, w.tid, g, T_, E); } } } PH_END(pb + 10 + 2 * c)
            }
            PH_BEGIN(pb + 9 + 2 * MOE_NCH) moe_seg_table(p, w); phase_moe_final(p, w); PH_END(pb + 9 + 2 * MOE_NCH)
        }
    }
#if defined(PROBE_SET) && !defined(EMU)
    if (blockIdx.x == 0 && threadIdx.x == 0) {
        unsigned tot = 0; for (int k = 0; k < 56; ++k) if ((PROBE_SET >> k) & 1ull) tot += ((unsigned*)(lds + LDS_MISC))[65 + 2 * k] - ((unsigned*)(lds + LDS_MISC))[64 + 2 * k];
        const unsigned long long t0 = wall_clock64(); while (wall_clock64() - t0 < (unsigned long long)tot * PROBE_MUL) __builtin_amdgcn_s_sleep(8);
    }
#endif
}

#ifndef MK_PER_PHASE
#define MK_PER_PHASE 0
#endif
extern "C" void kernel_launch(void* const* d_in, const int* in_sizes, int n_in, void* d_out, int out_size, void* d_ws, size_t ws_size, hipStream_t stream) {
    static int grid = 0;
    if (grid == 0) {
        if (n_in != 28 || in_sizes[0] != BATCH * SEQ * D_MODEL || out_size != BATCH * SEQ * D_MODEL || ws_size < WS_TOTAL) {
            fprintf(stderr, "kernel_launch: unexpected problem (n_in %d, x %d, out %d, ws %zu < %zu)\n", n_in, n_in > 0 ? in_sizes[0] : -1, out_size, ws_size, (size_t)WS_TOTAL); grid = -1; return; }
#ifndef EMU
        int dev = 0, cus = 0;
        if (hipGetDevice(&dev) != hipSuccess || hipDeviceGetAttribute(&cus, hipDeviceAttributeMultiprocessorCount, dev) != hipSuccess) { grid = -1; return; }
        if (hipFuncSetAttribute((const void*)fwd, hipFuncAttributeMaxDynamicSharedMemorySize, LDS_BYTES) != hipSuccess) { fprintf(stderr, "kernel_launch: hipFuncSetAttribute failed\n"); grid = -1; return; }
        int per_cu = 0;
        if (hipOccupancyMaxActiveBlocksPerMultiprocessor(&per_cu, (const void*)fwd, NTHR, LDS_BYTES) != hipSuccess || per_cu < 1) { fprintf(stderr, "kernel_launch: occupancy query says %d\n", per_cu); (void)hipGetLastError(); }
        grid = cus;
#else
        grid = 8;
#endif
    }
    if (grid < 0) return;
    (void)hipMemsetAsync((char*)d_ws + WS_CTL, 0, CTL_BYTES, stream);
    P p{};
    const float** pp = (const float**)&p;
    for (int i = 0; i < 28; ++i) pp[i] = (const float*)d_in[i];
    p.out = (float*)d_out; p.ws = (unsigned char*)d_ws;
#if MK_PER_PHASE
    for (int k = 0; k < N_PHASES; ++k) {
        if (k >= 1 + 10 && k < 1 + PH_L) continue;
        if (k >= 1 + PH_L + 10 + 2 * MOE_NCH) continue;
        p.ph_lo = k; p.ph_hi = k + 1;
        hipLaunchKernelGGL(fwd, dim3(grid), dim3(NTHR), LDS_BYTES, stream, p);
    }
#else
    p.ph_lo = 0; p.ph_hi = N_PHASES;
    hipLaunchKernelGGL(fwd, dim3(grid), dim3(NTHR), LDS_BYTES, stream, p);
#endif
}
```

```cpp
#ifndef EMU
#include <hip/hip_runtime.h>
#endif
#include <cstdio>
#include <cstdint>
#include <cmath>

#ifdef CFG_TINY
constexpr int D_MODEL = 256, BATCH = 2, SEQ = 512, CTX = 256, GRID_W = 16, D_FF = 512;
constexpr int MOE_PCH = 4, NSPLIT = 2;
#else
constexpr int D_MODEL = 1024, BATCH = 8, SEQ = 4096, CTX = 256, GRID_W = 64, D_FF = 3584;
constexpr int MOE_PCH = 64, NSPLIT = 7;
#endif
constexpr int TP = CTX + SEQ, M_ALL = BATCH * TP, NPAN = M_ALL / 256, PAN_B = TP / 256, NQL = SEQ / 256;
constexpr int MCH = 128;
constexpr int NCH = TP / MCH, NC_CTX = CTX / MCH, NQB = MCH / 32;
constexpr int PROJ_W = 2816, MIXW = 1024, NEXP = 8;
constexpr int C_MQ = 0, C_MK = 384, C_MV = 768, C_MO = 1152, C_G = 1536, C_AQ = 1552, C_AK = 1936, C_AV = 2064, C_CQ = 2192, C_CKV = 2448, C_KR = 2576, IN_W = 2608;
constexpr int NV = BATCH + 1;
constexpr int NCHAIN = BATCH * 4 * 2, NITEM = NCHAIN * NCH;
constexpr int NTOK = BATCH * SEQ, NSLOTP = NTOK * 2 + NEXP * 256;
constexpr int MOE_NCH = (NSLOTP / 256 + MOE_PCH - 1) / MOE_PCH;
constexpr float EPS = 1e-6f, LOG2E = 1.4426950408889634f;
constexpr float QSCALE_A = 0.125f * LOG2E, QSCALE_L = 0.10206207261596575f * LOG2E, KSCALE_M = 0.10206207261596575f;
constexpr int NTHR = 512, NWAVE = 8;
constexpr int KSPLIT = D_FF / NSPLIT;
static_assert(KSPLIT % 128 == 0 && KSPLIT >= 256 && NSPLIT * BATCH * 256 * D_MODEL * 2 <= M_ALL * 1024 * 2, "split-K geometry");
constexpr int NPOS = (SEQ / GRID_W > GRID_W) ? SEQ / GRID_W : GRID_W;

typedef unsigned short bf16;
#ifndef EMU
typedef short bf16x8 __attribute__((ext_vector_type(8)));
typedef short s16x4 __attribute__((ext_vector_type(4)));
typedef float f32x4 __attribute__((ext_vector_type(4)));
typedef float f32x2 __attribute__((ext_vector_type(2)));
typedef float f32x16 __attribute__((ext_vector_type(16)));
typedef unsigned u32x4 __attribute__((ext_vector_type(4)));
typedef unsigned u32x2 __attribute__((ext_vector_type(2)));
#define DEV __device__ __forceinline__
DEV f32x16 mfma32(bf16x8 a, bf16x8 b, f32x16 c) { return __builtin_amdgcn_mfma_f32_32x32x16_bf16(a, b, c, 0, 0, 0); }
DEV void wave_sync() { asm volatile("s_waitcnt vmcnt(0) lgkmcnt(0)" ::: "memory"); __builtin_amdgcn_wave_barrier(); }
typedef __bf16 bf16x2_hw __attribute__((ext_vector_type(2)));
typedef short v4i16_t __attribute__((ext_vector_type(4)));
DEV unsigned pk2_hw(float lo, float hi) { f32x2 v = {lo, hi}; bf16x2_hw b = __builtin_convertvector(v, bf16x2_hw); return __builtin_bit_cast(unsigned, b); }
DEV s16x4 lds_tr_read(const unsigned short* a) { return __builtin_bit_cast(s16x4, __builtin_amdgcn_ds_read_tr16_b64_v4i16((__attribute__((address_space(3))) v4i16_t*)(a))); }
DEV float exp2_fast(float x) { return __builtin_amdgcn_exp2f(x); }
DEV float rcp_fast(float x) { return __builtin_amdgcn_rcpf(x); }
DEV float rsqrt_fast(float x) { return __builtin_amdgcn_rsqf(x); }
DEV void atomic_addf(float* p, float v) { unsafeAtomicAdd(p, v); }
#define OPAQUE_V(x) asm volatile("" : "+v"(x))
#define SCHED_FENCE() __builtin_amdgcn_sched_barrier(0)
#define UNIFORM_I(x) __builtin_amdgcn_readfirstlane(x)
DEV unsigned fau(float f) { return __float_as_uint(f); }
DEV float uaf(unsigned u) { return __uint_as_float(u); }
DEV float my_shfl_xor(float v, int m, int lane) { return __int_as_float(__builtin_amdgcn_ds_bpermute((lane ^ m) << 2, __float_as_int(v))); }
#define SHX(v, m, lane) my_shfl_xor((v), (m), (lane))
DEV float my_shfl(float v, int src) { return __int_as_float(__builtin_amdgcn_ds_bpermute((src & 63) << 2, __float_as_int(v))); }
DEV int my_shfl(int v, int src) { return __builtin_amdgcn_ds_bpermute((src & 63) << 2, v); }
#define __shfl my_shfl
DEV int lane_fresh() { int l_; asm volatile("v_mbcnt_lo_u32_b32 %0, -1, 0\n\tv_mbcnt_hi_u32_b32 %0, -1, %0" : "=v"(l_)); return l_; }
#else
#define DEV inline
#define OPAQUE_V(x) do {} while (0)
#define SCHED_FENCE() do {} while (0)
#define UNIFORM_I(x) (x)
#define SHX(v, m, lane) __shfl_xor((v), (m))
DEV void wave_sync() { (void)emu_shfl_u(0u, emu::B->cur & 63); }
DEV void atomic_addf(float* p, float v) { atomicAdd(p, v); }
DEV float rsqrt_fast(float x) { return 1.0f / sqrtf(x); }
DEV unsigned fau(float f) { unsigned u; memcpy(&u, &f, 4); return u; }
DEV float uaf(unsigned u) { float f; memcpy(&f, &u, 4); return f; }
#endif
DEV bf16 f2bf(float f) { unsigned u = fau(f); u += 0x7fffu + ((u >> 16) & 1u); return (bf16)(u >> 16); }
DEV float bf2f(bf16 h) { return uaf(((unsigned)h) << 16); }
#ifndef EMU
DEV unsigned pk2(float lo, float hi) { return pk2_hw(lo, hi); }
#else
DEV unsigned pk2(float lo, float hi) { return (unsigned)f2bf(lo) | ((unsigned)f2bf(hi) << 16); }
#endif
DEV float wave_sum(float v, int lane) {
#pragma unroll
    for (int o = 1; o < 64; o <<= 1) v += SHX(v, o, lane);
    return v;
}
DEV float wave_max(float v, int lane) {
#pragma unroll
    for (int o = 1; o < 64; o <<= 1) v = fmaxf(v, SHX(v, o, lane));
    return v;
}
DEV float silu_f(float x) { return x / (1.0f + __expf(-x)); }
DEV float silu_fast(float x) { return x * rcp_fast(1.0f + exp2_fast(-x * LOG2E)); }
DEV float sigmoid_f(float x) { return rcp_fast(1.0f + exp2_fast(-x * LOG2E)); }
DEV float log_sigmoid_f(float x) { return x >= 0.f ? -log1pf(expf(-x)) : x - log1pf(expf(x)); }
DEV int crow(int i, int h) { return (i & 3) + 8 * (i >> 2) + 4 * h; }

constexpr size_t al256(size_t x) { return (x + 255) & ~(size_t)255; }
constexpr size_t WS_CTL = 0, CTL_BYTES = 65536;
constexpr int CW_Q = 0;
constexpr int CW_BAR = 4096;
constexpr size_t WS_MODV = WS_CTL + CTL_BYTES;
constexpr size_t WS_WIN_T = al256(WS_MODV + (size_t)2 * NV * 6 * D_MODEL * 4);
constexpr size_t WS_WOUT_T = al256(WS_WIN_T + (size_t)2 * PROJ_W * D_MODEL * 2);
constexpr size_t WS_MLA_T = al256(WS_WOUT_T + (size_t)2 * D_MODEL * MIXW * 2);
constexpr size_t WS_WGU_T = al256(WS_MLA_T + (size_t)2 * 1024 * 512 * 2);
constexpr size_t WS_WD_T = al256(WS_WGU_T + (size_t)2 * D_FF * D_MODEL * 2);
constexpr size_t WS_CX = al256(WS_WD_T + (size_t)D_MODEL * D_FF * 2);
constexpr size_t WS_GATES = al256(WS_CX + (size_t)BATCH * CTX * D_MODEL * 4);
constexpr size_t WS_NL = al256(WS_GATES + (size_t)M_ALL * 16 * 4);
constexpr size_t WS_FS = al256(WS_NL + (size_t)NITEM * 96 * 4);
constexpr size_t WS_PML = al256(WS_FS + (size_t)NITEM * 4);
constexpr size_t WS_MST = al256(WS_PML + (size_t)NITEM * 4);
constexpr size_t WS_TOPI = al256(WS_MST + (size_t)NITEM * 4);
constexpr size_t WS_TOPW = al256(WS_TOPI + (size_t)NTOK * 2 * 4);
constexpr size_t WS_CNTG = al256(WS_TOPW + (size_t)NTOK * 2 * 4);
constexpr size_t WS_STOK = al256(WS_CNTG + (size_t)1024 * 8 * 4);
constexpr size_t WS_SW = al256(WS_STOK + (size_t)NSLOTP * 4);
constexpr size_t WS_TSL = al256(WS_SW + (size_t)NSLOTP * 4);
constexpr size_t WS_ROPE = al256(WS_TSL + (size_t)NTOK * 2 * 4);
constexpr size_t WS_PROJ = al256(WS_ROPE + (size_t)NPOS * 24 * 2 * 4);
constexpr size_t WS_MQK = al256(WS_PROJ + (size_t)M_ALL * PROJ_W * 2);
constexpr size_t WS_MLAQ = al256(WS_MQK + (size_t)M_ALL * 768 * 2);
constexpr size_t WS_UC = al256(WS_MLAQ + (size_t)M_ALL * 1024 * 2);
constexpr size_t WS_H = al256(WS_UC + (size_t)NITEM * 9216 * 2);
constexpr size_t WS_END0 = al256(WS_H + (size_t)M_ALL * 1024 * 2);
constexpr size_t WS_ACT = WS_PROJ;
constexpr size_t WS_MOEW = WS_PROJ;
constexpr size_t MOEW_E = (size_t)3 * D_FF * D_MODEL * 2;
constexpr size_t WS_AG = al256(WS_MOEW + NEXP * MOEW_E);
constexpr size_t WS_ACT2 = al256(WS_AG + (size_t)NSLOTP * D_MODEL * 2);
constexpr size_t WS_YC = al256(WS_ACT2 + (size_t)MOE_PCH * 256 * D_FF * 2);
#ifdef CFG_TINY
constexpr size_t WS_TOTAL = WS_END0 + (4u << 20);
#else
constexpr size_t WS_TOTAL = (size_t)512 << 20;
#endif
static_assert(WS_END0 <= WS_TOTAL, "ws map");
constexpr int ML2_U = (NCH % 17 == 0) ? 17 : ((NCH % 4 == 0) ? 4 : 2);
static_assert(NCH % ML2_U == 0, "ML2 unroll");
static_assert(WS_ACT + (size_t)M_ALL * D_FF * 2 <= WS_MLAQ, "dense ACT overlays PROJ+MQK only");
static_assert(WS_MOEW + NEXP * MOEW_E <= WS_MQK, "MoE weights overlay PROJ only");
static_assert(WS_YC + (size_t)MOE_PCH * 256 * D_MODEL * 2 <= WS_TOTAL, "MoE chunk buffers");

constexpr int LDS_STAGE = 131072;
constexpr int LDS_MISC = LDS_STAGE;
constexpr int LDS_BYTES = LDS_STAGE + 4096;

struct P {
    const float *x, *c, *ctx, *c_ctx, *mod_w, *mod_b, *norm_mix, *norm_ffn, *w_in, *m_conv, *m_gate_b, *m_norm, *a_qnorm, *a_knorm, *l_cq_norm, *l_ckv_norm,
        *l_wuq, *l_wukv, *l_qnorm, *l_knorm, *w_out, *ffn_wg, *ffn_wu, *ffn_wd, *moe_router, *moe_wg, *moe_wu, *moe_wd;
    float* out; unsigned char* ws; int ph_lo, ph_hi;
};
constexpr int RPITCH = 2 * D_MODEL;
DEV bf16* resid_row(const P& p, int R) {
    const int b = R / TP, q = R % TP;
    return q < CTX ? (bf16*)(p.ws + WS_CX) + (size_t)(b * CTX + q) * RPITCH : (bf16*)(p.out + (size_t)(b * SEQ + q - CTX) * D_MODEL);
}
DEV const float* modv(const P& p, int l, int R) { const int b = R / TP, q = R % TP; return (const float*)(p.ws + WS_MODV) + (size_t)(l * NV + (q < CTX ? BATCH : b)) * 6 * D_MODEL; }

namespace pg8 {
constexpr int BM = 256, BK = 64, HALF = 128, HTB = HALF * BK * 2, STAGE_BYTES = 8 * HTB, NXCD = 8, WGM = 8;
struct Unit { int pm, pn, e, k0, po; };
struct Gemm { const bf16* A; const bf16* Bt; int lda, ldb, K; size_t bstride; };
DEV int lds_byte(int r, int c) { const int st = (r >> 4) * 2 + (c >> 5), rr = r & 15, cc = c & 31, ob = rr * 64 + cc * 2; return st * 1024 + (ob ^ (((ob >> 9) & 1) << 5)); }
DEV void stage_rc(int b, int& R, int& C) { const int st = b / 1024, sb = b % 1024, swz = sb ^ (((sb >> 9) & 1) << 5); R = (st >> 1) * 16 + swz / 64; C = (st & 1) * 32 + (swz % 64) / 2; }
DEV int perm32(int rho) { const int n = rho >> 4, i = rho & 15; return 8 * (i >> 2) + 4 * n + (i & 3); }
struct Order {
    int nM, nN, nwg, G, c, wgm;
    DEV void init(int nM_, int nN_, int G_, int c_, int wgm_ = WGM) { nM = nM_; nN = nN_; nwg = nM * nN; G = G_; c = c_; wgm = wgm_; }
    DEV bool nextL(int i, int& lm, int& ln) const {
        const long L = (long)i * G + c; if (L >= nwg) return false;
        int wgid = (int)L; { const int q = nwg / NXCD, r = nwg % NXCD, xcd = wgid % NXCD, off = wgid / NXCD; wgid = (xcd < r ? xcd * (q + 1) : r * (q + 1) + (xcd - r) * q) + off; }
        const int nig = wgm * nN, gid = wgid / nig, fm = gid * wgm, gsz = (nM - fm) < wgm ? (nM - fm) : wgm;
        lm = fm + ((wgid % nig) % gsz); ln = (wgid % nig) / gsz; return true;
    }
};
#ifndef EMU
#define PG8_LAS __attribute__((address_space(3)))
DEV unsigned cvt_pk_bf16(float lo, float hi) { unsigned r; asm volatile("v_cvt_pk_bf16_f32 %0, %1, %2" : "=v"(r) : "v"(lo), "v"(hi)); return r; }
template <class Epi, class Sched>
DEV void gemm_phase(unsigned char* lds_, const int tid, const Gemm g, const Sched& S, const Epi& E) {
    PG8_LAS unsigned char* lds = (PG8_LAS unsigned char*)lds_;
    const int wid = __builtin_amdgcn_readfirstlane(tid >> 6), lane = tid & 63, wr = wid >> 2, wc = wid & 3, fr = lane & 15, fq = lane >> 4;
    const int K = g.K, nt = K / BK, lda = g.lda, ldb = g.ldb;
    unsigned voffA[2], voffB[2];
#pragma unroll
    for (int i = 0; i < 2; ++i) { int R, C; stage_rc(tid * 16 + i * 8192, R, C); const int Rb = Epi::PERM ? ((R & ~31) + perm32(R & 31)) : R;
        voffA[i] = (unsigned)(R * lda + C) * 2u; voffB[i] = (unsigned)(Rb * ldb + C) * 2u; }
    const size_t kstep = (size_t)(BK * 2);
    const size_t hstepA = (size_t)HALF * lda * 2, hstepB = (size_t)HALF * ldb * 2;
    const size_t tstepA = 2 * hstepA, tstepB = 2 * hstepB;
    const unsigned ldsw = (unsigned)wid * 1024u;
    const int aoff = lds_byte(wr * 64 + fr, fq * 8), boff = lds_byte(wc * 32 + fr, fq * 8);
#define PG8_SA(b, h) (((b) * 2 + (h)) * HTB)
#define PG8_SB(b, h) ((4 + (b) * 2 + (h)) * HTB)
#define PG8_STAGE(bufoff, gbase, voff) do { _Pragma("unroll") for (int _i = 0; _i < 2; ++_i) \
        __builtin_amdgcn_global_load_lds((const unsigned*)((const char*)(gbase) + (voff)[_i]), (PG8_LAS unsigned*)(lds + (bufoff) + ldsw + _i * 8192), 16, 0, 0); } while (0)
#define PG8_LDA(dst, b, h) do { _Pragma("unroll") for (int m = 0; m < 4; ++m) _Pragma("unroll") for (int k = 0; k < 2; ++k) dst[m][k] = *(const PG8_LAS bf16x8*)(lds + PG8_SA(b, h) + aoff + m * 2048 + k * 1024); } while (0)
#define PG8_LDB(dst, b, h) do { _Pragma("unroll") for (int n = 0; n < 2; ++n) _Pragma("unroll") for (int k = 0; k < 2; ++k) dst[n][k] = *(const PG8_LAS bf16x8*)(lds + PG8_SB(b, h) + boff + n * 2048 + k * 1024); } while (0)
#define PG8_MMA(ai, bj, At, Bt) do { __builtin_amdgcn_s_setprio(1); _Pragma("unroll") for (int m = 0; m < 4; ++m) _Pragma("unroll") for (int n = 0; n < 2; ++n) _Pragma("unroll") for (int k = 0; k < 2; ++k) \
        acc[ai][bj][m][n] = __builtin_amdgcn_mfma_f32_16x16x32_bf16(Bt[n][k], At[m][k], acc[ai][bj][m][n], 0, 0, 0); __builtin_amdgcn_s_setprio(0); } while (0)
#define PG8_WAIT_V(n) asm volatile("s_waitcnt vmcnt(" #n ")" ::: "memory")
#define PG8_WAIT_L(n) asm volatile("s_waitcnt lgkmcnt(" #n ")" ::: "memory")
#define PG8_BAR __builtin_amdgcn_s_barrier()
#define PG8_SCHED __builtin_amdgcn_sched_barrier(0)
    Unit cur, nxt; int ui = 0;
    if (!S.next(0, cur)) return;
    f32x4 acc[2][2][4][2];
#pragma unroll
    for (int a = 0; a < 2; ++a)
#pragma unroll
        for (int b = 0; b < 2; ++b)
#pragma unroll
            for (int m = 0; m < 4; ++m)
#pragma unroll
                for (int n = 0; n < 2; ++n) acc[a][b][m][n] = (f32x4){0.f, 0.f, 0.f, 0.f};
    bf16x8 At[4][2], B0[2][2], B1[2][2];
    const char* cA = (const char*)g.A + (size_t)cur.pm * tstepA + (size_t)cur.k0 * 2; const char* cB = (const char*)g.Bt + (size_t)cur.e * g.bstride + (size_t)cur.pn * tstepB + (size_t)cur.k0 * 2;
    PG8_STAGE(PG8_SB(0, 0), cB, voffB); PG8_STAGE(PG8_SB(0, 1), cB + hstepB, voffB); PG8_STAGE(PG8_SA(0, 0), cA, voffA); PG8_STAGE(PG8_SA(0, 1), cA + hstepA, voffA);
    if (wr == 1) PG8_BAR;
    PG8_WAIT_V(2); PG8_BAR;
    PG8_STAGE(PG8_SB(1, 0), cB + kstep, voffB); PG8_STAGE(PG8_SA(1, 0), cA + kstep, voffA); PG8_STAGE(PG8_SB(1, 1), cB + hstepB + kstep, voffB);
    PG8_WAIT_V(6); PG8_BAR;
    for (;;) {
        const bool has_next = S.next(ui + 1, nxt);
        const char* nA = has_next ? (const char*)g.A + (size_t)nxt.pm * tstepA + (size_t)nxt.k0 * 2 : cA; const char* nB = has_next ? (const char*)g.Bt + (size_t)nxt.e * g.bstride + (size_t)nxt.pn * tstepB + (size_t)nxt.k0 * 2 : cB;
#pragma unroll 1
        for (int t = 0; t < nt; t += 2) {
            const bool last = (t == nt - 2);
            const char* a1 = cA + (size_t)(t + 1) * kstep;
            const char* a2 = last ? nA : cA + (size_t)(t + 2) * kstep; const char* b2 = last ? nB : cB + (size_t)(t + 2) * kstep;
            const char* a3 = a2 + kstep; const char* b3 = b2 + kstep;
            PG8_LDB(B0, 0, 0); PG8_LDB(B1, 0, 1); PG8_SCHED; PG8_LDA(At, 0, 0); PG8_STAGE(PG8_SA(1, 1), a1 + hstepA, voffA);
            PG8_WAIT_V(8); PG8_WAIT_L(0); PG8_BAR; PG8_MMA(0, 0, At, B0); PG8_MMA(0, 1, At, B1); PG8_BAR; PG8_SCHED;
            PG8_LDA(At, 0, 1); PG8_STAGE(PG8_SB(0, 0), b2, voffB); PG8_STAGE(PG8_SB(0, 1), b2 + hstepB, voffB); PG8_STAGE(PG8_SA(0, 0), a2, voffA);
            PG8_WAIT_V(8); PG8_WAIT_L(0); PG8_BAR; PG8_MMA(1, 0, At, B0); PG8_MMA(1, 1, At, B1); PG8_BAR; PG8_SCHED;
            PG8_LDB(B0, 1, 0); PG8_LDB(B1, 1, 1); PG8_SCHED; PG8_LDA(At, 1, 0); PG8_STAGE(PG8_SA(0, 1), a2 + hstepA, voffA);
            PG8_WAIT_V(8); PG8_WAIT_L(0); PG8_BAR; PG8_MMA(0, 0, At, B0); PG8_MMA(0, 1, At, B1); PG8_BAR; PG8_SCHED;
            PG8_LDA(At, 1, 1); PG8_STAGE(PG8_SB(1, 0), b3, voffB); PG8_STAGE(PG8_SB(1, 1), b3 + hstepB, voffB); PG8_STAGE(PG8_SA(1, 0), a3, voffA);
            PG8_WAIT_V(8); PG8_WAIT_L(0); PG8_BAR; PG8_MMA(1, 0, At, B0); PG8_MMA(1, 1, At, B1); PG8_BAR; PG8_SCHED;
        }
        if (wr == 0) PG8_BAR;
        E(acc, cur, wr, wc, fr, fq);
        if (!has_next) break;
#pragma unroll
        for (int a = 0; a < 2; ++a)
#pragma unroll
            for (int b = 0; b < 2; ++b)
#pragma unroll
                for (int m = 0; m < 4; ++m)
#pragma unroll
                    for (int n = 0; n < 2; ++n) acc[a][b][m][n] = (f32x4){0.f, 0.f, 0.f, 0.f};
        cur = nxt; cA = nA; cB = nB; ++ui;
        if (wr == 1) PG8_BAR;
    }
    PG8_WAIT_V(0);
    PG8_BAR;
#undef PG8_SA
#undef PG8_SB
#undef PG8_STAGE
#undef PG8_LDA
#undef PG8_LDB
#undef PG8_MMA
#undef PG8_WAIT_V
#undef PG8_WAIT_L
#undef PG8_BAR
#undef PG8_SCHED
}
#else
DEV unsigned cvt_pk_bf16(float lo, float hi) { return pk2(lo, hi); }
template <class Epi, class Sched>
DEV void gemm_phase(unsigned char*, const int tid, const Gemm g, const Sched& S, const Epi& E) {
    const int wid = tid >> 6, lane = tid & 63, wr = wid >> 2, wc = wid & 3, fr = lane & 15, fq = lane >> 4;
    Unit u;
    for (int ui = 0; S.next(ui, u); ++ui) {
        f32x4 acc[2][2][4][2];
        const bf16* Bt = (const bf16*)((const char*)g.Bt + (size_t)u.e * g.bstride);
        for (int ai = 0; ai < 2; ++ai) for (int bj = 0; bj < 2; ++bj) for (int m = 0; m < 4; ++m) for (int n = 0; n < 2; ++n) for (int j = 0; j < 4; ++j) {
            const size_t row = (size_t)u.pm * 256 + 128 * ai + 64 * wr + 16 * m + fr;
            const size_t col = (size_t)u.pn * 256 + 128 * bj + 32 * wc + (Epi::PERM ? 8 * fq + 4 * n + j : 16 * n + 4 * fq + j);
            const bf16* a = g.A + row * g.lda + u.k0; const bf16* b = Bt + col * g.ldb + u.k0; float s = 0.f;
            for (int k = 0; k < g.K; ++k) s += bf2f(a[k]) * bf2f(b[k]);
            acc[ai][bj][m][n][j] = s; }
        E(acc, u, wr, wc, fr, fq);
    }
}
#endif
}

using pg8::Unit;
struct EpiStore {
    static constexpr bool PERM = true;
    bf16* O; int ldc; float* gates;
    DEV void operator()(const f32x4 (&acc)[2][2][4][2], const Unit& u, int wr, int wc, int fr, int fq) const {
        const int row0 = u.pm * 256 + wr * 64 + fr, col0 = u.pn * 256 + wc * 32 + 8 * fq;
        const bool dog = gates != nullptr && u.pn == C_G / 256 && wc == 0 && fq < 2;
#pragma unroll
        for (int ai = 0; ai < 2; ++ai)
#pragma unroll
            for (int m = 0; m < 4; ++m) { const int row = row0 + ai * 128 + m * 16; bf16* rowp = O + (size_t)row * ldc + col0;
#pragma unroll
                for (int bj = 0; bj < 2; ++bj) { const f32x4 v0 = acc[ai][bj][m][0], v1 = acc[ai][bj][m][1];
                    u32x4 w; w.x = pg8::cvt_pk_bf16(v0[0], v0[1]); w.y = pg8::cvt_pk_bf16(v0[2], v0[3]); w.z = pg8::cvt_pk_bf16(v1[0], v1[1]); w.w = pg8::cvt_pk_bf16(v1[2], v1[3]);
                    *(u32x4*)(rowp + bj * 128) = w;
                    if (bj == 0 && dog) { float* gp = gates + (size_t)row * 16 + 8 * fq; *(f32x4*)gp = v0; *(f32x4*)(gp + 4) = v1; } } }
    }
};
template <bool from_input> struct EpiResid {
    static constexpr bool PERM = true;
    P p; int l, goff;
    DEV void operator()(const f32x4 (&acc)[2][2][4][2], const Unit& u, int wr, int wc, int fr, int fq) const {
        const int R0 = u.pm * 256, bb = R0 / TP, q0 = R0 % TP; const bool isctx = q0 < CTX;
        bf16* xb = resid_row(p, R0); constexpr size_t rs = RPITCH;
        const float* xin = isctx ? p.ctx + (size_t)(bb * CTX + q0) * D_MODEL : p.x + (size_t)(bb * SEQ + q0 - CTX) * D_MODEL;
        const float* gv = modv(p, l, R0) + goff;
        const int col0 = u.pn * 256 + wc * 32 + 8 * fq;
        constexpr int MB = from_input ? 2 : 4;
#pragma unroll
        for (int bj = 0; bj < 2; ++bj) { const int col = col0 + bj * 128; const f32x4 g0 = *(const f32x4*)(gv + col), g1 = *(const f32x4*)(gv + col + 4);
#pragma unroll
            for (int ai = 0; ai < 2; ++ai)
#pragma unroll
                for (int mb = 0; mb < 4; mb += MB) { f32x4 a0[MB], a1[MB];
#pragma unroll
                    for (int mm = 0; mm < MB; ++mm) { const size_t rl = (size_t)(wr * 64 + fr + ai * 128 + (mb + mm) * 16);
                        if (from_input) { a0[mm] = *(const f32x4*)(xin + rl * D_MODEL + col); a1[mm] = *(const f32x4*)(xin + rl * D_MODEL + col + 4); }
                        else { const u32x4 t = *(const u32x4*)(xb + rl * rs + col);
                            a0[mm] = (f32x4){bf2f((bf16)t.x), bf2f((bf16)(t.x >> 16)), bf2f((bf16)t.y), bf2f((bf16)(t.y >> 16))}; a1[mm] = (f32x4){bf2f((bf16)t.z), bf2f((bf16)(t.z >> 16)), bf2f((bf16)t.w), bf2f((bf16)(t.w >> 16))}; } }
#pragma unroll
                    for (int mm = 0; mm < MB; ++mm) { const size_t rl = (size_t)(wr * 64 + fr + ai * 128 + (mb + mm) * 16);
                        const f32x4 o0 = a0[mm] + g0 * acc[ai][bj][mb + mm][0], o1 = a1[mm] + g1 * acc[ai][bj][mb + mm][1];
                        u32x4 wv; wv.x = pg8::cvt_pk_bf16(o0[0], o0[1]); wv.y = pg8::cvt_pk_bf16(o0[2], o0[3]); wv.z = pg8::cvt_pk_bf16(o1[0], o1[1]); wv.w = pg8::cvt_pk_bf16(o1[2], o1[3]);
                        *(u32x4*)(xb + rl * rs + col) = wv; } } }
    }
};
struct EpiSwiglu {
    static constexpr bool PERM = true;
    bf16* O; int pm_base;
    DEV void operator()(const f32x4 (&acc)[2][2][4][2], const Unit& u, int wr, int wc, int fr, int fq) const {
        const int row0 = u.po * 256 + wr * 64 + fr, col0 = u.pn * 128 + wc * 32 + 8 * fq;
#pragma unroll
        for (int ai = 0; ai < 2; ++ai)
#pragma unroll
            for (int m = 0; m < 4; ++m) { float r[8];
#pragma unroll
                for (int n = 0; n < 2; ++n)
#pragma unroll
                    for (int j = 0; j < 4; ++j) r[4 * n + j] = silu_fast(acc[ai][0][m][n][j]) * acc[ai][1][m][n][j];
                u32x4 w; w.x = pg8::cvt_pk_bf16(r[0], r[1]); w.y = pg8::cvt_pk_bf16(r[2], r[3]); w.z = pg8::cvt_pk_bf16(r[4], r[5]); w.w = pg8::cvt_pk_bf16(r[6], r[7]);
                *(u32x4*)(O + (size_t)(row0 + ai * 128 + m * 16) * D_FF + col0) = w; }
    }
};
struct EpiStoreRel {
    static constexpr bool PERM = true;
    bf16* O; int ldc, pm_base;
    DEV void operator()(const f32x4 (&acc)[2][2][4][2], const Unit& u, int wr, int wc, int fr, int fq) const {
        const int row0 = u.po * 256 + wr * 64 + fr, col0 = u.pn * 256 + wc * 32 + 8 * fq;
#pragma unroll
        for (int ai = 0; ai < 2; ++ai)
#pragma unroll
            for (int m = 0; m < 4; ++m) { bf16* rowp = O + (size_t)(row0 + ai * 128 + m * 16) * ldc + col0;
#pragma unroll
                for (int bj = 0; bj < 2; ++bj) { const f32x4 v0 = acc[ai][bj][m][0], v1 = acc[ai][bj][m][1];
                    u32x4 w; w.x = pg8::cvt_pk_bf16(v0[0], v0[1]); w.y = pg8::cvt_pk_bf16(v0[2], v0[3]); w.z = pg8::cvt_pk_bf16(v1[0], v1[1]); w.w = pg8::cvt_pk_bf16(v1[2], v1[3]);
                    *(u32x4*)(rowp + bj * 128) = w; } }
    }
};
template <int mode> struct Sched {
    pg8::Order o; int pm_base; const int* seg; int nNc, kper;
    DEV bool next(int i, Unit& u) const {
        int lm, ln; if (!o.nextL(i, lm, ln)) return false;
        u.pn = ln; u.e = 0; u.k0 = 0; u.po = lm;
        if (mode == 0) u.pm = lm;
        else if (mode == 1) u.pm = (lm / NQL) * PAN_B + 1 + lm % NQL;
        else if (mode == 6) { u.pm = lm; u.k0 = (ln >= 2) ? 256 : 0; }
        else if (mode == 4) { u.pm = lm * PAN_B; u.pn = ln % nNc; u.k0 = (ln / nNc) * kper; u.po = (ln / nNc) * o.nM + lm; }
        else { const int gp = pm_base + lm; int e = 0;
#pragma unroll
            for (int k = 1; k < NEXP; ++k) e += (seg[k] <= gp) ? 1 : 0;
            u.e = e; u.pm = (mode == 2) ? gp : lm;
            if (mode == 5) { u.pn = ln % nNc; u.k0 = (ln / nNc) * kper; u.po = (ln / nNc) * o.nM + lm; } }
        return true;
    }
};

#ifndef WGM_MASK
#define WGM_MASK 0x01f
#endif
#define SITE_WGM(k) (((WGM_MASK >> (k)) & 1) ? 4 : 8)
struct TabSched {
    const int* tab; int n;
    DEV bool next(int i, Unit& u) const {
        if (i >= n) return false;
        u.pm = UNIFORM_I(tab[5 * i]); u.pn = UNIFORM_I(tab[5 * i + 1]); u.e = UNIFORM_I(tab[5 * i + 2]); u.k0 = UNIFORM_I(tab[5 * i + 3]); u.po = UNIFORM_I(tab[5 * i + 4]);
        return true;
    }
};
constexpr int MAX_UNITS = 150;
template <class S> DEV TabSched build_units(unsigned* misc, int tid, const S& sch) {
    int* tab = (int*)(misc + 256);
    __syncthreads();
    if (tid < MAX_UNITS) { Unit u; if (sch.next(tid, u)) { tab[5 * tid] = u.pm; tab[5 * tid + 1] = u.pn; tab[5 * tid + 2] = u.e; tab[5 * tid + 3] = u.k0; tab[5 * tid + 4] = u.po; } }
    __syncthreads();
    const int nwg = sch.o.nwg, c = sch.o.c, G = sch.o.G;
    TabSched t; t.tab = tab; t.n = (c < nwg) ? (nwg - c + G - 1) / G : 0;
    return t;
}

#ifndef EMU
#define XB_TMO      128
#define XB_XCNT(j)  (256  + 64 * (j))
#define XB_XSUB(j)  (1280 + 64 * (j))
#define XB_XGEN(j)  (2304 + 64 * (j))
#define XB_TOP      3328
#define XB_TOPGEN   3392
#define XCD_BAR_WORDS 3456
#define XB_SPIN_CAP (1u << 22)
#define LAS __attribute__((address_space(3)))
__device__ __forceinline__ unsigned xb_ld(unsigned* p)              { return __hip_atomic_load(p, __ATOMIC_RELAXED, __HIP_MEMORY_SCOPE_AGENT); }
__device__ __forceinline__ unsigned xb_add(unsigned* p, unsigned v) { return __hip_atomic_fetch_add(p, v, __ATOMIC_RELAXED, __HIP_MEMORY_SCOPE_AGENT); }
__device__ __forceinline__ unsigned xb_xcc_id() { return (unsigned)__builtin_amdgcn_s_getreg((3 << 11) | 20) & 0xFu; }
#define XB_SPIN(cond, bar) do { unsigned _sp = 0; while (cond) { __builtin_amdgcn_s_sleep(1); \
    if ((++_sp & 255u) == 0u) { if (xb_ld(&(bar)[XB_TMO])) break; if (_sp > XB_SPIN_CAP) { atomicAdd(&(bar)[XB_TMO], 1u); break; } } } } while (0)
struct XcdBarrier { unsigned* bar; unsigned x; volatile LAS unsigned* st; };
__device__ __forceinline__ XcdBarrier xcd_barrier_post(unsigned* bar, volatile LAS unsigned* st) {
    XcdBarrier b; b.bar = bar; b.x = xb_xcc_id(); b.st = st;
    if (threadIdx.x == 0) (void)xb_add(&bar[XB_XCNT(b.x)], 1u);
    return b;
}
__device__ __forceinline__ void xcd_barrier_complete(unsigned* bar, unsigned x, unsigned& nloc, unsigned& nx) {
    const unsigned G = gridDim.x * gridDim.y * gridDim.z;
    unsigned sum, cnt, mine, sp = 0u;
    for (;;) {
        sum = 0u; cnt = 0u; mine = 0u;
#pragma unroll
        for (unsigned j = 0; j < 16; ++j) { const unsigned c = xb_ld(&bar[XB_XCNT(j)]); sum += c; cnt += (c > 0u) ? 1u : 0u; mine = (j == x) ? c : mine; }
        if (sum == G) break;
        __builtin_amdgcn_s_sleep(1);
        if ((++sp & 255u) == 0u) { if (xb_ld(&bar[XB_TMO])) break; if (sp > XB_SPIN_CAP) { atomicAdd(&bar[XB_TMO], 1u); break; } }
    }
    nloc = mine > 0u ? mine : 1u; nx = cnt > 0u ? cnt : 1u;
}
__device__ __forceinline__ void xcd_barrier(const XcdBarrier& b) {
    asm volatile("s_waitcnt vmcnt(0)" ::: "memory");
    __syncthreads();
    if (threadIdx.x == 0) {
        unsigned* bar = b.bar;
        __builtin_amdgcn_s_waitcnt(0);
        unsigned nloc = b.st[0], nx = b.st[1];
        if (nloc == 0u) { xcd_barrier_complete(bar, b.x, nloc, nx); b.st[0] = nloc; b.st[1] = nx; }
        const unsigned old = xb_add(&bar[XB_XSUB(b.x)], 1u);
        const unsigned gen = old / nloc;
        if (old + 1u == (gen + 1u) * nloc) {
            __builtin_amdgcn_fence(__ATOMIC_RELEASE, "agent");
            asm volatile("s_waitcnt vmcnt(0)" ::: "memory");
            const unsigned og = xb_add(&bar[XB_TOP], 1u);
            const unsigned tg = og / nx;
            if (og + 1u == (tg + 1u) * nx) xb_add(&bar[XB_TOPGEN], 1u);
            else XB_SPIN(xb_ld(&bar[XB_TOPGEN]) == tg, bar);
            __builtin_amdgcn_fence(__ATOMIC_ACQUIRE, "agent");
            xb_add(&bar[XB_XGEN(b.x)], 1u);
            asm volatile("s_waitcnt vmcnt(0)" ::: "memory");
        } else {
            XB_SPIN(xb_ld(&bar[XB_XGEN(b.x)]) == gen, bar);
            __builtin_amdgcn_fence(__ATOMIC_ACQUIRE, "agent");
            asm volatile("s_waitcnt vmcnt(0)" ::: "memory");
        }
    }
    __syncthreads();
}
#endif

struct Wg { int tid, lane, wave, G, wg, gw, NGW; unsigned char* lds; unsigned* misc; };
DEV int q_next(Wg& w, unsigned* ctr) {
    if (w.tid == 0) w.misc[2] = atomicAdd(ctr, 1u);
    __syncthreads();
    const int v = (int)w.misc[2];
    __syncthreads();
    return v;
}

struct ConvJob { const float* src; int K, N, Npad; bf16* dst; int ldk, kdst0, rowofs, mode; };
struct ConvTile { const float* src; int N, k0, n0; bf16* dst; int ldk, kdst0, rowofs, mode; bool valid; };
DEV bool conv_job_pick(const ConvJob& j, int& it, ConvTile& t) {
    const int nkb = j.K / 64, nnb = j.Npad / 128, tot = nkb * nnb;
    if (it >= tot) { it -= tot; return false; }
    t.src = j.src; t.N = j.N; t.k0 = (it / nnb) * 64; t.n0 = (it % nnb) * 128; t.dst = j.dst; t.ldk = j.ldk; t.kdst0 = j.kdst0; t.rowofs = j.rowofs; t.mode = j.mode; t.valid = true;
    return true;
}
DEV void conv_load(const ConvTile& t, f32x4 (&v)[4], int tid) {
#pragma unroll
    for (int i = 0; i < 4; ++i) { const int kk = i * 16 + (tid >> 5), c4 = tid & 31; v[i] = (t.valid && t.n0 + 4 * c4 < t.N) ? *(const f32x4*)(t.src + (size_t)(t.k0 + kk) * t.N + t.n0 + 4 * c4) : (f32x4){0.f, 0.f, 0.f, 0.f}; }
}
DEV void conv_store(const ConvTile& t, const f32x4 (&v)[4], float* scr, int tid) {
#pragma unroll
    for (int i = 0; i < 4; ++i) { const int kk = i * 16 + (tid >> 5), c4 = tid & 31; *(f32x4*)(scr + kk * 132 + 4 * c4) = v[i]; }
    __syncthreads();
#pragma unroll
    for (int i = 0; i < 2; ++i) { const int idx = tid + NTHR * i, n = idx >> 3, c = idx & 7, ng = t.n0 + n; const float* s = scr + (8 * c) * 132 + n;
      const int row = t.rowofs + (t.mode == 0 ? ng : (ng / 128) * 256 + (ng % 128) + (t.mode == 2 ? 128 : 0));
      u32x4 o; o.x = pk2(s[0], s[132]); o.y = pk2(s[2 * 132], s[3 * 132]); o.z = pk2(s[4 * 132], s[5 * 132]); o.w = pk2(s[6 * 132], s[7 * 132]);
      *(u32x4*)(t.dst + (size_t)row * t.ldk + t.kdst0 + t.k0 + 8 * c) = o; }
    __syncthreads();
}
DEV void zero_rect(bf16* dst, int ld, int r0, int r1, int c0, int c1, int gtid, int gn) {
    const int cw = (c1 - c0) / 8; const long tot = (long)(r1 - r0) * cw;
    for (long i = gtid; i < tot; i += gn) { const int r = r0 + (int)(i / cw), c = c0 + 8 * (int)(i % cw); *(u32x4*)(dst + (size_t)r * ld + c) = (u32x4){0u, 0u, 0u, 0u}; }
}
DEV void phase0(const P& p, Wg& w) {
    float* scr = (float*)w.lds;
    {
        bf16* WIN = (bf16*)(p.ws + WS_WIN_T); bf16* WOUT = (bf16*)(p.ws + WS_WOUT_T); bf16* MLT = (bf16*)(p.ws + WS_MLA_T);
#define JOB_WIN(l) ConvJob{p.w_in + (size_t)(l) * D_MODEL * IN_W, D_MODEL, IN_W, PROJ_W, WIN + (size_t)(l) * PROJ_W * D_MODEL, D_MODEL, 0, 0, 0}
#define JOB_WOUT(l) ConvJob{p.w_out + (size_t)(l) * MIXW * D_MODEL, MIXW, D_MODEL, D_MODEL, WOUT + (size_t)(l) * D_MODEL * MIXW, MIXW, 0, 0, 0}
#define JOB_WUQ(l) ConvJob{p.l_wuq + (size_t)(l) * 256 * 384, 256, 384, 384, MLT + (size_t)(l) * 1024 * 512, 512, 0, 0, 0}
#define JOB_WUKV(l) ConvJob{p.l_wukv + (size_t)(l) * 128 * 512, 128, 512, 512, MLT + (size_t)(l) * 1024 * 512, 512, 256, 512, 0}
        constexpr int total = 2 * ((D_MODEL / 64) * (PROJ_W / 128) + (MIXW / 64) * (D_MODEL / 128) + 4 * 3 + 2 * 4) + 2 * (D_MODEL / 64) * (D_FF / 128) + (D_FF / 64) * (D_MODEL / 128);
        ConvTile cur, nxt; f32x4 vc[4], vn[4]; cur.valid = false;
#define PICK0(it0_, T) do { int it = (it0_); T.valid = false; if ((it0_) < total) { \
            if (!conv_job_pick(JOB_WIN(0), it, T)) if (!conv_job_pick(JOB_WIN(1), it, T)) if (!conv_job_pick(JOB_WOUT(0), it, T)) if (!conv_job_pick(JOB_WOUT(1), it, T)) \
            if (!conv_job_pick(JOB_WUQ(0), it, T)) if (!conv_job_pick(JOB_WUQ(1), it, T)) if (!conv_job_pick(JOB_WUKV(0), it, T)) if (!conv_job_pick(JOB_WUKV(1), it, T)) \
            if (!conv_job_pick(ConvJob{p.ffn_wg, D_MODEL, D_FF, D_FF, (bf16*)(p.ws + WS_WGU_T), D_MODEL, 0, 0, 1}, it, T)) \
            if (!conv_job_pick(ConvJob{p.ffn_wu, D_MODEL, D_FF, D_FF, (bf16*)(p.ws + WS_WGU_T), D_MODEL, 0, 0, 2}, it, T)) \
            conv_job_pick(ConvJob{p.ffn_wd, D_FF, D_MODEL, D_MODEL, (bf16*)(p.ws + WS_WD_T), D_FF, 0, 0, 0}, it, T); } } while (0)
        PICK0(w.wg, cur); if (cur.valid) conv_load(cur, vc, w.tid);
        for (int it0 = w.wg; it0 < total; it0 += w.G) {
            PICK0(it0 + w.G, nxt); if (nxt.valid) conv_load(nxt, vn, w.tid);
            conv_store(cur, vc, scr, w.tid);
            cur = nxt;
#pragma unroll
            for (int i = 0; i < 4; ++i) vc[i] = vn[i];
        }
#undef PICK0
    }
    for (int l = 0; l < 2; ++l) { bf16* mt = (bf16*)(p.ws + WS_MLA_T) + (size_t)l * 1024 * 512; const int gt = w.wg * NTHR + w.tid, gn = w.G * NTHR;
        zero_rect(mt, 512, 384, 512, 0, 256, gt, gn); zero_rect(mt, 512, 512, 1024, 384, 512, gt, gn); }
    if (w.wg == w.G - 1) for (int i = w.tid; i < NPOS * 24; i += NTHR) { const int pos = i / 24, f = i % 24;
        const float inv = f < 16 ? exp2f(-(float)f * (13.287712379549449f / 16.0f)) : exp2f(-(float)(f - 16) * (13.287712379549449f / 8.0f));
        float sn, cs; sincosf((float)pos * inv, &sn, &cs); float* rt = (float*)(p.ws + WS_ROPE) + 2 * i; rt[0] = cs; rt[1] = sn; }
    {
        float* sS = (float*)w.lds;
        float* part = sS + NV * D_MODEL;
        const int nitem = 2 * (6 * D_MODEL / 64);
        bool loaded = false;
        for (int it = w.wg; it < nitem; it += w.G) {
            if (!loaded) { for (int i = w.tid; i < NV * D_MODEL; i += NTHR) { const int v = i / D_MODEL, k = i % D_MODEL; sS[i] = silu_f(v < BATCH ? p.c[v * D_MODEL + k] : p.c_ctx[k]); } loaded = true; __syncthreads(); }
            const int l = it / (6 * D_MODEL / 64), cb = it % (6 * D_MODEL / 64), col = cb * 64 + w.lane;
            float acc[NV];
#pragma unroll
            for (int v = 0; v < NV; ++v) acc[v] = 0.f;
            const float* mw = p.mod_w + (size_t)l * D_MODEL * 6 * D_MODEL + col;
            for (int k0 = w.wave * (D_MODEL / 8); k0 < (w.wave + 1) * (D_MODEL / 8); k0 += 16) { float wv[16];
#pragma unroll
                for (int kk = 0; kk < 16; ++kk) wv[kk] = mw[(size_t)(k0 + kk) * 6 * D_MODEL];
#pragma unroll
                for (int kk = 0; kk < 16; ++kk)
#pragma unroll
                    for (int v = 0; v < NV; ++v) acc[v] += sS[v * D_MODEL + k0 + kk] * wv[kk]; }
#pragma unroll
            for (int v = 0; v < NV; ++v) part[(w.wave * NV + v) * 64 + w.lane] = acc[v];
            __syncthreads();
            for (int i = w.tid; i < NV * 64; i += NTHR) { const int v = i / 64, cc = i % 64; float s = p.mod_b[(size_t)l * 6 * D_MODEL + cb * 64 + cc];
#pragma unroll
                for (int ww = 0; ww < 8; ++ww) s += part[(ww * NV + v) * 64 + cc];
                ((float*)(p.ws + WS_MODV))[(size_t)(l * NV + v) * 6 * D_MODEL + cb * 64 + cc] = s; }
            __syncthreads();
        }
    }
}
DEV void phase_moe_weights(const P& p, Wg& w) {
    float* scr = (float*)w.lds;
    const int t_gu = (D_MODEL / 64) * (D_FF / 128), t_d = (D_FF / 64) * (D_MODEL / 128), per_e = 2 * t_gu + t_d;
    ConvTile cur, nxt; f32x4 vc[4], vn[4];
#define PICKM(it0_, T) do { T.valid = false; if ((it0_) < NEXP * per_e) { const int e = (it0_) / per_e; int it = (it0_) % per_e; bf16* base = (bf16*)(p.ws + WS_MOEW + (size_t)e * MOEW_E); \
        if (!conv_job_pick(ConvJob{p.moe_wg + (size_t)e * D_MODEL * D_FF, D_MODEL, D_FF, D_FF, base, D_MODEL, 0, 0, 1}, it, T)) \
        if (!conv_job_pick(ConvJob{p.moe_wu + (size_t)e * D_MODEL * D_FF, D_MODEL, D_FF, D_FF, base, D_MODEL, 0, 0, 2}, it, T)) \
        conv_job_pick(ConvJob{p.moe_wd + (size_t)e * D_FF * D_MODEL, D_FF, D_MODEL, D_MODEL, base + (size_t)2 * D_FF * D_MODEL, D_FF, 0, 0, 0}, it, T); } } while (0)
    PICKM(w.wg, cur); if (cur.valid) conv_load(cur, vc, w.tid);
    for (int it0 = w.wg; it0 < NEXP * per_e; it0 += w.G) {
        PICKM(it0 + w.G, nxt); if (nxt.valid) conv_load(nxt, vn, w.tid);
        conv_store(cur, vc, scr, w.tid);
        cur = nxt;
#pragma unroll
        for (int i = 0; i < 4; ++i) vc[i] = vn[i];
    }
#undef PICKM
}

template <int NB> DEV void phase_modulate(const P& p, Wg& w, int l, int which, bool first, bool skip_ctx, bool moe, bool ctx_part) {
    constexpr int NJ = D_MODEL / 256;
    bf16* H = (bf16*)(p.ws + WS_H);
    const float* gn = (which ? p.norm_ffn : p.norm_mix) + (size_t)l * D_MODEL;
    int cnt[NEXP];
#pragma unroll
    for (int e = 0; e < NEXP; ++e) cnt[e] = 0;
    f32x4 rw[NJ * 4][2];
    if (moe) {
#pragma unroll
        for (int j = 0; j < NJ; ++j)
#pragma unroll
            for (int k = 0; k < 4; ++k) { const float* rr = p.moe_router + (size_t)(4 * w.lane + 256 * j + k) * NEXP; rw[4 * j + k][0] = *(const f32x4*)rr; rw[4 * j + k][1] = *(const f32x4*)(rr + 4); } }
    f32x4 gnv[NJ];
#pragma unroll
    for (int j = 0; j < NJ; ++j) gnv[j] = *(const f32x4*)(gn + 4 * w.lane + 256 * j);
    for (int Rb = w.gw; Rb < M_ALL; Rb += NB * w.NGW) {
        f32x4 vv[NB][NJ]; bool okr[NB];
#pragma unroll
        for (int qq = 0; qq < NB; ++qq) { const int R = Rb + qq * w.NGW; okr[qq] = R < M_ALL && !(skip_ctx && (R % TP) < CTX); const int Rr = okr[qq] ? R : Rb;
            const int b = Rr / TP, q = Rr % TP; const bf16* xr = resid_row(p, Rr);
            const float* src = q < CTX ? p.ctx + (size_t)(b * CTX + q) * D_MODEL : p.x + (size_t)(b * SEQ + q - CTX) * D_MODEL;
#pragma unroll
            for (int j = 0; j < NJ; ++j) { const int col = 4 * w.lane + 256 * j;
                if (first) vv[qq][j] = *(const f32x4*)(src + col);
                else { const u32x2 t = *(const u32x2*)(xr + col); vv[qq][j] = (f32x4){bf2f((bf16)t.x), bf2f((bf16)(t.x >> 16)), bf2f((bf16)t.y), bf2f((bf16)(t.y >> 16))}; } } }
#pragma unroll
        for (int qq = 0; qq < NB; ++qq) { if (!okr[qq]) continue;
        const int R = Rb + qq * w.NGW; const int b = R / TP, q = R % TP;
        bf16* xr = resid_row(p, R);
        f32x4 v[NJ]; float ss = 0.f;
#pragma unroll
        for (int j = 0; j < NJ; ++j) { v[j] = vv[qq][j]; ss += v[j][0] * v[j][0] + v[j][1] * v[j][1] + v[j][2] * v[j][2] + v[j][3] * v[j][3]; }
        if (ctx_part && q < CTX) {
            const bf16* cp = (const bf16*)(p.ws + WS_MLAQ) + (size_t)(b * CTX + q) * D_MODEL; const float* gf = (const float*)(p.ws + WS_MODV) + (size_t)((l - 1) * NV + BATCH) * 6 * D_MODEL + 5 * D_MODEL;
            ss = 0.f;
#pragma unroll
            for (int j = 0; j < NJ; ++j) { const int col = 4 * w.lane + 256 * j; f32x4 a = (f32x4){0.f, 0.f, 0.f, 0.f};
                for (int ks = 0; ks < NSPLIT; ++ks) { const u32x2 t = *(const u32x2*)(cp + (size_t)ks * BATCH * CTX * D_MODEL + col);
                    a[0] += bf2f((bf16)t.x); a[1] += bf2f((bf16)(t.x >> 16)); a[2] += bf2f((bf16)t.y); a[3] += bf2f((bf16)(t.y >> 16)); }
                const f32x4 g = *(const f32x4*)(gf + col); v[j] = v[j] + g * a; { u32x2 wb; wb.x = pk2(v[j][0], v[j][1]); wb.y = pk2(v[j][2], v[j][3]); *(u32x2*)(xr + col) = wb; }
                ss += v[j][0] * v[j][0] + v[j][1] * v[j][1] + v[j][2] * v[j][2] + v[j][3] * v[j][3]; } }
        ss = wave_sum(ss, w.lane);
        const float rstd = rsqrt_fast(ss * (1.0f / D_MODEL) + EPS);
        const float* mv = modv(p, l, R); const float* sh = mv + (which ? 3 : 0) * D_MODEL; const float* sc = mv + (which ? 4 : 1) * D_MODEL;
        float lg[NEXP];
#pragma unroll
        for (int e = 0; e < NEXP; ++e) lg[e] = 0.f;
#pragma unroll
        for (int j = 0; j < NJ; ++j) { const int col = 4 * w.lane + 256 * j;
            const f32x4 g = gnv[j], s1 = *(const f32x4*)(sc + col), s0 = *(const f32x4*)(sh + col);
            f32x4 h;
#pragma unroll
            for (int k = 0; k < 4; ++k) h[k] = v[j][k] * rstd * g[k] * (1.0f + s1[k]) + s0[k];
            u32x2 o; o.x = pk2(h[0], h[1]); o.y = pk2(h[2], h[3]);
            *(u32x2*)(H + (size_t)R * D_MODEL + col) = o;
            if (moe) {
#pragma unroll
                for (int k = 0; k < 4; ++k) {
#pragma unroll
                    for (int e = 0; e < NEXP; ++e) lg[e] += h[k] * rw[4 * j + k][e >> 2][e & 3]; } } }
        if (moe) {
#pragma unroll
            for (int e = 0; e < NEXP; ++e) lg[e] = wave_sum(lg[e], w.lane);
            int i1 = 0; float v1 = lg[0];
#pragma unroll
            for (int e = 1; e < NEXP; ++e) if (lg[e] > v1) { v1 = lg[e]; i1 = e; }
            int i2 = -1; float v2 = -3.0e38f;
#pragma unroll
            for (int e = 0; e < NEXP; ++e) if (e != i1 && lg[e] > v2) { v2 = lg[e]; i2 = e; }
            const float w1 = 1.0f / (1.0f + expf(v2 - v1)), w2 = 1.0f - w1;
            const int tok = b * SEQ + q - CTX;
            if (w.lane == 0) { int* ti = (int*)(p.ws + WS_TOPI) + 2 * tok; float* tw = (float*)(p.ws + WS_TOPW) + 2 * tok; ti[0] = i1; ti[1] = i2; tw[0] = w1; tw[1] = w2; }
#pragma unroll
            for (int e = 0; e < NEXP; ++e) cnt[e] += (e == i1 || e == i2) ? 1 : 0;
        }
        }
    }
    if (moe) {
        int* lc = (int*)w.lds;
        if (w.lane == 0) {
#pragma unroll
            for (int e = 0; e < NEXP; ++e) lc[w.wave * NEXP + e] = cnt[e]; }
        __syncthreads();
        if (w.tid < NEXP) { int s = 0; for (int ww = 0; ww < NWAVE; ++ww) s += lc[ww * NEXP + w.tid]; ((int*)(p.ws + WS_CNTG))[w.wg * NEXP + w.tid] = s; }
        __syncthreads();
    }
}

DEV void phase_prep(const P& p, Wg& w, int l) {
    bf16* PROJ = (bf16*)(p.ws + WS_PROJ); bf16* MQK = (bf16*)(p.ws + WS_MQK);
    const float* cw = p.m_conv + (size_t)l * 3 * 768;
    const int lane = w.lane;
    const float gkr = p.l_knorm[l * 96 + 64 + (lane & 31)];
    const f32x4 gcq = *(const f32x4*)(p.l_cq_norm + l * 256 + 4 * lane); const float gkv0 = p.l_ckv_norm[l * 128 + 2 * lane], gkv1 = p.l_ckv_norm[l * 128 + 2 * lane + 1];
    const int hq = lane >> 3, hi8 = lane & 7, hbase = (hq < 6 ? C_AQ + hq * 64 : C_AK + (hq - 6) * 64) + 8 * hi8;
    f32x4 cwv[3][3];
#pragma unroll
    for (int j = 0; j < 3; ++j)
#pragma unroll
        for (int tp = 0; tp < 3; ++tp) cwv[j][tp] = *(const f32x4*)(cw + tp * 768 + 4 * lane + 256 * j);
    float gh[8];
    { const float* gp = (hq < 6 ? p.a_qnorm : p.a_knorm) + l * 64 + 8 * hi8;
#pragma unroll
      for (int j = 0; j < 8; ++j) gh[j] = gp[j] * (hq < 6 ? QSCALE_A : 1.0f); }
    const float* rtab = (const float*)(p.ws + WS_ROPE);
    constexpr int NB = 4;
    const int RPW = (M_ALL + w.NGW - 1) / w.NGW, Rend = ((w.gw + 1) * RPW < M_ALL) ? (w.gw + 1) * RPW : M_ALL;
    for (int R0 = w.gw * RPW; R0 < Rend; R0 += NB) {
        u32x2 c0[NB][3], cp[NB][3], cn[NB][3], cprev[3], cnext[3]; u32x4 hraw[NB]; u32x2 cqv[NB]; unsigned ckvv[NB]; bf16 krv[NB]; bool ok[NB];
        { const bool hpv = R0 > 0, hnv = R0 + NB < M_ALL;
#pragma unroll
          for (int j = 0; j < 3; ++j) { const int col = 4 * lane + 256 * j;
              cprev[j] = hpv ? *(const u32x2*)(PROJ + (size_t)(R0 - 1) * PROJ_W + col) : (u32x2){0u, 0u}; cnext[j] = hnv ? *(const u32x2*)(PROJ + (size_t)(R0 + NB) * PROJ_W + col) : (u32x2){0u, 0u}; } }
#pragma unroll
        for (int q = 0; q < NB; ++q) { const int R = R0 + q; ok[q] = R < Rend; const int Rr = R < M_ALL ? R : R0;
            const bf16* pr = PROJ + (size_t)Rr * PROJ_W;
#pragma unroll
            for (int j = 0; j < 3; ++j) c0[q][j] = *(const u32x2*)(pr + 4 * lane + 256 * j);
            hraw[q] = *(const u32x4*)(pr + hbase); cqv[q] = *(const u32x2*)(pr + C_CQ + 4 * lane); ckvv[q] = *(const unsigned*)(pr + C_CKV + 2 * lane); krv[q] = pr[C_KR + (lane & 31)]; }
#pragma unroll
        for (int q = 0; q < NB; ++q) { const int qq = (R0 + q) % TP; const bool hp = !(qq == 0 || qq == CTX), hn = !(qq == CTX - 1 || qq == TP - 1);
#pragma unroll
            for (int j = 0; j < 3; ++j) { const u32x2 a = (q == 0) ? cprev[j] : c0[q > 0 ? q - 1 : 0][j], n = (q == NB - 1) ? cnext[j] : c0[q < NB - 1 ? q + 1 : 0][j];
                cp[q][j] = hp ? a : (u32x2){0u, 0u}; cn[q][j] = hn ? n : (u32x2){0u, 0u}; } }
#pragma unroll
        for (int q = 0; q < NB; ++q) { const int Rr = (R0 + q < M_ALL) ? R0 + q : R0; const int qq = Rr % TP; const bool lat = qq >= CTX; const int t = qq - CTX;
            bf16* pr = PROJ + (size_t)Rr * PROJ_W;
            u32x2 ov[3];
#pragma unroll
            for (int j = 0; j < 3; ++j) { const int col = 4 * lane + 256 * j; float o[4];
#pragma unroll
                for (int k = 0; k < 4; ++k) { const unsigned sh = (k & 1) * 16; const unsigned a = (k < 2 ? cp[q][j].x : cp[q][j].y) >> sh, c = (k < 2 ? c0[q][j].x : c0[q][j].y) >> sh, n = (k < 2 ? cn[q][j].x : cn[q][j].y) >> sh;
                    const float sv = bf2f((bf16)a) * cwv[j][0][k] + bf2f((bf16)c) * cwv[j][1][k] + bf2f((bf16)n) * cwv[j][2][k]; o[k] = silu_fast(sv) * (col >= 384 ? KSCALE_M : 1.0f); }
                ov[j].x = pk2(o[0], o[1]); ov[j].y = pk2(o[2], o[3]); }
            u32x4 oh;
            { float x[8], ss = 0.f;
#pragma unroll
              for (int j = 0; j < 8; ++j) { x[j] = bf2f((bf16)(hraw[q][j >> 1] >> ((j & 1) * 16))); ss += x[j] * x[j]; }
              ss += SHX(ss, 1, lane); ss += SHX(ss, 2, lane); ss += SHX(ss, 4, lane);
              const float rs = rsqrt_fast(ss * (1.0f / 64.0f) + EPS);
#pragma unroll
              for (int j = 0; j < 8; ++j) x[j] *= rs * gh[j];
              const float* ct = rtab + ((size_t)(lat ? (hi8 < 4 ? t / GRID_W : t % GRID_W) : 0) * 24 + 8 * (hi8 & 1)) * 2;
              const f32x4 t0 = *(const f32x4*)ct, t1 = *(const f32x4*)(ct + 4), t2 = *(const f32x4*)(ct + 8), t3 = *(const f32x4*)(ct + 12);
              const float csv[8] = {t0[0], t0[2], t1[0], t1[2], t2[0], t2[2], t3[0], t3[2]}, snv[8] = {t0[1], t0[3], t1[1], t1[3], t2[1], t2[3], t3[1], t3[3]};
#pragma unroll
              for (int j = 0; j < 8; ++j) { const float pt = SHX(x[j], 2, lane);
                  if (lat) x[j] = (hi8 & 2) ? x[j] * csv[j] + pt * snv[j] : x[j] * csv[j] - pt * snv[j]; }
              oh.x = pk2(x[0], x[1]); oh.y = pk2(x[2], x[3]); oh.z = pk2(x[4], x[5]); oh.w = pk2(x[6], x[7]); }
            float csL = 1.f, snL = 0.f;
            if (lat) { const int d = lane & 31; const float* ct = rtab + ((size_t)(d < 16 ? t / GRID_W : t % GRID_W) * 24 + 16 + (d & 7)) * 2; csL = ct[0]; snL = ct[1]; }
            u32x2 ocq; unsigned ockv; float ykr;
            { float x[4] = {bf2f((bf16)cqv[q].x), bf2f((bf16)(cqv[q].x >> 16)), bf2f((bf16)cqv[q].y), bf2f((bf16)(cqv[q].y >> 16))};
              const float x0 = bf2f((bf16)ckvv[q]), x1 = bf2f((bf16)(ckvv[q] >> 16)); const float vk = lane < 32 ? bf2f(krv[q]) : 0.f;
              float s1 = x[0] * x[0] + x[1] * x[1] + x[2] * x[2] + x[3] * x[3], s2 = x0 * x0 + x1 * x1, s3 = vk * vk;
#pragma unroll
              for (int o = 1; o < 64; o <<= 1) { s1 += SHX(s1, o, lane); s2 += SHX(s2, o, lane); s3 += SHX(s3, o, lane); }
              const float r1 = rsqrt_fast(s1 * (1.0f / 256.0f) + EPS), r2 = rsqrt_fast(s2 * (1.0f / 128.0f) + EPS), r3 = rsqrt_fast(s3 * (1.0f / 32.0f) + EPS);
              ocq.x = pk2(x[0] * r1 * gcq[0], x[1] * r1 * gcq[1]); ocq.y = pk2(x[2] * r1 * gcq[2], x[3] * r1 * gcq[3]);
              ockv = pk2(x0 * r2 * gkv0, x1 * r2 * gkv1);
              float y = vk * r3 * gkr; const float pt = SHX(y, 8, lane);
              if (lat) y = (lane & 8) ? y * csL + pt * snL : y * csL - pt * snL;
              ykr = y; }
            if (ok[q]) {
#pragma unroll
                for (int j = 0; j < 3; ++j) *(u32x2*)(MQK + (size_t)Rr * 768 + 4 * lane + 256 * j) = ov[j];
                *(u32x4*)(pr + hbase) = oh;
                *(u32x2*)(pr + C_CQ + 4 * lane) = ocq; *(unsigned*)(pr + C_CKV + 2 * lane) = ockv;
                if (lane < 32) pr[C_KR + lane] = f2bf(ykr); }
        }
    }
}

DEV float scan_add(float v, int lane) {
#pragma unroll
    for (int d = 1; d < 64; d <<= 1) { const float t = __shfl(v, lane >= d ? lane - d : lane); if (lane >= d) v += t; }
    return v;
}
DEV float scan_max(float v, int lane) {
#pragma unroll
    for (int d = 1; d < 64; d <<= 1) { const float t = __shfl(v, lane >= d ? lane - d : lane); if (lane >= d) v = fmaxf(v, t); }
    return v;
}
DEV int chain_step(int dir, int cl) { return dir == 0 ? cl : (cl < NC_CTX ? NC_CTX - 1 - cl : NCH + NC_CTX - 1 - cl); }
DEV void gate_scan2(const P& p, int l, int R0, int hh, int dir, int lane, float* al, float* pm, float* bcl, float& F, float& pml) {
    static_assert(MCH == 128, "two positions per lane");
    const float* gb = p.m_gate_b + l * 16; float bc[2], a[2], px[2];
    float carry = 0.f, pcar = -3.0e38f;
#pragma unroll
    for (int hf = 0; hf < 2; ++hf) { const int j = lane + 64 * hf, o = dir ? MCH - 1 - j : j;
        const float* G = (const float*)(p.ws + WS_GATES) + (size_t)(R0 + o) * 16;
        const float gi = G[dir * 8 + hh] + gb[dir * 8 + hh], gf = G[dir * 8 + 4 + hh] + gb[dir * 8 + 4 + hh];
        bc[hf] = scan_add(log_sigmoid_f(gf), lane) + carry; a[hf] = gi - bc[hf]; px[hf] = fmaxf(scan_max(a[hf], lane), pcar);
        carry = __shfl(bc[hf], 63); pcar = __shfl(px[hf], 63);
        al[o] = a[hf]; pm[o] = px[hf]; bcl[o] = bc[hf]; }
    F = carry; pml = pcar;
}
DEV void ml1_item(const P& p, Wg& w, int l, int item) {
    const int b = item / (4 * NCH), hh = (item / NCH) % 4, cl = item % NCH, R0 = b * TP + cl * MCH;
    float* wgt = (float*)w.lds;
    float* scr = wgt + 2 * MCH;
    bf16* Ks = (bf16*)(w.lds + 4096);
    bf16* Vw = Ks + MCH * 104;
    const bf16* MQK = (const bf16*)(p.ws + WS_MQK); const bf16* PROJ = (const bf16*)(p.ws + WS_PROJ);
    bf16* UC = (bf16*)(p.ws + WS_UC); float* NL = (float*)(p.ws + WS_NL);
    const int lane = w.lane, r = lane & 31, h = lane >> 5;
    if (w.wave < 2) { const int dir = w.wave; float F, pml; float* sc = scr + dir * 3 * MCH;
        gate_scan2(p, l, R0, hh, dir, lane, sc, sc + MCH, sc + 2 * MCH, F, pml);
        wave_sync();
#pragma unroll
        for (int hf = 0; hf < 2; ++hf) wgt[dir * MCH + lane + 64 * hf] = __expf(sc[lane + 64 * hf] - pml);
        const int ci = ((b * 4 + hh) * 2 + dir) * NCH + chain_step(dir, cl);
        if (lane == 0) { ((float*)(p.ws + WS_FS))[ci] = F; ((float*)(p.ws + WS_PML))[ci] = pml; } }
    __syncthreads();
    for (int idx = w.tid; idx < MCH * 12; idx += NTHR) { const int s = idx / 12, c = idx % 12;
        const u32x4 kr = *(const u32x4*)(MQK + (size_t)(R0 + s) * 768 + 384 + hh * 96 + 8 * c), vr = *(const u32x4*)(PROJ + (size_t)(R0 + s) * PROJ_W + C_MV + hh * 96 + 8 * c);
        *(u32x4*)(Ks + s * 104 + 8 * c) = kr;
#pragma unroll
        for (int dir = 0; dir < 2; ++dir) { const float wd = wgt[dir * MCH + s]; u32x4 o;
            o.x = pk2(wd * bf2f((bf16)vr.x), wd * bf2f((bf16)(vr.x >> 16))); o.y = pk2(wd * bf2f((bf16)vr.y), wd * bf2f((bf16)(vr.y >> 16)));
            o.z = pk2(wd * bf2f((bf16)vr.z), wd * bf2f((bf16)(vr.z >> 16))); o.w = pk2(wd * bf2f((bf16)vr.w), wd * bf2f((bf16)(vr.w >> 16)));
            *(u32x4*)(Vw + (dir * MCH + s) * 104 + 8 * c) = o;
            if (c == 0) Vw[(dir * MCH + s) * 104 + 96] = f2bf(wd); } }
    __syncthreads();
    const int toff = (8 * h + ((lane & 15) >> 2)) * 104 + 16 * ((lane >> 4) & 1) + 4 * (lane & 3);
    for (int task = w.wave; task < 24; task += NWAVE) {
        const bool nt = task >= 18; const int tt = nt ? task - 18 : task;
        const int dir = nt ? tt / 3 : tt / 9, dt = nt ? tt % 3 : (tt % 9) / 3, et = nt ? 3 : tt % 3;
        f32x16 acc;
#pragma unroll
        for (int i = 0; i < 16; ++i) acc[i] = 0.f;
#pragma unroll
        for (int ks = 0; ks < MCH / 16; ++ks) { const bf16* ap = Ks + (16 * ks) * 104 + 32 * dt + toff; const bf16* bp = Vw + (dir * MCH + 16 * ks) * 104 + 32 * et + toff;
            const s16x4 al = lds_tr_read(ap), ah = lds_tr_read(ap + 4 * 104), bl = lds_tr_read(bp), bh = lds_tr_read(bp + 4 * 104);
            const bf16x8 af = (bf16x8){al[0], al[1], al[2], al[3], ah[0], ah[1], ah[2], ah[3]}, bfr = (bf16x8){bl[0], bl[1], bl[2], bl[3], bh[0], bh[1], bh[2], bh[3]};
            acc = mfma32(af, bfr, acc); }
        const int ci = ((b * 4 + hh) * 2 + dir) * NCH + chain_step(dir, cl);
        if (!nt) { bf16* up = UC + (size_t)ci * 9216 + (32 * et + r) * 96 + 32 * dt + 4 * h;
#pragma unroll
            for (int g = 0; g < 4; ++g) { u32x2 o; o.x = pk2(acc[4 * g], acc[4 * g + 1]); o.y = pk2(acc[4 * g + 2], acc[4 * g + 3]); *(u32x2*)(up + 8 * g) = o; } }
        else if (r == 0) { float* np = NL + (size_t)ci * 96 + 32 * dt + 4 * h;
#pragma unroll
            for (int g = 0; g < 4; ++g) *(f32x4*)(np + 8 * g) = (f32x4){acc[4 * g], acc[4 * g + 1], acc[4 * g + 2], acc[4 * g + 3]}; } }
    __syncthreads();
}
DEV void phase_ml2(const P& p, Wg& w) {
    constexpr int GPC = 1152 + 12;
    bf16* UC = (bf16*)(p.ws + WS_UC); float* NL = (float*)(p.ws + WS_NL);
    const float* FS = (const float*)(p.ws + WS_FS); const float* PML = (const float*)(p.ws + WS_PML); float* MST = (float*)(p.ws + WS_MST);
    for (int j = w.wg * NTHR + w.tid; j < NCHAIN * GPC; j += w.G * NTHR) {
        const int chain = j / GPC, g = j % GPC;
        float C[8], m = 0.f;
#pragma unroll
        for (int i = 0; i < 8; ++i) C[i] = 0.f;
        for (int k0 = 0; k0 < NCH; k0 += ML2_U) {
            float Fv[ML2_U], pv[ML2_U];
#pragma unroll
            for (int q = 0; q < ML2_U; ++q) { Fv[q] = FS[chain * NCH + k0 + q]; pv[q] = PML[chain * NCH + k0 + q]; }
            if (g < 1152) { u32x4 raw[ML2_U];
#pragma unroll
                for (int q = 0; q < ML2_U; ++q) raw[q] = *(const u32x4*)(UC + (size_t)(chain * NCH + k0 + q) * 9216 + 8 * g);
#pragma unroll
                for (int q = 0; q < ML2_U; ++q) { const int ci = chain * NCH + k0 + q; const float mx = fmaxf(m, pv[q]), dec = __expf(m - mx), sc = __expf(pv[q] - mx);
                    u32x4 st; st.x = pk2(C[0], C[1]); st.y = pk2(C[2], C[3]); st.z = pk2(C[4], C[5]); st.w = pk2(C[6], C[7]); *(u32x4*)(UC + (size_t)ci * 9216 + 8 * g) = st;
#pragma unroll
                    for (int i = 0; i < 8; ++i) C[i] = dec * C[i] + sc * bf2f((bf16)(raw[q][i >> 1] >> ((i & 1) * 16)));
                    if (g == 0) MST[ci] = m;
                    m = Fv[q] + mx; } }
            else {
                for (int q = 0; q < ML2_U; ++q) { float* nl = NL + (size_t)(chain * NCH + k0 + q) * 96 + 8 * (g - 1152); const f32x4 r0 = *(const f32x4*)nl, r1 = *(const f32x4*)(nl + 4);
                    const float mx = fmaxf(m, pv[q]), dec = __expf(m - mx), sc = __expf(pv[q] - mx);
                    *(f32x4*)nl = (f32x4){C[0], C[1], C[2], C[3]}; *(f32x4*)(nl + 4) = (f32x4){C[4], C[5], C[6], C[7]};
#pragma unroll
                    for (int i = 0; i < 4; ++i) { C[i] = dec * C[i] + sc * r0[i]; C[4 + i] = dec * C[4 + i] + sc * r1[i]; }
                    m = Fv[q] + mx; } }
        }
    }
}
DEV void ml3_item(const P& p, Wg& w, int l, int item) {
    const int lane = w.lane, r = lane & 31, h = lane >> 5, dir = w.wave >> 2, tq = w.wave & 3;
    const int b = item / (4 * NCH), hh = (item / NCH) % 4, cl = item % NCH, R0 = b * TP + cl * MCH;
    const int ci = ((b * 4 + hh) * 2 + dir) * NCH + chain_step(dir, cl);
    bf16* Qs = (bf16*)w.lds;
    bf16* Ksm = Qs + MCH * 104;
    bf16* Vs = Ksm + MCH * 104;
    float* nls = (float*)(w.lds + 3 * MCH * 104 * 2);
    float* scn = nls + 192;
    float* hx = (float*)w.lds;
    const bf16* MQK = (const bf16*)(p.ws + WS_MQK); const bf16* PROJ = (const bf16*)(p.ws + WS_PROJ);
    const bf16* UCi = (const bf16*)(p.ws + WS_UC) + (size_t)ci * 9216;
    for (int idx = w.tid; idx < MCH * 12; idx += NTHR) { const int s = idx / 12, c = idx % 12;
        const u32x4 qv = *(const u32x4*)(MQK + (size_t)(R0 + s) * 768 + hh * 96 + 8 * c), kv = *(const u32x4*)(MQK + (size_t)(R0 + s) * 768 + 384 + hh * 96 + 8 * c),
                    vv = *(const u32x4*)(PROJ + (size_t)(R0 + s) * PROJ_W + C_MV + hh * 96 + 8 * c);
        *(u32x4*)(Qs + s * 104 + 8 * c) = qv; *(u32x4*)(Ksm + s * 104 + 8 * c) = kv; *(u32x4*)(Vs + s * 104 + 8 * c) = vv; }
    if (w.tid < 192) { const int dd = w.tid / 96; nls[w.tid] = ((const float*)(p.ws + WS_NL))[(size_t)(((b * 4 + hh) * 2 + dd) * NCH + chain_step(dd, cl)) * 96 + w.tid % 96]; }
    if (tq == 0) { float F, pml; float* sc = scn + dir * 3 * MCH; gate_scan2(p, l, R0, hh, dir, lane, sc, sc + MCH, sc + 2 * MCH, F, pml); }
    const float m_st = ((const float*)(p.ws + WS_MST))[ci];
    __syncthreads();
    const float* al = scn + dir * 3 * MCH; const float* pmv = al + MCH; const float* bcl = al + 2 * MCH;
    const int t = 32 * tq + r;
    const float mx_t = fmaxf(m_st, pmv[t]), bc_t = bcl[t];
    bf16x8 qf[6]; float qn = 0.f;
#pragma unroll
    for (int ks = 0; ks < 6; ++ks) { qf[ks] = *(const bf16x8*)(Qs + t * 104 + 16 * ks + 8 * h);
        const f32x4 n0 = *(const f32x4*)(nls + dir * 96 + 16 * ks + 8 * h), n1 = *(const f32x4*)(nls + dir * 96 + 16 * ks + 8 * h + 4);
#pragma unroll
        for (int j = 0; j < 4; ++j) { qn += bf2f((bf16)qf[ks][j]) * n0[j]; qn += bf2f((bf16)qf[ks][4 + j]) * n1[j]; } }
    qn += SHX(qn, 32, lane);
    f32x16 o[3]; float rs = 0.f;
#pragma unroll
    for (int et = 0; et < 3; ++et)
#pragma unroll
        for (int i = 0; i < 16; ++i) o[et][i] = 0.f;
    for (int kb = dir ? tq : 0; kb < (dir ? NQB : tq + 1); ++kb) {
        f32x16 pw;
#pragma unroll
        for (int i = 0; i < 16; ++i) pw[i] = 0.f;
#pragma unroll
        for (int ks = 0; ks < 6; ++ks) { const bf16x8 kf = *(const bf16x8*)(Ksm + (32 * kb + r) * 104 + 16 * ks + 8 * h); pw = mfma32(kf, qf[ks], pw); }
#pragma unroll
        for (int g = 0; g < 4; ++g) { const int s0 = 32 * kb + 8 * g + 4 * h; const f32x4 av = *(const f32x4*)(al + s0);
#pragma unroll
            for (int j = 0; j < 4; ++j) { const int sidx = s0 + j; const bool okk = dir ? (sidx >= t) : (sidx <= t);
                const float wv = okk ? __expf(av[j] - mx_t) * pw[4 * g + j] : 0.f; pw[4 * g + j] = wv; rs += wv; } }
        bf16x8 pb[2];
#pragma unroll
        for (int sp = 0; sp < 2; ++sp) { u32x4 u; u.x = pk2(pw[8 * sp], pw[8 * sp + 1]); u.y = pk2(pw[8 * sp + 2], pw[8 * sp + 3]); u.z = pk2(pw[8 * sp + 4], pw[8 * sp + 5]); u.w = pk2(pw[8 * sp + 6], pw[8 * sp + 7]);
            pb[sp] = __builtin_bit_cast(bf16x8, u); }
#pragma unroll
        for (int et = 0; et < 3; ++et)
#pragma unroll
            for (int sp = 0; sp < 2; ++sp) { const bf16* vp = Vs + (32 * kb + 16 * sp + 4 * h + ((lane & 15) >> 2)) * 104 + 32 * et + 16 * ((lane >> 4) & 1) + 4 * (lane & 3);
                const s16x4 lo = lds_tr_read(vp), hi = lds_tr_read(vp + 8 * 104);
                const bf16x8 vf = (bf16x8){lo[0], lo[1], lo[2], lo[3], hi[0], hi[1], hi[2], hi[3]};
                o[et] = mfma32(vf, pb[sp], o[et]); }
    }
    rs += SHX(rs, 32, lane);
    const float a_int = __expf(m_st - mx_t), den = a_int * qn + rs, inv = 1.0f / fmaxf(fabsf(den), __expf(-(bc_t + mx_t)));
#pragma unroll
    for (int et = 0; et < 3; ++et) { f32x16 oi;
#pragma unroll
        for (int i = 0; i < 16; ++i) oi[i] = 0.f;
#pragma unroll
        for (int ks = 0; ks < 6; ++ks) { const bf16x8 cf = *(const bf16x8*)(UCi + (32 * et + r) * 96 + 16 * ks + 8 * h); oi = mfma32(cf, qf[ks], oi); }
#pragma unroll
        for (int i = 0; i < 16; ++i) o[et][i] = (a_int * oi[i] + o[et][i]) * inv; }
    __syncthreads();
    if (dir == 1) {
#pragma unroll
        for (int et = 0; et < 3; ++et)
#pragma unroll
            for (int i = 0; i < 16; ++i) hx[t * 97 + 32 * et + crow(i, h)] = o[et][i]; }
    __syncthreads();
    if (dir == 0) { float ss = 0.f;
#pragma unroll
        for (int et = 0; et < 3; ++et)
#pragma unroll
            for (int i = 0; i < 16; ++i) { o[et][i] += hx[t * 97 + 32 * et + crow(i, h)]; ss += o[et][i] * o[et][i]; }
        ss += SHX(ss, 32, lane);
        const float rstd = rsqrt_fast(ss * (1.0f / 96.0f) + EPS);
        bf16* MIX = (bf16*)(p.ws + WS_H);
#pragma unroll
        for (int et = 0; et < 3; ++et)
#pragma unroll
            for (int g = 0; g < 4; ++g) { const int e = 32 * et + 8 * g + 4 * h;
                const u32x2 og = *(const u32x2*)(PROJ + (size_t)(R0 + t) * PROJ_W + C_MO + hh * 96 + e); const f32x4 mn = *(const f32x4*)(p.m_norm + l * 384 + hh * 96 + e);
                float o4[4];
#pragma unroll
                for (int j = 0; j < 4; ++j) { const float gate = bf2f((bf16)((j < 2 ? og.x : og.y) >> ((j & 1) * 16))); o4[j] = o[et][4 * g + j] * rstd * mn[j] * sigmoid_f(gate); }
                u32x2 ov; ov.x = pk2(o4[0], o4[1]); ov.y = pk2(o4[2], o4[3]);
                *(u32x2*)(MIX + (size_t)(R0 + t) * MIXW + hh * 96 + e) = ov; } }
    __syncthreads();
}

DEV void phase_mla_post(const P& p, Wg& w, int l) {
    bf16* MLAQ = (bf16*)(p.ws + WS_MLAQ); const bf16* PROJ = (const bf16*)(p.ws + WS_PROJ);
    const int lane = w.lane;
    int baseA = 0, nA = 8, dstA = 8 * lane; bool normA = true, ropeA = false; const float* gA = p.l_qnorm + l * 96;
    if (lane < 48) { const int hh = lane / 12, o = lane % 12;
        if (o < 8) { baseA = 12 * hh; nA = 8; gA = p.l_qnorm + l * 96 + 8 * o; }
        else { baseA = 12 * hh + 8; nA = 4; gA = p.l_qnorm + l * 96 + 64 + 8 * (o - 8); ropeA = true; } }
    else { normA = false; }
    const int hb = lane / 16, ob = lane % 16; const bool normB = ob < 8;
    const int baseB = (16 * (lane / 16)) & 63;
    const int dstB = normB ? 384 + 96 * hb + 8 * ob : 768 + 64 * hb + 8 * (ob - 8);
    const float* gB = p.l_knorm + l * 96 + 8 * (ob & 7);
    float gAv[8], gBv[8];
#pragma unroll
    for (int j = 0; j < 8; ++j) { gAv[j] = gA[j]; gBv[j] = gB[j]; }
    const int cidx = (lane % 12) - 8;
    constexpr int NB = 2;
    for (int R0 = w.gw; R0 < M_ALL; R0 += NB * w.NGW) {
        u32x4 ra[NB], rb[NB], kr[NB]; bool ok[NB];
#pragma unroll
        for (int q = 0; q < NB; ++q) { const int R = R0 + q * w.NGW; ok[q] = R < M_ALL; const int Rr = ok[q] ? R : R0; const bf16* row = MLAQ + (size_t)Rr * 1024;
            ra[q] = *(const u32x4*)(row + 8 * lane); rb[q] = *(const u32x4*)(row + 512 + 8 * lane);
            kr[q] = (lane >= 48) ? *(const u32x4*)(PROJ + (size_t)Rr * PROJ_W + C_KR + 8 * ((lane - 48) & 3)) : (u32x4){0u, 0u, 0u, 0u}; }
        u32x4 oa[NB], obv[NB];
#pragma unroll
        for (int q = 0; q < NB; ++q) { const int Rr = ok[q] ? R0 + q * w.NGW : R0; const int qq = Rr % TP; const bool lat = qq >= CTX; const int t = qq - CTX;
            float xa[8], xb[8], ssA = 0.f, ssB = 0.f;
#pragma unroll
            for (int j = 0; j < 8; ++j) { xa[j] = bf2f((bf16)(ra[q][j >> 1] >> ((j & 1) * 16))); xb[j] = bf2f((bf16)(rb[q][j >> 1] >> ((j & 1) * 16))); ssA += xa[j] * xa[j]; ssB += xb[j] * xb[j]; }
            float sA = 0.f, sB = 0.f;
#pragma unroll
            for (int i = 0; i < 8; ++i) { const float v = __shfl(ssA, (baseA + i) & 63); if (i < nA) sA += v; sB += __shfl(ssB, (baseB + i) & 63); }
            const float rsA = normA ? rsqrt_fast(sA / (float)(8 * nA) + EPS) : 1.0f, rsB = normB ? rsqrt_fast(sB * (1.0f / 64.0f) + EPS) : 1.0f;
#pragma unroll
            for (int j = 0; j < 8; ++j) { xa[j] = normA ? xa[j] * rsA * gAv[j] : xa[j]; xb[j] = normB ? xb[j] * rsB * gBv[j] : xb[j]; }
            const float* ct = (const float*)(p.ws + WS_ROPE) + ((size_t)(lat ? ((cidx & 3) < 2 ? t / GRID_W : t % GRID_W) : 0) * 24 + 16) * 2;
            const f32x4 t0 = *(const f32x4*)ct, t1 = *(const f32x4*)(ct + 4), t2 = *(const f32x4*)(ct + 8), t3 = *(const f32x4*)(ct + 12);
            const float csv[8] = {t0[0], t0[2], t1[0], t1[2], t2[0], t2[2], t3[0], t3[2]}, snv[8] = {t0[1], t0[3], t1[1], t1[3], t2[1], t2[3], t3[1], t3[3]};
#pragma unroll
            for (int j = 0; j < 8; ++j) { const float pt = SHX(xa[j], 1, lane);
                if (ropeA && lat) xa[j] = (cidx & 1) ? xa[j] * csv[j] + pt * snv[j] : xa[j] * csv[j] - pt * snv[j]; }
            if (lane < 48) {
#pragma unroll
                for (int j = 0; j < 8; ++j) xa[j] *= QSCALE_L; }
            oa[q].x = pk2(xa[0], xa[1]); oa[q].y = pk2(xa[2], xa[3]); oa[q].z = pk2(xa[4], xa[5]); oa[q].w = pk2(xa[6], xa[7]);
            obv[q].x = pk2(xb[0], xb[1]); obv[q].y = pk2(xb[2], xb[3]); obv[q].z = pk2(xb[4], xb[5]); obv[q].w = pk2(xb[6], xb[7]); }
        wave_sync();
#pragma unroll
        for (int q = 0; q < NB; ++q) if (ok[q]) { bf16* row = MLAQ + (size_t)(R0 + q * w.NGW) * 1024;
            if (lane < 48) *(u32x4*)(row + dstA) = oa[q];
            else { const int i = lane - 48; *(u32x4*)(row + 384 + 96 * (i >> 2) + 64 + 8 * (i & 3)) = kr[q]; }
            *(u32x4*)(row + dstB) = obv[q]; }
        wave_sync();
    }
}

template <int DQK>
DEV void attn_unit(const bf16* Q, int ldq, const bf16* K, int ldk, const bf16* V, int ldv, bf16* O, int ldo, int nkeys, Wg& w) {
    constexpr int KS = DQK + 8, NKD = DQK / 16, CPR = DQK / 8, NKC = 64 * CPR, VS = 72;
    bf16* Ks = (bf16*)w.lds;
    bf16* Vs = (bf16*)(w.lds + 2 * 64 * KS * 2);
    const int tid = w.tid, lane = w.lane, r = lane & 31, h = lane >> 5;
    bf16x8 qr[NKD];
    { const bf16* qp = Q + (size_t)(w.wave * 32 + r) * ldq + 8 * h;
#pragma unroll
      for (int d0 = 0; d0 < NKD; ++d0) qr[d0] = *(const bf16x8*)(qp + 16 * d0); }
    const int kr0 = tid / CPR, kc0 = tid % CPR, kr1 = (tid + NTHR) / CPR, kc1 = (tid + NTHR) % CPR; const bool k1 = (tid + NTHR) < NKC;
    const int vr = tid >> 3, vc = tid & 7;
    u32x4 rk0, rk1 = (u32x4){0u, 0u, 0u, 0u}, rv;
    const int NT = nkeys / 64;
    const int vtr_off = (4 * h + ((lane & 15) >> 2)) * VS + 16 * ((lane >> 4) & 1) + 4 * (lane & 3);
#define AT_LOAD(kt) do { rk0 = *(const u32x4*)(K + (size_t)((kt) * 64 + kr0) * ldk + 8 * kc0); if (k1) rk1 = *(const u32x4*)(K + (size_t)((kt) * 64 + kr1) * ldk + 8 * kc1); \
        rv = *(const u32x4*)(V + (size_t)((kt) * 64 + vr) * ldv + 8 * vc); } while (0)
#define AT_STORE(buf) do { *(u32x4*)(Ks + ((buf) * 64 + kr0) * KS + 8 * kc0) = rk0; if (k1) *(u32x4*)(Ks + ((buf) * 64 + kr1) * KS + 8 * kc1) = rk1; \
        *(u32x4*)(Vs + ((buf) * 64 + vr) * VS + 8 * vc) = rv; } while (0)
    AT_LOAD(0); AT_STORE(0);
    __syncthreads();
    float m_run = 0.f, l_run = 0.f; f32x16 o[2], negm;
#pragma unroll
    for (int i = 0; i < 16; ++i) { o[0][i] = 0.f; o[1][i] = 0.f; negm[i] = 0.f; }
    for (int kt = 0; kt < NT; ++kt) {
        const int buf = kt & 1;
        if (kt + 1 < NT) AT_LOAD(kt + 1);
        f32x16 pt[2];
        { bf16x8 kf[2][NKD];
#pragma unroll
          for (int kh = 0; kh < 2; ++kh)
#pragma unroll
              for (int d0 = 0; d0 < NKD; ++d0) kf[kh][d0] = *(const bf16x8*)(Ks + (buf * 64 + 32 * kh + r) * KS + 16 * d0 + 8 * h);
          SCHED_FENCE();
          pt[0] = negm; pt[1] = negm;
#pragma unroll
          for (int d0 = 0; d0 < NKD; ++d0) { pt[0] = mfma32(kf[0][d0], qr[d0], pt[0]); pt[1] = mfma32(kf[1][d0], qr[d0], pt[1]); } }
        bf16x8 vf[2][2][2];
#pragma unroll
        for (int et = 0; et < 2; ++et)
#pragma unroll
            for (int kh = 0; kh < 2; ++kh)
#pragma unroll
                for (int sp = 0; sp < 2; ++sp) { const bf16* vp = Vs + (buf * 64 + 32 * kh + 16 * sp) * VS + 32 * et + vtr_off;
                    const s16x4 lo = lds_tr_read(vp), hi = lds_tr_read(vp + 8 * VS);
                    vf[et][kh][sp] = (bf16x8){lo[0], lo[1], lo[2], lo[3], hi[0], hi[1], hi[2], hi[3]}; }
        SCHED_FENCE();
        float mq[4];
#pragma unroll
        for (int c = 0; c < 4; ++c) mq[c] = fmaxf(pt[0][c], pt[1][c]);
#pragma unroll
        for (int i = 4; i < 16; ++i) mq[i & 3] = fmaxf(mq[i & 3], fmaxf(pt[0][i], pt[1][i]));
        float mt = fmaxf(fmaxf(mq[0], mq[1]), fmaxf(mq[2], mq[3]));
        if (__any(kt == 0 || mt > 8.0f)) {
            mt = fmaxf(mt, SHX(mt, 32, lane));
            const float dl = (kt == 0) ? mt : fmaxf(mt, 0.f), alpha = exp2_fast(-dl);
            m_run += dl; l_run *= alpha;
#pragma unroll
            for (int i = 0; i < 16; ++i) { pt[0][i] -= dl; pt[1][i] -= dl; o[0][i] *= alpha; o[1][i] *= alpha; negm[i] = -m_run; }
        }
        float rq[4] = {0.f, 0.f, 0.f, 0.f};
#pragma unroll
        for (int kh = 0; kh < 2; ++kh)
#pragma unroll
            for (int i = 0; i < 16; ++i) { const float e = exp2_fast(pt[kh][i]); pt[kh][i] = e; rq[i & 3] += e; }
        l_run += (rq[0] + rq[1]) + (rq[2] + rq[3]);
        bf16x8 pb[2][2];
#pragma unroll
        for (int kh = 0; kh < 2; ++kh)
#pragma unroll
            for (int sp = 0; sp < 2; ++sp) { u32x4 u; u.x = pk2(pt[kh][8 * sp], pt[kh][8 * sp + 1]); u.y = pk2(pt[kh][8 * sp + 2], pt[kh][8 * sp + 3]); u.z = pk2(pt[kh][8 * sp + 4], pt[kh][8 * sp + 5]); u.w = pk2(pt[kh][8 * sp + 6], pt[kh][8 * sp + 7]);
                pb[kh][sp] = __builtin_bit_cast(bf16x8, u); }
        SCHED_FENCE();
#pragma unroll
        for (int kh = 0; kh < 2; ++kh)
#pragma unroll
            for (int sp = 0; sp < 2; ++sp)
#pragma unroll
                for (int et = 0; et < 2; ++et) o[et] = mfma32(vf[et][kh][sp], pb[kh][sp], o[et]);
        if (kt + 1 < NT) AT_STORE(buf ^ 1);
        __syncthreads();
    }
#undef AT_LOAD
#undef AT_STORE
    l_run += SHX(l_run, 32, lane);
    const float inv = 1.0f / l_run;
    bf16* op = O + (size_t)(w.wave * 32 + r) * ldo + 4 * h;
#pragma unroll
    for (int et = 0; et < 2; ++et)
#pragma unroll
        for (int g = 0; g < 4; ++g) { u32x2 ov; ov.x = pk2(o[et][4 * g] * inv, o[et][4 * g + 1] * inv); ov.y = pk2(o[et][4 * g + 2] * inv, o[et][4 * g + 3] * inv); *(u32x2*)(op + 32 * et + 8 * g) = ov; }
}
#ifndef REP_ATT
#define REP_ATT 1
#endif
#ifndef REP_ML3
#define REP_ML3 1
#endif
DEV void relaunder(Wg& w) { int t_ = w.tid; OPAQUE_V(t_); w.tid = t_; w.lane = t_ & 63; }
DEV void phase_mix(const P& p, Wg& w, int l) {
    const bf16* PROJ = (const bf16*)(p.ws + WS_PROJ); const bf16* MLAQ = (const bf16*)(p.ws + WS_MLAQ); bf16* MIX = (bf16*)(p.ws + WS_H);
    unsigned* ctr = (unsigned*)(p.ws + WS_CTL) + CW_Q + 1024 * l;
    const int n_ml3 = BATCH * 4 * NCH;
    for (int rep = 0; rep < REP_ATT; ++rep) {
        { const int n_lat = BATCH * 4 * NQL, n_all = n_lat + ((l == 0) ? BATCH * 4 : 0);
          for (;;) {
            int idx = q_next(w, ctr + 64 * rep);
            if (idx >= n_all) break;
            int b, head, qb, nkeys;
            if (idx < n_lat) { b = idx / (4 * NQL); head = (idx / NQL) % 4; qb = 1 + idx % NQL; nkeys = TP; }
            else { idx -= n_lat; b = idx / 4; head = idx % 4; qb = 0; nkeys = CTX; }
            const size_t Rq = (size_t)b * TP + qb * 256, Rk = (size_t)b * TP;
            attn_unit<96>(MLAQ + Rq * 1024 + head * 96, 1024, MLAQ + Rk * 1024 + 384 + head * 96, 1024, MLAQ + Rk * 1024 + 768 + head * 64, 1024, MIX + Rq * MIXW + 768 + head * 64, MIXW, nkeys, w);
          } }
        relaunder(w);
        { const int n_lat = BATCH * 6 * NQL, n_all = n_lat + ((l == 0) ? BATCH * 6 : 0);
          for (;;) {
            int idx = q_next(w, ctr + 256 + 64 * rep);
            if (idx >= n_all) break;
            int b, head, qb, nkeys;
            if (idx < n_lat) { b = idx / (6 * NQL); const int rem = idx % (6 * NQL); head = (rem / (3 * NQL)) * 3 + rem % 3; qb = 1 + (rem % (3 * NQL)) / 3; nkeys = TP; }
            else { idx -= n_lat; b = idx / 6; head = idx % 6; qb = 0; nkeys = CTX; }
            const size_t Rq = (size_t)b * TP + qb * 256, Rk = (size_t)b * TP;
            attn_unit<64>(PROJ + Rq * PROJ_W + C_AQ + head * 64, PROJ_W, PROJ + Rk * PROJ_W + C_AK + (head / 3) * 64, PROJ_W, PROJ + Rk * PROJ_W + C_AV + (head / 3) * 64, PROJ_W, MIX + Rq * MIXW + 384 + head * 64, MIXW, nkeys, w);
          } }
        relaunder(w);
    }
    for (int rep = 0; rep < REP_ML3; ++rep)
    for (;;) {
        const int idx = q_next(w, ctr + 512 + 64 * rep);
        if (idx >= n_ml3) break;
        if (l == 1 && idx % NCH < NC_CTX) continue;
        ml3_item(p, w, l, idx);
    }
}

DEV void moe_seg_table(const P& p, Wg& w) {
    const int* cntg = (const int*)(p.ws + WS_CNTG); int* part = (int*)w.lds;
    { const int e = w.tid & 7; int tot = 0, pre = 0;
      for (int g = w.tid >> 3; g < w.G; g += NTHR / 8) { const int c = cntg[g * NEXP + e]; tot += c; pre += (g < w.wg) ? c : 0; }
      part[2 * w.tid] = tot; part[2 * w.tid + 1] = pre; }
    __syncthreads();
    if (w.tid < NEXP) { int tot = 0, pre = 0; for (int i = 0; i < NTHR / 8; ++i) { tot += part[2 * (8 * i + w.tid)]; pre += part[2 * (8 * i + w.tid) + 1]; } w.misc[32 + w.tid] = (unsigned)tot; w.misc[48 + w.tid] = (unsigned)pre; }
    __syncthreads();
    if (w.tid == 0) { int s = 0; for (int e = 0; e < NEXP; ++e) { w.misc[16 + e] = (unsigned)s; s += ((int)w.misc[32 + e] + 255) / 256; } w.misc[16 + NEXP] = (unsigned)s; }
    __syncthreads();
}
DEV void phase_gather(const P& p, Wg& w) {
    moe_seg_table(p, w);
    const int* topi = (const int*)(p.ws + WS_TOPI); const float* topw = (const float*)(p.ws + WS_TOPW);
    int* stok = (int*)(p.ws + WS_STOK); float* sw = (float*)(p.ws + WS_SW);
    const bf16* H = (const bf16*)(p.ws + WS_H); bf16* AG = (bf16*)(p.ws + WS_AG);
    int* lc = (int*)w.lds;
    if (w.lane == 0) { for (int e = 0; e < NEXP; ++e) lc[w.wave * NEXP + e] = 0;
        for (int R = w.gw; R < M_ALL; R += w.NGW) { const int q = R % TP; if (q < CTX) continue; const int tok = (R / TP) * SEQ + q - CTX; lc[w.wave * NEXP + topi[2 * tok]]++; lc[w.wave * NEXP + topi[2 * tok + 1]]++; } }
    __syncthreads();
    if (w.tid < NEXP) { int s = (int)w.misc[16 + w.tid] * 256 + (int)w.misc[48 + w.tid]; for (int ww = 0; ww < NWAVE; ++ww) { const int c = lc[ww * NEXP + w.tid]; lc[ww * NEXP + w.tid] = s; s += c; } }
    __syncthreads();
    constexpr int NJ8 = (D_MODEL + 511) / 512;
    for (int R0 = w.gw; R0 < M_ALL; R0 += 4 * w.NGW) {
        int s0[4], s1[4]; bool ok[4];
#pragma unroll
        for (int qq = 0; qq < 4; ++qq) { const int R = R0 + qq * w.NGW; const int q = R % TP; ok[qq] = R < M_ALL && q >= CTX; const int tok = (R / TP) * SEQ + q - CTX;
            int a0 = 0, a1 = 0;
            if (w.lane == 0 && ok[qq]) { const int e0 = topi[2 * tok], e1 = topi[2 * tok + 1]; a0 = lc[w.wave * NEXP + e0]; lc[w.wave * NEXP + e0] = a0 + 1; a1 = lc[w.wave * NEXP + e1]; lc[w.wave * NEXP + e1] = a1 + 1;
                stok[a0] = tok; stok[a1] = tok; sw[a0] = topw[2 * tok]; sw[a1] = topw[2 * tok + 1]; int* tsl = (int*)(p.ws + WS_TSL) + 2 * tok; tsl[0] = a0; tsl[1] = a1; }
            s0[qq] = __shfl(a0, 0); s1[qq] = __shfl(a1, 0); }
        u32x4 v[4][NJ8];
#pragma unroll
        for (int qq = 0; qq < 4; ++qq)
#pragma unroll
            for (int j = 0; j < NJ8; ++j) { const int c = 8 * w.lane + 512 * j; if (ok[qq] && c < D_MODEL) v[qq][j] = *(const u32x4*)(H + (size_t)(R0 + qq * w.NGW) * D_MODEL + c); }
#pragma unroll
        for (int qq = 0; qq < 4; ++qq)
#pragma unroll
            for (int j = 0; j < NJ8; ++j) { const int c = 8 * w.lane + 512 * j; if (ok[qq] && c < D_MODEL) { *(u32x4*)(AG + (size_t)s0[qq] * D_MODEL + c) = v[qq][j]; *(u32x4*)(AG + (size_t)s1[qq] * D_MODEL + c) = v[qq][j]; } }
    }
    for (int e = w.wg; e < NEXP; e += w.G) { const int lo = (int)w.misc[16 + e] * 256 + (int)w.misc[32 + e], hi = (int)w.misc[16 + e + 1] * 256;
        for (int s = lo + w.wave; s < hi; s += NWAVE) { if (w.lane == 0) { stok[s] = -1; sw[s] = 0.f; }
            for (int c = 8 * w.lane; c < D_MODEL; c += 512) *(u32x4*)(AG + (size_t)s * D_MODEL + c) = (u32x4){0u, 0u, 0u, 0u}; } }
}

DEV void phase_moe_combine(const P& p, Wg& w, int c) {
    const int* tsl = (const int*)(p.ws + WS_TSL); const float* topw = (const float*)(p.ws + WS_TOPW); const bf16* YC = (const bf16*)(p.ws + WS_YC);
    const int lo = c * MOE_PCH * 256, hi = lo + MOE_PCH * 256;
    const int ptot = (int)w.misc[16 + NEXP], np = (ptot - c * MOE_PCH) < MOE_PCH ? (ptot - c * MOE_PCH) : MOE_PCH;
    if (np <= 0) return;
    const int nsp = (np * NSPLIT > MOE_PCH) ? 1 : NSPLIT; const size_t pstr = (size_t)np * 256 * D_MODEL;
    constexpr int CB = 2;
    for (int tok0 = w.gw; tok0 < NTOK; tok0 += CB * w.NGW) {
        const bf16* y0[CB]; const bf16* y1[CB]; float w0[CB], w1[CB]; bool act[CB]; bf16* xr[CB]; const float* gv[CB];
#pragma unroll
        for (int q = 0; q < CB; ++q) { const int tok = tok0 + q * w.NGW; const bool ok = tok < NTOK; const int tk = ok ? tok : 0;
            const int s0 = tsl[2 * tk], s1 = tsl[2 * tk + 1]; const bool in0 = ok && s0 >= lo && s0 < hi, in1 = ok && s1 >= lo && s1 < hi;
            act[q] = in0 || in1; w0[q] = in0 ? topw[2 * tk] : 0.f; w1[q] = in1 ? topw[2 * tk + 1] : 0.f;
            y0[q] = YC + (size_t)(in0 ? s0 - lo : 0) * D_MODEL; y1[q] = YC + (size_t)(in1 ? s1 - lo : 0) * D_MODEL;
            xr[q] = (bf16*)(p.out + (size_t)tk * D_MODEL); gv[q] = (const float*)(p.ws + WS_MODV) + (size_t)(1 * NV + tk / SEQ) * 6 * D_MODEL + 5 * D_MODEL; }
#pragma unroll
        for (int j = 0; j < D_MODEL / 256; ++j) { const int col = 4 * w.lane + 256 * j;
            f32x4 ya[CB], g[CB]; u32x2 x[CB];
#pragma unroll
            for (int q = 0; q < CB; ++q) if (act[q]) { g[q] = *(const f32x4*)(gv[q] + col); x[q] = *(const u32x2*)(xr[q] + col); ya[q] = (f32x4){0.f, 0.f, 0.f, 0.f};
                for (int ks = 0; ks < nsp; ++ks) { const u32x2 a = *(const u32x2*)(y0[q] + ks * pstr + col), bq = *(const u32x2*)(y1[q] + ks * pstr + col);
                    ya[q][0] += w0[q] * bf2f((bf16)a.x) + w1[q] * bf2f((bf16)bq.x); ya[q][1] += w0[q] * bf2f((bf16)(a.x >> 16)) + w1[q] * bf2f((bf16)(bq.x >> 16));
                    ya[q][2] += w0[q] * bf2f((bf16)a.y) + w1[q] * bf2f((bf16)bq.y); ya[q][3] += w0[q] * bf2f((bf16)(a.y >> 16)) + w1[q] * bf2f((bf16)(bq.y >> 16)); } }
#pragma unroll
            for (int q = 0; q < CB; ++q) if (act[q]) { u32x2 o;
                o.x = pk2(bf2f((bf16)x[q].x) + g[q][0] * ya[q][0], bf2f((bf16)(x[q].x >> 16)) + g[q][1] * ya[q][1]); o.y = pk2(bf2f((bf16)x[q].y) + g[q][2] * ya[q][2], bf2f((bf16)(x[q].y >> 16)) + g[q][3] * ya[q][3]);
                *(u32x2*)(xr[q] + col) = o; } }
    }
}
DEV void phase_moe_final(const P& p, Wg& w) {
    constexpr int c = MOE_NCH - 1, NJ = D_MODEL / 256;
    const int* tsl = (const int*)(p.ws + WS_TSL); const float* topw = (const float*)(p.ws + WS_TOPW); const bf16* YC = (const bf16*)(p.ws + WS_YC);
    const int lo = c * MOE_PCH * 256, hi = lo + MOE_PCH * 256;
    const int ptot = (int)w.misc[16 + NEXP], np = (ptot - c * MOE_PCH) < MOE_PCH ? (ptot - c * MOE_PCH) : MOE_PCH;
    const int nsp = (np * NSPLIT > MOE_PCH) ? 1 : NSPLIT; const size_t pstr = (size_t)(np > 0 ? np : 0) * 256 * D_MODEL;
    for (int tok0 = w.gw; tok0 < NTOK; tok0 += 2 * w.NGW) {
        f32x4 xo[2][NJ]; bool ok[2];
#pragma unroll
        for (int q = 0; q < 2; ++q) { const int tok = tok0 + q * w.NGW; ok[q] = tok < NTOK; const int tk = ok[q] ? tok : 0;
            const int s0 = tsl[2 * tk], s1 = tsl[2 * tk + 1]; const bool in0 = np > 0 && s0 >= lo && s0 < hi, in1 = np > 0 && s1 >= lo && s1 < hi;
            const float w0 = in0 ? topw[2 * tk] : 0.f, w1 = in1 ? topw[2 * tk + 1] : 0.f;
            const bf16* y0 = YC + (size_t)(in0 ? s0 - lo : 0) * D_MODEL; const bf16* y1 = YC + (size_t)(in1 ? s1 - lo : 0) * D_MODEL;
            const bf16* xr = (const bf16*)(p.out + (size_t)tk * D_MODEL); const float* gv = (const float*)(p.ws + WS_MODV) + (size_t)(1 * NV + tk / SEQ) * 6 * D_MODEL + 5 * D_MODEL;
#pragma unroll
            for (int j = 0; j < NJ; ++j) { const int col = 4 * w.lane + 256 * j; const u32x2 t = *(const u32x2*)(xr + col);
                xo[q][j] = (f32x4){bf2f((bf16)t.x), bf2f((bf16)(t.x >> 16)), bf2f((bf16)t.y), bf2f((bf16)(t.y >> 16))};
                if (in0 || in1) { f32x4 ya = (f32x4){0.f, 0.f, 0.f, 0.f};
                    for (int ks = 0; ks < nsp; ++ks) { const u32x2 a = *(const u32x2*)(y0 + ks * pstr + col), bq = *(const u32x2*)(y1 + ks * pstr + col);
                        ya[0] += w0 * bf2f((bf16)a.x) + w1 * bf2f((bf16)bq.x); ya[1] += w0 * bf2f((bf16)(a.x >> 16)) + w1 * bf2f((bf16)(bq.x >> 16));
                        ya[2] += w0 * bf2f((bf16)a.y) + w1 * bf2f((bf16)bq.y); ya[3] += w0 * bf2f((bf16)(a.y >> 16)) + w1 * bf2f((bf16)(bq.y >> 16)); }
                    xo[q][j] = xo[q][j] + *(const f32x4*)(gv + col) * ya; } } }
        wave_sync();
#pragma unroll
        for (int q = 0; q < 2; ++q) if (ok[q]) { float* orow = p.out + (size_t)(tok0 + q * w.NGW) * D_MODEL;
#pragma unroll
            for (int j = 0; j < NJ; ++j) *(f32x4*)(orow + 4 * w.lane + 256 * j) = xo[q][j]; }
    }
}

constexpr int PH_L = 24;
constexpr int N_PHASES = 1 + 2 * PH_L;
#ifndef PROBE_MUL
#define PROBE_MUL 1
#endif
#ifdef EMU
#define GRID_BAR() do {} while (0)
#define DYN_LDS() unsigned char* lds = EMU_DYN_LDS()
#else
#define GRID_BAR() xcd_barrier(bar)
#define DYN_LDS() extern __shared__ __attribute__((aligned(16))) unsigned char lds[]
#endif
__global__ void __launch_bounds__(NTHR, 2) fwd(P p_in) {
    DYN_LDS();
    Wg w; w.tid = threadIdx.x; w.lane = w.tid & 63;
#ifndef EMU
    w.wave = __builtin_amdgcn_readfirstlane(w.tid >> 6);
#else
    w.wave = w.tid >> 6;
#endif
    w.G = gridDim.x; w.wg = blockIdx.x; w.gw = w.wg * NWAVE + w.wave; w.NGW = w.G * NWAVE; w.lds = lds; w.misc = (unsigned*)(lds + LDS_MISC);
    if (w.tid < 64) w.misc[w.tid] = 0u;
    __syncthreads();
#ifndef EMU
    XcdBarrier bar = xcd_barrier_post((unsigned*)(p_in.ws + WS_CTL) + CW_BAR, (volatile LAS unsigned*)(w.misc));
#endif
    const int lo = p_in.ph_lo, hi = p_in.ph_hi; const int wave_s = w.wave; (void)wave_s;
#ifndef PH_MASK
#define PH_MASK 0xffffffffu
#endif
#if defined(PROBE_SET) && !defined(EMU)
#define PROBE_T0(k) if (blockIdx.x == 0 && threadIdx.x == 0) { ((unsigned*)(lds + LDS_MISC))[64 + 2 * (k)] = (unsigned)wall_clock64(); }
#define PROBE_T1(k) if (blockIdx.x == 0 && threadIdx.x == 0) { ((unsigned*)(lds + LDS_MISC))[65 + 2 * (k)] = (unsigned)wall_clock64(); }
#define PROBE_SPLIT(k, vk) { GRID_BAR(); if (blockIdx.x == 0 && threadIdx.x == 0) { unsigned* m_ = (unsigned*)(lds + LDS_MISC); m_[64 + 2 * (vk)] = m_[64 + 2 * (k)]; m_[65 + 2 * (vk)] = (unsigned)wall_clock64(); } }
#else
#define PROBE_T0(k)
#define PROBE_T1(k)
#define PROBE_SPLIT(k, vk)
#endif
#ifndef EMU
#define TID_NOW() (wave_s * 64 + lane_fresh())
#define WAVE_OF(t) __builtin_amdgcn_readfirstlane((t) >> 6)
#else
#define TID_NOW() ((int)threadIdx.x)
#define WAVE_OF(t) ((t) >> 6)
#endif
#ifndef EMU
#define LOAD_P() const __attribute__((address_space(4))) P* pq_ = (const __attribute__((address_space(4))) P*)__builtin_amdgcn_kernarg_segment_ptr(); asm volatile("" : "+s"(pq_)); const P p = *(const P*)pq_;
#else
#define LOAD_P() const P& p = p_in;
#endif
#define PH_BEGIN(k) if (((PH_MASK >> ((k) - pb_)) & 1u) && lo <= (k) && (k) < hi) { LOAD_P() { int t_ = TID_NOW(); OPAQUE_V(t_); w.tid = t_; w.lane = t_ & 63; w.wave = WAVE_OF(t_); w.gw = w.wg * NWAVE + w.wave; } PROBE_T0(k)
#define PH_END(k) if ((k) + 1 < hi) GRID_BAR(); PROBE_T1(k) }
    { const int pb_ = -31; PH_BEGIN(0) phase0(p, w); PH_END(0) }
    for (int l = 0; l < 2; ++l) {
        const int pb = 1 + PH_L * l, pb_ = pb;
        PH_BEGIN(pb + 0) phase_modulate<4>(p, w, l, 0, l == 0, false, false, l == 1); PH_END(pb + 0)
        PH_BEGIN(pb + 1) {
            pg8::Gemm g{(const bf16*)(p.ws + WS_H), (const bf16*)(p.ws + WS_WIN_T) + (size_t)l * PROJ_W * D_MODEL, D_MODEL, D_MODEL, D_MODEL, 0};
            Sched<0> S; S.o.init(NPAN, PROJ_W / 256, w.G, w.wg, SITE_WGM(0)); S.pm_base = 0; S.seg = nullptr; S.nNc = 0; S.kper = 0;
            EpiStore E{(bf16*)(p.ws + WS_PROJ), PROJ_W, (float*)(p.ws + WS_GATES)};
            { const TabSched T_ = build_units(w.misc, w.tid, S); pg8::gemm_phase<EpiStore, TabSched>(w.lds, w.tid, g, T_, E); } } PH_END(pb + 1)
        PH_BEGIN(pb + 2) phase_prep(p, w, l); PH_END(pb + 2)
        PH_BEGIN(pb + 3) {
            pg8::Gemm g{(const bf16*)(p.ws + WS_PROJ) + C_CQ, (const bf16*)(p.ws + WS_MLA_T) + (size_t)l * 1024 * 512, PROJ_W, 512, 256, 0};
            Sched<6> S; S.o.init(NPAN, 4, w.G, w.wg, SITE_WGM(1)); S.pm_base = 0; S.seg = nullptr; S.nNc = 0; S.kper = 0;
            EpiStore E{(bf16*)(p.ws + WS_MLAQ), 1024, nullptr};
            { const TabSched T_ = build_units(w.misc, w.tid, S); pg8::gemm_phase<EpiStore, TabSched>(w.lds, w.tid, g, T_, E); }
            __syncthreads();
            PROBE_SPLIT(pb + 3, 49 + 3 * l)
#ifndef NO_ML1
            for (int it = w.G - 1 - w.wg; it < BATCH * 4 * NCH; it += w.G) ml1_item(p, w, l, it);
#endif
            } PH_END(pb + 3)
        PH_BEGIN(pb + 4) phase_mla_post(p, w, l); PROBE_SPLIT(pb + 4, 50 + 3 * l) phase_ml2(p, w); PH_END(pb + 4)
        PH_BEGIN(pb + 5) phase_mix(p, w, l); PH_END(pb + 5)
        PH_BEGIN(pb + 6) {
            pg8::Gemm g{(const bf16*)(p.ws + WS_H), (const bf16*)(p.ws + WS_WOUT_T) + (size_t)l * D_MODEL * MIXW, MIXW, MIXW, MIXW, 0};
            Sched<0> S0; Sched<1> S1; S0.o.init(NPAN, D_MODEL / 256, w.G, w.wg, SITE_WGM(2)); S1.o.init(BATCH * NQL, D_MODEL / 256, w.G, w.wg, SITE_WGM(3)); S0.pm_base = 0; S0.seg = nullptr; S0.nNc = 0; S0.kper = 0; S1.pm_base = 0; S1.seg = nullptr; S1.nNc = 0; S1.kper = 0;
            if (l == 0) { EpiResid<true> E{p, l, 2 * D_MODEL}; const TabSched T_ = build_units(w.misc, w.tid, S0); pg8::gemm_phase<EpiResid<true>, TabSched>(w.lds, w.tid, g, T_, E); }
            else { EpiResid<false> E{p, l, 2 * D_MODEL}; const TabSched T_ = build_units(w.misc, w.tid, S1); pg8::gemm_phase<EpiResid<false>, TabSched>(w.lds, w.tid, g, T_, E); } } PH_END(pb + 6)
        if (l == 0) {
            PH_BEGIN(pb + 7) phase_modulate<4>(p, w, 0, 1, false, false, false, false); PH_END(pb + 7)
            PH_BEGIN(pb + 8) {
                pg8::Gemm g{(const bf16*)(p.ws + WS_H), (const bf16*)(p.ws + WS_WGU_T), D_MODEL, D_MODEL, D_MODEL, 0};
                Sched<0> S; S.o.init(NPAN, 2 * D_FF / 256, w.G, w.wg, SITE_WGM(4)); S.pm_base = 0; S.seg = nullptr; S.nNc = 0; S.kper = 0;
                EpiSwiglu E{(bf16*)(p.ws + WS_ACT), 0};
                { const TabSched T_ = build_units(w.misc, w.tid, S); pg8::gemm_phase<EpiSwiglu, TabSched>(w.lds, w.tid, g, T_, E); } } PH_END(pb + 8)
            PH_BEGIN(pb + 9) {
                { pg8::Gemm g{(const bf16*)(p.ws + WS_ACT), (const bf16*)(p.ws + WS_WD_T), D_FF, D_FF, D_FF, 0};
                  Sched<1> S; S.o.init(BATCH * NQL, D_MODEL / 256, w.G, w.wg, SITE_WGM(5)); S.pm_base = 0; S.seg = nullptr; S.nNc = 0; S.kper = 0;
                  EpiResid<false> E{p, 0, 5 * D_MODEL};
                  { const TabSched T_ = build_units(w.misc, w.tid, S); pg8::gemm_phase<EpiResid<false>, TabSched>(w.lds, w.tid, g, T_, E); } }
                __syncthreads();
                { pg8::Gemm g{(const bf16*)(p.ws + WS_ACT), (const bf16*)(p.ws + WS_WD_T), D_FF, D_FF, KSPLIT, 0};
                  Sched<4> S; S.o.init(BATCH, (D_MODEL / 256) * NSPLIT, w.G, w.wg, SITE_WGM(6)); S.pm_base = 0; S.seg = nullptr; S.nNc = D_MODEL / 256; S.kper = KSPLIT;
                  EpiStoreRel E{(bf16*)(p.ws + WS_MLAQ), D_MODEL, 0};
                  { const TabSched T_ = build_units(w.misc, w.tid, S); pg8::gemm_phase<EpiStoreRel, TabSched>(w.lds, w.tid, g, T_, E); } } } PH_END(pb + 9)
        } else {
            PH_BEGIN(pb + 7) phase_modulate<1>(p, w, 1, 1, false, true, true, false); PROBE_SPLIT(pb + 7, 51 + 3 * l) phase_moe_weights(p, w); PH_END(pb + 7)
            PH_BEGIN(pb + 8) phase_gather(p, w); PH_END(pb + 8)
            for (int c = 0; c < MOE_NCH; ++c) {
                PH_BEGIN(pb + 9 + 2 * c) {
                    moe_seg_table(p, w);
                    const int ptot = (int)w.misc[16 + NEXP], pm0 = c * MOE_PCH, np = (ptot - pm0) < MOE_PCH ? (ptot - pm0) : MOE_PCH;
                    if (c > 0 && (w.wg & 1)) phase_moe_combine(p, w, c - 1);
                    if (np > 0) {
                        pg8::Gemm g{(const bf16*)(p.ws + WS_AG), (const bf16*)(p.ws + WS_MOEW), D_MODEL, D_MODEL, D_MODEL, MOEW_E};
                        Sched<2> S; S.o.init(np, 2 * D_FF / 256, w.G, w.wg, SITE_WGM(7)); S.pm_base = pm0; S.seg = (const int*)(w.misc + 16); S.nNc = 0; S.kper = 0;
                        EpiSwiglu E{(bf16*)(p.ws + WS_ACT2), pm0};
                        { const TabSched T_ = build_units(w.misc, w.tid, S); pg8::gemm_phase<EpiSwiglu, TabSched>(w.lds, w.tid, g, T_, E); } }
                    if (c > 0 && !(w.wg & 1)) phase_moe_combine(p, w, c - 1); } PH_END(pb + 9 + 2 * c)
                PH_BEGIN(pb + 10 + 2 * c) {
                    moe_seg_table(p, w);
                    const int ptot = (int)w.misc[16 + NEXP], pm0 = c * MOE_PCH, np = (ptot - pm0) < MOE_PCH ? (ptot - pm0) : MOE_PCH;
                    if (np > 0 && np * NSPLIT > MOE_PCH) {
                        pg8::Gemm g{(const bf16*)(p.ws + WS_ACT2), (const bf16*)(p.ws + WS_MOEW) + (size_t)2 * D_FF * D_MODEL, D_FF, D_FF, D_FF, MOEW_E};
                        Sched<3> S; S.o.init(np, D_MODEL / 256, w.G, w.wg, SITE_WGM(8)); S.pm_base = pm0; S.seg = (const int*)(w.misc + 16); S.nNc = 0; S.kper = 0;
                        EpiStoreRel E{(bf16*)(p.ws + WS_YC), D_MODEL, 0};
                        { const TabSched T_ = build_units(w.misc, w.tid, S); pg8::gemm_phase<EpiStoreRel, TabSched>(w.lds, w.tid, g, T_, E); } }
                    else if (np > 0) {
                        pg8::Gemm g{(const bf16*)(p.ws + WS_ACT2), (const bf16*)(p.ws + WS_MOEW) + (size_t)2 * D_FF * D_MODEL, D_FF, D_FF, KSPLIT, MOEW_E};
                        Sched<5> S; S.o.init(np, (D_MODEL / 256) * NSPLIT, w.G, w.wg, SITE_WGM(9)); S.pm_base = pm0; S.seg = (const int*)(w.misc + 16); S.nNc = D_MODEL / 256; S.kper = KSPLIT;
                        EpiStoreRel E{(bf16*)(p.ws + WS_YC), D_MODEL, 0};
                        { const TabSched T_ = build_units(w.misc, w.tid, S); pg8::gemm_phase<EpiStoreRel, TabSched>(w.lds, w.tid, g, T_, E); } } } PH_END(pb + 10 + 2 * c)
            }
            PH_BEGIN(pb + 9 + 2 * MOE_NCH) moe_seg_table(p, w); phase_moe_final(p, w); PH_END(pb + 9 + 2 * MOE_NCH)
        }
    }
#if defined(PROBE_SET) && !defined(EMU)
    if (blockIdx.x == 0 && threadIdx.x == 0) {
        unsigned tot = 0; for (int k = 0; k < 56; ++k) if ((PROBE_SET >> k) & 1ull) tot += ((unsigned*)(lds + LDS_MISC))[65 + 2 * k] - ((unsigned*)(lds + LDS_MISC))[64 + 2 * k];
        const unsigned long long t0 = wall_clock64(); while (wall_clock64() - t0 < (unsigned long long)tot * PROBE_MUL) __builtin_amdgcn_s_sleep(8);
    }
#endif
}

#ifndef MK_PER_PHASE
#define MK_PER_PHASE 0
#endif
extern "C" void kernel_launch(void* const* d_in, const int* in_sizes, int n_in, void* d_out, int out_size, void* d_ws, size_t ws_size, hipStream_t stream) {
    static int grid = 0;
    if (grid == 0) {
        if (n_in != 28 || in_sizes[0] != BATCH * SEQ * D_MODEL || out_size != BATCH * SEQ * D_MODEL || ws_size < WS_TOTAL) {
            fprintf(stderr, "kernel_launch: unexpected problem (n_in %d, x %d, out %d, ws %zu < %zu)\n", n_in, n_in > 0 ? in_sizes[0] : -1, out_size, ws_size, (size_t)WS_TOTAL); grid = -1; return; }
#ifndef EMU
        int dev = 0, cus = 0;
        if (hipGetDevice(&dev) != hipSuccess || hipDeviceGetAttribute(&cus, hipDeviceAttributeMultiprocessorCount, dev) != hipSuccess) { grid = -1; return; }
        if (hipFuncSetAttribute((const void*)fwd, hipFuncAttributeMaxDynamicSharedMemorySize, LDS_BYTES) != hipSuccess) { fprintf(stderr, "kernel_launch: hipFuncSetAttribute failed\n"); grid = -1; return; }
        int per_cu = 0;
        if (hipOccupancyMaxActiveBlocksPerMultiprocessor(&per_cu, (const void*)fwd, NTHR, LDS_BYTES) != hipSuccess || per_cu < 1) { fprintf(stderr, "kernel_launch: occupancy query says %d\n", per_cu); (void)hipGetLastError(); }
        grid = cus;
#else
        grid = 8;
#endif
    }
    if (grid < 0) return;
    (void)hipMemsetAsync((char*)d_ws + WS_CTL, 0, CTL_BYTES, stream);
    P p{};
    const float** pp = (const float**)&p;
    for (int i = 0; i < 28; ++i) pp[i] = (const float*)d_in[i];
    p.out = (float*)d_out; p.ws = (unsigned char*)d_ws;
#if MK_PER_PHASE
    for (int k = 0; k < N_PHASES; ++k) {
        if (k >= 1 + 10 && k < 1 + PH_L) continue;
        if (k >= 1 + PH_L + 10 + 2 * MOE_NCH) continue;
        p.ph_lo = k; p.ph_hi = k + 1;
        hipLaunchKernelGGL(fwd, dim3(grid), dim3(NTHR), LDS_BYTES, stream, p);
    }
#else
    p.ph_lo = 0; p.ph_hi = N_PHASES;
    hipLaunchKernelGGL(fwd, dim3(grid), dim3(NTHR), LDS_BYTES, stream, p);
#endif
}
```

```cpp
#ifndef EMU
#include <hip/hip_runtime.h>
#endif
#include <cstdio>
#include <cstdint>
#include <cmath>

#ifdef CFG_TINY
constexpr int D_MODEL = 256, BATCH = 2, SEQ = 512, CTX = 256, GRID_W = 16, D_FF = 512;
constexpr int MOE_PCH = 4, NSPLIT = 2;
#else
constexpr int D_MODEL = 1024, BATCH = 8, SEQ = 4096, CTX = 256, GRID_W = 64, D_FF = 3584;
constexpr int MOE_PCH = 64, NSPLIT = 7;
#endif
constexpr int TP = CTX + SEQ, M_ALL = BATCH * TP, NPAN = M_ALL / 256, PAN_B = TP / 256, NQL = SEQ / 256;
constexpr int MCH = 128;
constexpr int NCH = TP / MCH, NC_CTX = CTX / MCH, NQB = MCH / 32;
constexpr int PROJ_W = 2816, MIXW = 1024, NEXP = 8;
constexpr int C_MQ = 0, C_MK = 384, C_MV = 768, C_MO = 1152, C_G = 1536, C_AQ = 1552, C_AK = 1936, C_AV = 2064, C_CQ = 2192, C_CKV = 2448, C_KR = 2576, IN_W = 2608;
constexpr int NV = BATCH + 1;
constexpr int NCHAIN = BATCH * 4 * 2, NITEM = NCHAIN * NCH;
constexpr int NTOK = BATCH * SEQ, NSLOTP = NTOK * 2 + NEXP * 256;
constexpr int MOE_NCH = (NSLOTP / 256 + MOE_PCH - 1) / MOE_PCH;
constexpr float EPS = 1e-6f, LOG2E = 1.4426950408889634f;
constexpr float QSCALE_A = 0.125f * LOG2E, QSCALE_L = 0.10206207261596575f * LOG2E, KSCALE_M = 0.10206207261596575f;
constexpr int NTHR = 512, NWAVE = 8;
constexpr int KSPLIT = D_FF / NSPLIT;
static_assert(KSPLIT % 128 == 0 && KSPLIT >= 256 && NSPLIT * BATCH * 256 * D_MODEL * 2 <= M_ALL * 1024 * 2, "split-K geometry");
constexpr int NPOS = (SEQ / GRID_W > GRID_W) ? SEQ / GRID_W : GRID_W;

typedef unsigned short bf16;
#ifndef EMU
typedef short bf16x8 __attribute__((ext_vector_type(8)));
typedef short s16x4 __attribute__((ext_vector_type(4)));
typedef float f32x4 __attribute__((ext_vector_type(4)));
typedef float f32x2 __attribute__((ext_vector_type(2)));
typedef float f32x16 __attribute__((ext_vector_type(16)));
typedef unsigned u32x4 __attribute__((ext_vector_type(4)));
typedef unsigned u32x2 __attribute__((ext_vector_type(2)));
#define DEV __device__ __forceinline__
DEV f32x16 mfma32(bf16x8 a, bf16x8 b, f32x16 c) { return __builtin_amdgcn_mfma_f32_32x32x16_bf16(a, b, c, 0, 0, 0); }
DEV void wave_sync() { asm volatile("s_waitcnt vmcnt(0) lgkmcnt(0)" ::: "memory"); __builtin_amdgcn_wave_barrier(); }
typedef __bf16 bf16x2_hw __attribute__((ext_vector_type(2)));
typedef short v4i16_t __attribute__((ext_vector_type(4)));
DEV unsigned pk2_hw(float lo, float hi) { f32x2 v = {lo, hi}; bf16x2_hw b = __builtin_convertvector(v, bf16x2_hw); return __builtin_bit_cast(unsigned, b); }
DEV s16x4 lds_tr_read(const unsigned short* a) { return __builtin_bit_cast(s16x4, __builtin_amdgcn_ds_read_tr16_b64_v4i16((__attribute__((address_space(3))) v4i16_t*)(a))); }
DEV float exp2_fast(float x) { return __builtin_amdgcn_exp2f(x); }
DEV float rcp_fast(float x) { return __builtin_amdgcn_rcpf(x); }
DEV float rsqrt_fast(float x) { return __builtin_amdgcn_rsqf(x); }
DEV void atomic_addf(float* p, float v) { unsafeAtomicAdd(p, v); }
#define OPAQUE_V(x) asm volatile("" : "+v"(x))
#define SCHED_FENCE() __builtin_amdgcn_sched_barrier(0)
#define UNIFORM_I(x) __builtin_amdgcn_readfirstlane(x)
DEV unsigned fau(float f) { return __float_as_uint(f); }
DEV float uaf(unsigned u) { return __uint_as_float(u); }
DEV float my_shfl_xor(float v, int m, int lane) { return __int_as_float(__builtin_amdgcn_ds_bpermute((lane ^ m) << 2, __float_as_int(v))); }
#define SHX(v, m, lane) my_shfl_xor((v), (m), (lane))
DEV float my_shfl(float v, int src) { return __int_as_float(__builtin_amdgcn_ds_bpermute((src & 63) << 2, __float_as_int(v))); }
DEV int my_shfl(int v, int src) { return __builtin_amdgcn_ds_bpermute((src & 63) << 2, v); }
#define __shfl my_shfl
DEV int lane_fresh() { int l_; asm volatile("v_mbcnt_lo_u32_b32 %0, -1, 0\n\tv_mbcnt_hi_u32_b32 %0, -1, %0" : "=v"(l_)); return l_; }
#else
#define DEV inline
#define OPAQUE_V(x) do {} while (0)
#define SCHED_FENCE() do {} while (0)
#define UNIFORM_I(x) (x)
#define SHX(v, m, lane) __shfl_xor((v), (m))
DEV void wave_sync() { (void)emu_shfl_u(0u, emu::B->cur & 63); }
DEV void atomic_addf(float* p, float v) { atomicAdd(p, v); }
DEV float rsqrt_fast(float x) { return 1.0f / sqrtf(x); }
DEV unsigned fau(float f) { unsigned u; memcpy(&u, &f, 4); return u; }
DEV float uaf(unsigned u) { float f; memcpy(&f, &u, 4); return f; }
#endif
DEV bf16 f2bf(float f) { unsigned u = fau(f); u += 0x7fffu + ((u >> 16) & 1u); return (bf16)(u >> 16); }
DEV float bf2f(bf16 h) { return uaf(((unsigned)h) << 16); }
#ifndef EMU
DEV unsigned pk2(float lo, float hi) { return pk2_hw(lo, hi); }
#else
DEV unsigned pk2(float lo, float hi) { return (unsigned)f2bf(lo) | ((unsigned)f2bf(hi) << 16); }
#endif
DEV float wave_sum(float v, int lane) {
#pragma unroll
    for (int o = 1; o < 64; o <<= 1) v += SHX(v, o, lane);
    return v;
}
DEV float wave_max(float v, int lane) {
#pragma unroll
    for (int o = 1; o < 64; o <<= 1) v = fmaxf(v, SHX(v, o, lane));
    return v;
}
DEV float silu_f(float x) { return x / (1.0f + __expf(-x)); }
DEV float silu_fast(float x) { return x * rcp_fast(1.0f + exp2_fast(-x * LOG2E)); }
DEV float sigmoid_f(float x) { return rcp_fast(1.0f + exp2_fast(-x * LOG2E)); }
DEV float log_sigmoid_f(float x) { return x >= 0.f ? -log1pf(expf(-x)) : x - log1pf(expf(x)); }
DEV int crow(int i, int h) { return (i & 3) + 8 * (i >> 2) + 4 * h; }

constexpr size_t al256(size_t x) { return (x + 255) & ~(size_t)255; }
constexpr size_t WS_CTL = 0, CTL_BYTES = 65536;
constexpr int CW_Q = 0;
constexpr int CW_BAR = 4096;
constexpr size_t WS_MODV = WS_CTL + CTL_BYTES;
constexpr size_t WS_WIN_T = al256(WS_MODV + (size_t)2 * NV * 6 * D_MODEL * 4);
constexpr size_t WS_WOUT_T = al256(WS_WIN_T + (size_t)2 * PROJ_W * D_MODEL * 2);
constexpr size_t WS_MLA_T = al256(WS_WOUT_T + (size_t)2 * D_MODEL * MIXW * 2);
constexpr size_t WS_WGU_T = al256(WS_MLA_T + (size_t)2 * 1024 * 512 * 2);
constexpr size_t WS_WD_T = al256(WS_WGU_T + (size_t)2 * D_FF * D_MODEL * 2);
constexpr size_t WS_CX = al256(WS_WD_T + (size_t)D_MODEL * D_FF * 2);
constexpr size_t WS_GATES = al256(WS_CX + (size_t)BATCH * CTX * D_MODEL * 4);
constexpr size_t WS_NL = al256(WS_GATES + (size_t)M_ALL * 16 * 4);
constexpr size_t WS_FS = al256(WS_NL + (size_t)NITEM * 96 * 4);
constexpr size_t WS_PML = al256(WS_FS + (size_t)NITEM * 4);
constexpr size_t WS_MST = al256(WS_PML + (size_t)NITEM * 4);
constexpr size_t WS_TOPI = al256(WS_MST + (size_t)NITEM * 4);
constexpr size_t WS_TOPW = al256(WS_TOPI + (size_t)NTOK * 2 * 4);
constexpr size_t WS_CNTG = al256(WS_TOPW + (size_t)NTOK * 2 * 4);
constexpr size_t WS_STOK = al256(WS_CNTG + (size_t)1024 * 8 * 4);
constexpr size_t WS_SW = al256(WS_STOK + (size_t)NSLOTP * 4);
constexpr size_t WS_TSL = al256(WS_SW + (size_t)NSLOTP * 4);
constexpr size_t WS_ROPE = al256(WS_TSL + (size_t)NTOK * 2 * 4);
constexpr size_t WS_PROJ = al256(WS_ROPE + (size_t)NPOS * 24 * 2 * 4);
constexpr size_t WS_MQK = al256(WS_PROJ + (size_t)M_ALL * PROJ_W * 2);
constexpr size_t WS_MLAQ = al256(WS_MQK + (size_t)M_ALL * 768 * 2);
constexpr size_t WS_UC = al256(WS_MLAQ + (size_t)M_ALL * 1024 * 2);
constexpr size_t WS_H = al256(WS_UC + (size_t)NITEM * 9216 * 2);
constexpr size_t WS_END0 = al256(WS_H + (size_t)M_ALL * 1024 * 2);
constexpr size_t WS_ACT = WS_PROJ;
constexpr size_t WS_MOEW = WS_PROJ;
constexpr size_t MOEW_E = (size_t)3 * D_FF * D_MODEL * 2;
constexpr size_t WS_AG = al256(WS_MOEW + NEXP * MOEW_E);
constexpr size_t WS_ACT2 = al256(WS_AG + (size_t)NSLOTP * D_MODEL * 2);
constexpr size_t WS_YC = al256(WS_ACT2 + (size_t)MOE_PCH * 256 * D_FF * 2);
#ifdef CFG_TINY
constexpr size_t WS_TOTAL = WS_END0 + (4u << 20);
#else
constexpr size_t WS_TOTAL = (size_t)512 << 20;
#endif
static_assert(WS_END0 <= WS_TOTAL, "ws map");
constexpr int ML2_U = (NCH % 17 == 0) ? 17 : ((NCH % 4 == 0) ? 4 : 2);
static_assert(NCH % ML2_U == 0, "ML2 unroll");
static_assert(WS_ACT + (size_t)M_ALL * D_FF * 2 <= WS_MLAQ, "dense ACT overlays PROJ+MQK only");
static_assert(WS_MOEW + NEXP * MOEW_E <= WS_MQK, "MoE weights overlay PROJ only");
static_assert(WS_YC + (size_t)MOE_PCH * 256 * D_MODEL * 2 <= WS_TOTAL, "MoE chunk buffers");

constexpr int LDS_STAGE = 131072;
constexpr int LDS_MISC = LDS_STAGE;
constexpr int LDS_BYTES = LDS_STAGE + 4096;

struct P {
    const float *x, *c, *ctx, *c_ctx, *mod_w, *mod_b, *norm_mix, *norm_ffn, *w_in, *m_conv, *m_gate_b, *m_norm, *a_qnorm, *a_knorm, *l_cq_norm, *l_ckv_norm,
        *l_wuq, *l_wukv, *l_qnorm, *l_knorm, *w_out, *ffn_wg, *ffn_wu, *ffn_wd, *moe_router, *moe_wg, *moe_wu, *moe_wd;
    float* out; unsigned char* ws; int ph_lo, ph_hi;
};
constexpr int RPITCH = 2 * D_MODEL;
DEV bf16* resid_row(const P& p, int R) {
    const int b = R / TP, q = R % TP;
    return q < CTX ? (bf16*)(p.ws + WS_CX) + (size_t)(b * CTX + q) * RPITCH : (bf16*)(p.out + (size_t)(b * SEQ + q - CTX) * D_MODEL);
}
DEV const float* modv(const P& p, int l, int R) { const int b = R / TP, q = R % TP; return (const float*)(p.ws + WS_MODV) + (size_t)(l * NV + (q < CTX ? BATCH : b)) * 6 * D_MODEL; }

namespace pg8 {
constexpr int BM = 256, BK = 64, HALF = 128, HTB = HALF * BK * 2, STAGE_BYTES = 8 * HTB, NXCD = 8, WGM = 8;
struct Unit { int pm, pn, e, k0, po; };
struct Gemm { const bf16* A; const bf16* Bt; int lda, ldb, K; size_t bstride; };
DEV int lds_byte(int r, int c) { const int st = (r >> 4) * 2 + (c >> 5), rr = r & 15, cc = c & 31, ob = rr * 64 + cc * 2; return st * 1024 + (ob ^ (((ob >> 9) & 1) << 5)); }
DEV void stage_rc(int b, int& R, int& C) { const int st = b / 1024, sb = b % 1024, swz = sb ^ (((sb >> 9) & 1) << 5); R = (st >> 1) * 16 + swz / 64; C = (st & 1) * 32 + (swz % 64) / 2; }
DEV int perm32(int rho) { const int n = rho >> 4, i = rho & 15; return 8 * (i >> 2) + 4 * n + (i & 3); }
struct Order {
    int nM, nN, nwg, G, c, wgm;
    DEV void init(int nM_, int nN_, int G_, int c_, int wgm_ = WGM) { nM = nM_; nN = nN_; nwg = nM * nN; G = G_; c = c_; wgm = wgm_; }
    DEV bool nextL(int i, int& lm, int& ln) const {
        const long L = (long)i * G + c; if (L >= nwg) return false;
        int wgid = (int)L; { const int q = nwg / NXCD, r = nwg % NXCD, xcd = wgid % NXCD, off = wgid / NXCD; wgid = (xcd < r ? xcd * (q + 1) : r * (q + 1) + (xcd - r) * q) + off; }
        const int nig = wgm * nN, gid = wgid / nig, fm = gid * wgm, gsz = (nM - fm) < wgm ? (nM - fm) : wgm;
        lm = fm + ((wgid % nig) % gsz); ln = (wgid % nig) / gsz; return true;
    }
};
#ifndef EMU
#define PG8_LAS __attribute__((address_space(3)))
DEV unsigned cvt_pk_bf16(float lo, float hi) { unsigned r; asm volatile("v_cvt_pk_bf16_f32 %0, %1, %2" : "=v"(r) : "v"(lo), "v"(hi)); return r; }
template <class Epi, class Sched>
DEV void gemm_phase(unsigned char* lds_, const int tid, const Gemm g, const Sched& S, const Epi& E) {
    PG8_LAS unsigned char* lds = (PG8_LAS unsigned char*)lds_;
    const int wid = __builtin_amdgcn_readfirstlane(tid >> 6), lane = tid & 63, wr = wid >> 2, wc = wid & 3, fr = lane & 15, fq = lane >> 4;
    const int K = g.K, nt = K / BK, lda = g.lda, ldb = g.ldb;
    unsigned voffA[2], voffB[2];
#pragma unroll
    for (int i = 0; i < 2; ++i) { int R, C; stage_rc(tid * 16 + i * 8192, R, C); const int Rb = Epi::PERM ? ((R & ~31) + perm32(R & 31)) : R;
        voffA[i] = (unsigned)(R * lda + C) * 2u; voffB[i] = (unsigned)(Rb * ldb + C) * 2u; }
    const size_t kstep = (size_t)(BK * 2);
    const size_t hstepA = (size_t)HALF * lda * 2, hstepB = (size_t)HALF * ldb * 2;
    const size_t tstepA = 2 * hstepA, tstepB = 2 * hstepB;
    const unsigned ldsw = (unsigned)wid * 1024u;
    const int aoff = lds_byte(wr * 64 + fr, fq * 8), boff = lds_byte(wc * 32 + fr, fq * 8);
#define PG8_SA(b, h) (((b) * 2 + (h)) * HTB)
#define PG8_SB(b, h) ((4 + (b) * 2 + (h)) * HTB)
#define PG8_STAGE(bufoff, gbase, voff) do { _Pragma("unroll") for (int _i = 0; _i < 2; ++_i) \
        __builtin_amdgcn_global_load_lds((const unsigned*)((const char*)(gbase) + (voff)[_i]), (PG8_LAS unsigned*)(lds + (bufoff) + ldsw + _i * 8192), 16, 0, 0); } while (0)
#define PG8_LDA(dst, b, h) do { _Pragma("unroll") for (int m = 0; m < 4; ++m) _Pragma("unroll") for (int k = 0; k < 2; ++k) dst[m][k] = *(const PG8_LAS bf16x8*)(lds + PG8_SA(b, h) + aoff + m * 2048 + k * 1024); } while (0)
#define PG8_LDB(dst, b, h) do { _Pragma("unroll") for (int n = 0; n < 2; ++n) _Pragma("unroll") for (int k = 0; k < 2; ++k) dst[n][k] = *(const PG8_LAS bf16x8*)(lds + PG8_SB(b, h) + boff + n * 2048 + k * 1024); } while (0)
#define PG8_MMA(ai, bj, At, Bt) do { __builtin_amdgcn_s_setprio(1); _Pragma("unroll") for (int m = 0; m < 4; ++m) _Pragma("unroll") for (int n = 0; n < 2; ++n) _Pragma("unroll") for (int k = 0; k < 2; ++k) \
        acc[ai][bj][m][n] = __builtin_amdgcn_mfma_f32_16x16x32_bf16(Bt[n][k], At[m][k], acc[ai][bj][m][n], 0, 0, 0); __builtin_amdgcn_s_setprio(0); } while (0)
#define PG8_WAIT_V(n) asm volatile("s_waitcnt vmcnt(" #n ")" ::: "memory")
#define PG8_WAIT_L(n) asm volatile("s_waitcnt lgkmcnt(" #n ")" ::: "memory")
#define PG8_BAR __builtin_amdgcn_s_barrier()
#define PG8_SCHED __builtin_amdgcn_sched_barrier(0)
    Unit cur, nxt; int ui = 0;
    if (!S.next(0, cur)) return;
    f32x4 acc[2][2][4][2];
#pragma unroll
    for (int a = 0; a < 2; ++a)
#pragma unroll
        for (int b = 0; b < 2; ++b)
#pragma unroll
            for (int m = 0; m < 4; ++m)
#pragma unroll
                for (int n = 0; n < 2; ++n) acc[a][b][m][n] = (f32x4){0.f, 0.f, 0.f, 0.f};
    bf16x8 At[4][2], B0[2][2], B1[2][2];
    const char* cA = (const char*)g.A + (size_t)cur.pm * tstepA + (size_t)cur.k0 * 2; const char* cB = (const char*)g.Bt + (size_t)cur.e * g.bstride + (size_t)cur.pn * tstepB + (size_t)cur.k0 * 2;
    PG8_STAGE(PG8_SB(0, 0), cB, voffB); PG8_STAGE(PG8_SB(0, 1), cB + hstepB, voffB); PG8_STAGE(PG8_SA(0, 0), cA, voffA); PG8_STAGE(PG8_SA(0, 1), cA + hstepA, voffA);
    if (wr == 1) PG8_BAR;
    PG8_WAIT_V(2); PG8_BAR;
    PG8_STAGE(PG8_SB(1, 0), cB + kstep, voffB); PG8_STAGE(PG8_SA(1, 0), cA + kstep, voffA); PG8_STAGE(PG8_SB(1, 1), cB + hstepB + kstep, voffB);
    PG8_WAIT_V(6); PG8_BAR;
    for (;;) {
        const bool has_next = S.next(ui + 1, nxt);
        const char* nA = has_next ? (const char*)g.A + (size_t)nxt.pm * tstepA + (size_t)nxt.k0 * 2 : cA; const char* nB = has_next ? (const char*)g.Bt + (size_t)nxt.e * g.bstride + (size_t)nxt.pn * tstepB + (size_t)nxt.k0 * 2 : cB;
#pragma unroll 1
        for (int t = 0; t < nt; t += 2) {
            const bool last = (t == nt - 2);
            const char* a1 = cA + (size_t)(t + 1) * kstep;
            const char* a2 = last ? nA : cA + (size_t)(t + 2) * kstep; const char* b2 = last ? nB : cB + (size_t)(t + 2) * kstep;
            const char* a3 = a2 + kstep; const char* b3 = b2 + kstep;
            PG8_LDB(B0, 0, 0); PG8_LDB(B1, 0, 1); PG8_SCHED; PG8_LDA(At, 0, 0); PG8_STAGE(PG8_SA(1, 1), a1 + hstepA, voffA);
            PG8_WAIT_V(8); PG8_WAIT_L(0); PG8_BAR; PG8_MMA(0, 0, At, B0); PG8_MMA(0, 1, At, B1); PG8_BAR; PG8_SCHED;
            PG8_LDA(At, 0, 1); PG8_STAGE(PG8_SB(0, 0), b2, voffB); PG8_STAGE(PG8_SB(0, 1), b2 + hstepB, voffB); PG8_STAGE(PG8_SA(0, 0), a2, voffA);
            PG8_WAIT_V(8); PG8_WAIT_L(0); PG8_BAR; PG8_MMA(1, 0, At, B0); PG8_MMA(1, 1, At, B1); PG8_BAR; PG8_SCHED;
            PG8_LDB(B0, 1, 0); PG8_LDB(B1, 1, 1); PG8_SCHED; PG8_LDA(At, 1, 0); PG8_STAGE(PG8_SA(0, 1), a2 + hstepA, voffA);
            PG8_WAIT_V(8); PG8_WAIT_L(0); PG8_BAR; PG8_MMA(0, 0, At, B0); PG8_MMA(0, 1, At, B1); PG8_BAR; PG8_SCHED;
            PG8_LDA(At, 1, 1); PG8_STAGE(PG8_SB(1, 0), b3, voffB); PG8_STAGE(PG8_SB(1, 1), b3 + hstepB, voffB); PG8_STAGE(PG8_SA(1, 0), a3, voffA);
            PG8_WAIT_V(8); PG8_WAIT_L(0); PG8_BAR; PG8_MMA(1, 0, At, B0); PG8_MMA(1, 1, At, B1); PG8_BAR; PG8_SCHED;
        }
        if (wr == 0) PG8_BAR;
        E(acc, cur, wr, wc, fr, fq);
        if (!has_next) break;
#pragma unroll
        for (int a = 0; a < 2; ++a)
#pragma unroll
            for (int b = 0; b < 2; ++b)
#pragma unroll
                for (int m = 0; m < 4; ++m)
#pragma unroll
                    for (int n = 0; n < 2; ++n) acc[a][b][m][n] = (f32x4){0.f, 0.f, 0.f, 0.f};
        cur = nxt; cA = nA; cB = nB; ++ui;
        if (wr == 1) PG8_BAR;
    }
    PG8_WAIT_V(0);
    PG8_BAR;
#undef PG8_SA
#undef PG8_SB
#undef PG8_STAGE
#undef PG8_LDA
#undef PG8_LDB
#undef PG8_MMA
#undef PG8_WAIT_V
#undef PG8_WAIT_L
#undef PG8_BAR
#undef PG8_SCHED
}
#else
DEV unsigned cvt_pk_bf16(float lo, float hi) { return pk2(lo, hi); }
template <class Epi, class Sched>
DEV void gemm_phase(unsigned char*, const int tid, const Gemm g, const Sched& S, const Epi& E) {
    const int wid = tid >> 6, lane = tid & 63, wr = wid >> 2, wc = wid & 3, fr = lane & 15, fq = lane >> 4;
    Unit u;
    for (int ui = 0; S.next(ui, u); ++ui) {
        f32x4 acc[2][2][4][2];
        const bf16* Bt = (const bf16*)((const char*)g.Bt + (size_t)u.e * g.bstride);
        for (int ai = 0; ai < 2; ++ai) for (int bj = 0; bj < 2; ++bj) for (int m = 0; m < 4; ++m) for (int n = 0; n < 2; ++n) for (int j = 0; j < 4; ++j) {
            const size_t row = (size_t)u.pm * 256 + 128 * ai + 64 * wr + 16 * m + fr;
            const size_t col = (size_t)u.pn * 256 + 128 * bj + 32 * wc + (Epi::PERM ? 8 * fq + 4 * n + j : 16 * n + 4 * fq + j);
            const bf16* a = g.A + row * g.lda + u.k0; const bf16* b = Bt + col * g.ldb + u.k0; float s = 0.f;
            for (int k = 0; k < g.K; ++k) s += bf2f(a[k]) * bf2f(b[k]);
            acc[ai][bj][m][n][j] = s; }
        E(acc, u, wr, wc, fr, fq);
    }
}
#endif
}

using pg8::Unit;
struct EpiStore {
    static constexpr bool PERM = true;
    bf16* O; int ldc; float* gates;
    DEV void operator()(const f32x4 (&acc)[2][2][4][2], const Unit& u, int wr, int wc, int fr, int fq) const {
        const int row0 = u.pm * 256 + wr * 64 + fr, col0 = u.pn * 256 + wc * 32 + 8 * fq;
        const bool dog = gates != nullptr && u.pn == C_G / 256 && wc == 0 && fq < 2;
#pragma unroll
        for (int ai = 0; ai < 2; ++ai)
#pragma unroll
            for (int m = 0; m < 4; ++m) { const int row = row0 + ai * 128 + m * 16; bf16* rowp = O + (size_t)row * ldc + col0;
#pragma unroll
                for (int bj = 0; bj < 2; ++bj) { const f32x4 v0 = acc[ai][bj][m][0], v1 = acc[ai][bj][m][1];
                    u32x4 w; w.x = pg8::cvt_pk_bf16(v0[0], v0[1]); w.y = pg8::cvt_pk_bf16(v0[2], v0[3]); w.z = pg8::cvt_pk_bf16(v1[0], v1[1]); w.w = pg8::cvt_pk_bf16(v1[2], v1[3]);
                    *(u32x4*)(rowp + bj * 128) = w;
                    if (bj == 0 && dog) { float* gp = gates + (size_t)row * 16 + 8 * fq; *(f32x4*)gp = v0; *(f32x4*)(gp + 4) = v1; } } }
    }
};
template <bool from_input> struct EpiResid {
    static constexpr bool PERM = true;
    P p; int l, goff;
    DEV void operator()(const f32x4 (&acc)[2][2][4][2], const Unit& u, int wr, int wc, int fr, int fq) const {
        const int R0 = u.pm * 256, bb = R0 / TP, q0 = R0 % TP; const bool isctx = q0 < CTX;
        bf16* xb = resid_row(p, R0); constexpr size_t rs = RPITCH;
        const float* xin = isctx ? p.ctx + (size_t)(bb * CTX + q0) * D_MODEL : p.x + (size_t)(bb * SEQ + q0 - CTX) * D_MODEL;
        const float* gv = modv(p, l, R0) + goff;
        const int col0 = u.pn * 256 + wc * 32 + 8 * fq;
        constexpr int MB = from_input ? 2 : 4;
#pragma unroll
        for (int bj = 0; bj < 2; ++bj) { const int col = col0 + bj * 128; const f32x4 g0 = *(const f32x4*)(gv + col), g1 = *(const f32x4*)(gv + col + 4);
#pragma unroll
            for (int ai = 0; ai < 2; ++ai)
#pragma unroll
                for (int mb = 0; mb < 4; mb += MB) { f32x4 a0[MB], a1[MB];
#pragma unroll
                    for (int mm = 0; mm < MB; ++mm) { const size_t rl = (size_t)(wr * 64 + fr + ai * 128 + (mb + mm) * 16);
                        if (from_input) { a0[mm] = *(const f32x4*)(xin + rl * D_MODEL + col); a1[mm] = *(const f32x4*)(xin + rl * D_MODEL + col + 4); }
                        else { const u32x4 t = *(const u32x4*)(xb + rl * rs + col);
                            a0[mm] = (f32x4){bf2f((bf16)t.x), bf2f((bf16)(t.x >> 16)), bf2f((bf16)t.y), bf2f((bf16)(t.y >> 16))}; a1[mm] = (f32x4){bf2f((bf16)t.z), bf2f((bf16)(t.z >> 16)), bf2f((bf16)t.w), bf2f((bf16)(t.w >> 16))}; } }
#pragma unroll
                    for (int mm = 0; mm < MB; ++mm) { const size_t rl = (size_t)(wr * 64 + fr + ai * 128 + (mb + mm) * 16);
                        const f32x4 o0 = a0[mm] + g0 * acc[ai][bj][mb + mm][0], o1 = a1[mm] + g1 * acc[ai][bj][mb + mm][1];
                        u32x4 wv; wv.x = pg8::cvt_pk_bf16(o0[0], o0[1]); wv.y = pg8::cvt_pk_bf16(o0[2], o0[3]); wv.z = pg8::cvt_pk_bf16(o1[0], o1[1]); wv.w = pg8::cvt_pk_bf16(o1[2], o1[3]);
                        *(u32x4*)(xb + rl * rs + col) = wv; } } }
    }
};
struct EpiSwiglu {
    static constexpr bool PERM = true;
    bf16* O; int pm_base;
    DEV void operator()(const f32x4 (&acc)[2][2][4][2], const Unit& u, int wr, int wc, int fr, int fq) const {
        const int row0 = u.po * 256 + wr * 64 + fr, col0 = u.pn * 128 + wc * 32 + 8 * fq;
#pragma unroll
        for (int ai = 0; ai < 2; ++ai)
#pragma unroll
            for (int m = 0; m < 4; ++m) { float r[8];
#pragma unroll
                for (int n = 0; n < 2; ++n)
#pragma unroll
                    for (int j = 0; j < 4; ++j) r[4 * n + j] = silu_fast(acc[ai][0][m][n][j]) * acc[ai][1][m][n][j];
                u32x4 w; w.x = pg8::cvt_pk_bf16(r[0], r[1]); w.y = pg8::cvt_pk_bf16(r[2], r[3]); w.z = pg8::cvt_pk_bf16(r[4], r[5]); w.w = pg8::cvt_pk_bf16(r[6], r[7]);
                *(u32x4*)(O + (size_t)(row0 + ai * 128 + m * 16) * D_FF + col0) = w; }
    }
};
struct EpiStoreRel {
    static constexpr bool PERM = true;
    bf16* O; int ldc, pm_base;
    DEV void operator()(const f32x4 (&acc)[2][2][4][2], const Unit& u, int wr, int wc, int fr, int fq) const {
        const int row0 = u.po * 256 + wr * 64 + fr, col0 = u.pn * 256 + wc * 32 + 8 * fq;
#pragma unroll
        for (int ai = 0; ai < 2; ++ai)
#pragma unroll
            for (int m = 0; m < 4; ++m) { bf16* rowp = O + (size_t)(row0 + ai * 128 + m * 16) * ldc + col0;
#pragma unroll
                for (int bj = 0; bj < 2; ++bj) { const f32x4 v0 = acc[ai][bj][m][0], v1 = acc[ai][bj][m][1];
                    u32x4 w; w.x = pg8::cvt_pk_bf16(v0[0], v0[1]); w.y = pg8::cvt_pk_bf16(v0[2], v0[3]); w.z = pg8::cvt_pk_bf16(v1[0], v1[1]); w.w = pg8::cvt_pk_bf16(v1[2], v1[3]);
                    *(u32x4*)(rowp + bj * 128) = w; } }
    }
};
template <int mode> struct Sched {
    pg8::Order o; int pm_base; const int* seg; int nNc, kper;
    DEV bool next(int i, Unit& u) const {
        int lm, ln; if (!o.nextL(i, lm, ln)) return false;
        u.pn = ln; u.e = 0; u.k0 = 0; u.po = lm;
        if (mode == 0) u.pm = lm;
        else if (mode == 1) u.pm = (lm / NQL) * PAN_B + 1 + lm % NQL;
        else if (mode == 6) { u.pm = lm; u.k0 = (ln >= 2) ? 256 : 0; }
        else if (mode == 4) { u.pm = lm * PAN_B; u.pn = ln % nNc; u.k0 = (ln / nNc) * kper; u.po = (ln / nNc) * o.nM + lm; }
        else { const int gp = pm_base + lm; int e = 0;
#pragma unroll
            for (int k = 1; k < NEXP; ++k) e += (seg[k] <= gp) ? 1 : 0;
            u.e = e; u.pm = (mode == 2) ? gp : lm;
            if (mode == 5) { u.pn = ln % nNc; u.k0 = (ln / nNc) * kper; u.po = (ln / nNc) * o.nM + lm; } }
        return true;
    }
};

#ifndef WGM_MASK
#define WGM_MASK 0x01f
#endif
#define SITE_WGM(k) (((WGM_MASK >> (k)) & 1) ? 4 : 8)
struct TabSched {
    const int* tab; int n;
    DEV bool next(int i, Unit& u) const {
        if (i >= n) return false;
        u.pm = UNIFORM_I(tab[5 * i]); u.pn = UNIFORM_I(tab[5 * i + 1]); u.e = UNIFORM_I(tab[5 * i + 2]); u.k0 = UNIFORM_I(tab[5 * i + 3]); u.po = UNIFORM_I(tab[5 * i + 4]);
        return true;
    }
};
constexpr int MAX_UNITS = 150;
template <class S> DEV TabSched build_units(unsigned* misc, int tid, const S& sch) {
    int* tab = (int*)(misc + 256);
    __syncthreads();
    if (tid < MAX_UNITS) { Unit u; if (sch.next(tid, u)) { tab[5 * tid] = u.pm; tab[5 * tid + 1] = u.pn; tab[5 * tid + 2] = u.e; tab[5 * tid + 3] = u.k0; tab[5 * tid + 4] = u.po; } }
    __syncthreads();
    const int nwg = sch.o.nwg, c = sch.o.c, G = sch.o.G;
    TabSched t; t.tab = tab; t.n = (c < nwg) ? (nwg - c + G - 1) / G : 0;
    return t;
}

#ifndef EMU
#define XB_TMO      128
#define XB_XCNT(j)  (256  + 64 * (j))
#define XB_XSUB(j)  (1280 + 64 * (j))
#define XB_XGEN(j)  (2304 + 64 * (j))
#define XB_TOP      3328
#define XB_TOPGEN   3392
#define XCD_BAR_WORDS 3456
#define XB_SPIN_CAP (1u << 22)
#define LAS __attribute__((address_space(3)))
__device__ __forceinline__ unsigned xb_ld(unsigned* p)              { return __hip_atomic_load(p, __ATOMIC_RELAXED, __HIP_MEMORY_SCOPE_AGENT); }
__device__ __forceinline__ unsigned xb_add(unsigned* p, unsigned v) { return __hip_atomic_fetch_add(p, v, __ATOMIC_RELAXED, __HIP_MEMORY_SCOPE_AGENT); }
__device__ __forceinline__ unsigned xb_xcc_id() { return (unsigned)__builtin_amdgcn_s_getreg((3 << 11) | 20) & 0xFu; }
#define XB_SPIN(cond, bar) do { unsigned _sp = 0; while (cond) { __builtin_amdgcn_s_sleep(1); \
    if ((++_sp & 255u) == 0u) { if (xb_ld(&(bar)[XB_TMO])) break; if (_sp > XB_SPIN_CAP) { atomicAdd(&(bar)[XB_TMO], 1u); break; } } } } while (0)
struct XcdBarrier { unsigned* bar; unsigned x; volatile LAS unsigned* st; };
__device__ __forceinline__ XcdBarrier xcd_barrier_post(unsigned* bar, volatile LAS unsigned* st) {
    XcdBarrier b; b.bar = bar; b.x = xb_xcc_id(); b.st = st;
    if (threadIdx.x == 0) (void)xb_add(&bar[XB_XCNT(b.x)], 1u);
    return b;
}
__device__ __forceinline__ void xcd_barrier_complete(unsigned* bar, unsigned x, unsigned& nloc, unsigned& nx) {
    const unsigned G = gridDim.x * gridDim.y * gridDim.z;
    unsigned sum, cnt, mine, sp = 0u;
    for (;;) {
        sum = 0u; cnt = 0u; mine = 0u;
#pragma unroll
        for (unsigned j = 0; j < 16; ++j) { const unsigned c = xb_ld(&bar[XB_XCNT(j)]); sum += c; cnt += (c > 0u) ? 1u : 0u; mine = (j == x) ? c : mine; }
        if (sum == G) break;
        __builtin_amdgcn_s_sleep(1);
        if ((++sp & 255u) == 0u) { if (xb_ld(&bar[XB_TMO])) break; if (sp > XB_SPIN_CAP) { atomicAdd(&bar[XB_TMO], 1u); break; } }
    }
    nloc = mine > 0u ? mine : 1u; nx = cnt > 0u ? cnt : 1u;
}
__device__ __forceinline__ void xcd_barrier(const XcdBarrier& b) {
    asm volatile("s_waitcnt vmcnt(0)" ::: "memory");
    __syncthreads();
    if (threadIdx.x == 0) {
        unsigned* bar = b.bar;
        __builtin_amdgcn_s_waitcnt(0);
        unsigned nloc = b.st[0], nx = b.st[1];
        if (nloc == 0u) { xcd_barrier_complete(bar, b.x, nloc, nx); b.st[0] = nloc; b.st[1] = nx; }
        const unsigned old = xb_add(&bar[XB_XSUB(b.x)], 1u);
        const unsigned gen = old / nloc;
        if (old + 1u == (gen + 1u) * nloc) {
            __builtin_amdgcn_fence(__ATOMIC_RELEASE, "agent");
            asm volatile("s_waitcnt vmcnt(0)" ::: "memory");
            const unsigned og = xb_add(&bar[XB_TOP], 1u);
            const unsigned tg = og / nx;
            if (og + 1u == (tg + 1u) * nx) xb_add(&bar[XB_TOPGEN], 1u);
            else XB_SPIN(xb_ld(&bar[XB_TOPGEN]) == tg, bar);
            __builtin_amdgcn_fence(__ATOMIC_ACQUIRE, "agent");
            xb_add(&bar[XB_XGEN(b.x)], 1u);
            asm volatile("s_waitcnt vmcnt(0)" ::: "memory");
        } else {
            XB_SPIN(xb_ld(&bar[XB_XGEN(b.x)]) == gen, bar);
            __builtin_amdgcn_fence(__ATOMIC_ACQUIRE, "agent");
            asm volatile("s_waitcnt vmcnt(0)" ::: "memory");
        }
    }
    __syncthreads();
}
#endif

struct Wg { int tid, lane, wave, G, wg, gw, NGW; unsigned char* lds; unsigned* misc; };
DEV int q_next(Wg& w, unsigned* ctr) {
    if (w.tid == 0) w.misc[2] = atomicAdd(ctr, 1u);
    __syncthreads();
    const int v = (int)w.misc[2];
    __syncthreads();
    return v;
}

struct ConvJob { const float* src; int K, N, Npad; bf16* dst; int ldk, kdst0, rowofs, mode; };
struct ConvTile { const float* src; int N, k0, n0; bf16* dst; int ldk, kdst0, rowofs, mode; bool valid; };
DEV bool conv_job_pick(const ConvJob& j, int& it, ConvTile& t) {
    const int nkb = j.K / 64, nnb = j.Npad / 128, tot = nkb * nnb;
    if (it >= tot) { it -= tot; return false; }
    t.src = j.src; t.N = j.N; t.k0 = (it / nnb) * 64; t.n0 = (it % nnb) * 128; t.dst = j.dst; t.ldk = j.ldk; t.kdst0 = j.kdst0; t.rowofs = j.rowofs; t.mode = j.mode; t.valid = true;
    return true;
}
DEV void conv_load(const ConvTile& t, f32x4 (&v)[4], int tid) {
#pragma unroll
    for (int i = 0; i < 4; ++i) { const int kk = i * 16 + (tid >> 5), c4 = tid & 31; v[i] = (t.valid && t.n0 + 4 * c4 < t.N) ? *(const f32x4*)(t.src + (size_t)(t.k0 + kk) * t.N + t.n0 + 4 * c4) : (f32x4){0.f, 0.f, 0.f, 0.f}; }
}
DEV void conv_store(const ConvTile& t, const f32x4 (&v)[4], float* scr, int tid) {
#pragma unroll
    for (int i = 0; i < 4; ++i) { const int kk = i * 16 + (tid >> 5), c4 = tid & 31; *(f32x4*)(scr + kk * 132 + 4 * c4) = v[i]; }
    __syncthreads();
#pragma unroll
    for (int i = 0; i < 2; ++i) { const int idx = tid + NTHR * i, n = idx >> 3, c = idx & 7, ng = t.n0 + n; const float* s = scr + (8 * c) * 132 + n;
      const int row = t.rowofs + (t.mode == 0 ? ng : (ng / 128) * 256 + (ng % 128) + (t.mode == 2 ? 128 : 0));
      u32x4 o; o.x = pk2(s[0], s[132]); o.y = pk2(s[2 * 132], s[3 * 132]); o.z = pk2(s[4 * 132], s[5 * 132]); o.w = pk2(s[6 * 132], s[7 * 132]);
      *(u32x4*)(t.dst + (size_t)row * t.ldk + t.kdst0 + t.k0 + 8 * c) = o; }
    __syncthreads();
}
DEV void zero_rect(bf16* dst, int ld, int r0, int r1, int c0, int c1, int gtid, int gn) {
    const int cw = (c1 - c0) / 8; const long tot = (long)(r1 - r0) * cw;
    for (long i = gtid; i < tot; i += gn) { const int r = r0 + (int)(i / cw), c = c0 + 8 * (int)(i % cw); *(u32x4*)(dst + (size_t)r * ld + c) = (u32x4){0u, 0u, 0u, 0u}; }
}
DEV void phase0(const P& p, Wg& w) {
    float* scr = (float*)w.lds;
    {
        bf16* WIN = (bf16*)(p.ws + WS_WIN_T); bf16* WOUT = (bf16*)(p.ws + WS_WOUT_T); bf16* MLT = (bf16*)(p.ws + WS_MLA_T);
#define JOB_WIN(l) ConvJob{p.w_in + (size_t)(l) * D_MODEL * IN_W, D_MODEL, IN_W, PROJ_W, WIN + (size_t)(l) * PROJ_W * D_MODEL, D_MODEL, 0, 0, 0}
#define JOB_WOUT(l) ConvJob{p.w_out + (size_t)(l) * MIXW * D_MODEL, MIXW, D_MODEL, D_MODEL, WOUT + (size_t)(l) * D_MODEL * MIXW, MIXW, 0, 0, 0}
#define JOB_WUQ(l) ConvJob{p.l_wuq + (size_t)(l) * 256 * 384, 256, 384, 384, MLT + (size_t)(l) * 1024 * 512, 512, 0, 0, 0}
#define JOB_WUKV(l) ConvJob{p.l_wukv + (size_t)(l) * 128 * 512, 128, 512, 512, MLT + (size_t)(l) * 1024 * 512, 512, 256, 512, 0}
        constexpr int total = 2 * ((D_MODEL / 64) * (PROJ_W / 128) + (MIXW / 64) * (D_MODEL / 128) + 4 * 3 + 2 * 4) + 2 * (D_MODEL / 64) * (D_FF / 128) + (D_FF / 64) * (D_MODEL / 128);
        ConvTile cur, nxt; f32x4 vc[4], vn[4]; cur.valid = false;
#define PICK0(it0_, T) do { int it = (it0_); T.valid = false; if ((it0_) < total) { \
            if (!conv_job_pick(JOB_WIN(0), it, T)) if (!conv_job_pick(JOB_WIN(1), it, T)) if (!conv_job_pick(JOB_WOUT(0), it, T)) if (!conv_job_pick(JOB_WOUT(1), it, T)) \
            if (!conv_job_pick(JOB_WUQ(0), it, T)) if (!conv_job_pick(JOB_WUQ(1), it, T)) if (!conv_job_pick(JOB_WUKV(0), it, T)) if (!conv_job_pick(JOB_WUKV(1), it, T)) \
            if (!conv_job_pick(ConvJob{p.ffn_wg, D_MODEL, D_FF, D_FF, (bf16*)(p.ws + WS_WGU_T), D_MODEL, 0, 0, 1}, it, T)) \
            if (!conv_job_pick(ConvJob{p.ffn_wu, D_MODEL, D_FF, D_FF, (bf16*)(p.ws + WS_WGU_T), D_MODEL, 0, 0, 2}, it, T)) \
            conv_job_pick(ConvJob{p.ffn_wd, D_FF, D_MODEL, D_MODEL, (bf16*)(p.ws + WS_WD_T), D_FF, 0, 0, 0}, it, T); } } while (0)
        PICK0(w.wg, cur); if (cur.valid) conv_load(cur, vc, w.tid);
        for (int it0 = w.wg; it0 < total; it0 += w.G) {
            PICK0(it0 + w.G, nxt); if (nxt.valid) conv_load(nxt, vn, w.tid);
            conv_store(cur, vc, scr, w.tid);
            cur = nxt;
#pragma unroll
            for (int i = 0; i < 4; ++i) vc[i] = vn[i];
        }
#undef PICK0
    }
    for (int l = 0; l < 2; ++l) { bf16* mt = (bf16*)(p.ws + WS_MLA_T) + (size_t)l * 1024 * 512; const int gt = w.wg * NTHR + w.tid, gn = w.G * NTHR;
        zero_rect(mt, 512, 384, 512, 0, 256, gt, gn); zero_rect(mt, 512, 512, 1024, 384, 512, gt, gn); }
    if (w.wg == w.G - 1) for (int i = w.tid; i < NPOS * 24; i += NTHR) { const int pos = i / 24, f = i % 24;
        const float inv = f < 16 ? exp2f(-(float)f * (13.287712379549449f / 16.0f)) : exp2f(-(float)(f - 16) * (13.287712379549449f / 8.0f));
        float sn, cs; sincosf((float)pos * inv, &sn, &cs); float* rt = (float*)(p.ws + WS_ROPE) + 2 * i; rt[0] = cs; rt[1] = sn; }
    {
        float* sS = (float*)w.lds;
        float* part = sS + NV * D_MODEL;
        const int nitem = 2 * (6 * D_MODEL / 64);
        bool loaded = false;
        for (int it = w.wg; it < nitem; it += w.G) {
            if (!loaded) { for (int i = w.tid; i < NV * D_MODEL; i += NTHR) { const int v = i / D_MODEL, k = i % D_MODEL; sS[i] = silu_f(v < BATCH ? p.c[v * D_MODEL + k] : p.c_ctx[k]); } loaded = true; __syncthreads(); }
            const int l = it / (6 * D_MODEL / 64), cb = it % (6 * D_MODEL / 64), col = cb * 64 + w.lane;
            float acc[NV];
#pragma unroll
            for (int v = 0; v < NV; ++v) acc[v] = 0.f;
            const float* mw = p.mod_w + (size_t)l * D_MODEL * 6 * D_MODEL + col;
            for (int k0 = w.wave * (D_MODEL / 8); k0 < (w.wave + 1) * (D_MODEL / 8); k0 += 16) { float wv[16];
#pragma unroll
                for (int kk = 0; kk < 16; ++kk) wv[kk] = mw[(size_t)(k0 + kk) * 6 * D_MODEL];
#pragma unroll
                for (int kk = 0; kk < 16; ++kk)
#pragma unroll
                    for (int v = 0; v < NV; ++v) acc[v] += sS[v * D_MODEL + k0 + kk] * wv[kk]; }
#pragma unroll
            for (int v = 0; v < NV; ++v) part[(w.wave * NV + v) * 64 + w.lane] = acc[v];
            __syncthreads();
            for (int i = w.tid; i < NV * 64; i += NTHR) { const int v = i / 64, cc = i % 64; float s = p.mod_b[(size_t)l * 6 * D_MODEL + cb * 64 + cc];
#pragma unroll
                for (int ww = 0; ww < 8; ++ww) s += part[(ww * NV + v) * 64 + cc];
                ((float*)(p.ws + WS_MODV))[(size_t)(l * NV + v) * 6 * D_MODEL + cb * 64 + cc] = s; }
            __syncthreads();
        }
    }
}
DEV void phase_moe_weights(const P& p, Wg& w) {
    float* scr = (float*)w.lds;
    const int t_gu = (D_MODEL / 64) * (D_FF / 128), t_d = (D_FF / 64) * (D_MODEL / 128), per_e = 2 * t_gu + t_d;
    ConvTile cur, nxt; f32x4 vc[4], vn[4];
#define PICKM(it0_, T) do { T.valid = false; if ((it0_) < NEXP * per_e) { const int e = (it0_) / per_e; int it = (it0_) % per_e; bf16* base = (bf16*)(p.ws + WS_MOEW + (size_t)e * MOEW_E); \
        if (!conv_job_pick(ConvJob{p.moe_wg + (size_t)e * D_MODEL * D_FF, D_MODEL, D_FF, D_FF, base, D_MODEL, 0, 0, 1}, it, T)) \
        if (!conv_job_pick(ConvJob{p.moe_wu + (size_t)e * D_MODEL * D_FF, D_MODEL, D_FF, D_FF, base, D_MODEL, 0, 0, 2}, it, T)) \
        conv_job_pick(ConvJob{p.moe_wd + (size_t)e * D_FF * D_MODEL, D_FF, D_MODEL, D_MODEL, base + (size_t)2 * D_FF * D_MODEL, D_FF, 0, 0, 0}, it, T); } } while (0)
    PICKM(w.wg, cur); if (cur.valid) conv_load(cur, vc, w.tid);
    for (int it0 = w.wg; it0 < NEXP * per_e; it0 += w.G) {
        PICKM(it0 + w.G, nxt); if (nxt.valid) conv_load(nxt, vn, w.tid);
        conv_store(cur, vc, scr, w.tid);
        cur = nxt;
#pragma unroll
        for (int i = 0; i < 4; ++i) vc[i] = vn[i];
    }
#undef PICKM
}

template <int NB> DEV void phase_modulate(const P& p, Wg& w, int l, int which, bool first, bool skip_ctx, bool moe, bool ctx_part) {
    constexpr int NJ = D_MODEL / 256;
    bf16* H = (bf16*)(p.ws + WS_H);
    const float* gn = (which ? p.norm_ffn : p.norm_mix) + (size_t)l * D_MODEL;
    int cnt[NEXP];
#pragma unroll
    for (int e = 0; e < NEXP; ++e) cnt[e] = 0;
    f32x4 rw[NJ * 4][2];
    if (moe) {
#pragma unroll
        for (int j = 0; j < NJ; ++j)
#pragma unroll
            for (int k = 0; k < 4; ++k) { const float* rr = p.moe_router + (size_t)(4 * w.lane + 256 * j + k) * NEXP; rw[4 * j + k][0] = *(const f32x4*)rr; rw[4 * j + k][1] = *(const f32x4*)(rr + 4); } }
    f32x4 gnv[NJ];
#pragma unroll
    for (int j = 0; j < NJ; ++j) gnv[j] = *(const f32x4*)(gn + 4 * w.lane + 256 * j);
    for (int Rb = w.gw; Rb < M_ALL; Rb += NB * w.NGW) {
        f32x4 vv[NB][NJ]; bool okr[NB];
#pragma unroll
        for (int qq = 0; qq < NB; ++qq) { const int R = Rb + qq * w.NGW; okr[qq] = R < M_ALL && !(skip_ctx && (R % TP) < CTX); const int Rr = okr[qq] ? R : Rb;
            const int b = Rr / TP, q = Rr % TP; const bf16* xr = resid_row(p, Rr);
            const float* src = q < CTX ? p.ctx + (size_t)(b * CTX + q) * D_MODEL : p.x + (size_t)(b * SEQ + q - CTX) * D_MODEL;
#pragma unroll
            for (int j = 0; j < NJ; ++j) { const int col = 4 * w.lane + 256 * j;
                if (first) vv[qq][j] = *(const f32x4*)(src + col);
                else { const u32x2 t = *(const u32x2*)(xr + col); vv[qq][j] = (f32x4){bf2f((bf16)t.x), bf2f((bf16)(t.x >> 16)), bf2f((bf16)t.y), bf2f((bf16)(t.y >> 16))}; } } }
#pragma unroll
        for (int qq = 0; qq < NB; ++qq) { if (!okr[qq]) continue;
        const int R = Rb + qq * w.NGW; const int b = R / TP, q = R % TP;
        bf16* xr = resid_row(p, R);
        f32x4 v[NJ]; float ss = 0.f;
#pragma unroll
        for (int j = 0; j < NJ; ++j) { v[j] = vv[qq][j]; ss += v[j][0] * v[j][0] + v[j][1] * v[j][1] + v[j][2] * v[j][2] + v[j][3] * v[j][3]; }
        if (ctx_part && q < CTX) {
            const bf16* cp = (const bf16*)(p.ws + WS_MLAQ) + (size_t)(b * CTX + q) * D_MODEL; const float* gf = (const float*)(p.ws + WS_MODV) + (size_t)((l - 1) * NV + BATCH) * 6 * D_MODEL + 5 * D_MODEL;
            ss = 0.f;
#pragma unroll
            for (int j = 0; j < NJ; ++j) { const int col = 4 * w.lane + 256 * j; f32x4 a = (f32x4){0.f, 0.f, 0.f, 0.f};
                for (int ks = 0; ks < NSPLIT; ++ks) { const u32x2 t = *(const u32x2*)(cp + (size_t)ks * BATCH * CTX * D_MODEL + col);
                    a[0] += bf2f((bf16)t.x); a[1] += bf2f((bf16)(t.x >> 16)); a[2] += bf2f((bf16)t.y); a[3] += bf2f((bf16)(t.y >> 16)); }
                const f32x4 g = *(const f32x4*)(gf + col); v[j] = v[j] + g * a; { u32x2 wb; wb.x = pk2(v[j][0], v[j][1]); wb.y = pk2(v[j][2], v[j][3]); *(u32x2*)(xr + col) = wb; }
                ss += v[j][0] * v[j][0] + v[j][1] * v[j][1] + v[j][2] * v[j][2] + v[j][3] * v[j][3]; } }
        ss = wave_sum(ss, w.lane);
        const float rstd = rsqrt_fast(ss * (1.0f / D_MODEL) + EPS);
        const float* mv = modv(p, l, R); const float* sh = mv + (which ? 3 : 0) * D_MODEL; const float* sc = mv + (which ? 4 : 1) * D_MODEL;
        float lg[NEXP];
#pragma unroll
        for (int e = 0; e < NEXP; ++e) lg[e] = 0.f;
#pragma unroll
        for (int j = 0; j < NJ; ++j) { const int col = 4 * w.lane + 256 * j;
            const f32x4 g = gnv[j], s1 = *(const f32x4*)(sc + col), s0 = *(const f32x4*)(sh + col);
            f32x4 h;
#pragma unroll
            for (int k = 0; k < 4; ++k) h[k] = v[j][k] * rstd * g[k] * (1.0f + s1[k]) + s0[k];
            u32x2 o; o.x = pk2(h[0], h[1]); o.y = pk2(h[2], h[3]);
            *(u32x2*)(H + (size_t)R * D_MODEL + col) = o;
            if (moe) {
#pragma unroll
                for (int k = 0; k < 4; ++k) {
#pragma unroll
                    for (int e = 0; e < NEXP; ++e) lg[e] += h[k] * rw[4 * j + k][e >> 2][e & 3]; } } }
        if (moe) {
#pragma unroll
            for (int e = 0; e < NEXP; ++e) lg[e] = wave_sum(lg[e], w.lane);
            int i1 = 0; float v1 = lg[0];
#pragma unroll
            for (int e = 1; e < NEXP; ++e) if (lg[e] > v1) { v1 = lg[e]; i1 = e; }
            int i2 = -1; float v2 = -3.0e38f;
#pragma unroll
            for (int e = 0; e < NEXP; ++e) if (e != i1 && lg[e] > v2) { v2 = lg[e]; i2 = e; }
            const float w1 = 1.0f / (1.0f + expf(v2 - v1)), w2 = 1.0f - w1;
            const int tok = b * SEQ + q - CTX;
            if (w.lane == 0) { int* ti = (int*)(p.ws + WS_TOPI) + 2 * tok; float* tw = (float*)(p.ws + WS_TOPW) + 2 * tok; ti[0] = i1; ti[1] = i2; tw[0] = w1; tw[1] = w2; }
#pragma unroll
            for (int e = 0; e < NEXP; ++e) cnt[e] += (e == i1 || e == i2) ? 1 : 0;
        }
        }
    }
    if (moe) {
        int* lc = (int*)w.lds;
        if (w.lane == 0) {
#pragma unroll
            for (int e = 0; e < NEXP; ++e) lc[w.wave * NEXP + e] = cnt[e]; }
        __syncthreads();
        if (w.tid < NEXP) { int s = 0; for (int ww = 0; ww < NWAVE; ++ww) s += lc[ww * NEXP + w.tid]; ((int*)(p.ws + WS_CNTG))[w.wg * NEXP + w.tid] = s; }
        __syncthreads();
    }
}

DEV void phase_prep(const P& p, Wg& w, int l) {
    bf16* PROJ = (bf16*)(p.ws + WS_PROJ); bf16* MQK = (bf16*)(p.ws + WS_MQK);
    const float* cw = p.m_conv + (size_t)l * 3 * 768;
    const int lane = w.lane;
    const float gkr = p.l_knorm[l * 96 + 64 + (lane & 31)];
    const f32x4 gcq = *(const f32x4*)(p.l_cq_norm + l * 256 + 4 * lane); const float gkv0 = p.l_ckv_norm[l * 128 + 2 * lane], gkv1 = p.l_ckv_norm[l * 128 + 2 * lane + 1];
    const int hq = lane >> 3, hi8 = lane & 7, hbase = (hq < 6 ? C_AQ + hq * 64 : C_AK + (hq - 6) * 64) + 8 * hi8;
    f32x4 cwv[3][3];
#pragma unroll
    for (int j = 0; j < 3; ++j)
#pragma unroll
        for (int tp = 0; tp < 3; ++tp) cwv[j][tp] = *(const f32x4*)(cw + tp * 768 + 4 * lane + 256 * j);
    float gh[8];
    { const float* gp = (hq < 6 ? p.a_qnorm : p.a_knorm) + l * 64 + 8 * hi8;
#pragma unroll
      for (int j = 0; j < 8; ++j) gh[j] = gp[j] * (hq < 6 ? QSCALE_A : 1.0f); }
    const float* rtab = (const float*)(p.ws + WS_ROPE);
    constexpr int NB = 4;
    const int RPW = (M_ALL + w.NGW - 1) / w.NGW, Rend = ((w.gw + 1) * RPW < M_ALL) ? (w.gw + 1) * RPW : M_ALL;
    for (int R0 = w.gw * RPW; R0 < Rend; R0 += NB) {
        u32x2 c0[NB][3], cp[NB][3], cn[NB][3], cprev[3], cnext[3]; u32x4 hraw[NB]; u32x2 cqv[NB]; unsigned ckvv[NB]; bf16 krv[NB]; bool ok[NB];
        { const bool hpv = R0 > 0, hnv = R0 + NB < M_ALL;
#pragma unroll
          for (int j = 0; j < 3; ++j) { const int col = 4 * lane + 256 * j;
              cprev[j] = hpv ? *(const u32x2*)(PROJ + (size_t)(R0 - 1) * PROJ_W + col) : (u32x2){0u, 0u}; cnext[j] = hnv ? *(const u32x2*)(PROJ + (size_t)(R0 + NB) * PROJ_W + col) : (u32x2){0u, 0u}; } }
#pragma unroll
        for (int q = 0; q < NB; ++q) { const int R = R0 + q; ok[q] = R < Rend; const int Rr = R < M_ALL ? R : R0;
            const bf16* pr = PROJ + (size_t)Rr * PROJ_W;
#pragma unroll
            for (int j = 0; j < 3; ++j) c0[q][j] = *(const u32x2*)(pr + 4 * lane + 256 * j);
            hraw[q] = *(const u32x4*)(pr + hbase); cqv[q] = *(const u32x2*)(pr + C_CQ + 4 * lane); ckvv[q] = *(const unsigned*)(pr + C_CKV + 2 * lane); krv[q] = pr[C_KR + (lane & 31)]; }
#pragma unroll
        for (int q = 0; q < NB; ++q) { const int qq = (R0 + q) % TP; const bool hp = !(qq == 0 || qq == CTX), hn = !(qq == CTX - 1 || qq == TP - 1);
#pragma unroll
            for (int j = 0; j < 3; ++j) { const u32x2 a = (q == 0) ? cprev[j] : c0[q > 0 ? q - 1 : 0][j], n = (q == NB - 1) ? cnext[j] : c0[q < NB - 1 ? q + 1 : 0][j];
                cp[q][j] = hp ? a : (u32x2){0u, 0u}; cn[q][j] = hn ? n : (u32x2){0u, 0u}; } }
#pragma unroll
        for (int q = 0; q < NB; ++q) { const int Rr = (R0 + q < M_ALL) ? R0 + q : R0; const int qq = Rr % TP; const bool lat = qq >= CTX; const int t = qq - CTX;
            bf16* pr = PROJ + (size_t)Rr * PROJ_W;
            u32x2 ov[3];
#pragma unroll
            for (int j = 0; j < 3; ++j) { const int col = 4 * lane + 256 * j; float o[4];
#pragma unroll
                for (int k = 0; k < 4; ++k) { const unsigned sh = (k & 1) * 16; const unsigned a = (k < 2 ? cp[q][j].x : cp[q][j].y) >> sh, c = (k < 2 ? c0[q][j].x : c0[q][j].y) >> sh, n = (k < 2 ? cn[q][j].x : cn[q][j].y) >> sh;
                    const float sv = bf2f((bf16)a) * cwv[j][0][k] + bf2f((bf16)c) * cwv[j][1][k] + bf2f((bf16)n) * cwv[j][2][k]; o[k] = silu_fast(sv) * (col >= 384 ? KSCALE_M : 1.0f); }
                ov[j].x = pk2(o[0], o[1]); ov[j].y = pk2(o[2], o[3]); }
            u32x4 oh;
            { float x[8], ss = 0.f;
#pragma unroll
              for (int j = 0; j < 8; ++j) { x[j] = bf2f((bf16)(hraw[q][j >> 1] >> ((j & 1) * 16))); ss += x[j] * x[j]; }
              ss += SHX(ss, 1, lane); ss += SHX(ss, 2, lane); ss += SHX(ss, 4, lane);
              const float rs = rsqrt_fast(ss * (1.0f / 64.0f) + EPS);
#pragma unroll
              for (int j = 0; j < 8; ++j) x[j] *= rs * gh[j];
              const float* ct = rtab + ((size_t)(lat ? (hi8 < 4 ? t / GRID_W : t % GRID_W) : 0) * 24 + 8 * (hi8 & 1)) * 2;
              const f32x4 t0 = *(const f32x4*)ct, t1 = *(const f32x4*)(ct + 4), t2 = *(const f32x4*)(ct + 8), t3 = *(const f32x4*)(ct + 12);
              const float csv[8] = {t0[0], t0[2], t1[0], t1[2], t2[0], t2[2], t3[0], t3[2]}, snv[8] = {t0[1], t0[3], t1[1], t1[3], t2[1], t2[3], t3[1], t3[3]};
#pragma unroll
              for (int j = 0; j < 8; ++j) { const float pt = SHX(x[j], 2, lane);
                  if (lat) x[j] = (hi8 & 2) ? x[j] * csv[j] + pt * snv[j] : x[j] * csv[j] - pt * snv[j]; }
              oh.x = pk2(x[0], x[1]); oh.y = pk2(x[2], x[3]); oh.z = pk2(x[4], x[5]); oh.w = pk2(x[6], x[7]); }
            float csL = 1.f, snL = 0.f;
            if (lat) { const int d = lane & 31; const float* ct = rtab + ((size_t)(d < 16 ? t / GRID_W : t % GRID_W) * 24 + 16 + (d & 7)) * 2; csL = ct[0]; snL = ct[1]; }
            u32x2 ocq; unsigned ockv; float ykr;
            { float x[4] = {bf2f((bf16)cqv[q].x), bf2f((bf16)(cqv[q].x >> 16)), bf2f((bf16)cqv[q].y), bf2f((bf16)(cqv[q].y >> 16))};
              const float x0 = bf2f((bf16)ckvv[q]), x1 = bf2f((bf16)(ckvv[q] >> 16)); const float vk = lane < 32 ? bf2f(krv[q]) : 0.f;
              float s1 = x[0] * x[0] + x[1] * x[1] + x[2] * x[2] + x[3] * x[3], s2 = x0 * x0 + x1 * x1, s3 = vk * vk;
#pragma unroll
              for (int o = 1; o < 64; o <<= 1) { s1 += SHX(s1, o, lane); s2 += SHX(s2, o, lane); s3 += SHX(s3, o, lane); }
              const float r1 = rsqrt_fast(s1 * (1.0f / 256.0f) + EPS), r2 = rsqrt_fast(s2 * (1.0f / 128.0f) + EPS), r3 = rsqrt_fast(s3 * (1.0f / 32.0f) + EPS);
              ocq.x = pk2(x[0] * r1 * gcq[0], x[1] * r1 * gcq[1]); ocq.y = pk2(x[2] * r1 * gcq[2], x[3] * r1 * gcq[3]);
              ockv = pk2(x0 * r2 * gkv0, x1 * r2 * gkv1);
              float y = vk * r3 * gkr; const float pt = SHX(y, 8, lane);
              if (lat) y = (lane & 8) ? y * csL + pt * snL : y * csL - pt * snL;
              ykr = y; }
            if (ok[q]) {
#pragma unroll
                for (int j = 0; j < 3; ++j) *(u32x2*)(MQK + (size_t)Rr * 768 + 4 * lane + 256 * j) = ov[j];
                *(u32x4*)(pr + hbase) = oh;
                *(u32x2*)(pr + C_CQ + 4 * lane) = ocq; *(unsigned*)(pr + C_CKV + 2 * lane) = ockv;
                if (lane < 32) pr[C_KR + lane] = f2bf(ykr); }
        }
    }
}

DEV float scan_add(float v, int lane) {
#pragma unroll
    for (int d = 1; d < 64; d <<= 1) { const float t = __shfl(v, lane >= d ? lane - d : lane); if (lane >= d) v += t; }
    return v;
}
DEV float scan_max(float v, int lane) {
#pragma unroll
    for (int d = 1; d < 64; d <<= 1) { const float t = __shfl(v, lane >= d ? lane - d : lane); if (lane >= d) v = fmaxf(v, t); }
    return v;
}
DEV int chain_step(int dir, int cl) { return dir == 0 ? cl : (cl < NC_CTX ? NC_CTX - 1 - cl : NCH + NC_CTX - 1 - cl); }
DEV void gate_scan2(const P& p, int l, int R0, int hh, int dir, int lane, float* al, float* pm, float* bcl, float& F, float& pml) {
    static_assert(MCH == 128, "two positions per lane");
    const float* gb = p.m_gate_b + l * 16; float gi[2], lf[2];
#pragma unroll
    for (int e = 0; e < 2; ++e) { const int j = 2 * lane + e, o = dir ? MCH - 1 - j : j;
        const float* G = (const float*)(p.ws + WS_GATES) + (size_t)(R0 + o) * 16;
        gi[e] = G[dir * 8 + hh] + gb[dir * 8 + hh]; lf[e] = log_sigmoid_f(G[dir * 8 + 4 + hh] + gb[dir * 8 + 4 + hh]); }
    const float incl = scan_add(lf[0] + lf[1], lane);
    const float up1 = __shfl(incl, lane ? lane - 1 : 0), excl = lane ? up1 : 0.f;
    const float bc0 = excl + lf[0], bc1 = incl, a0 = gi[0] - bc0, a1 = gi[1] - bc1;
    const float pin = scan_max(fmaxf(a0, a1), lane);
    const float pu = __shfl(pin, lane ? lane - 1 : 0), px0 = lane ? fmaxf(pu, a0) : a0;
    F = __shfl(incl, 63); pml = __shfl(pin, 63);
    { const int o0 = dir ? MCH - 1 - 2 * lane : 2 * lane, o1 = dir ? o0 - 1 : o0 + 1;
      al[o0] = a0; pm[o0] = px0; bcl[o0] = bc0; al[o1] = a1; pm[o1] = pin; bcl[o1] = bc1; }
}
DEV void ml1_item(const P& p, Wg& w, int l, int item) {
    const int b = item / (4 * NCH), hh = (item / NCH) % 4, cl = item % NCH, R0 = b * TP + cl * MCH;
    float* wgt = (float*)w.lds;
    float* scr = wgt + 2 * MCH;
    bf16* Ks = (bf16*)(w.lds + 4096);
    bf16* Vw = Ks + MCH * 104;
    const bf16* MQK = (const bf16*)(p.ws + WS_MQK); const bf16* PROJ = (const bf16*)(p.ws + WS_PROJ);
    bf16* UC = (bf16*)(p.ws + WS_UC); float* NL = (float*)(p.ws + WS_NL);
    const int lane = w.lane, r = lane & 31, h = lane >> 5;
    static_assert(MCH * 12 == 3 * NTHR, "three k/v vectors per thread");
    u32x4 kq[3], vq[3];
#pragma unroll
    for (int q = 0; q < 3; ++q) { const int idx = w.tid + q * NTHR, s = idx / 12, c = idx % 12;
        kq[q] = *(const u32x4*)(MQK + (size_t)(R0 + s) * 768 + 384 + hh * 96 + 8 * c); vq[q] = *(const u32x4*)(PROJ + (size_t)(R0 + s) * PROJ_W + C_MV + hh * 96 + 8 * c); }
    if (w.wave < 2) { const int dir = w.wave; float F, pml; float* sc = scr + dir * 3 * MCH;
        gate_scan2(p, l, R0, hh, dir, lane, sc, sc + MCH, sc + 2 * MCH, F, pml);
        wave_sync();
#pragma unroll
        for (int hf = 0; hf < 2; ++hf) wgt[dir * MCH + lane + 64 * hf] = __expf(sc[lane + 64 * hf] - pml);
        const int ci = ((b * 4 + hh) * 2 + dir) * NCH + chain_step(dir, cl);
        if (lane == 0) { ((float*)(p.ws + WS_FS))[ci] = F; ((float*)(p.ws + WS_PML))[ci] = pml; } }
    __syncthreads();
#pragma unroll
    for (int q = 0; q < 3; ++q) { const int idx = w.tid + q * NTHR, s = idx / 12, c = idx % 12;
        const u32x4 kr = kq[q], vr = vq[q];
        *(u32x4*)(Ks + s * 104 + 8 * c) = kr;
#pragma unroll
        for (int dir = 0; dir < 2; ++dir) { const float wd = wgt[dir * MCH + s]; u32x4 o;
            o.x = pk2(wd * bf2f((bf16)vr.x), wd * bf2f((bf16)(vr.x >> 16))); o.y = pk2(wd * bf2f((bf16)vr.y), wd * bf2f((bf16)(vr.y >> 16)));
            o.z = pk2(wd * bf2f((bf16)vr.z), wd * bf2f((bf16)(vr.z >> 16))); o.w = pk2(wd * bf2f((bf16)vr.w), wd * bf2f((bf16)(vr.w >> 16)));
            *(u32x4*)(Vw + (dir * MCH + s) * 104 + 8 * c) = o;
            if (c == 0) Vw[(dir * MCH + s) * 104 + 96] = f2bf(wd); } }
    __syncthreads();
    const int toff = (8 * h + ((lane & 15) >> 2)) * 104 + 16 * ((lane >> 4) & 1) + 4 * (lane & 3);
    for (int task = w.wave; task < 24; task += NWAVE) {
        const bool nt = task >= 18; const int tt = nt ? task - 18 : task;
        const int dir = nt ? tt / 3 : tt / 9, dt = nt ? tt % 3 : (tt % 9) / 3, et = nt ? 3 : tt % 3;
        f32x16 acc;
#pragma unroll
        for (int i = 0; i < 16; ++i) acc[i] = 0.f;
#pragma unroll
        for (int ks = 0; ks < MCH / 16; ++ks) { const bf16* ap = Ks + (16 * ks) * 104 + 32 * dt + toff; const bf16* bp = Vw + (dir * MCH + 16 * ks) * 104 + 32 * et + toff;
            const s16x4 al = lds_tr_read(ap), ah = lds_tr_read(ap + 4 * 104), bl = lds_tr_read(bp), bh = lds_tr_read(bp + 4 * 104);
            const bf16x8 af = (bf16x8){al[0], al[1], al[2], al[3], ah[0], ah[1], ah[2], ah[3]}, bfr = (bf16x8){bl[0], bl[1], bl[2], bl[3], bh[0], bh[1], bh[2], bh[3]};
            acc = mfma32(af, bfr, acc); }
        const int ci = ((b * 4 + hh) * 2 + dir) * NCH + chain_step(dir, cl);
        if (!nt) { bf16* up = UC + (size_t)ci * 9216 + (32 * et + r) * 96 + 32 * dt + 4 * h;
#pragma unroll
            for (int g = 0; g < 4; ++g) { u32x2 o; o.x = pk2(acc[4 * g], acc[4 * g + 1]); o.y = pk2(acc[4 * g + 2], acc[4 * g + 3]); *(u32x2*)(up + 8 * g) = o; } }
        else if (r == 0) { float* np = NL + (size_t)ci * 96 + 32 * dt + 4 * h;
#pragma unroll
            for (int g = 0; g < 4; ++g) *(f32x4*)(np + 8 * g) = (f32x4){acc[4 * g], acc[4 * g + 1], acc[4 * g + 2], acc[4 * g + 3]}; } }
    __syncthreads();
}
DEV void phase_ml2(const P& p, Wg& w) {
    constexpr int GPC = 1152 + 12;
    bf16* UC = (bf16*)(p.ws + WS_UC); float* NL = (float*)(p.ws + WS_NL);
    const float* FS = (const float*)(p.ws + WS_FS); const float* PML = (const float*)(p.ws + WS_PML); float* MST = (float*)(p.ws + WS_MST);
    for (int j = w.wg * NTHR + w.tid; j < NCHAIN * GPC; j += w.G * NTHR) {
        const int chain = j / GPC, g = j % GPC;
        float C[8], m = 0.f;
#pragma unroll
        for (int i = 0; i < 8; ++i) C[i] = 0.f;
        for (int k0 = 0; k0 < NCH; k0 += ML2_U) {
            float Fv[ML2_U], pv[ML2_U];
#pragma unroll
            for (int q = 0; q < ML2_U; ++q) { Fv[q] = FS[chain * NCH + k0 + q]; pv[q] = PML[chain * NCH + k0 + q]; }
            if (g < 1152) { u32x4 raw[ML2_U];
#pragma unroll
                for (int q = 0; q < ML2_U; ++q) raw[q] = *(const u32x4*)(UC + (size_t)(chain * NCH + k0 + q) * 9216 + 8 * g);
#pragma unroll
                for (int q = 0; q < ML2_U; ++q) { const int ci = chain * NCH + k0 + q; const float mx = fmaxf(m, pv[q]), dec = __expf(m - mx), sc = __expf(pv[q] - mx);
                    u32x4 st; st.x = pk2(C[0], C[1]); st.y = pk2(C[2], C[3]); st.z = pk2(C[4], C[5]); st.w = pk2(C[6], C[7]); *(u32x4*)(UC + (size_t)ci * 9216 + 8 * g) = st;
#pragma unroll
                    for (int i = 0; i < 8; ++i) C[i] = dec * C[i] + sc * bf2f((bf16)(raw[q][i >> 1] >> ((i & 1) * 16)));
                    if (g == 0) MST[ci] = m;
                    m = Fv[q] + mx; } }
            else {
                for (int q = 0; q < ML2_U; ++q) { float* nl = NL + (size_t)(chain * NCH + k0 + q) * 96 + 8 * (g - 1152); const f32x4 r0 = *(const f32x4*)nl, r1 = *(const f32x4*)(nl + 4);
                    const float mx = fmaxf(m, pv[q]), dec = __expf(m - mx), sc = __expf(pv[q] - mx);
                    *(f32x4*)nl = (f32x4){C[0], C[1], C[2], C[3]}; *(f32x4*)(nl + 4) = (f32x4){C[4], C[5], C[6], C[7]};
#pragma unroll
                    for (int i = 0; i < 4; ++i) { C[i] = dec * C[i] + sc * r0[i]; C[4 + i] = dec * C[4 + i] + sc * r1[i]; }
                    m = Fv[q] + mx; } }
        }
    }
}
DEV void ml3_item(const P& p, Wg& w, int l, int item) {
    const int lane = w.lane, r = lane & 31, h = lane >> 5, dir = w.wave >> 2, tq = w.wave & 3;
    const int b = item / (4 * NCH), hh = (item / NCH) % 4, cl = item % NCH, R0 = b * TP + cl * MCH;
    const int ci = ((b * 4 + hh) * 2 + dir) * NCH + chain_step(dir, cl);
    bf16* Qs = (bf16*)w.lds;
    bf16* Ksm = Qs + MCH * 104;
    bf16* Vs = Ksm + MCH * 104;
    float* nls = (float*)(w.lds + 3 * MCH * 104 * 2);
    float* scn = nls + 192;
    float* hx = (float*)w.lds;
    const bf16* MQK = (const bf16*)(p.ws + WS_MQK); const bf16* PROJ = (const bf16*)(p.ws + WS_PROJ);
    const bf16* UCi = (const bf16*)(p.ws + WS_UC) + (size_t)ci * 9216;
    for (int idx = w.tid; idx < MCH * 12; idx += NTHR) { const int s = idx / 12, c = idx % 12;
        const u32x4 qv = *(const u32x4*)(MQK + (size_t)(R0 + s) * 768 + hh * 96 + 8 * c), kv = *(const u32x4*)(MQK + (size_t)(R0 + s) * 768 + 384 + hh * 96 + 8 * c),
                    vv = *(const u32x4*)(PROJ + (size_t)(R0 + s) * PROJ_W + C_MV + hh * 96 + 8 * c);
        *(u32x4*)(Qs + s * 104 + 8 * c) = qv; *(u32x4*)(Ksm + s * 104 + 8 * c) = kv; *(u32x4*)(Vs + s * 104 + 8 * c) = vv; }
    if (w.tid < 192) { const int dd = w.tid / 96; nls[w.tid] = ((const float*)(p.ws + WS_NL))[(size_t)(((b * 4 + hh) * 2 + dd) * NCH + chain_step(dd, cl)) * 96 + w.tid % 96]; }
    if (tq == 0) { float F, pml; float* sc = scn + dir * 3 * MCH; gate_scan2(p, l, R0, hh, dir, lane, sc, sc + MCH, sc + 2 * MCH, F, pml); }
    const float m_st = ((const float*)(p.ws + WS_MST))[ci];
    __syncthreads();
    const float* al = scn + dir * 3 * MCH; const float* pmv = al + MCH; const float* bcl = al + 2 * MCH;
    const int t = 32 * tq + r;
    const float mx_t = fmaxf(m_st, pmv[t]), bc_t = bcl[t];
    bf16x8 qf[6]; float qn = 0.f;
#pragma unroll
    for (int ks = 0; ks < 6; ++ks) { qf[ks] = *(const bf16x8*)(Qs + t * 104 + 16 * ks + 8 * h);
        const f32x4 n0 = *(const f32x4*)(nls + dir * 96 + 16 * ks + 8 * h), n1 = *(const f32x4*)(nls + dir * 96 + 16 * ks + 8 * h + 4);
#pragma unroll
        for (int j = 0; j < 4; ++j) { qn += bf2f((bf16)qf[ks][j]) * n0[j]; qn += bf2f((bf16)qf[ks][4 + j]) * n1[j]; } }
    qn += SHX(qn, 32, lane);
    f32x16 o[3]; float rs = 0.f;
#pragma unroll
    for (int et = 0; et < 3; ++et)
#pragma unroll
        for (int i = 0; i < 16; ++i) o[et][i] = 0.f;
    for (int kb = dir ? tq : 0; kb < (dir ? NQB : tq + 1); ++kb) {
        f32x16 pw;
#pragma unroll
        for (int i = 0; i < 16; ++i) pw[i] = 0.f;
#pragma unroll
        for (int ks = 0; ks < 6; ++ks) { const bf16x8 kf = *(const bf16x8*)(Ksm + (32 * kb + r) * 104 + 16 * ks + 8 * h); pw = mfma32(kf, qf[ks], pw); }
#pragma unroll
        for (int g = 0; g < 4; ++g) { const int s0 = 32 * kb + 8 * g + 4 * h; const f32x4 av = *(const f32x4*)(al + s0);
#pragma unroll
            for (int j = 0; j < 4; ++j) { const int sidx = s0 + j; const bool okk = dir ? (sidx >= t) : (sidx <= t);
                const float wv = okk ? __expf(av[j] - mx_t) * pw[4 * g + j] : 0.f; pw[4 * g + j] = wv; rs += wv; } }
        bf16x8 pb[2];
#pragma unroll
        for (int sp = 0; sp < 2; ++sp) { u32x4 u; u.x = pk2(pw[8 * sp], pw[8 * sp + 1]); u.y = pk2(pw[8 * sp + 2], pw[8 * sp + 3]); u.z = pk2(pw[8 * sp + 4], pw[8 * sp + 5]); u.w = pk2(pw[8 * sp + 6], pw[8 * sp + 7]);
            pb[sp] = __builtin_bit_cast(bf16x8, u); }
#pragma unroll
        for (int et = 0; et < 3; ++et)
#pragma unroll
            for (int sp = 0; sp < 2; ++sp) { const bf16* vp = Vs + (32 * kb + 16 * sp + 4 * h + ((lane & 15) >> 2)) * 104 + 32 * et + 16 * ((lane >> 4) & 1) + 4 * (lane & 3);
                const s16x4 lo = lds_tr_read(vp), hi = lds_tr_read(vp + 8 * 104);
                const bf16x8 vf = (bf16x8){lo[0], lo[1], lo[2], lo[3], hi[0], hi[1], hi[2], hi[3]};
                o[et] = mfma32(vf, pb[sp], o[et]); }
    }
    rs += SHX(rs, 32, lane);
    const float a_int = __expf(m_st - mx_t), den = a_int * qn + rs, inv = 1.0f / fmaxf(fabsf(den), __expf(-(bc_t + mx_t)));
#pragma unroll
    for (int et = 0; et < 3; ++et) { f32x16 oi;
#pragma unroll
        for (int i = 0; i < 16; ++i) oi[i] = 0.f;
#pragma unroll
        for (int ks = 0; ks < 6; ++ks) { const bf16x8 cf = *(const bf16x8*)(UCi + (32 * et + r) * 96 + 16 * ks + 8 * h); oi = mfma32(cf, qf[ks], oi); }
#pragma unroll
        for (int i = 0; i < 16; ++i) o[et][i] = (a_int * oi[i] + o[et][i]) * inv; }
    __syncthreads();
    if (dir == 1) {
#pragma unroll
        for (int et = 0; et < 3; ++et)
#pragma unroll
            for (int i = 0; i < 16; ++i) hx[t * 97 + 32 * et + crow(i, h)] = o[et][i]; }
    __syncthreads();
    if (dir == 0) { float ss = 0.f;
#pragma unroll
        for (int et = 0; et < 3; ++et)
#pragma unroll
            for (int i = 0; i < 16; ++i) { o[et][i] += hx[t * 97 + 32 * et + crow(i, h)]; ss += o[et][i] * o[et][i]; }
        ss += SHX(ss, 32, lane);
        const float rstd = rsqrt_fast(ss * (1.0f / 96.0f) + EPS);
        bf16* MIX = (bf16*)(p.ws + WS_H);
#pragma unroll
        for (int et = 0; et < 3; ++et)
#pragma unroll
            for (int g = 0; g < 4; ++g) { const int e = 32 * et + 8 * g + 4 * h;
                const u32x2 og = *(const u32x2*)(PROJ + (size_t)(R0 + t) * PROJ_W + C_MO + hh * 96 + e); const f32x4 mn = *(const f32x4*)(p.m_norm + l * 384 + hh * 96 + e);
                float o4[4];
#pragma unroll
                for (int j = 0; j < 4; ++j) { const float gate = bf2f((bf16)((j < 2 ? og.x : og.y) >> ((j & 1) * 16))); o4[j] = o[et][4 * g + j] * rstd * mn[j] * sigmoid_f(gate); }
                u32x2 ov; ov.x = pk2(o4[0], o4[1]); ov.y = pk2(o4[2], o4[3]);
                *(u32x2*)(MIX + (size_t)(R0 + t) * MIXW + hh * 96 + e) = ov; } }
    __syncthreads();
}

DEV void phase_mla_post(const P& p, Wg& w, int l) {
    bf16* MLAQ = (bf16*)(p.ws + WS_MLAQ); const bf16* PROJ = (const bf16*)(p.ws + WS_PROJ);
    const int lane = w.lane;
    int baseA = 0, nA = 8, dstA = 8 * lane; bool normA = true, ropeA = false; const float* gA = p.l_qnorm + l * 96;
    if (lane < 48) { const int hh = lane / 12, o = lane % 12;
        if (o < 8) { baseA = 12 * hh; nA = 8; gA = p.l_qnorm + l * 96 + 8 * o; }
        else { baseA = 12 * hh + 8; nA = 4; gA = p.l_qnorm + l * 96 + 64 + 8 * (o - 8); ropeA = true; } }
    else { normA = false; }
    const int hb = lane / 16, ob = lane % 16; const bool normB = ob < 8;
    const int baseB = (16 * (lane / 16)) & 63;
    const int dstB = normB ? 384 + 96 * hb + 8 * ob : 768 + 64 * hb + 8 * (ob - 8);
    const float* gB = p.l_knorm + l * 96 + 8 * (ob & 7);
    float gAv[8], gBv[8];
#pragma unroll
    for (int j = 0; j < 8; ++j) { gAv[j] = gA[j]; gBv[j] = gB[j]; }
    const int cidx = (lane % 12) - 8;
    constexpr int NB = 2;
    for (int R0 = w.gw; R0 < M_ALL; R0 += NB * w.NGW) {
        u32x4 ra[NB], rb[NB], kr[NB]; bool ok[NB];
#pragma unroll
        for (int q = 0; q < NB; ++q) { const int R = R0 + q * w.NGW; ok[q] = R < M_ALL; const int Rr = ok[q] ? R : R0; const bf16* row = MLAQ + (size_t)Rr * 1024;
            ra[q] = *(const u32x4*)(row + 8 * lane); rb[q] = *(const u32x4*)(row + 512 + 8 * lane);
            kr[q] = (lane >= 48) ? *(const u32x4*)(PROJ + (size_t)Rr * PROJ_W + C_KR + 8 * ((lane - 48) & 3)) : (u32x4){0u, 0u, 0u, 0u}; }
        u32x4 oa[NB], obv[NB];
#pragma unroll
        for (int q = 0; q < NB; ++q) { const int Rr = ok[q] ? R0 + q * w.NGW : R0; const int qq = Rr % TP; const bool lat = qq >= CTX; const int t = qq - CTX;
            float xa[8], xb[8], ssA = 0.f, ssB = 0.f;
#pragma unroll
            for (int j = 0; j < 8; ++j) { xa[j] = bf2f((bf16)(ra[q][j >> 1] >> ((j & 1) * 16))); xb[j] = bf2f((bf16)(rb[q][j >> 1] >> ((j & 1) * 16))); ssA += xa[j] * xa[j]; ssB += xb[j] * xb[j]; }
            float sA = 0.f, sB = 0.f;
#pragma unroll
            for (int i = 0; i < 8; ++i) { const float v = __shfl(ssA, (baseA + i) & 63); if (i < nA) sA += v; sB += __shfl(ssB, (baseB + i) & 63); }
            const float rsA = normA ? rsqrt_fast(sA / (float)(8 * nA) + EPS) : 1.0f, rsB = normB ? rsqrt_fast(sB * (1.0f / 64.0f) + EPS) : 1.0f;
#pragma unroll
            for (int j = 0; j < 8; ++j) { xa[j] = normA ? xa[j] * rsA * gAv[j] : xa[j]; xb[j] = normB ? xb[j] * rsB * gBv[j] : xb[j]; }
            const float* ct = (const float*)(p.ws + WS_ROPE) + ((size_t)(lat ? ((cidx & 3) < 2 ? t / GRID_W : t % GRID_W) : 0) * 24 + 16) * 2;
            const f32x4 t0 = *(const f32x4*)ct, t1 = *(const f32x4*)(ct + 4), t2 = *(const f32x4*)(ct + 8), t3 = *(const f32x4*)(ct + 12);
            const float csv[8] = {t0[0], t0[2], t1[0], t1[2], t2[0], t2[2], t3[0], t3[2]}, snv[8] = {t0[1], t0[3], t1[1], t1[3], t2[1], t2[3], t3[1], t3[3]};
#pragma unroll
            for (int j = 0; j < 8; ++j) { const float pt = SHX(xa[j], 1, lane);
                if (ropeA && lat) xa[j] = (cidx & 1) ? xa[j] * csv[j] + pt * snv[j] : xa[j] * csv[j] - pt * snv[j]; }
            if (lane < 48) {
#pragma unroll
                for (int j = 0; j < 8; ++j) xa[j] *= QSCALE_L; }
            oa[q].x = pk2(xa[0], xa[1]); oa[q].y = pk2(xa[2], xa[3]); oa[q].z = pk2(xa[4], xa[5]); oa[q].w = pk2(xa[6], xa[7]);
            obv[q].x = pk2(xb[0], xb[1]); obv[q].y = pk2(xb[2], xb[3]); obv[q].z = pk2(xb[4], xb[5]); obv[q].w = pk2(xb[6], xb[7]); }
        wave_sync();
#pragma unroll
        for (int q = 0; q < NB; ++q) if (ok[q]) { bf16* row = MLAQ + (size_t)(R0 + q * w.NGW) * 1024;
            if (lane < 48) *(u32x4*)(row + dstA) = oa[q];
            else { const int i = lane - 48; *(u32x4*)(row + 384 + 96 * (i >> 2) + 64 + 8 * (i & 3)) = kr[q]; }
            *(u32x4*)(row + dstB) = obv[q]; }
        wave_sync();
    }
}

template <int DQK>
DEV void attn_unit(const bf16* Q, int ldq, const bf16* K, int ldk, const bf16* V, int ldv, bf16* O, int ldo, int nkeys, Wg& w) {
    constexpr int KS = DQK + 8, NKD = DQK / 16, CPR = DQK / 8, NKC = 64 * CPR, VS = 72;
    bf16* Ks = (bf16*)w.lds;
    bf16* Vs = (bf16*)(w.lds + 2 * 64 * KS * 2);
    const int tid = w.tid, lane = w.lane, r = lane & 31, h = lane >> 5;
    bf16x8 qr[NKD];
    { const bf16* qp = Q + (size_t)(w.wave * 32 + r) * ldq + 8 * h;
#pragma unroll
      for (int d0 = 0; d0 < NKD; ++d0) qr[d0] = *(const bf16x8*)(qp + 16 * d0); }
    const int kr0 = tid / CPR, kc0 = tid % CPR, kr1 = (tid + NTHR) / CPR, kc1 = (tid + NTHR) % CPR; const bool k1 = (tid + NTHR) < NKC;
    const int vr = tid >> 3, vc = tid & 7;
    u32x4 rk0, rk1 = (u32x4){0u, 0u, 0u, 0u}, rv;
    const int NT = nkeys / 64;
    const int vtr_off = (4 * h + ((lane & 15) >> 2)) * VS + 16 * ((lane >> 4) & 1) + 4 * (lane & 3);
#define AT_LOAD(kt) do { rk0 = *(const u32x4*)(K + (size_t)((kt) * 64 + kr0) * ldk + 8 * kc0); if (k1) rk1 = *(const u32x4*)(K + (size_t)((kt) * 64 + kr1) * ldk + 8 * kc1); \
        rv = *(const u32x4*)(V + (size_t)((kt) * 64 + vr) * ldv + 8 * vc); } while (0)
#define AT_STORE(buf) do { *(u32x4*)(Ks + ((buf) * 64 + kr0) * KS + 8 * kc0) = rk0; if (k1) *(u32x4*)(Ks + ((buf) * 64 + kr1) * KS + 8 * kc1) = rk1; \
        *(u32x4*)(Vs + ((buf) * 64 + vr) * VS + 8 * vc) = rv; } while (0)
    AT_LOAD(0); AT_STORE(0);
    __syncthreads();
    float m_run = 0.f, l_run = 0.f; f32x16 o[2], negm;
#pragma unroll
    for (int i = 0; i < 16; ++i) { o[0][i] = 0.f; o[1][i] = 0.f; negm[i] = 0.f; }
    for (int kt = 0; kt < NT; ++kt) {
        const int buf = kt & 1;
        if (kt + 1 < NT) AT_LOAD(kt + 1);
        f32x16 pt[2];
        { bf16x8 kf[2][NKD];
#pragma unroll
          for (int kh = 0; kh < 2; ++kh)
#pragma unroll
              for (int d0 = 0; d0 < NKD; ++d0) kf[kh][d0] = *(const bf16x8*)(Ks + (buf * 64 + 32 * kh + r) * KS + 16 * d0 + 8 * h);
          SCHED_FENCE();
          pt[0] = negm; pt[1] = negm;
#pragma unroll
          for (int d0 = 0; d0 < NKD; ++d0) { pt[0] = mfma32(kf[0][d0], qr[d0], pt[0]); pt[1] = mfma32(kf[1][d0], qr[d0], pt[1]); } }
        bf16x8 vf[2][2][2];
#pragma unroll
        for (int et = 0; et < 2; ++et)
#pragma unroll
            for (int kh = 0; kh < 2; ++kh)
#pragma unroll
                for (int sp = 0; sp < 2; ++sp) { const bf16* vp = Vs + (buf * 64 + 32 * kh + 16 * sp) * VS + 32 * et + vtr_off;
                    const s16x4 lo = lds_tr_read(vp), hi = lds_tr_read(vp + 8 * VS);
                    vf[et][kh][sp] = (bf16x8){lo[0], lo[1], lo[2], lo[3], hi[0], hi[1], hi[2], hi[3]}; }
        SCHED_FENCE();
        float mq[4];
#pragma unroll
        for (int c = 0; c < 4; ++c) mq[c] = fmaxf(pt[0][c], pt[1][c]);
#pragma unroll
        for (int i = 4; i < 16; ++i) mq[i & 3] = fmaxf(mq[i & 3], fmaxf(pt[0][i], pt[1][i]));
        float mt = fmaxf(fmaxf(mq[0], mq[1]), fmaxf(mq[2], mq[3]));
        if (__any(kt == 0 || mt > 8.0f)) {
            mt = fmaxf(mt, SHX(mt, 32, lane));
            const float dl = (kt == 0) ? mt : fmaxf(mt, 0.f), alpha = exp2_fast(-dl);
            m_run += dl; l_run *= alpha;
#pragma unroll
            for (int i = 0; i < 16; ++i) { pt[0][i] -= dl; pt[1][i] -= dl; o[0][i] *= alpha; o[1][i] *= alpha; negm[i] = -m_run; }
        }
        float rq[4] = {0.f, 0.f, 0.f, 0.f};
#pragma unroll
        for (int kh = 0; kh < 2; ++kh)
#pragma unroll
            for (int i = 0; i < 16; ++i) { const float e = exp2_fast(pt[kh][i]); pt[kh][i] = e; rq[i & 3] += e; }
        l_run += (rq[0] + rq[1]) + (rq[2] + rq[3]);
        bf16x8 pb[2][2];
#pragma unroll
        for (int kh = 0; kh < 2; ++kh)
#pragma unroll
            for (int sp = 0; sp < 2; ++sp) { u32x4 u; u.x = pk2(pt[kh][8 * sp], pt[kh][8 * sp + 1]); u.y = pk2(pt[kh][8 * sp + 2], pt[kh][8 * sp + 3]); u.z = pk2(pt[kh][8 * sp + 4], pt[kh][8 * sp + 5]); u.w = pk2(pt[kh][8 * sp + 6], pt[kh][8 * sp + 7]);
                pb[kh][sp] = __builtin_bit_cast(bf16x8, u); }
        SCHED_FENCE();
#pragma unroll
        for (int kh = 0; kh < 2; ++kh)
#pragma unroll
            for (int sp = 0; sp < 2; ++sp)
#pragma unroll
                for (int et = 0; et < 2; ++et) o[et] = mfma32(vf[et][kh][sp], pb[kh][sp], o[et]);
        if (kt + 1 < NT) AT_STORE(buf ^ 1);
        __syncthreads();
    }
#undef AT_LOAD
#undef AT_STORE
    l_run += SHX(l_run, 32, lane);
    const float inv = 1.0f / l_run;
    bf16* op = O + (size_t)(w.wave * 32 + r) * ldo + 4 * h;
#pragma unroll
    for (int et = 0; et < 2; ++et)
#pragma unroll
        for (int g = 0; g < 4; ++g) { u32x2 ov; ov.x = pk2(o[et][4 * g] * inv, o[et][4 * g + 1] * inv); ov.y = pk2(o[et][4 * g + 2] * inv, o[et][4 * g + 3] * inv); *(u32x2*)(op + 32 * et + 8 * g) = ov; }
}
#ifndef REP_ATT
#define REP_ATT 1
#endif
#ifndef REP_ML3
#define REP_ML3 1
#endif
DEV void relaunder(Wg& w) { int t_ = w.tid; OPAQUE_V(t_); w.tid = t_; w.lane = t_ & 63; }
DEV void phase_mix(const P& p, Wg& w, int l) {
    const bf16* PROJ = (const bf16*)(p.ws + WS_PROJ); const bf16* MLAQ = (const bf16*)(p.ws + WS_MLAQ); bf16* MIX = (bf16*)(p.ws + WS_H);
    unsigned* ctr = (unsigned*)(p.ws + WS_CTL) + CW_Q + 1024 * l;
    const int n_ml3 = BATCH * 4 * NCH;
    for (int rep = 0; rep < REP_ATT; ++rep) {
        { const int n_lat = BATCH * 4 * NQL, n_all = n_lat + ((l == 0) ? BATCH * 4 : 0);
          for (;;) {
            int idx = q_next(w, ctr + 64 * rep);
            if (idx >= n_all) break;
            int b, head, qb, nkeys;
            if (idx < n_lat) { b = idx / (4 * NQL); head = (idx / NQL) % 4; qb = 1 + idx % NQL; nkeys = TP; }
            else { idx -= n_lat; b = idx / 4; head = idx % 4; qb = 0; nkeys = CTX; }
            const size_t Rq = (size_t)b * TP + qb * 256, Rk = (size_t)b * TP;
            attn_unit<96>(MLAQ + Rq * 1024 + head * 96, 1024, MLAQ + Rk * 1024 + 384 + head * 96, 1024, MLAQ + Rk * 1024 + 768 + head * 64, 1024, MIX + Rq * MIXW + 768 + head * 64, MIXW, nkeys, w);
          } }
        relaunder(w);
        { const int n_lat = BATCH * 6 * NQL, n_all = n_lat + ((l == 0) ? BATCH * 6 : 0);
          for (;;) {
            int idx = q_next(w, ctr + 256 + 64 * rep);
            if (idx >= n_all) break;
            int b, head, qb, nkeys;
            if (idx < n_lat) { b = idx / (6 * NQL); const int rem = idx % (6 * NQL); head = (rem / (3 * NQL)) * 3 + rem % 3; qb = 1 + (rem % (3 * NQL)) / 3; nkeys = TP; }
            else { idx -= n_lat; b = idx / 6; head = idx % 6; qb = 0; nkeys = CTX; }
            const size_t Rq = (size_t)b * TP + qb * 256, Rk = (size_t)b * TP;
            attn_unit<64>(PROJ + Rq * PROJ_W + C_AQ + head * 64, PROJ_W, PROJ + Rk * PROJ_W + C_AK + (head / 3) * 64, PROJ_W, PROJ + Rk * PROJ_W + C_AV + (head / 3) * 64, PROJ_W, MIX + Rq * MIXW + 384 + head * 64, MIXW, nkeys, w);
          } }
        relaunder(w);
    }
    for (int rep = 0; rep < REP_ML3; ++rep)
    for (;;) {
        const int idx = q_next(w, ctr + 512 + 64 * rep);
        if (idx >= n_ml3) break;
        if (l == 1 && idx % NCH < NC_CTX) continue;
        ml3_item(p, w, l, idx);
    }
}

DEV void moe_seg_table(const P& p, Wg& w) {
    const int* cntg = (const int*)(p.ws + WS_CNTG); int* part = (int*)w.lds;
    { const int e = w.tid & 7; int tot = 0, pre = 0;
      for (int g = w.tid >> 3; g < w.G; g += NTHR / 8) { const int c = cntg[g * NEXP + e]; tot += c; pre += (g < w.wg) ? c : 0; }
      part[2 * w.tid] = tot; part[2 * w.tid + 1] = pre; }
    __syncthreads();
    if (w.tid < NEXP) { int tot = 0, pre = 0; for (int i = 0; i < NTHR / 8; ++i) { tot += part[2 * (8 * i + w.tid)]; pre += part[2 * (8 * i + w.tid) + 1]; } w.misc[32 + w.tid] = (unsigned)tot; w.misc[48 + w.tid] = (unsigned)pre; }
    __syncthreads();
    if (w.tid == 0) { int s = 0; for (int e = 0; e < NEXP; ++e) { w.misc[16 + e] = (unsigned)s; s += ((int)w.misc[32 + e] + 255) / 256; } w.misc[16 + NEXP] = (unsigned)s; }
    __syncthreads();
}
DEV void phase_gather(const P& p, Wg& w) {
    moe_seg_table(p, w);
    const int* topi = (const int*)(p.ws + WS_TOPI); const float* topw = (const float*)(p.ws + WS_TOPW);
    int* stok = (int*)(p.ws + WS_STOK); float* sw = (float*)(p.ws + WS_SW);
    const bf16* H = (const bf16*)(p.ws + WS_H); bf16* AG = (bf16*)(p.ws + WS_AG);
    int* lc = (int*)w.lds;
    if (w.lane == 0) { for (int e = 0; e < NEXP; ++e) lc[w.wave * NEXP + e] = 0;
        for (int R = w.gw; R < M_ALL; R += w.NGW) { const int q = R % TP; if (q < CTX) continue; const int tok = (R / TP) * SEQ + q - CTX; lc[w.wave * NEXP + topi[2 * tok]]++; lc[w.wave * NEXP + topi[2 * tok + 1]]++; } }
    __syncthreads();
    if (w.tid < NEXP) { int s = (int)w.misc[16 + w.tid] * 256 + (int)w.misc[48 + w.tid]; for (int ww = 0; ww < NWAVE; ++ww) { const int c = lc[ww * NEXP + w.tid]; lc[ww * NEXP + w.tid] = s; s += c; } }
    __syncthreads();
    constexpr int NJ8 = (D_MODEL + 511) / 512;
    for (int R0 = w.gw; R0 < M_ALL; R0 += 4 * w.NGW) {
        int s0[4], s1[4]; bool ok[4];
#pragma unroll
        for (int qq = 0; qq < 4; ++qq) { const int R = R0 + qq * w.NGW; const int q = R % TP; ok[qq] = R < M_ALL && q >= CTX; const int tok = (R / TP) * SEQ + q - CTX;
            int a0 = 0, a1 = 0;
            if (w.lane == 0 && ok[qq]) { const int e0 = topi[2 * tok], e1 = topi[2 * tok + 1]; a0 = lc[w.wave * NEXP + e0]; lc[w.wave * NEXP + e0] = a0 + 1; a1 = lc[w.wave * NEXP + e1]; lc[w.wave * NEXP + e1] = a1 + 1;
                stok[a0] = tok; stok[a1] = tok; sw[a0] = topw[2 * tok]; sw[a1] = topw[2 * tok + 1]; int* tsl = (int*)(p.ws + WS_TSL) + 2 * tok; tsl[0] = a0; tsl[1] = a1; }
            s0[qq] = __shfl(a0, 0); s1[qq] = __shfl(a1, 0); }
        u32x4 v[4][NJ8];
#pragma unroll
        for (int qq = 0; qq < 4; ++qq)
#pragma unroll
            for (int j = 0; j < NJ8; ++j) { const int c = 8 * w.lane + 512 * j; if (ok[qq] && c < D_MODEL) v[qq][j] = *(const u32x4*)(H + (size_t)(R0 + qq * w.NGW) * D_MODEL + c); }
#pragma unroll
        for (int qq = 0; qq < 4; ++qq)
#pragma unroll
            for (int j = 0; j < NJ8; ++j) { const int c = 8 * w.lane + 512 * j; if (ok[qq] && c < D_MODEL) { *(u32x4*)(AG + (size_t)s0[qq] * D_MODEL + c) = v[qq][j]; *(u32x4*)(AG + (size_t)s1[qq] * D_MODEL + c) = v[qq][j]; } }
    }
    for (int e = w.wg; e < NEXP; e += w.G) { const int lo = (int)w.misc[16 + e] * 256 + (int)w.misc[32 + e], hi = (int)w.misc[16 + e + 1] * 256;
        for (int s = lo + w.wave; s < hi; s += NWAVE) { if (w.lane == 0) { stok[s] = -1; sw[s] = 0.f; }
            for (int c = 8 * w.lane; c < D_MODEL; c += 512) *(u32x4*)(AG + (size_t)s * D_MODEL + c) = (u32x4){0u, 0u, 0u, 0u}; } }
}

DEV void phase_moe_combine(const P& p, Wg& w, int c) {
    const int* tsl = (const int*)(p.ws + WS_TSL); const float* topw = (const float*)(p.ws + WS_TOPW); const bf16* YC = (const bf16*)(p.ws + WS_YC);
    const int lo = c * MOE_PCH * 256, hi = lo + MOE_PCH * 256;
    const int ptot = (int)w.misc[16 + NEXP], np = (ptot - c * MOE_PCH) < MOE_PCH ? (ptot - c * MOE_PCH) : MOE_PCH;
    if (np <= 0) return;
    const int nsp = (np * NSPLIT > MOE_PCH) ? 1 : NSPLIT; const size_t pstr = (size_t)np * 256 * D_MODEL;
    constexpr int CB = 2;
    for (int tok0 = w.gw; tok0 < NTOK; tok0 += CB * w.NGW) {
        const bf16* y0[CB]; const bf16* y1[CB]; float w0[CB], w1[CB]; bool act[CB]; bf16* xr[CB]; const float* gv[CB];
#pragma unroll
        for (int q = 0; q < CB; ++q) { const int tok = tok0 + q * w.NGW; const bool ok = tok < NTOK; const int tk = ok ? tok : 0;
            const int s0 = tsl[2 * tk], s1 = tsl[2 * tk + 1]; const bool in0 = ok && s0 >= lo && s0 < hi, in1 = ok && s1 >= lo && s1 < hi;
            act[q] = in0 || in1; w0[q] = in0 ? topw[2 * tk] : 0.f; w1[q] = in1 ? topw[2 * tk + 1] : 0.f;
            y0[q] = YC + (size_t)(in0 ? s0 - lo : 0) * D_MODEL; y1[q] = YC + (size_t)(in1 ? s1 - lo : 0) * D_MODEL;
            xr[q] = (bf16*)(p.out + (size_t)tk * D_MODEL); gv[q] = (const float*)(p.ws + WS_MODV) + (size_t)(1 * NV + tk / SEQ) * 6 * D_MODEL + 5 * D_MODEL; }
#pragma unroll
        for (int j = 0; j < D_MODEL / 256; ++j) { const int col = 4 * w.lane + 256 * j;
            f32x4 ya[CB], g[CB]; u32x2 x[CB];
#pragma unroll
            for (int q = 0; q < CB; ++q) if (act[q]) { g[q] = *(const f32x4*)(gv[q] + col); x[q] = *(const u32x2*)(xr[q] + col); ya[q] = (f32x4){0.f, 0.f, 0.f, 0.f};
                for (int ks = 0; ks < nsp; ++ks) { const u32x2 a = *(const u32x2*)(y0[q] + ks * pstr + col), bq = *(const u32x2*)(y1[q] + ks * pstr + col);
                    ya[q][0] += w0[q] * bf2f((bf16)a.x) + w1[q] * bf2f((bf16)bq.x); ya[q][1] += w0[q] * bf2f((bf16)(a.x >> 16)) + w1[q] * bf2f((bf16)(bq.x >> 16));
                    ya[q][2] += w0[q] * bf2f((bf16)a.y) + w1[q] * bf2f((bf16)bq.y); ya[q][3] += w0[q] * bf2f((bf16)(a.y >> 16)) + w1[q] * bf2f((bf16)(bq.y >> 16)); } }
#pragma unroll
            for (int q = 0; q < CB; ++q) if (act[q]) { u32x2 o;
                o.x = pk2(bf2f((bf16)x[q].x) + g[q][0] * ya[q][0], bf2f((bf16)(x[q].x >> 16)) + g[q][1] * ya[q][1]); o.y = pk2(bf2f((bf16)x[q].y) + g[q][2] * ya[q][2], bf2f((bf16)(x[q].y >> 16)) + g[q][3] * ya[q][3]);
                *(u32x2*)(xr[q] + col) = o; } }
    }
}
DEV void phase_moe_final(const P& p, Wg& w) {
    constexpr int c = MOE_NCH - 1, NJ = D_MODEL / 256;
    const int* tsl = (const int*)(p.ws + WS_TSL); const float* topw = (const float*)(p.ws + WS_TOPW); const bf16* YC = (const bf16*)(p.ws + WS_YC);
    const int lo = c * MOE_PCH * 256, hi = lo + MOE_PCH * 256;
    const int ptot = (int)w.misc[16 + NEXP], np = (ptot - c * MOE_PCH) < MOE_PCH ? (ptot - c * MOE_PCH) : MOE_PCH;
    const int nsp = (np * NSPLIT > MOE_PCH) ? 1 : NSPLIT; const size_t pstr = (size_t)(np > 0 ? np : 0) * 256 * D_MODEL;
    for (int tok0 = w.gw; tok0 < NTOK; tok0 += 2 * w.NGW) {
        f32x4 xo[2][NJ]; bool ok[2];
#pragma unroll
        for (int q = 0; q < 2; ++q) { const int tok = tok0 + q * w.NGW; ok[q] = tok < NTOK; const int tk = ok[q] ? tok : 0;
            const int s0 = tsl[2 * tk], s1 = tsl[2 * tk + 1]; const bool in0 = np > 0 && s0 >= lo && s0 < hi, in1 = np > 0 && s1 >= lo && s1 < hi;
            const float w0 = in0 ? topw[2 * tk] : 0.f, w1 = in1 ? topw[2 * tk + 1] : 0.f;
            const bf16* y0 = YC + (size_t)(in0 ? s0 - lo : 0) * D_MODEL; const bf16* y1 = YC + (size_t)(in1 ? s1 - lo : 0) * D_MODEL;
            const bf16* xr = (const bf16*)(p.out + (size_t)tk * D_MODEL); const float* gv = (const float*)(p.ws + WS_MODV) + (size_t)(1 * NV + tk / SEQ) * 6 * D_MODEL + 5 * D_MODEL;
#pragma unroll
            for (int j = 0; j < NJ; ++j) { const int col = 4 * w.lane + 256 * j; const u32x2 t = *(const u32x2*)(xr + col);
                xo[q][j] = (f32x4){bf2f((bf16)t.x), bf2f((bf16)(t.x >> 16)), bf2f((bf16)t.y), bf2f((bf16)(t.y >> 16))};
                if (in0 || in1) { f32x4 ya = (f32x4){0.f, 0.f, 0.f, 0.f};
                    for (int ks = 0; ks < nsp; ++ks) { const u32x2 a = *(const u32x2*)(y0 + ks * pstr + col), bq = *(const u32x2*)(y1 + ks * pstr + col);
                        ya[0] += w0 * bf2f((bf16)a.x) + w1 * bf2f((bf16)bq.x); ya[1] += w0 * bf2f((bf16)(a.x >> 16)) + w1 * bf2f((bf16)(bq.x >> 16));
                        ya[2] += w0 * bf2f((bf16)a.y) + w1 * bf2f((bf16)bq.y); ya[3] += w0 * bf2f((bf16)(a.y >> 16)) + w1 * bf2f((bf16)(bq.y >> 16)); }
                    xo[q][j] = xo[q][j] + *(const f32x4*)(gv + col) * ya; } } }
        wave_sync();
#pragma unroll
        for (int q = 0; q < 2; ++q) if (ok[q]) { float* orow = p.out + (size_t)(tok0 + q * w.NGW) * D_MODEL;
#pragma unroll
            for (int j = 0; j < NJ; ++j) *(f32x4*)(orow + 4 * w.lane + 256 * j) = xo[q][j]; }
    }
}

constexpr int PH_L = 24;
constexpr int N_PHASES = 1 + 2 * PH_L;
#ifndef PROBE_MUL
#define PROBE_MUL 1
#endif
#ifdef EMU
#define GRID_BAR() do {} while (0)
#define DYN_LDS() unsigned char* lds = EMU_DYN_LDS()
#else
#define GRID_BAR() xcd_barrier(bar)
#define DYN_LDS() extern __shared__ __attribute__((aligned(16))) unsigned char lds[]
#endif
__global__ void __launch_bounds__(NTHR, 2) fwd(P p_in) {
    DYN_LDS();
    Wg w; w.tid = threadIdx.x; w.lane = w.tid & 63;
#ifndef EMU
    w.wave = __builtin_amdgcn_readfirstlane(w.tid >> 6);
#else
    w.wave = w.tid >> 6;
#endif
    w.G = gridDim.x; w.wg = blockIdx.x; w.gw = w.wg * NWAVE + w.wave; w.NGW = w.G * NWAVE; w.lds = lds; w.misc = (unsigned*)(lds + LDS_MISC);
    if (w.tid < 64) w.misc[w.tid] = 0u;
    __syncthreads();
#ifndef EMU
    XcdBarrier bar = xcd_barrier_post((unsigned*)(p_in.ws + WS_CTL) + CW_BAR, (volatile LAS unsigned*)(w.misc));
#endif
    const int lo = p_in.ph_lo, hi = p_in.ph_hi; const int wave_s = w.wave; (void)wave_s;
#ifndef PH_MASK
#define PH_MASK 0xffffffffu
#endif
#if defined(PROBE_SET) && !defined(EMU)
#define PROBE_T0(k) if (blockIdx.x == 0 && threadIdx.x == 0) { ((unsigned*)(lds + LDS_MISC))[64 + 2 * (k)] = (unsigned)wall_clock64(); }
#define PROBE_T1(k) if (blockIdx.x == 0 && threadIdx.x == 0) { ((unsigned*)(lds + LDS_MISC))[65 + 2 * (k)] = (unsigned)wall_clock64(); }
#define PROBE_SPLIT(k, vk) { GRID_BAR(); if (blockIdx.x == 0 && threadIdx.x == 0) { unsigned* m_ = (unsigned*)(lds + LDS_MISC); m_[64 + 2 * (vk)] = m_[64 + 2 * (k)]; m_[65 + 2 * (vk)] = (unsigned)wall_clock64(); } }
#else
#define PROBE_T0(k)
#define PROBE_T1(k)
#define PROBE_SPLIT(k, vk)
#endif
#ifndef EMU
#define TID_NOW() (wave_s * 64 + lane_fresh())
#define WAVE_OF(t) __builtin_amdgcn_readfirstlane((t) >> 6)
#else
#define TID_NOW() ((int)threadIdx.x)
#define WAVE_OF(t) ((t) >> 6)
#endif
#ifndef EMU
#define LOAD_P() const __attribute__((address_space(4))) P* pq_ = (const __attribute__((address_space(4))) P*)__builtin_amdgcn_kernarg_segment_ptr(); asm volatile("" : "+s"(pq_)); const P p = *(const P*)pq_;
#else
#define LOAD_P() const P& p = p_in;
#endif
#define PH_BEGIN(k) if (((PH_MASK >> ((k) - pb_)) & 1u) && lo <= (k) && (k) < hi) { LOAD_P() { int t_ = TID_NOW(); OPAQUE_V(t_); w.tid = t_; w.lane = t_ & 63; w.wave = WAVE_OF(t_); w.gw = w.wg * NWAVE + w.wave; } PROBE_T0(k)
#define PH_END(k) if ((k) + 1 < hi) GRID_BAR(); PROBE_T1(k) }
    { const int pb_ = -31; PH_BEGIN(0) phase0(p, w); PH_END(0) }
    for (int l = 0; l < 2; ++l) {
        const int pb = 1 + PH_L * l, pb_ = pb;
        PH_BEGIN(pb + 0) phase_modulate<4>(p, w, l, 0, l == 0, false, false, l == 1); PH_END(pb + 0)
        PH_BEGIN(pb + 1) {
            pg8::Gemm g{(const bf16*)(p.ws + WS_H), (const bf16*)(p.ws + WS_WIN_T) + (size_t)l * PROJ_W * D_MODEL, D_MODEL, D_MODEL, D_MODEL, 0};
            Sched<0> S; S.o.init(NPAN, PROJ_W / 256, w.G, w.wg, SITE_WGM(0)); S.pm_base = 0; S.seg = nullptr; S.nNc = 0; S.kper = 0;
            EpiStore E{(bf16*)(p.ws + WS_PROJ), PROJ_W, (float*)(p.ws + WS_GATES)};
            { const TabSched T_ = build_units(w.misc, w.tid, S); pg8::gemm_phase<EpiStore, TabSched>(w.lds, w.tid, g, T_, E); } } PH_END(pb + 1)
        PH_BEGIN(pb + 2) phase_prep(p, w, l); PH_END(pb + 2)
        PH_BEGIN(pb + 3) {
            pg8::Gemm g{(const bf16*)(p.ws + WS_PROJ) + C_CQ, (const bf16*)(p.ws + WS_MLA_T) + (size_t)l * 1024 * 512, PROJ_W, 512, 256, 0};
            Sched<6> S; S.o.init(NPAN, 4, w.G, w.wg, SITE_WGM(1)); S.pm_base = 0; S.seg = nullptr; S.nNc = 0; S.kper = 0;
            EpiStore E{(bf16*)(p.ws + WS_MLAQ), 1024, nullptr};
            { const TabSched T_ = build_units(w.misc, w.tid, S); pg8::gemm_phase<EpiStore, TabSched>(w.lds, w.tid, g, T_, E); }
            __syncthreads();
            PROBE_SPLIT(pb + 3, 49 + 3 * l)
#ifndef NO_ML1
            for (int it = w.G - 1 - w.wg; it < BATCH * 4 * NCH; it += w.G) ml1_item(p, w, l, it);
#endif
            } PH_END(pb + 3)
        PH_BEGIN(pb + 4) phase_mla_post(p, w, l); PROBE_SPLIT(pb + 4, 50 + 3 * l) phase_ml2(p, w); PH_END(pb + 4)
        PH_BEGIN(pb + 5) phase_mix(p, w, l); PH_END(pb + 5)
        PH_BEGIN(pb + 6) {
            pg8::Gemm g{(const bf16*)(p.ws + WS_H), (const bf16*)(p.ws + WS_WOUT_T) + (size_t)l * D_MODEL * MIXW, MIXW, MIXW, MIXW, 0};
            Sched<0> S0; Sched<1> S1; S0.o.init(NPAN, D_MODEL / 256, w.G, w.wg, SITE_WGM(2)); S1.o.init(BATCH * NQL, D_MODEL / 256, w.G, w.wg, SITE_WGM(3)); S0.pm_base = 0; S0.seg = nullptr; S0.nNc = 0; S0.kper = 0; S1.pm_base = 0; S1.seg = nullptr; S1.nNc = 0; S1.kper = 0;
            if (l == 0) { EpiResid<true> E{p, l, 2 * D_MODEL}; const TabSched T_ = build_units(w.misc, w.tid, S0); pg8::gemm_phase<EpiResid<true>, TabSched>(w.lds, w.tid, g, T_, E); }
            else { EpiResid<false> E{p, l, 2 * D_MODEL}; const TabSched T_ = build_units(w.misc, w.tid, S1); pg8::gemm_phase<EpiResid<false>, TabSched>(w.lds, w.tid, g, T_, E); } } PH_END(pb + 6)
        if (l == 0) {
            PH_BEGIN(pb + 7) phase_modulate<4>(p, w, 0, 1, false, false, false, false); PH_END(pb + 7)
            PH_BEGIN(pb + 8) {
                pg8::Gemm g{(const bf16*)(p.ws + WS_H), (const bf16*)(p.ws + WS_WGU_T), D_MODEL, D_MODEL, D_MODEL, 0};
                Sched<0> S; S.o.init(NPAN, 2 * D_FF / 256, w.G, w.wg, SITE_WGM(4)); S.pm_base = 0; S.seg = nullptr; S.nNc = 0; S.kper = 0;
                EpiSwiglu E{(bf16*)(p.ws + WS_ACT), 0};
                { const TabSched T_ = build_units(w.misc, w.tid, S); pg8::gemm_phase<EpiSwiglu, TabSched>(w.lds, w.tid, g, T_, E); } } PH_END(pb + 8)
            PH_BEGIN(pb + 9) {
                { pg8::Gemm g{(const bf16*)(p.ws + WS_ACT), (const bf16*)(p.ws + WS_WD_T), D_FF, D_FF, D_FF, 0};
                  Sched<1> S; S.o.init(BATCH * NQL, D_MODEL / 256, w.G, w.wg, SITE_WGM(5)); S.pm_base = 0; S.seg = nullptr; S.nNc = 0; S.kper = 0;
                  EpiResid<false> E{p, 0, 5 * D_MODEL};
                  { const TabSched T_ = build_units(w.misc, w.tid, S); pg8::gemm_phase<EpiResid<false>, TabSched>(w.lds, w.tid, g, T_, E); } }
                __syncthreads();
                { pg8::Gemm g{(const bf16*)(p.ws + WS_ACT), (const bf16*)(p.ws + WS_WD_T), D_FF, D_FF, KSPLIT, 0};
                  Sched<4> S; S.o.init(BATCH, (D_MODEL / 256) * NSPLIT, w.G, w.wg, SITE_WGM(6)); S.pm_base = 0; S.seg = nullptr; S.nNc = D_MODEL / 256; S.kper = KSPLIT;
                  EpiStoreRel E{(bf16*)(p.ws + WS_MLAQ), D_MODEL, 0};
                  { const TabSched T_ = build_units(w.misc, w.tid, S); pg8::gemm_phase<EpiStoreRel, TabSched>(w.lds, w.tid, g, T_, E); } } } PH_END(pb + 9)
        } else {
            PH_BEGIN(pb + 7) phase_modulate<1>(p, w, 1, 1, false, true, true, false); PROBE_SPLIT(pb + 7, 51 + 3 * l) phase_moe_weights(p, w); PH_END(pb + 7)
            PH_BEGIN(pb + 8) phase_gather(p, w); PH_END(pb + 8)
            for (int c = 0; c < MOE_NCH; ++c) {
                PH_BEGIN(pb + 9 + 2 * c) {
                    moe_seg_table(p, w);
                    const int ptot = (int)w.misc[16 + NEXP], pm0 = c * MOE_PCH, np = (ptot - pm0) < MOE_PCH ? (ptot - pm0) : MOE_PCH;
                    if (c > 0 && (w.wg & 1)) phase_moe_combine(p, w, c - 1);
                    if (np > 0) {
                        pg8::Gemm g{(const bf16*)(p.ws + WS_AG), (const bf16*)(p.ws + WS_MOEW), D_MODEL, D_MODEL, D_MODEL, MOEW_E};
                        Sched<2> S; S.o.init(np, 2 * D_FF / 256, w.G, w.wg, SITE_WGM(7)); S.pm_base = pm0; S.seg = (const int*)(w.misc + 16); S.nNc = 0; S.kper = 0;
                        EpiSwiglu E{(bf16*)(p.ws + WS_ACT2), pm0};
                        { const TabSched T_ = build_units(w.misc, w.tid, S); pg8::gemm_phase<EpiSwiglu, TabSched>(w.lds, w.tid, g, T_, E); } }
                    if (c > 0 && !(w.wg & 1)) phase_moe_combine(p, w, c - 1); } PH_END(pb + 9 + 2 * c)
                PH_BEGIN(pb + 10 + 2 * c) {
                    moe_seg_table(p, w);
                    const int ptot = (int)w.misc[16 + NEXP], pm0 = c * MOE_PCH, np = (ptot - pm0) < MOE_PCH ? (ptot - pm0) : MOE_PCH;
                    if (np > 0 && np * NSPLIT > MOE_PCH) {
                        pg8::Gemm g{(const bf16*)(p.ws + WS_ACT2), (const bf16*)(p.ws + WS_MOEW) + (size_t)2 * D_FF * D_MODEL, D_FF, D_FF, D_FF, MOEW_E};
                        Sched<3> S; S.o.init(np, D_MODEL / 256, w.G, w.wg, SITE_WGM(8)); S.pm_base = pm0; S.seg = (const int*)(w.misc + 16); S.nNc = 0; S.kper = 0;
                        EpiStoreRel E{(bf16*)(p.ws + WS_YC), D_MODEL, 0};
                        { const TabSched T_ = build_units(w.misc, w.tid, S); pg8::gemm_phase<EpiStoreRel, TabSched>(w.lds, w.tid, g, T_, E); } }
                    else if (np > 0) {
                        pg8::Gemm g{(const bf16*)(p.ws + WS_ACT2), (const bf16*)(p.ws + WS_MOEW) + (size_t)2 * D_FF * D_MODEL, D_FF, D_FF, KSPLIT, MOEW_E};
                        Sched<5> S; S.o.init(np, (D_MODEL / 256) * NSPLIT, w.G, w.wg, SITE_WGM(9)); S.pm_base = pm0; S.seg = (const int*)(w.misc + 16); S.nNc = D_MODEL / 256; S.kper = KSPLIT;
                        EpiStoreRel E{(bf16*)(p.ws + WS_YC), D_MODEL, 0};
                        { const TabSched T_ = build_units(w.misc, w.tid, S); pg8::gemm_phase<EpiStoreRel, TabSched>(w.lds, w.tid, g, T_, E); } } } PH_END(pb + 10 + 2 * c)
            }
            PH_BEGIN(pb + 9 + 2 * MOE_NCH) moe_seg_table(p, w); phase_moe_final(p, w); PH_END(pb + 9 + 2 * MOE_NCH)
        }
    }
#if defined(PROBE_SET) && !defined(EMU)
    if (blockIdx.x == 0 && threadIdx.x == 0) {
        unsigned tot = 0; for (int k = 0; k < 56; ++k) if ((PROBE_SET >> k) & 1ull) tot += ((unsigned*)(lds + LDS_MISC))[65 + 2 * k] - ((unsigned*)(lds + LDS_MISC))[64 + 2 * k];
        const unsigned long long t0 = wall_clock64(); while (wall_clock64() - t0 < (unsigned long long)tot * PROBE_MUL) __builtin_amdgcn_s_sleep(8);
    }
#endif
}

#ifndef MK_PER_PHASE
#define MK_PER_PHASE 0
#endif
extern "C" void kernel_launch(void* const* d_in, const int* in_sizes, int n_in, void* d_out, int out_size, void* d_ws, size_t ws_size, hipStream_t stream) {
    static int grid = 0;
    if (grid == 0) {
        if (n_in != 28 || in_sizes[0] != BATCH * SEQ * D_MODEL || out_size != BATCH * SEQ * D_MODEL || ws_size < WS_TOTAL) {
            fprintf(stderr, "kernel_launch: unexpected problem (n_in %d, x %d, out %d, ws %zu < %zu)\n", n_in, n_in > 0 ? in_sizes[0] : -1, out_size, ws_size, (size_t)WS_TOTAL); grid = -1; return; }
#ifndef EMU
        int dev = 0, cus = 0;
        if (hipGetDevice(&dev) != hipSuccess || hipDeviceGetAttribute(&cus, hipDeviceAttributeMultiprocessorCount, dev) != hipSuccess) { grid = -1; return; }
        if (hipFuncSetAttribute((const void*)fwd, hipFuncAttributeMaxDynamicSharedMemorySize, LDS_BYTES) != hipSuccess) { fprintf(stderr, "kernel_launch: hipFuncSetAttribute failed\n"); grid = -1; return; }
        int per_cu = 0;
        if (hipOccupancyMaxActiveBlocksPerMultiprocessor(&per_cu, (const void*)fwd, NTHR, LDS_BYTES) != hipSuccess || per_cu < 1) { fprintf(stderr, "kernel_launch: occupancy query says %d\n", per_cu); (void)hipGetLastError(); }
        grid = cus;
#else
        grid = 8;
#endif
    }
    if (grid < 0) return;
    (void)hipMemsetAsync((char*)d_ws + WS_CTL, 0, CTL_BYTES, stream);
    P p{};
    const float** pp = (const float**)&p;
    for (int i = 0; i < 28; ++i) pp[i] = (const float*)d_in[i];
    p.out = (float*)d_out; p.ws = (unsigned char*)d_ws;
#if MK_PER_PHASE
    for (int k = 0; k < N_PHASES; ++k) {
        if (k >= 1 + 10 && k < 1 + PH_L) continue;
        if (k >= 1 + PH_L + 10 + 2 * MOE_NCH) continue;
        p.ph_lo = k; p.ph_hi = k + 1;
        hipLaunchKernelGGL(fwd, dim3(grid), dim3(NTHR), LDS_BYTES, stream, p);
    }
#else
    p.ph_lo = 0; p.ph_hi = N_PHASES;
    hipLaunchKernelGGL(fwd, dim3(grid), dim3(NTHR), LDS_BYTES, stream, p);
#endif
}
```

```cpp
#ifndef EMU
#include <hip/hip_runtime.h>
#endif
#include <cstdio>
#include <cstdint>
#include <cmath>

#ifdef CFG_TINY
constexpr int D_MODEL = 256, BATCH = 2, SEQ = 512, CTX = 256, GRID_W = 16, D_FF = 512;
constexpr int MOE_PCH = 4, NSPLIT = 2;
#else
constexpr int D_MODEL = 1024, BATCH = 8, SEQ = 4096, CTX = 256, GRID_W = 64, D_FF = 3584;
constexpr int MOE_PCH = 64, NSPLIT = 7;
#endif
constexpr int TP = CTX + SEQ, M_ALL = BATCH * TP, NPAN = M_ALL / 256, PAN_B = TP / 256, NQL = SEQ / 256;
constexpr int MCH = 128;
constexpr int NCH = TP / MCH, NC_CTX = CTX / MCH, NQB = MCH / 32;
constexpr int PROJ_W = 2816, MIXW = 1024, NEXP = 8;
constexpr int C_MQ = 0, C_MK = 384, C_MV = 768, C_MO = 1152, C_G = 1536, C_AQ = 1552, C_AK = 1936, C_AV = 2064, C_CQ = 2192, C_CKV = 2448, C_KR = 2576, IN_W = 2608;
constexpr int NV = BATCH + 1;
constexpr int NCHAIN = BATCH * 4 * 2, NITEM = NCHAIN * NCH;
constexpr int NTOK = BATCH * SEQ, NSLOTP = NTOK * 2 + NEXP * 256;
constexpr int MOE_NCH = (NSLOTP / 256 + MOE_PCH - 1) / MOE_PCH;
constexpr float EPS = 1e-6f, LOG2E = 1.4426950408889634f;
constexpr float QSCALE_A = 0.125f * LOG2E, QSCALE_L = 0.10206207261596575f * LOG2E, KSCALE_M = 0.10206207261596575f;
constexpr int NTHR = 512, NWAVE = 8;
constexpr int KSPLIT = D_FF / NSPLIT;
static_assert(KSPLIT % 128 == 0 && KSPLIT >= 256 && NSPLIT * BATCH * 256 * D_MODEL * 2 <= M_ALL * 1024 * 2, "split-K geometry");
constexpr int NPOS = (SEQ / GRID_W > GRID_W) ? SEQ / GRID_W : GRID_W;

typedef unsigned short bf16;
#ifndef EMU
typedef short bf16x8 __attribute__((ext_vector_type(8)));
typedef short s16x4 __attribute__((ext_vector_type(4)));
typedef float f32x4 __attribute__((ext_vector_type(4)));
typedef float f32x2 __attribute__((ext_vector_type(2)));
typedef float f32x16 __attribute__((ext_vector_type(16)));
typedef unsigned u32x4 __attribute__((ext_vector_type(4)));
typedef unsigned u32x2 __attribute__((ext_vector_type(2)));
#define DEV __device__ __forceinline__
DEV f32x16 mfma32(bf16x8 a, bf16x8 b, f32x16 c) { return __builtin_amdgcn_mfma_f32_32x32x16_bf16(a, b, c, 0, 0, 0); }
DEV void wave_sync() { asm volatile("s_waitcnt vmcnt(0) lgkmcnt(0)" ::: "memory"); __builtin_amdgcn_wave_barrier(); }
typedef __bf16 bf16x2_hw __attribute__((ext_vector_type(2)));
typedef short v4i16_t __attribute__((ext_vector_type(4)));
DEV unsigned pk2_hw(float lo, float hi) { f32x2 v = {lo, hi}; bf16x2_hw b = __builtin_convertvector(v, bf16x2_hw); return __builtin_bit_cast(unsigned, b); }
DEV s16x4 lds_tr_read(const unsigned short* a) { return __builtin_bit_cast(s16x4, __builtin_amdgcn_ds_read_tr16_b64_v4i16((__attribute__((address_space(3))) v4i16_t*)(a))); }
DEV float exp2_fast(float x) { return __builtin_amdgcn_exp2f(x); }
DEV float rcp_fast(float x) { return __builtin_amdgcn_rcpf(x); }
DEV float rsqrt_fast(float x) { return __builtin_amdgcn_rsqf(x); }
DEV void atomic_addf(float* p, float v) { unsafeAtomicAdd(p, v); }
#define OPAQUE_V(x) asm volatile("" : "+v"(x))
#define SCHED_FENCE() __builtin_amdgcn_sched_barrier(0)
#define UNIFORM_I(x) __builtin_amdgcn_readfirstlane(x)
DEV unsigned fau(float f) { return __float_as_uint(f); }
DEV float uaf(unsigned u) { return __uint_as_float(u); }
DEV float my_shfl_xor(float v, int m, int lane) { return __int_as_float(__builtin_amdgcn_ds_bpermute((lane ^ m) << 2, __float_as_int(v))); }
#define SHX(v, m, lane) my_shfl_xor((v), (m), (lane))
DEV float my_shfl(float v, int src) { return __int_as_float(__builtin_amdgcn_ds_bpermute((src & 63) << 2, __float_as_int(v))); }
DEV int my_shfl(int v, int src) { return __builtin_amdgcn_ds_bpermute((src & 63) << 2, v); }
#define __shfl my_shfl
DEV int lane_fresh() { int l_; asm volatile("v_mbcnt_lo_u32_b32 %0, -1, 0\n\tv_mbcnt_hi_u32_b32 %0, -1, %0" : "=v"(l_)); return l_; }
#else
#define DEV inline
#define OPAQUE_V(x) do {} while (0)
#define SCHED_FENCE() do {} while (0)
#define UNIFORM_I(x) (x)
#define SHX(v, m, lane) __shfl_xor((v), (m))
DEV void wave_sync() { (void)emu_shfl_u(0u, emu::B->cur & 63); }
DEV void atomic_addf(float* p, float v) { atomicAdd(p, v); }
DEV float rsqrt_fast(float x) { return 1.0f / sqrtf(x); }
DEV unsigned fau(float f) { unsigned u; memcpy(&u, &f, 4); return u; }
DEV float uaf(unsigned u) { float f; memcpy(&f, &u, 4); return f; }
#endif
DEV bf16 f2bf(float f) { unsigned u = fau(f); u += 0x7fffu + ((u >> 16) & 1u); return (bf16)(u >> 16); }
DEV float bf2f(bf16 h) { return uaf(((unsigned)h) << 16); }
#ifndef EMU
DEV unsigned pk2(float lo, float hi) { return pk2_hw(lo, hi); }
#else
DEV unsigned pk2(float lo, float hi) { return (unsigned)f2bf(lo) | ((unsigned)f2bf(hi) << 16); }
#endif
DEV float wave_sum(float v, int lane) {
#pragma unroll
    for (int o = 1; o < 64; o <<= 1) v += SHX(v, o, lane);
    return v;
}
DEV float wave_max(float v, int lane) {
#pragma unroll
    for (int o = 1; o < 64; o <<= 1) v = fmaxf(v, SHX(v, o, lane));
    return v;
}
DEV float silu_f(float x) { return x / (1.0f + __expf(-x)); }
DEV float silu_fast(float x) { return x * rcp_fast(1.0f + exp2_fast(-x * LOG2E)); }
DEV float sigmoid_f(float x) { return rcp_fast(1.0f + exp2_fast(-x * LOG2E)); }
DEV float log_sigmoid_f(float x) { return x >= 0.f ? -log1pf(expf(-x)) : x - log1pf(expf(x)); }
DEV int crow(int i, int h) { return (i & 3) + 8 * (i >> 2) + 4 * h; }

constexpr size_t al256(size_t x) { return (x + 255) & ~(size_t)255; }
constexpr size_t WS_CTL = 0, CTL_BYTES = 65536;
constexpr int CW_Q = 0;
constexpr int CW_BAR = 4096;
constexpr size_t WS_MODV = WS_CTL + CTL_BYTES;
constexpr size_t WS_WIN_T = al256(WS_MODV + (size_t)2 * NV * 6 * D_MODEL * 4);
constexpr size_t WS_WOUT_T = al256(WS_WIN_T + (size_t)2 * PROJ_W * D_MODEL * 2);
constexpr size_t WS_MLA_T = al256(WS_WOUT_T + (size_t)2 * D_MODEL * MIXW * 2);
constexpr size_t WS_WGU_T = al256(WS_MLA_T + (size_t)2 * 1024 * 512 * 2);
constexpr size_t WS_WD_T = al256(WS_WGU_T + (size_t)2 * D_FF * D_MODEL * 2);
constexpr size_t WS_CX = al256(WS_WD_T + (size_t)D_MODEL * D_FF * 2);
constexpr size_t WS_GATES = al256(WS_CX + (size_t)BATCH * CTX * D_MODEL * 4);
constexpr size_t WS_NL = al256(WS_GATES + (size_t)M_ALL * 16 * 4);
constexpr size_t WS_FS = al256(WS_NL + (size_t)NITEM * 96 * 4);
constexpr size_t WS_PML = al256(WS_FS + (size_t)NITEM * 4);
constexpr size_t WS_MST = al256(WS_PML + (size_t)NITEM * 4);
constexpr size_t WS_TOPI = al256(WS_MST + (size_t)NITEM * 4);
constexpr size_t WS_TOPW = al256(WS_TOPI + (size_t)NTOK * 2 * 4);
constexpr size_t WS_CNTG = al256(WS_TOPW + (size_t)NTOK * 2 * 4);
constexpr size_t WS_STOK = al256(WS_CNTG + (size_t)1024 * 8 * 4);
constexpr size_t WS_SW = al256(WS_STOK + (size_t)NSLOTP * 4);
constexpr size_t WS_TSL = al256(WS_SW + (size_t)NSLOTP * 4);
constexpr size_t WS_ROPE = al256(WS_TSL + (size_t)NTOK * 2 * 4);
constexpr size_t WS_PROJ = al256(WS_ROPE + (size_t)NPOS * 24 * 2 * 4);
constexpr size_t WS_MQK = al256(WS_PROJ + (size_t)M_ALL * PROJ_W * 2);
constexpr size_t WS_MLAQ = al256(WS_MQK + (size_t)M_ALL * 768 * 2);
constexpr size_t WS_UC = al256(WS_MLAQ + (size_t)M_ALL * 1024 * 2);
constexpr size_t WS_H = al256(WS_UC + (size_t)NITEM * 9216 * 2);
constexpr size_t WS_END0 = al256(WS_H + (size_t)M_ALL * 1024 * 2);
constexpr size_t WS_ACT = WS_PROJ;
constexpr size_t WS_MOEW = WS_PROJ;
constexpr size_t MOEW_E = (size_t)3 * D_FF * D_MODEL * 2;
constexpr size_t WS_AG = al256(WS_MOEW + NEXP * MOEW_E);
constexpr size_t WS_ACT2 = al256(WS_AG + (size_t)NSLOTP * D_MODEL * 2);
constexpr size_t WS_YC = al256(WS_ACT2 + (size_t)MOE_PCH * 256 * D_FF * 2);
#ifdef CFG_TINY
constexpr size_t WS_TOTAL = WS_END0 + (4u << 20);
#else
constexpr size_t WS_TOTAL = (size_t)512 << 20;
#endif
static_assert(WS_END0 <= WS_TOTAL, "ws map");
constexpr int ML2_U = (NCH % 17 == 0) ? 17 : ((NCH % 4 == 0) ? 4 : 2);
static_assert(NCH % ML2_U == 0, "ML2 unroll");
static_assert(WS_ACT + (size_t)M_ALL * D_FF * 2 <= WS_MLAQ, "dense ACT overlays PROJ+MQK only");
static_assert(WS_MOEW + NEXP * MOEW_E <= WS_MQK, "MoE weights overlay PROJ only");
static_assert(WS_YC + (size_t)MOE_PCH * 256 * D_MODEL * 2 <= WS_TOTAL, "MoE chunk buffers");

constexpr int LDS_STAGE = 131072;
constexpr int LDS_MISC = LDS_STAGE;
constexpr int LDS_BYTES = LDS_STAGE + 4096;

struct P {
    const float *x, *c, *ctx, *c_ctx, *mod_w, *mod_b, *norm_mix, *norm_ffn, *w_in, *m_conv, *m_gate_b, *m_norm, *a_qnorm, *a_knorm, *l_cq_norm, *l_ckv_norm,
        *l_wuq, *l_wukv, *l_qnorm, *l_knorm, *w_out, *ffn_wg, *ffn_wu, *ffn_wd, *moe_router, *moe_wg, *moe_wu, *moe_wd;
    float* out; unsigned char* ws; int ph_lo, ph_hi;
};
constexpr int RPITCH = 2 * D_MODEL;
DEV bf16* resid_row(const P& p, int R) {
    const int b = R / TP, q = R % TP;
    return q < CTX ? (bf16*)(p.ws + WS_CX) + (size_t)(b * CTX + q) * RPITCH : (bf16*)(p.out + (size_t)(b * SEQ + q - CTX) * D_MODEL);
}
DEV const float* modv(const P& p, int l, int R) { const int b = R / TP, q = R % TP; return (const float*)(p.ws + WS_MODV) + (size_t)(l * NV + (q < CTX ? BATCH : b)) * 6 * D_MODEL; }

namespace pg8 {
constexpr int BM = 256, BK = 64, HALF = 128, HTB = HALF * BK * 2, STAGE_BYTES = 8 * HTB, NXCD = 8, WGM = 8;
struct Unit { int pm, pn, e, k0, po; };
struct Gemm { const bf16* A; const bf16* Bt; int lda, ldb, K; size_t bstride; };
DEV int lds_byte(int r, int c) { const int st = (r >> 4) * 2 + (c >> 5), rr = r & 15, cc = c & 31, ob = rr * 64 + cc * 2; return st * 1024 + (ob ^ (((ob >> 9) & 1) << 5)); }
DEV void stage_rc(int b, int& R, int& C) { const int st = b / 1024, sb = b % 1024, swz = sb ^ (((sb >> 9) & 1) << 5); R = (st >> 1) * 16 + swz / 64; C = (st & 1) * 32 + (swz % 64) / 2; }
DEV int perm32(int rho) { const int n = rho >> 4, i = rho & 15; return 8 * (i >> 2) + 4 * n + (i & 3); }
struct Order {
    int nM, nN, nwg, G, c, wgm;
    DEV void init(int nM_, int nN_, int G_, int c_, int wgm_ = WGM) { nM = nM_; nN = nN_; nwg = nM * nN; G = G_; c = c_; wgm = wgm_; }
    DEV bool nextL(int i, int& lm, int& ln) const {
        const long L = (long)i * G + c; if (L >= nwg) return false;
        int wgid = (int)L; { const int q = nwg / NXCD, r = nwg % NXCD, xcd = wgid % NXCD, off = wgid / NXCD; wgid = (xcd < r ? xcd * (q + 1) : r * (q + 1) + (xcd - r) * q) + off; }
        const int nig = wgm * nN, gid = wgid / nig, fm = gid * wgm, gsz = (nM - fm) < wgm ? (nM - fm) : wgm;
        lm = fm + ((wgid % nig) % gsz); ln = (wgid % nig) / gsz; return true;
    }
};
#ifndef EMU
#define PG8_LAS __attribute__((address_space(3)))
DEV unsigned cvt_pk_bf16(float lo, float hi) { unsigned r; asm volatile("v_cvt_pk_bf16_f32 %0, %1, %2" : "=v"(r) : "v"(lo), "v"(hi)); return r; }
template <class Epi, class Sched>
DEV void gemm_phase(unsigned char* lds_, const int tid, const Gemm g, const Sched& S, const Epi& E) {
    PG8_LAS unsigned char* lds = (PG8_LAS unsigned char*)lds_;
    const int wid = __builtin_amdgcn_readfirstlane(tid >> 6), lane = tid & 63, wr = wid >> 2, wc = wid & 3, fr = lane & 15, fq = lane >> 4;
    const int K = g.K, nt = K / BK, lda = g.lda, ldb = g.ldb;
    unsigned voffA[2], voffB[2];
#pragma unroll
    for (int i = 0; i < 2; ++i) { int R, C; stage_rc(tid * 16 + i * 8192, R, C); const int Rb = Epi::PERM ? ((R & ~31) + perm32(R & 31)) : R;
        voffA[i] = (unsigned)(R * lda + C) * 2u; voffB[i] = (unsigned)(Rb * ldb + C) * 2u; }
    const size_t kstep = (size_t)(BK * 2);
    const size_t hstepA = (size_t)HALF * lda * 2, hstepB = (size_t)HALF * ldb * 2;
    const size_t tstepA = 2 * hstepA, tstepB = 2 * hstepB;
    const unsigned ldsw = (unsigned)wid * 1024u;
    const int aoff = lds_byte(wr * 64 + fr, fq * 8), boff = lds_byte(wc * 32 + fr, fq * 8);
#define PG8_SA(b, h) (((b) * 2 + (h)) * HTB)
#define PG8_SB(b, h) ((4 + (b) * 2 + (h)) * HTB)
#define PG8_STAGE(bufoff, gbase, voff) do { _Pragma("unroll") for (int _i = 0; _i < 2; ++_i) \
        __builtin_amdgcn_global_load_lds((const unsigned*)((const char*)(gbase) + (voff)[_i]), (PG8_LAS unsigned*)(lds + (bufoff) + ldsw + _i * 8192), 16, 0, 0); } while (0)
#define PG8_LDA(dst, b, h) do { _Pragma("unroll") for (int m = 0; m < 4; ++m) _Pragma("unroll") for (int k = 0; k < 2; ++k) dst[m][k] = *(const PG8_LAS bf16x8*)(lds + PG8_SA(b, h) + aoff + m * 2048 + k * 1024); } while (0)
#define PG8_LDB(dst, b, h) do { _Pragma("unroll") for (int n = 0; n < 2; ++n) _Pragma("unroll") for (int k = 0; k < 2; ++k) dst[n][k] = *(const PG8_LAS bf16x8*)(lds + PG8_SB(b, h) + boff + n * 2048 + k * 1024); } while (0)
#define PG8_MMA(ai, bj, At, Bt) do { __builtin_amdgcn_s_setprio(1); _Pragma("unroll") for (int m = 0; m < 4; ++m) _Pragma("unroll") for (int n = 0; n < 2; ++n) _Pragma("unroll") for (int k = 0; k < 2; ++k) \
        acc[ai][bj][m][n] = __builtin_amdgcn_mfma_f32_16x16x32_bf16(Bt[n][k], At[m][k], acc[ai][bj][m][n], 0, 0, 0); __builtin_amdgcn_s_setprio(0); } while (0)
#define PG8_WAIT_V(n) asm volatile("s_waitcnt vmcnt(" #n ")" ::: "memory")
#define PG8_WAIT_L(n) asm volatile("s_waitcnt lgkmcnt(" #n ")" ::: "memory")
#define PG8_BAR __builtin_amdgcn_s_barrier()
#define PG8_SCHED __builtin_amdgcn_sched_barrier(0)
    Unit cur, nxt; int ui = 0;
    if (!S.next(0, cur)) return;
    f32x4 acc[2][2][4][2];
#pragma unroll
    for (int a = 0; a < 2; ++a)
#pragma unroll
        for (int b = 0; b < 2; ++b)
#pragma unroll
            for (int m = 0; m < 4; ++m)
#pragma unroll
                for (int n = 0; n < 2; ++n) acc[a][b][m][n] = (f32x4){0.f, 0.f, 0.f, 0.f};
    bf16x8 At[4][2], B0[2][2], B1[2][2];
    const char* cA = (const char*)g.A + (size_t)cur.pm * tstepA + (size_t)cur.k0 * 2; const char* cB = (const char*)g.Bt + (size_t)cur.e * g.bstride + (size_t)cur.pn * tstepB + (size_t)cur.k0 * 2;
    PG8_STAGE(PG8_SB(0, 0), cB, voffB); PG8_STAGE(PG8_SB(0, 1), cB + hstepB, voffB); PG8_STAGE(PG8_SA(0, 0), cA, voffA); PG8_STAGE(PG8_SA(0, 1), cA + hstepA, voffA);
    if (wr == 1) PG8_BAR;
    PG8_WAIT_V(2); PG8_BAR;
    PG8_STAGE(PG8_SB(1, 0), cB + kstep, voffB); PG8_STAGE(PG8_SA(1, 0), cA + kstep, voffA); PG8_STAGE(PG8_SB(1, 1), cB + hstepB + kstep, voffB);
    PG8_WAIT_V(6); PG8_BAR;
    for (;;) {
        const bool has_next = S.next(ui + 1, nxt);
        const char* nA = has_next ? (const char*)g.A + (size_t)nxt.pm * tstepA + (size_t)nxt.k0 * 2 : cA; const char* nB = has_next ? (const char*)g.Bt + (size_t)nxt.e * g.bstride + (size_t)nxt.pn * tstepB + (size_t)nxt.k0 * 2 : cB;
#pragma unroll 1
        for (int t = 0; t < nt; t += 2) {
            const bool last = (t == nt - 2);
            const char* a1 = cA + (size_t)(t + 1) * kstep;
            const char* a2 = last ? nA : cA + (size_t)(t + 2) * kstep; const char* b2 = last ? nB : cB + (size_t)(t + 2) * kstep;
            const char* a3 = a2 + kstep; const char* b3 = b2 + kstep;
            PG8_LDB(B0, 0, 0); PG8_LDB(B1, 0, 1); PG8_SCHED; PG8_LDA(At, 0, 0); PG8_STAGE(PG8_SA(1, 1), a1 + hstepA, voffA);
            PG8_WAIT_V(8); PG8_WAIT_L(0); PG8_BAR; PG8_MMA(0, 0, At, B0); PG8_MMA(0, 1, At, B1); PG8_BAR; PG8_SCHED;
            PG8_LDA(At, 0, 1); PG8_STAGE(PG8_SB(0, 0), b2, voffB); PG8_STAGE(PG8_SB(0, 1), b2 + hstepB, voffB); PG8_STAGE(PG8_SA(0, 0), a2, voffA);
            PG8_WAIT_V(8); PG8_WAIT_L(0); PG8_BAR; PG8_MMA(1, 0, At, B0); PG8_MMA(1, 1, At, B1); PG8_BAR; PG8_SCHED;
            PG8_LDB(B0, 1, 0); PG8_LDB(B1, 1, 1); PG8_SCHED; PG8_LDA(At, 1, 0); PG8_STAGE(PG8_SA(0, 1), a2 + hstepA, voffA);
            PG8_WAIT_V(8); PG8_WAIT_L(0); PG8_BAR; PG8_MMA(0, 0, At, B0); PG8_MMA(0, 1, At, B1); PG8_BAR; PG8_SCHED;
            PG8_LDA(At, 1, 1); PG8_STAGE(PG8_SB(1, 0), b3, voffB); PG8_STAGE(PG8_SB(1, 1), b3 + hstepB, voffB); PG8_STAGE(PG8_SA(1, 0), a3, voffA);
            PG8_WAIT_V(8); PG8_WAIT_L(0); PG8_BAR; PG8_MMA(1, 0, At, B0); PG8_MMA(1, 1, At, B1); PG8_BAR; PG8_SCHED;
        }
        if (wr == 0) PG8_BAR;
        E(acc, cur, wr, wc, fr, fq);
        if (!has_next) break;
#pragma unroll
        for (int a = 0; a < 2; ++a)
#pragma unroll
            for (int b = 0; b < 2; ++b)
#pragma unroll
                for (int m = 0; m < 4; ++m)
#pragma unroll
                    for (int n = 0; n < 2; ++n) acc[a][b][m][n] = (f32x4){0.f, 0.f, 0.f, 0.f};
        cur = nxt; cA = nA; cB = nB; ++ui;
        if (wr == 1) PG8_BAR;
    }
    PG8_WAIT_V(0);
    PG8_BAR;
#undef PG8_SA
#undef PG8_SB
#undef PG8_STAGE
#undef PG8_LDA
#undef PG8_LDB
#undef PG8_MMA
#undef PG8_WAIT_V
#undef PG8_WAIT_L
#undef PG8_BAR
#undef PG8_SCHED
}
#else
DEV unsigned cvt_pk_bf16(float lo, float hi) { return pk2(lo, hi); }
template <class Epi, class Sched>
DEV void gemm_phase(unsigned char*, const int tid, const Gemm g, const Sched& S, const Epi& E) {
    const int wid = tid >> 6, lane = tid & 63, wr = wid >> 2, wc = wid & 3, fr = lane & 15, fq = lane >> 4;
    Unit u;
    for (int ui = 0; S.next(ui, u); ++ui) {
        f32x4 acc[2][2][4][2];
        const bf16* Bt = (const bf16*)((const char*)g.Bt + (size_t)u.e * g.bstride);
        for (int ai = 0; ai < 2; ++ai) for (int bj = 0; bj < 2; ++bj) for (int m = 0; m < 4; ++m) for (int n = 0; n < 2; ++n) for (int j = 0; j < 4; ++j) {
            const size_t row = (size_t)u.pm * 256 + 128 * ai + 64 * wr + 16 * m + fr;
            const size_t col = (size_t)u.pn * 256 + 128 * bj + 32 * wc + (Epi::PERM ? 8 * fq + 4 * n + j : 16 * n + 4 * fq + j);
            const bf16* a = g.A + row * g.lda + u.k0; const bf16* b = Bt + col * g.ldb + u.k0; float s = 0.f;
            for (int k = 0; k < g.K; ++k) s += bf2f(a[k]) * bf2f(b[k]);
            acc[ai][bj][m][n][j] = s; }
        E(acc, u, wr, wc, fr, fq);
    }
}
#endif
}

using pg8::Unit;
struct EpiStore {
    static constexpr bool PERM = true;
    bf16* O; int ldc; float* gates;
    DEV void operator()(const f32x4 (&acc)[2][2][4][2], const Unit& u, int wr, int wc, int fr, int fq) const {
        const int row0 = u.pm * 256 + wr * 64 + fr, col0 = u.pn * 256 + wc * 32 + 8 * fq;
        const bool dog = gates != nullptr && u.pn == C_G / 256 && wc == 0 && fq < 2;
#pragma unroll
        for (int ai = 0; ai < 2; ++ai)
#pragma unroll
            for (int m = 0; m < 4; ++m) { const int row = row0 + ai * 128 + m * 16; bf16* rowp = O + (size_t)row * ldc + col0;
#pragma unroll
                for (int bj = 0; bj < 2; ++bj) { const f32x4 v0 = acc[ai][bj][m][0], v1 = acc[ai][bj][m][1];
                    u32x4 w; w.x = pg8::cvt_pk_bf16(v0[0], v0[1]); w.y = pg8::cvt_pk_bf16(v0[2], v0[3]); w.z = pg8::cvt_pk_bf16(v1[0], v1[1]); w.w = pg8::cvt_pk_bf16(v1[2], v1[3]);
                    *(u32x4*)(rowp + bj * 128) = w;
                    if (bj == 0 && dog) { float* gp = gates + (size_t)row * 16 + 8 * fq; *(f32x4*)gp = v0; *(f32x4*)(gp + 4) = v1; } } }
    }
};
template <bool from_input> struct EpiResid {
    static constexpr bool PERM = true;
    P p; int l, goff;
    DEV void operator()(const f32x4 (&acc)[2][2][4][2], const Unit& u, int wr, int wc, int fr, int fq) const {
        const int R0 = u.pm * 256, bb = R0 / TP, q0 = R0 % TP; const bool isctx = q0 < CTX;
        bf16* xb = resid_row(p, R0); constexpr size_t rs = RPITCH;
        const float* xin = isctx ? p.ctx + (size_t)(bb * CTX + q0) * D_MODEL : p.x + (size_t)(bb * SEQ + q0 - CTX) * D_MODEL;
        const float* gv = modv(p, l, R0) + goff;
        const int col0 = u.pn * 256 + wc * 32 + 8 * fq;
        constexpr int MB = from_input ? 2 : 4;
#pragma unroll
        for (int bj = 0; bj < 2; ++bj) { const int col = col0 + bj * 128; const f32x4 g0 = *(const f32x4*)(gv + col), g1 = *(const f32x4*)(gv + col + 4);
#pragma unroll
            for (int ai = 0; ai < 2; ++ai)
#pragma unroll
                for (int mb = 0; mb < 4; mb += MB) { f32x4 a0[MB], a1[MB];
#pragma unroll
                    for (int mm = 0; mm < MB; ++mm) { const size_t rl = (size_t)(wr * 64 + fr + ai * 128 + (mb + mm) * 16);
                        if (from_input) { a0[mm] = *(const f32x4*)(xin + rl * D_MODEL + col); a1[mm] = *(const f32x4*)(xin + rl * D_MODEL + col + 4); }
                        else { const u32x4 t = *(const u32x4*)(xb + rl * rs + col);
                            a0[mm] = (f32x4){bf2f((bf16)t.x), bf2f((bf16)(t.x >> 16)), bf2f((bf16)t.y), bf2f((bf16)(t.y >> 16))}; a1[mm] = (f32x4){bf2f((bf16)t.z), bf2f((bf16)(t.z >> 16)), bf2f((bf16)t.w), bf2f((bf16)(t.w >> 16))}; } }
#pragma unroll
                    for (int mm = 0; mm < MB; ++mm) { const size_t rl = (size_t)(wr * 64 + fr + ai * 128 + (mb + mm) * 16);
                        const f32x4 o0 = a0[mm] + g0 * acc[ai][bj][mb + mm][0], o1 = a1[mm] + g1 * acc[ai][bj][mb + mm][1];
                        u32x4 wv; wv.x = pg8::cvt_pk_bf16(o0[0], o0[1]); wv.y = pg8::cvt_pk_bf16(o0[2], o0[3]); wv.z = pg8::cvt_pk_bf16(o1[0], o1[1]); wv.w = pg8::cvt_pk_bf16(o1[2], o1[3]);
                        *(u32x4*)(xb + rl * rs + col) = wv; } } }
    }
};
struct EpiSwiglu {
    static constexpr bool PERM = true;
    bf16* O; int pm_base;
    DEV void operator()(const f32x4 (&acc)[2][2][4][2], const Unit& u, int wr, int wc, int fr, int fq) const {
        const int row0 = u.po * 256 + wr * 64 + fr, col0 = u.pn * 128 + wc * 32 + 8 * fq;
#pragma unroll
        for (int ai = 0; ai < 2; ++ai)
#pragma unroll
            for (int m = 0; m < 4; ++m) { float r[8];
#pragma unroll
                for (int n = 0; n < 2; ++n)
#pragma unroll
                    for (int j = 0; j < 4; ++j) r[4 * n + j] = silu_fast(acc[ai][0][m][n][j]) * acc[ai][1][m][n][j];
                u32x4 w; w.x = pg8::cvt_pk_bf16(r[0], r[1]); w.y = pg8::cvt_pk_bf16(r[2], r[3]); w.z = pg8::cvt_pk_bf16(r[4], r[5]); w.w = pg8::cvt_pk_bf16(r[6], r[7]);
                *(u32x4*)(O + (size_t)(row0 + ai * 128 + m * 16) * D_FF + col0) = w; }
    }
};
struct EpiStoreRel {
    static constexpr bool PERM = true;
    bf16* O; int ldc, pm_base;
    DEV void operator()(const f32x4 (&acc)[2][2][4][2], const Unit& u, int wr, int wc, int fr, int fq) const {
        const int row0 = u.po * 256 + wr * 64 + fr, col0 = u.pn * 256 + wc * 32 + 8 * fq;
#pragma unroll
        for (int ai = 0; ai < 2; ++ai)
#pragma unroll
            for (int m = 0; m < 4; ++m) { bf16* rowp = O + (size_t)(row0 + ai * 128 + m * 16) * ldc + col0;
#pragma unroll
                for (int bj = 0; bj < 2; ++bj) { const f32x4 v0 = acc[ai][bj][m][0], v1 = acc[ai][bj][m][1];
                    u32x4 w; w.x = pg8::cvt_pk_bf16(v0[0], v0[1]); w.y = pg8::cvt_pk_bf16(v0[2], v0[3]); w.z = pg8::cvt_pk_bf16(v1[0], v1[1]); w.w = pg8::cvt_pk_bf16(v1[2], v1[3]);
                    *(u32x4*)(rowp + bj * 128) = w; } }
    }
};
template <int mode> struct Sched {
    pg8::Order o; int pm_base; const int* seg; int nNc, kper;
    DEV bool next(int i, Unit& u) const {
        int lm, ln; if (!o.nextL(i, lm, ln)) return false;
        u.pn = ln; u.e = 0; u.k0 = 0; u.po = lm;
        if (mode == 0) u.pm = lm;
        else if (mode == 1) u.pm = (lm / NQL) * PAN_B + 1 + lm % NQL;
        else if (mode == 6) { u.pm = lm; u.k0 = (ln >= 2) ? 256 : 0; }
        else if (mode == 4) { u.pm = lm * PAN_B; u.pn = ln % nNc; u.k0 = (ln / nNc) * kper; u.po = (ln / nNc) * o.nM + lm; }
        else { const int gp = pm_base + lm; int e = 0;
#pragma unroll
            for (int k = 1; k < NEXP; ++k) e += (seg[k] <= gp) ? 1 : 0;
            u.e = e; u.pm = (mode == 2) ? gp : lm;
            if (mode == 5) { u.pn = ln % nNc; u.k0 = (ln / nNc) * kper; u.po = (ln / nNc) * o.nM + lm; } }
        return true;
    }
};

#ifndef WGM_MASK
#define WGM_MASK 0x01f
#endif
#define SITE_WGM(k) (((WGM_MASK >> (k)) & 1) ? 4 : 8)
struct TabSched {
    const int* tab; int n;
    DEV bool next(int i, Unit& u) const {
        if (i >= n) return false;
        u.pm = UNIFORM_I(tab[5 * i]); u.pn = UNIFORM_I(tab[5 * i + 1]); u.e = UNIFORM_I(tab[5 * i + 2]); u.k0 = UNIFORM_I(tab[5 * i + 3]); u.po = UNIFORM_I(tab[5 * i + 4]);
        return true;
    }
};
constexpr int MAX_UNITS = 150;
template <class S> DEV TabSched build_units(unsigned* misc, int tid, const S& sch) {
    int* tab = (int*)(misc + 256);
    __syncthreads();
    if (tid < MAX_UNITS) { Unit u; if (sch.next(tid, u)) { tab[5 * tid] = u.pm; tab[5 * tid + 1] = u.pn; tab[5 * tid + 2] = u.e; tab[5 * tid + 3] = u.k0; tab[5 * tid + 4] = u.po; } }
    __syncthreads();
    const int nwg = sch.o.nwg, c = sch.o.c, G = sch.o.G;
    TabSched t; t.tab = tab; t.n = (c < nwg) ? (nwg - c + G - 1) / G : 0;
    return t;
}

#ifndef EMU
#define XB_TMO      128
#define XB_XCNT(j)  (256  + 64 * (j))
#define XB_XSUB(j)  (1280 + 64 * (j))
#define XB_XGEN(j)  (2304 + 64 * (j))
#define XB_TOP      3328
#define XB_TOPGEN   3392
#define XCD_BAR_WORDS 3456
#define XB_SPIN_CAP (1u << 22)
#define LAS __attribute__((address_space(3)))
__device__ __forceinline__ unsigned xb_ld(unsigned* p)              { return __hip_atomic_load(p, __ATOMIC_RELAXED, __HIP_MEMORY_SCOPE_AGENT); }
__device__ __forceinline__ unsigned xb_add(unsigned* p, unsigned v) { return __hip_atomic_fetch_add(p, v, __ATOMIC_RELAXED, __HIP_MEMORY_SCOPE_AGENT); }
__device__ __forceinline__ unsigned xb_xcc_id() { return (unsigned)__builtin_amdgcn_s_getreg((3 << 11) | 20) & 0xFu; }
#define XB_SPIN(cond, bar) do { unsigned _sp = 0; while (cond) { __builtin_amdgcn_s_sleep(1); \
    if ((++_sp & 255u) == 0u) { if (xb_ld(&(bar)[XB_TMO])) break; if (_sp > XB_SPIN_CAP) { atomicAdd(&(bar)[XB_TMO], 1u); break; } } } } while (0)
struct XcdBarrier { unsigned* bar; unsigned x; volatile LAS unsigned* st; };
__device__ __forceinline__ XcdBarrier xcd_barrier_post(unsigned* bar, volatile LAS unsigned* st) {
    XcdBarrier b; b.bar = bar; b.x = xb_xcc_id(); b.st = st;
    if (threadIdx.x == 0) (void)xb_add(&bar[XB_XCNT(b.x)], 1u);
    return b;
}
__device__ __forceinline__ void xcd_barrier_complete(unsigned* bar, unsigned x, unsigned& nloc, unsigned& nx) {
    const unsigned G = gridDim.x * gridDim.y * gridDim.z;
    unsigned sum, cnt, mine, sp = 0u;
    for (;;) {
        sum = 0u; cnt = 0u; mine = 0u;
#pragma unroll
        for (unsigned j = 0; j < 16; ++j) { const unsigned c = xb_ld(&bar[XB_XCNT(j)]); sum += c; cnt += (c > 0u) ? 1u : 0u; mine = (j == x) ? c : mine; }
        if (sum == G) break;
        __builtin_amdgcn_s_sleep(1);
        if ((++sp & 255u) == 0u) { if (xb_ld(&bar[XB_TMO])) break; if (sp > XB_SPIN_CAP) { atomicAdd(&bar[XB_TMO], 1u); break; } }
    }
    nloc = mine > 0u ? mine : 1u; nx = cnt > 0u ? cnt : 1u;
}
__device__ __forceinline__ void xcd_barrier(const XcdBarrier& b) {
    asm volatile("s_waitcnt vmcnt(0)" ::: "memory");
    __syncthreads();
    if (threadIdx.x == 0) {
        unsigned* bar = b.bar;
        __builtin_amdgcn_s_waitcnt(0);
        unsigned nloc = b.st[0], nx = b.st[1];
        if (nloc == 0u) { xcd_barrier_complete(bar, b.x, nloc, nx); b.st[0] = nloc; b.st[1] = nx; }
        const unsigned old = xb_add(&bar[XB_XSUB(b.x)], 1u);
        const unsigned gen = old / nloc;
        if (old + 1u == (gen + 1u) * nloc) {
            __builtin_amdgcn_fence(__ATOMIC_RELEASE, "agent");
            asm volatile("s_waitcnt vmcnt(0)" ::: "memory");
            const unsigned og = xb_add(&bar[XB_TOP], 1u);
            const unsigned tg = og / nx;
            if (og + 1u == (tg + 1u) * nx) xb_add(&bar[XB_TOPGEN], 1u);
            else XB_SPIN(xb_ld(&bar[XB_TOPGEN]) == tg, bar);
            __builtin_amdgcn_fence(__ATOMIC_ACQUIRE, "agent");
            xb_add(&bar[XB_XGEN(b.x)], 1u);
            asm volatile("s_waitcnt vmcnt(0)" ::: "memory");
        } else {
            XB_SPIN(xb_ld(&bar[XB_XGEN(b.x)]) == gen, bar);
            __builtin_amdgcn_fence(__ATOMIC_ACQUIRE, "agent");
            asm volatile("s_waitcnt vmcnt(0)" ::: "memory");
        }
    }
    __syncthreads();
}
#endif

struct Wg { int tid, lane, wave, G, wg, gw, NGW; unsigned char* lds; unsigned* misc; };
DEV int q_next(Wg& w, unsigned* ctr) {
    if (w.tid == 0) w.misc[2] = atomicAdd(ctr, 1u);
    __syncthreads();
    const int v = (int)w.misc[2];
    __syncthreads();
    return v;
}

struct ConvJob { const float* src; int K, N, Npad; bf16* dst; int ldk, kdst0, rowofs, mode; };
struct ConvTile { const float* src; int N, k0, n0; bf16* dst; int ldk, kdst0, rowofs, mode; bool valid; };
DEV bool conv_job_pick(const ConvJob& j, int& it, ConvTile& t) {
    const int nkb = j.K / 64, nnb = j.Npad / 128, tot = nkb * nnb;
    if (it >= tot) { it -= tot; return false; }
    t.src = j.src; t.N = j.N; t.k0 = (it / nnb) * 64; t.n0 = (it % nnb) * 128; t.dst = j.dst; t.ldk = j.ldk; t.kdst0 = j.kdst0; t.rowofs = j.rowofs; t.mode = j.mode; t.valid = true;
    return true;
}
DEV void conv_load(const ConvTile& t, f32x4 (&v)[4], int tid) {
#pragma unroll
    for (int i = 0; i < 4; ++i) { const int kk = i * 16 + (tid >> 5), c4 = tid & 31; v[i] = (t.valid && t.n0 + 4 * c4 < t.N) ? *(const f32x4*)(t.src + (size_t)(t.k0 + kk) * t.N + t.n0 + 4 * c4) : (f32x4){0.f, 0.f, 0.f, 0.f}; }
}
DEV void conv_store(const ConvTile& t, const f32x4 (&v)[4], float* scr, int tid) {
#pragma unroll
    for (int i = 0; i < 4; ++i) { const int kk = i * 16 + (tid >> 5), c4 = tid & 31; *(f32x4*)(scr + kk * 132 + 4 * c4) = v[i]; }
    __syncthreads();
#pragma unroll
    for (int i = 0; i < 2; ++i) { const int idx = tid + NTHR * i, n = idx >> 3, c = idx & 7, ng = t.n0 + n; const float* s = scr + (8 * c) * 132 + n;
      const int row = t.rowofs + (t.mode == 0 ? ng : (ng / 128) * 256 + (ng % 128) + (t.mode == 2 ? 128 : 0));
      u32x4 o; o.x = pk2(s[0], s[132]); o.y = pk2(s[2 * 132], s[3 * 132]); o.z = pk2(s[4 * 132], s[5 * 132]); o.w = pk2(s[6 * 132], s[7 * 132]);
      *(u32x4*)(t.dst + (size_t)row * t.ldk + t.kdst0 + t.k0 + 8 * c) = o; }
    __syncthreads();
}
DEV void zero_rect(bf16* dst, int ld, int r0, int r1, int c0, int c1, int gtid, int gn) {
    const int cw = (c1 - c0) / 8; const long tot = (long)(r1 - r0) * cw;
    for (long i = gtid; i < tot; i += gn) { const int r = r0 + (int)(i / cw), c = c0 + 8 * (int)(i % cw); *(u32x4*)(dst + (size_t)r * ld + c) = (u32x4){0u, 0u, 0u, 0u}; }
}
DEV void phase0(const P& p, Wg& w) {
    float* scr = (float*)w.lds;
    {
        bf16* WIN = (bf16*)(p.ws + WS_WIN_T); bf16* WOUT = (bf16*)(p.ws + WS_WOUT_T); bf16* MLT = (bf16*)(p.ws + WS_MLA_T);
#define JOB_WIN(l) ConvJob{p.w_in + (size_t)(l) * D_MODEL * IN_W, D_MODEL, IN_W, PROJ_W, WIN + (size_t)(l) * PROJ_W * D_MODEL, D_MODEL, 0, 0, 0}
#define JOB_WOUT(l) ConvJob{p.w_out + (size_t)(l) * MIXW * D_MODEL, MIXW, D_MODEL, D_MODEL, WOUT + (size_t)(l) * D_MODEL * MIXW, MIXW, 0, 0, 0}
#define JOB_WUQ(l) ConvJob{p.l_wuq + (size_t)(l) * 256 * 384, 256, 384, 384, MLT + (size_t)(l) * 1024 * 512, 512, 0, 0, 0}
#define JOB_WUKV(l) ConvJob{p.l_wukv + (size_t)(l) * 128 * 512, 128, 512, 512, MLT + (size_t)(l) * 1024 * 512, 512, 256, 512, 0}
        constexpr int total = 2 * ((D_MODEL / 64) * (PROJ_W / 128) + (MIXW / 64) * (D_MODEL / 128) + 4 * 3 + 2 * 4) + 2 * (D_MODEL / 64) * (D_FF / 128) + (D_FF / 64) * (D_MODEL / 128);
        ConvTile cur, nxt; f32x4 vc[4], vn[4]; cur.valid = false;
#define PICK0(it0_, T) do { int it = (it0_); T.valid = false; if ((it0_) < total) { \
            if (!conv_job_pick(JOB_WIN(0), it, T)) if (!conv_job_pick(JOB_WIN(1), it, T)) if (!conv_job_pick(JOB_WOUT(0), it, T)) if (!conv_job_pick(JOB_WOUT(1), it, T)) \
            if (!conv_job_pick(JOB_WUQ(0), it, T)) if (!conv_job_pick(JOB_WUQ(1), it, T)) if (!conv_job_pick(JOB_WUKV(0), it, T)) if (!conv_job_pick(JOB_WUKV(1), it, T)) \
            if (!conv_job_pick(ConvJob{p.ffn_wg, D_MODEL, D_FF, D_FF, (bf16*)(p.ws + WS_WGU_T), D_MODEL, 0, 0, 1}, it, T)) \
            if (!conv_job_pick(ConvJob{p.ffn_wu, D_MODEL, D_FF, D_FF, (bf16*)(p.ws + WS_WGU_T), D_MODEL, 0, 0, 2}, it, T)) \
            conv_job_pick(ConvJob{p.ffn_wd, D_FF, D_MODEL, D_MODEL, (bf16*)(p.ws + WS_WD_T), D_FF, 0, 0, 0}, it, T); } } while (0)
        PICK0(w.wg, cur); if (cur.valid) conv_load(cur, vc, w.tid);
        for (int it0 = w.wg; it0 < total; it0 += w.G) {
            PICK0(it0 + w.G, nxt); if (nxt.valid) conv_load(nxt, vn, w.tid);
            conv_store(cur, vc, scr, w.tid);
            cur = nxt;
#pragma unroll
            for (int i = 0; i < 4; ++i) vc[i] = vn[i];
        }
#undef PICK0
    }
    for (int l = 0; l < 2; ++l) { bf16* mt = (bf16*)(p.ws + WS_MLA_T) + (size_t)l * 1024 * 512; const int gt = w.wg * NTHR + w.tid, gn = w.G * NTHR;
        zero_rect(mt, 512, 384, 512, 0, 256, gt, gn); zero_rect(mt, 512, 512, 1024, 384, 512, gt, gn); }
    if (w.wg == w.G - 1) for (int i = w.tid; i < NPOS * 24; i += NTHR) { const int pos = i / 24, f = i % 24;
        const float inv = f < 16 ? exp2f(-(float)f * (13.287712379549449f / 16.0f)) : exp2f(-(float)(f - 16) * (13.287712379549449f / 8.0f));
        float sn, cs; sincosf((float)pos * inv, &sn, &cs); float* rt = (float*)(p.ws + WS_ROPE) + 2 * i; rt[0] = cs; rt[1] = sn; }
    {
        float* sS = (float*)w.lds;
        float* part = sS + NV * D_MODEL;
        const int nitem = 2 * (6 * D_MODEL / 64);
        bool loaded = false;
        for (int it = w.wg; it < nitem; it += w.G) {
            if (!loaded) { for (int i = w.tid; i < NV * D_MODEL; i += NTHR) { const int v = i / D_MODEL, k = i % D_MODEL; sS[i] = silu_f(v < BATCH ? p.c[v * D_MODEL + k] : p.c_ctx[k]); } loaded = true; __syncthreads(); }
            const int l = it / (6 * D_MODEL / 64), cb = it % (6 * D_MODEL / 64), col = cb * 64 + w.lane;
            float acc[NV];
#pragma unroll
            for (int v = 0; v < NV; ++v) acc[v] = 0.f;
            const float* mw = p.mod_w + (size_t)l * D_MODEL * 6 * D_MODEL + col;
            for (int k0 = w.wave * (D_MODEL / 8); k0 < (w.wave + 1) * (D_MODEL / 8); k0 += 16) { float wv[16];
#pragma unroll
                for (int kk = 0; kk < 16; ++kk) wv[kk] = mw[(size_t)(k0 + kk) * 6 * D_MODEL];
#pragma unroll
                for (int kk = 0; kk < 16; ++kk)
#pragma unroll
                    for (int v = 0; v < NV; ++v) acc[v] += sS[v * D_MODEL + k0 + kk] * wv[kk]; }
#pragma unroll
            for (int v = 0; v < NV; ++v) part[(w.wave * NV + v) * 64 + w.lane] = acc[v];
            __syncthreads();
            for (int i = w.tid; i < NV * 64; i += NTHR) { const int v = i / 64, cc = i % 64; float s = p.mod_b[(size_t)l * 6 * D_MODEL + cb * 64 + cc];
#pragma unroll
                for (int ww = 0; ww < 8; ++ww) s += part[(ww * NV + v) * 64 + cc];
                ((float*)(p.ws + WS_MODV))[(size_t)(l * NV + v) * 6 * D_MODEL + cb * 64 + cc] = s; }
            __syncthreads();
        }
    }
}
DEV void phase_moe_weights(const P& p, Wg& w) {
    float* scr = (float*)w.lds;
    const int t_gu = (D_MODEL / 64) * (D_FF / 128), t_d = (D_FF / 64) * (D_MODEL / 128), per_e = 2 * t_gu + t_d;
    ConvTile cur, nxt; f32x4 vc[4], vn[4];
#define PICKM(it0_, T) do { T.valid = false; if ((it0_) < NEXP * per_e) { const int e = (it0_) / per_e; int it = (it0_) % per_e; bf16* base = (bf16*)(p.ws + WS_MOEW + (size_t)e * MOEW_E); \
        if (!conv_job_pick(ConvJob{p.moe_wg + (size_t)e * D_MODEL * D_FF, D_MODEL, D_FF, D_FF, base, D_MODEL, 0, 0, 1}, it, T)) \
        if (!conv_job_pick(ConvJob{p.moe_wu + (size_t)e * D_MODEL * D_FF, D_MODEL, D_FF, D_FF, base, D_MODEL, 0, 0, 2}, it, T)) \
        conv_job_pick(ConvJob{p.moe_wd + (size_t)e * D_FF * D_MODEL, D_FF, D_MODEL, D_MODEL, base + (size_t)2 * D_FF * D_MODEL, D_FF, 0, 0, 0}, it, T); } } while (0)
    PICKM(w.wg, cur); if (cur.valid) conv_load(cur, vc, w.tid);
    for (int it0 = w.wg; it0 < NEXP * per_e; it0 += w.G) {
        PICKM(it0 + w.G, nxt); if (nxt.valid) conv_load(nxt, vn, w.tid);
        conv_store(cur, vc, scr, w.tid);
        cur = nxt;
#pragma unroll
        for (int i = 0; i < 4; ++i) vc[i] = vn[i];
    }
#undef PICKM
}

template <int NB> DEV void phase_modulate(const P& p, Wg& w, int l, int which, bool first, bool skip_ctx, bool moe, bool ctx_part) {
    constexpr int NJ = D_MODEL / 256;
    bf16* H = (bf16*)(p.ws + WS_H);
    const float* gn = (which ? p.norm_ffn : p.norm_mix) + (size_t)l * D_MODEL;
    int cnt[NEXP];
#pragma unroll
    for (int e = 0; e < NEXP; ++e) cnt[e] = 0;
    f32x4 rw[NJ * 4][2];
    if (moe) {
#pragma unroll
        for (int j = 0; j < NJ; ++j)
#pragma unroll
            for (int k = 0; k < 4; ++k) { const float* rr = p.moe_router + (size_t)(4 * w.lane + 256 * j + k) * NEXP; rw[4 * j + k][0] = *(const f32x4*)rr; rw[4 * j + k][1] = *(const f32x4*)(rr + 4); } }
    f32x4 gnv[NJ];
#pragma unroll
    for (int j = 0; j < NJ; ++j) gnv[j] = *(const f32x4*)(gn + 4 * w.lane + 256 * j);
    static_assert(TP % NB == 0 && CTX % NB == 0 && M_ALL % NB == 0, "a group of NB consecutive rows never straddles a batch / context boundary");
    const int step = NB * w.NGW;
    u32x2 nraw[NB][NJ];
#define MOD_PF(Rg_) do { _Pragma("unroll") for (int qq = 0; qq < NB; ++qq) { const bf16* xr_ = resid_row(p, (Rg_) + qq); \
        _Pragma("unroll") for (int j = 0; j < NJ; ++j) nraw[qq][j] = *(const u32x2*)(xr_ + 4 * w.lane + 256 * j); } } while (0)
    if (!first) MOD_PF(NB * w.gw);
    for (int Rb = NB * w.gw; Rb < M_ALL; Rb += step) {
        f32x4 vv[NB][NJ];
        if (first) {
#pragma unroll
            for (int qq = 0; qq < NB; ++qq) { const int R = Rb + qq, b = R / TP, q = R % TP;
                const float* src = q < CTX ? p.ctx + (size_t)(b * CTX + q) * D_MODEL : p.x + (size_t)(b * SEQ + q - CTX) * D_MODEL;
#pragma unroll
                for (int j = 0; j < NJ; ++j) vv[qq][j] = *(const f32x4*)(src + 4 * w.lane + 256 * j); } }
        else {
#pragma unroll
            for (int qq = 0; qq < NB; ++qq)
#pragma unroll
                for (int j = 0; j < NJ; ++j) { const u32x2 t = nraw[qq][j]; vv[qq][j] = (f32x4){bf2f((bf16)t.x), bf2f((bf16)(t.x >> 16)), bf2f((bf16)t.y), bf2f((bf16)(t.y >> 16))}; } }
        f32x4 gs[NJ], s0v[NJ];
        { const float* mv = modv(p, l, Rb); const float* sh = mv + (which ? 3 : 0) * D_MODEL; const float* sc = mv + (which ? 4 : 1) * D_MODEL;
#pragma unroll
          for (int j = 0; j < NJ; ++j) { gs[j] = *(const f32x4*)(sc + 4 * w.lane + 256 * j); s0v[j] = *(const f32x4*)(sh + 4 * w.lane + 256 * j); } }
        if (!first && Rb + step < M_ALL) MOD_PF(Rb + step);
        if (skip_ctx && (Rb % TP) < CTX) continue;
#pragma unroll
        for (int j = 0; j < NJ; ++j) gs[j] = gnv[j] * (1.0f + gs[j]);
#pragma unroll
        for (int qq = 0; qq < NB; ++qq) {
        const int R = Rb + qq; const int b = R / TP, q = R % TP;
        bf16* xr = resid_row(p, R);
        f32x4 v[NJ]; float ss = 0.f;
#pragma unroll
        for (int j = 0; j < NJ; ++j) { v[j] = vv[qq][j]; ss += v[j][0] * v[j][0] + v[j][1] * v[j][1] + v[j][2] * v[j][2] + v[j][3] * v[j][3]; }
        if (ctx_part && q < CTX) {
            const bf16* cp = (const bf16*)(p.ws + WS_MLAQ) + (size_t)(b * CTX + q) * D_MODEL; const float* gf = (const float*)(p.ws + WS_MODV) + (size_t)((l - 1) * NV + BATCH) * 6 * D_MODEL + 5 * D_MODEL;
            ss = 0.f;
#pragma unroll
            for (int j = 0; j < NJ; ++j) { const int col = 4 * w.lane + 256 * j; f32x4 a = (f32x4){0.f, 0.f, 0.f, 0.f};
                for (int ks = 0; ks < NSPLIT; ++ks) { const u32x2 t = *(const u32x2*)(cp + (size_t)ks * BATCH * CTX * D_MODEL + col);
                    a[0] += bf2f((bf16)t.x); a[1] += bf2f((bf16)(t.x >> 16)); a[2] += bf2f((bf16)t.y); a[3] += bf2f((bf16)(t.y >> 16)); }
                const f32x4 g = *(const f32x4*)(gf + col); v[j] = v[j] + g * a; { u32x2 wb; wb.x = pk2(v[j][0], v[j][1]); wb.y = pk2(v[j][2], v[j][3]); *(u32x2*)(xr + col) = wb; }
                ss += v[j][0] * v[j][0] + v[j][1] * v[j][1] + v[j][2] * v[j][2] + v[j][3] * v[j][3]; } }
        ss = wave_sum(ss, w.lane);
        const float rstd = rsqrt_fast(ss * (1.0f / D_MODEL) + EPS);
        float lg[NEXP];
#pragma unroll
        for (int e = 0; e < NEXP; ++e) lg[e] = 0.f;
#pragma unroll
        for (int j = 0; j < NJ; ++j) { const int col = 4 * w.lane + 256 * j;
            f32x4 h;
#pragma unroll
            for (int k = 0; k < 4; ++k) h[k] = v[j][k] * rstd * gs[j][k] + s0v[j][k];
            u32x2 o; o.x = pk2(h[0], h[1]); o.y = pk2(h[2], h[3]);
            *(u32x2*)(H + (size_t)R * D_MODEL + col) = o;
            if (moe) {
#pragma unroll
                for (int k = 0; k < 4; ++k) {
#pragma unroll
                    for (int e = 0; e < NEXP; ++e) lg[e] += h[k] * rw[4 * j + k][e >> 2][e & 3]; } } }
        if (moe) {
#pragma unroll
            for (int e = 0; e < NEXP; ++e) lg[e] = wave_sum(lg[e], w.lane);
            int i1 = 0; float v1 = lg[0];
#pragma unroll
            for (int e = 1; e < NEXP; ++e) if (lg[e] > v1) { v1 = lg[e]; i1 = e; }
            int i2 = -1; float v2 = -3.0e38f;
#pragma unroll
            for (int e = 0; e < NEXP; ++e) if (e != i1 && lg[e] > v2) { v2 = lg[e]; i2 = e; }
            const float w1 = 1.0f / (1.0f + expf(v2 - v1)), w2 = 1.0f - w1;
            const int tok = b * SEQ + q - CTX;
            if (w.lane == 0) { int* ti = (int*)(p.ws + WS_TOPI) + 2 * tok; float* tw = (float*)(p.ws + WS_TOPW) + 2 * tok; ti[0] = i1; ti[1] = i2; tw[0] = w1; tw[1] = w2; }
#pragma unroll
            for (int e = 0; e < NEXP; ++e) cnt[e] += (e == i1 || e == i2) ? 1 : 0;
        }
        }
    }
    if (moe) {
        int* lc = (int*)w.lds;
        if (w.lane == 0) {
#pragma unroll
            for (int e = 0; e < NEXP; ++e) lc[w.wave * NEXP + e] = cnt[e]; }
        __syncthreads();
        if (w.tid < NEXP) { int s = 0; for (int ww = 0; ww < NWAVE; ++ww) s += lc[ww * NEXP + w.tid]; ((int*)(p.ws + WS_CNTG))[w.wg * NEXP + w.tid] = s; }
        __syncthreads();
    }
}

#undef MOD_PF
DEV void phase_prep(const P& p, Wg& w, int l) {
    bf16* PROJ = (bf16*)(p.ws + WS_PROJ); bf16* MQK = (bf16*)(p.ws + WS_MQK);
    const float* cw = p.m_conv + (size_t)l * 3 * 768;
    const int lane = w.lane;
    const float gkr = p.l_knorm[l * 96 + 64 + (lane & 31)];
    const f32x4 gcq = *(const f32x4*)(p.l_cq_norm + l * 256 + 4 * lane); const float gkv0 = p.l_ckv_norm[l * 128 + 2 * lane], gkv1 = p.l_ckv_norm[l * 128 + 2 * lane + 1];
    const int hq = lane >> 3, hi8 = lane & 7, hbase = (hq < 6 ? C_AQ + hq * 64 : C_AK + (hq - 6) * 64) + 8 * hi8;
    f32x4 cwv[3][3];
#pragma unroll
    for (int j = 0; j < 3; ++j)
#pragma unroll
        for (int tp = 0; tp < 3; ++tp) cwv[j][tp] = *(const f32x4*)(cw + tp * 768 + 4 * lane + 256 * j);
    float gh[8];
    { const float* gp = (hq < 6 ? p.a_qnorm : p.a_knorm) + l * 64 + 8 * hi8;
#pragma unroll
      for (int j = 0; j < 8; ++j) gh[j] = gp[j] * (hq < 6 ? QSCALE_A : 1.0f); }
    const float* rtab = (const float*)(p.ws + WS_ROPE);
    constexpr int NB = 4;
    const int RPW = (M_ALL + w.NGW - 1) / w.NGW, Rend = ((w.gw + 1) * RPW < M_ALL) ? (w.gw + 1) * RPW : M_ALL;
    for (int R0 = w.gw * RPW; R0 < Rend; R0 += NB) {
        u32x2 c0[NB][3], cp[NB][3], cn[NB][3], cprev[3], cnext[3]; u32x4 hraw[NB]; u32x2 cqv[NB]; unsigned ckvv[NB]; bf16 krv[NB]; bool ok[NB];
        { const bool hpv = R0 > 0, hnv = R0 + NB < M_ALL;
#pragma unroll
          for (int j = 0; j < 3; ++j) { const int col = 4 * lane + 256 * j;
              cprev[j] = hpv ? *(const u32x2*)(PROJ + (size_t)(R0 - 1) * PROJ_W + col) : (u32x2){0u, 0u}; cnext[j] = hnv ? *(const u32x2*)(PROJ + (size_t)(R0 + NB) * PROJ_W + col) : (u32x2){0u, 0u}; } }
#pragma unroll
        for (int q = 0; q < NB; ++q) { const int R = R0 + q; ok[q] = R < Rend; const int Rr = R < M_ALL ? R : R0;
            const bf16* pr = PROJ + (size_t)Rr * PROJ_W;
#pragma unroll
            for (int j = 0; j < 3; ++j) c0[q][j] = *(const u32x2*)(pr + 4 * lane + 256 * j);
            hraw[q] = *(const u32x4*)(pr + hbase); cqv[q] = *(const u32x2*)(pr + C_CQ + 4 * lane); ckvv[q] = *(const unsigned*)(pr + C_CKV + 2 * lane); krv[q] = pr[C_KR + (lane & 31)]; }
#pragma unroll
        for (int q = 0; q < NB; ++q) { const int qq = (R0 + q) % TP; const bool hp = !(qq == 0 || qq == CTX), hn = !(qq == CTX - 1 || qq == TP - 1);
#pragma unroll
            for (int j = 0; j < 3; ++j) { const u32x2 a = (q == 0) ? cprev[j] : c0[q > 0 ? q - 1 : 0][j], n = (q == NB - 1) ? cnext[j] : c0[q < NB - 1 ? q + 1 : 0][j];
                cp[q][j] = hp ? a : (u32x2){0u, 0u}; cn[q][j] = hn ? n : (u32x2){0u, 0u}; } }
#pragma unroll
        for (int q = 0; q < NB; ++q) { const int Rr = (R0 + q < M_ALL) ? R0 + q : R0; const int qq = Rr % TP; const bool lat = qq >= CTX; const int t = qq - CTX;
            bf16* pr = PROJ + (size_t)Rr * PROJ_W;
            u32x2 ov[3];
#pragma unroll
            for (int j = 0; j < 3; ++j) { const int col = 4 * lane + 256 * j; float o[4];
#pragma unroll
                for (int k = 0; k < 4; ++k) { const unsigned sh = (k & 1) * 16; const unsigned a = (k < 2 ? cp[q][j].x : cp[q][j].y) >> sh, c = (k < 2 ? c0[q][j].x : c0[q][j].y) >> sh, n = (k < 2 ? cn[q][j].x : cn[q][j].y) >> sh;
                    const float sv = bf2f((bf16)a) * cwv[j][0][k] + bf2f((bf16)c) * cwv[j][1][k] + bf2f((bf16)n) * cwv[j][2][k]; o[k] = silu_fast(sv) * (col >= 384 ? KSCALE_M : 1.0f); }
                ov[j].x = pk2(o[0], o[1]); ov[j].y = pk2(o[2], o[3]); }
            u32x4 oh;
            { float x[8], ss = 0.f;
#pragma unroll
              for (int j = 0; j < 8; ++j) { x[j] = bf2f((bf16)(hraw[q][j >> 1] >> ((j & 1) * 16))); ss += x[j] * x[j]; }
              ss += SHX(ss, 1, lane); ss += SHX(ss, 2, lane); ss += SHX(ss, 4, lane);
              const float rs = rsqrt_fast(ss * (1.0f / 64.0f) + EPS);
#pragma unroll
              for (int j = 0; j < 8; ++j) x[j] *= rs * gh[j];
              const float* ct = rtab + ((size_t)(lat ? (hi8 < 4 ? t / GRID_W : t % GRID_W) : 0) * 24 + 8 * (hi8 & 1)) * 2;
              const f32x4 t0 = *(const f32x4*)ct, t1 = *(const f32x4*)(ct + 4), t2 = *(const f32x4*)(ct + 8), t3 = *(const f32x4*)(ct + 12);
              const float csv[8] = {t0[0], t0[2], t1[0], t1[2], t2[0], t2[2], t3[0], t3[2]}, snv[8] = {t0[1], t0[3], t1[1], t1[3], t2[1], t2[3], t3[1], t3[3]};
#pragma unroll
              for (int j = 0; j < 8; ++j) { const float pt = SHX(x[j], 2, lane);
                  if (lat) x[j] = (hi8 & 2) ? x[j] * csv[j] + pt * snv[j] : x[j] * csv[j] - pt * snv[j]; }
              oh.x = pk2(x[0], x[1]); oh.y = pk2(x[2], x[3]); oh.z = pk2(x[4], x[5]); oh.w = pk2(x[6], x[7]); }
            float csL = 1.f, snL = 0.f;
            if (lat) { const int d = lane & 31; const float* ct = rtab + ((size_t)(d < 16 ? t / GRID_W : t % GRID_W) * 24 + 16 + (d & 7)) * 2; csL = ct[0]; snL = ct[1]; }
            u32x2 ocq; unsigned ockv; float ykr;
            { float x[4] = {bf2f((bf16)cqv[q].x), bf2f((bf16)(cqv[q].x >> 16)), bf2f((bf16)cqv[q].y), bf2f((bf16)(cqv[q].y >> 16))};
              const float x0 = bf2f((bf16)ckvv[q]), x1 = bf2f((bf16)(ckvv[q] >> 16)); const float vk = lane < 32 ? bf2f(krv[q]) : 0.f;
              float s1 = x[0] * x[0] + x[1] * x[1] + x[2] * x[2] + x[3] * x[3], s2 = x0 * x0 + x1 * x1, s3 = vk * vk;
#pragma unroll
              for (int o = 1; o < 64; o <<= 1) { s1 += SHX(s1, o, lane); s2 += SHX(s2, o, lane); s3 += SHX(s3, o, lane); }
              const float r1 = rsqrt_fast(s1 * (1.0f / 256.0f) + EPS), r2 = rsqrt_fast(s2 * (1.0f / 128.0f) + EPS), r3 = rsqrt_fast(s3 * (1.0f / 32.0f) + EPS);
              ocq.x = pk2(x[0] * r1 * gcq[0], x[1] * r1 * gcq[1]); ocq.y = pk2(x[2] * r1 * gcq[2], x[3] * r1 * gcq[3]);
              ockv = pk2(x0 * r2 * gkv0, x1 * r2 * gkv1);
              float y = vk * r3 * gkr; const float pt = SHX(y, 8, lane);
              if (lat) y = (lane & 8) ? y * csL + pt * snL : y * csL - pt * snL;
              ykr = y; }
            if (ok[q]) {
#pragma unroll
                for (int j = 0; j < 3; ++j) *(u32x2*)(MQK + (size_t)Rr * 768 + 4 * lane + 256 * j) = ov[j];
                *(u32x4*)(pr + hbase) = oh;
                *(u32x2*)(pr + C_CQ + 4 * lane) = ocq; *(unsigned*)(pr + C_CKV + 2 * lane) = ockv;
                if (lane < 32) pr[C_KR + lane] = f2bf(ykr); }
        }
    }
}

DEV float scan_add(float v, int lane) {
#pragma unroll
    for (int d = 1; d < 64; d <<= 1) { const float t = __shfl(v, lane >= d ? lane - d : lane); if (lane >= d) v += t; }
    return v;
}
DEV float scan_max(float v, int lane) {
#pragma unroll
    for (int d = 1; d < 64; d <<= 1) { const float t = __shfl(v, lane >= d ? lane - d : lane); if (lane >= d) v = fmaxf(v, t); }
    return v;
}
DEV int chain_step(int dir, int cl) { return dir == 0 ? cl : (cl < NC_CTX ? NC_CTX - 1 - cl : NCH + NC_CTX - 1 - cl); }
DEV void gate_scan2(const P& p, int l, int R0, int hh, int dir, int lane, float* al, float* pm, float* bcl, float& F, float& pml) {
    static_assert(MCH == 128, "two positions per lane");
    const float* gb = p.m_gate_b + l * 16; float gi[2], lf[2];
#pragma unroll
    for (int e = 0; e < 2; ++e) { const int j = 2 * lane + e, o = dir ? MCH - 1 - j : j;
        const float* G = (const float*)(p.ws + WS_GATES) + (size_t)(R0 + o) * 16;
        gi[e] = G[dir * 8 + hh] + gb[dir * 8 + hh]; lf[e] = log_sigmoid_f(G[dir * 8 + 4 + hh] + gb[dir * 8 + 4 + hh]); }
    const float incl = scan_add(lf[0] + lf[1], lane);
    const float up1 = __shfl(incl, lane ? lane - 1 : 0), excl = lane ? up1 : 0.f;
    const float bc0 = excl + lf[0], bc1 = incl, a0 = gi[0] - bc0, a1 = gi[1] - bc1;
    const float pin = scan_max(fmaxf(a0, a1), lane);
    const float pu = __shfl(pin, lane ? lane - 1 : 0), px0 = lane ? fmaxf(pu, a0) : a0;
    F = __shfl(incl, 63); pml = __shfl(pin, 63);
    { const int o0 = dir ? MCH - 1 - 2 * lane : 2 * lane, o1 = dir ? o0 - 1 : o0 + 1;
      al[o0] = a0; pm[o0] = px0; bcl[o0] = bc0; al[o1] = a1; pm[o1] = pin; bcl[o1] = bc1; }
}
DEV void ml1_item(const P& p, Wg& w, int l, int item) {
    const int b = item / (4 * NCH), hh = (item / NCH) % 4, cl = item % NCH, R0 = b * TP + cl * MCH;
    float* wgt = (float*)w.lds;
    float* scr = wgt + 2 * MCH;
    bf16* Ks = (bf16*)(w.lds + 4096);
    bf16* Vw = Ks + MCH * 104;
    const bf16* MQK = (const bf16*)(p.ws + WS_MQK); const bf16* PROJ = (const bf16*)(p.ws + WS_PROJ);
    bf16* UC = (bf16*)(p.ws + WS_UC); float* NL = (float*)(p.ws + WS_NL);
    const int lane = w.lane, r = lane & 31, h = lane >> 5;
    static_assert(MCH * 12 == 3 * NTHR, "three k/v vectors per thread");
    u32x4 kq[3], vq[3];
#pragma unroll
    for (int q = 0; q < 3; ++q) { const int idx = w.tid + q * NTHR, s = idx / 12, c = idx % 12;
        kq[q] = *(const u32x4*)(MQK + (size_t)(R0 + s) * 768 + 384 + hh * 96 + 8 * c); vq[q] = *(const u32x4*)(PROJ + (size_t)(R0 + s) * PROJ_W + C_MV + hh * 96 + 8 * c); }
    if (w.wave < 2) { const int dir = w.wave; float F, pml; float* sc = scr + dir * 3 * MCH;
        gate_scan2(p, l, R0, hh, dir, lane, sc, sc + MCH, sc + 2 * MCH, F, pml);
        wave_sync();
#pragma unroll
        for (int hf = 0; hf < 2; ++hf) wgt[dir * MCH + lane + 64 * hf] = __expf(sc[lane + 64 * hf] - pml);
        const int ci = ((b * 4 + hh) * 2 + dir) * NCH + chain_step(dir, cl);
        if (lane == 0) { ((float*)(p.ws + WS_FS))[ci] = F; ((float*)(p.ws + WS_PML))[ci] = pml; } }
    __syncthreads();
#pragma unroll
    for (int q = 0; q < 3; ++q) { const int idx = w.tid + q * NTHR, s = idx / 12, c = idx % 12;
        const u32x4 kr = kq[q], vr = vq[q];
        *(u32x4*)(Ks + s * 104 + 8 * c) = kr;
#pragma unroll
        for (int dir = 0; dir < 2; ++dir) { const float wd = wgt[dir * MCH + s]; u32x4 o;
            o.x = pk2(wd * bf2f((bf16)vr.x), wd * bf2f((bf16)(vr.x >> 16))); o.y = pk2(wd * bf2f((bf16)vr.y), wd * bf2f((bf16)(vr.y >> 16)));
            o.z = pk2(wd * bf2f((bf16)vr.z), wd * bf2f((bf16)(vr.z >> 16))); o.w = pk2(wd * bf2f((bf16)vr.w), wd * bf2f((bf16)(vr.w >> 16)));
            *(u32x4*)(Vw + (dir * MCH + s) * 104 + 8 * c) = o;
            if (c == 0) Vw[(dir * MCH + s) * 104 + 96] = f2bf(wd); } }
    __syncthreads();
    const int toff = (8 * h + ((lane & 15) >> 2)) * 104 + 16 * ((lane >> 4) & 1) + 4 * (lane & 3);
    for (int task = w.wave; task < 24; task += NWAVE) {
        const bool nt = task >= 18; const int tt = nt ? task - 18 : task;
        const int dir = nt ? tt / 3 : tt / 9, dt = nt ? tt % 3 : (tt % 9) / 3, et = nt ? 3 : tt % 3;
        f32x16 acc;
#pragma unroll
        for (int i = 0; i < 16; ++i) acc[i] = 0.f;
#pragma unroll
        for (int ks = 0; ks < MCH / 16; ++ks) { const bf16* ap = Ks + (16 * ks) * 104 + 32 * dt + toff; const bf16* bp = Vw + (dir * MCH + 16 * ks) * 104 + 32 * et + toff;
            const s16x4 al = lds_tr_read(ap), ah = lds_tr_read(ap + 4 * 104), bl = lds_tr_read(bp), bh = lds_tr_read(bp + 4 * 104);
            const bf16x8 af = (bf16x8){al[0], al[1], al[2], al[3], ah[0], ah[1], ah[2], ah[3]}, bfr = (bf16x8){bl[0], bl[1], bl[2], bl[3], bh[0], bh[1], bh[2], bh[3]};
            acc = mfma32(af, bfr, acc); }
        const int ci = ((b * 4 + hh) * 2 + dir) * NCH + chain_step(dir, cl);
        if (!nt) { bf16* up = UC + (size_t)ci * 9216 + (32 * et + r) * 96 + 32 * dt + 4 * h;
#pragma unroll
            for (int g = 0; g < 4; ++g) { u32x2 o; o.x = pk2(acc[4 * g], acc[4 * g + 1]); o.y = pk2(acc[4 * g + 2], acc[4 * g + 3]); *(u32x2*)(up + 8 * g) = o; } }
        else if (r == 0) { float* np = NL + (size_t)ci * 96 + 32 * dt + 4 * h;
#pragma unroll
            for (int g = 0; g < 4; ++g) *(f32x4*)(np + 8 * g) = (f32x4){acc[4 * g], acc[4 * g + 1], acc[4 * g + 2], acc[4 * g + 3]}; } }
    __syncthreads();
}
DEV void phase_ml2(const P& p, Wg& w) {
    constexpr int GPC = 1152 + 12;
    bf16* UC = (bf16*)(p.ws + WS_UC); float* NL = (float*)(p.ws + WS_NL);
    const float* FS = (const float*)(p.ws + WS_FS); const float* PML = (const float*)(p.ws + WS_PML); float* MST = (float*)(p.ws + WS_MST);
    for (int j = w.wg * NTHR + w.tid; j < NCHAIN * GPC; j += w.G * NTHR) {
        const int chain = j / GPC, g = j % GPC;
        float C[8], m = 0.f;
#pragma unroll
        for (int i = 0; i < 8; ++i) C[i] = 0.f;
        for (int k0 = 0; k0 < NCH; k0 += ML2_U) {
            float Fv[ML2_U], pv[ML2_U];
#pragma unroll
            for (int q = 0; q < ML2_U; ++q) { Fv[q] = FS[chain * NCH + k0 + q]; pv[q] = PML[chain * NCH + k0 + q]; }
            if (g < 1152) { u32x4 raw[ML2_U];
#pragma unroll
                for (int q = 0; q < ML2_U; ++q) raw[q] = *(const u32x4*)(UC + (size_t)(chain * NCH + k0 + q) * 9216 + 8 * g);
#pragma unroll
                for (int q = 0; q < ML2_U; ++q) { const int ci = chain * NCH + k0 + q; const float mx = fmaxf(m, pv[q]), dec = __expf(m - mx), sc = __expf(pv[q] - mx);
                    u32x4 st; st.x = pk2(C[0], C[1]); st.y = pk2(C[2], C[3]); st.z = pk2(C[4], C[5]); st.w = pk2(C[6], C[7]); *(u32x4*)(UC + (size_t)ci * 9216 + 8 * g) = st;
#pragma unroll
                    for (int i = 0; i < 8; ++i) C[i] = dec * C[i] + sc * bf2f((bf16)(raw[q][i >> 1] >> ((i & 1) * 16)));
                    if (g == 0) MST[ci] = m;
                    m = Fv[q] + mx; } }
            else {
                for (int q = 0; q < ML2_U; ++q) { float* nl = NL + (size_t)(chain * NCH + k0 + q) * 96 + 8 * (g - 1152); const f32x4 r0 = *(const f32x4*)nl, r1 = *(const f32x4*)(nl + 4);
                    const float mx = fmaxf(m, pv[q]), dec = __expf(m - mx), sc = __expf(pv[q] - mx);
                    *(f32x4*)nl = (f32x4){C[0], C[1], C[2], C[3]}; *(f32x4*)(nl + 4) = (f32x4){C[4], C[5], C[6], C[7]};
#pragma unroll
                    for (int i = 0; i < 4; ++i) { C[i] = dec * C[i] + sc * r0[i]; C[4 + i] = dec * C[4 + i] + sc * r1[i]; }
                    m = Fv[q] + mx; } }
        }
    }
}
DEV void ml3_item(const P& p, Wg& w, int l, int item) {
    const int lane = w.lane, r = lane & 31, h = lane >> 5, dir = w.wave >> 2, tq = w.wave & 3;
    const int b = item / (4 * NCH), hh = (item / NCH) % 4, cl = item % NCH, R0 = b * TP + cl * MCH;
    const int ci = ((b * 4 + hh) * 2 + dir) * NCH + chain_step(dir, cl);
    bf16* Qs = (bf16*)w.lds;
    bf16* Ksm = Qs + MCH * 104;
    bf16* Vs = Ksm + MCH * 104;
    float* nls = (float*)(w.lds + 3 * MCH * 104 * 2);
    float* scn = nls + 192;
    float* hx = (float*)w.lds;
    const bf16* MQK = (const bf16*)(p.ws + WS_MQK); const bf16* PROJ = (const bf16*)(p.ws + WS_PROJ);
    const bf16* UCi = (const bf16*)(p.ws + WS_UC) + (size_t)ci * 9216;
    for (int idx = w.tid; idx < MCH * 12; idx += NTHR) { const int s = idx / 12, c = idx % 12;
        const u32x4 qv = *(const u32x4*)(MQK + (size_t)(R0 + s) * 768 + hh * 96 + 8 * c), kv = *(const u32x4*)(MQK + (size_t)(R0 + s) * 768 + 384 + hh * 96 + 8 * c),
                    vv = *(const u32x4*)(PROJ + (size_t)(R0 + s) * PROJ_W + C_MV + hh * 96 + 8 * c);
        *(u32x4*)(Qs + s * 104 + 8 * c) = qv; *(u32x4*)(Ksm + s * 104 + 8 * c) = kv; *(u32x4*)(Vs + s * 104 + 8 * c) = vv; }
    if (w.tid < 192) { const int dd = w.tid / 96; nls[w.tid] = ((const float*)(p.ws + WS_NL))[(size_t)(((b * 4 + hh) * 2 + dd) * NCH + chain_step(dd, cl)) * 96 + w.tid % 96]; }
    if (tq == 0) { float F, pml; float* sc = scn + dir * 3 * MCH; gate_scan2(p, l, R0, hh, dir, lane, sc, sc + MCH, sc + 2 * MCH, F, pml); }
    const float m_st = ((const float*)(p.ws + WS_MST))[ci];
    __syncthreads();
    const float* al = scn + dir * 3 * MCH; const float* pmv = al + MCH; const float* bcl = al + 2 * MCH;
    const int t = 32 * tq + r;
    const float mx_t = fmaxf(m_st, pmv[t]), bc_t = bcl[t];
    bf16x8 qf[6]; float qn = 0.f;
#pragma unroll
    for (int ks = 0; ks < 6; ++ks) { qf[ks] = *(const bf16x8*)(Qs + t * 104 + 16 * ks + 8 * h);
        const f32x4 n0 = *(const f32x4*)(nls + dir * 96 + 16 * ks + 8 * h), n1 = *(const f32x4*)(nls + dir * 96 + 16 * ks + 8 * h + 4);
#pragma unroll
        for (int j = 0; j < 4; ++j) { qn += bf2f((bf16)qf[ks][j]) * n0[j]; qn += bf2f((bf16)qf[ks][4 + j]) * n1[j]; } }
    qn += SHX(qn, 32, lane);
    f32x16 o[3]; float rs = 0.f;
#pragma unroll
    for (int et = 0; et < 3; ++et)
#pragma unroll
        for (int i = 0; i < 16; ++i) o[et][i] = 0.f;
    for (int kb = dir ? tq : 0; kb < (dir ? NQB : tq + 1); ++kb) {
        f32x16 pw;
#pragma unroll
        for (int i = 0; i < 16; ++i) pw[i] = 0.f;
#pragma unroll
        for (int ks = 0; ks < 6; ++ks) { const bf16x8 kf = *(const bf16x8*)(Ksm + (32 * kb + r) * 104 + 16 * ks + 8 * h); pw = mfma32(kf, qf[ks], pw); }
#pragma unroll
        for (int g = 0; g < 4; ++g) { const int s0 = 32 * kb + 8 * g + 4 * h; const f32x4 av = *(const f32x4*)(al + s0);
#pragma unroll
            for (int j = 0; j < 4; ++j) { const int sidx = s0 + j; const bool okk = dir ? (sidx >= t) : (sidx <= t);
                const float wv = okk ? __expf(av[j] - mx_t) * pw[4 * g + j] : 0.f; pw[4 * g + j] = wv; rs += wv; } }
        bf16x8 pb[2];
#pragma unroll
        for (int sp = 0; sp < 2; ++sp) { u32x4 u; u.x = pk2(pw[8 * sp], pw[8 * sp + 1]); u.y = pk2(pw[8 * sp + 2], pw[8 * sp + 3]); u.z = pk2(pw[8 * sp + 4], pw[8 * sp + 5]); u.w = pk2(pw[8 * sp + 6], pw[8 * sp + 7]);
            pb[sp] = __builtin_bit_cast(bf16x8, u); }
#pragma unroll
        for (int et = 0; et < 3; ++et)
#pragma unroll
            for (int sp = 0; sp < 2; ++sp) { const bf16* vp = Vs + (32 * kb + 16 * sp + 4 * h + ((lane & 15) >> 2)) * 104 + 32 * et + 16 * ((lane >> 4) & 1) + 4 * (lane & 3);
                const s16x4 lo = lds_tr_read(vp), hi = lds_tr_read(vp + 8 * 104);
                const bf16x8 vf = (bf16x8){lo[0], lo[1], lo[2], lo[3], hi[0], hi[1], hi[2], hi[3]};
                o[et] = mfma32(vf, pb[sp], o[et]); }
    }
    rs += SHX(rs, 32, lane);
    const float a_int = __expf(m_st - mx_t), den = a_int * qn + rs, inv = 1.0f / fmaxf(fabsf(den), __expf(-(bc_t + mx_t)));
#pragma unroll
    for (int et = 0; et < 3; ++et) { f32x16 oi;
#pragma unroll
        for (int i = 0; i < 16; ++i) oi[i] = 0.f;
#pragma unroll
        for (int ks = 0; ks < 6; ++ks) { const bf16x8 cf = *(const bf16x8*)(UCi + (32 * et + r) * 96 + 16 * ks + 8 * h); oi = mfma32(cf, qf[ks], oi); }
#pragma unroll
        for (int i = 0; i < 16; ++i) o[et][i] = (a_int * oi[i] + o[et][i]) * inv; }
    __syncthreads();
    if (dir == 1) {
#pragma unroll
        for (int et = 0; et < 3; ++et)
#pragma unroll
            for (int i = 0; i < 16; ++i) hx[t * 97 + 32 * et + crow(i, h)] = o[et][i]; }
    __syncthreads();
    if (dir == 0) { float ss = 0.f;
#pragma unroll
        for (int et = 0; et < 3; ++et)
#pragma unroll
            for (int i = 0; i < 16; ++i) { o[et][i] += hx[t * 97 + 32 * et + crow(i, h)]; ss += o[et][i] * o[et][i]; }
        ss += SHX(ss, 32, lane);
        const float rstd = rsqrt_fast(ss * (1.0f / 96.0f) + EPS);
        bf16* MIX = (bf16*)(p.ws + WS_H);
#pragma unroll
        for (int et = 0; et < 3; ++et)
#pragma unroll
            for (int g = 0; g < 4; ++g) { const int e = 32 * et + 8 * g + 4 * h;
                const u32x2 og = *(const u32x2*)(PROJ + (size_t)(R0 + t) * PROJ_W + C_MO + hh * 96 + e); const f32x4 mn = *(const f32x4*)(p.m_norm + l * 384 + hh * 96 + e);
                float o4[4];
#pragma unroll
                for (int j = 0; j < 4; ++j) { const float gate = bf2f((bf16)((j < 2 ? og.x : og.y) >> ((j & 1) * 16))); o4[j] = o[et][4 * g + j] * rstd * mn[j] * sigmoid_f(gate); }
                u32x2 ov; ov.x = pk2(o4[0], o4[1]); ov.y = pk2(o4[2], o4[3]);
                *(u32x2*)(MIX + (size_t)(R0 + t) * MIXW + hh * 96 + e) = ov; } }
    __syncthreads();
}

DEV void phase_mla_post(const P& p, Wg& w, int l) {
    bf16* MLAQ = (bf16*)(p.ws + WS_MLAQ); const bf16* PROJ = (const bf16*)(p.ws + WS_PROJ);
    const int lane = w.lane;
    int baseA = 0, nA = 8, dstA = 8 * lane; bool normA = true, ropeA = false; const float* gA = p.l_qnorm + l * 96;
    if (lane < 48) { const int hh = lane / 12, o = lane % 12;
        if (o < 8) { baseA = 12 * hh; nA = 8; gA = p.l_qnorm + l * 96 + 8 * o; }
        else { baseA = 12 * hh + 8; nA = 4; gA = p.l_qnorm + l * 96 + 64 + 8 * (o - 8); ropeA = true; } }
    else { normA = false; }
    const int hb = lane / 16, ob = lane % 16; const bool normB = ob < 8;
    const int baseB = (16 * (lane / 16)) & 63;
    const int dstB = normB ? 384 + 96 * hb + 8 * ob : 768 + 64 * hb + 8 * (ob - 8);
    const float* gB = p.l_knorm + l * 96 + 8 * (ob & 7);
    float gAv[8], gBv[8];
#pragma unroll
    for (int j = 0; j < 8; ++j) { gAv[j] = gA[j]; gBv[j] = gB[j]; }
    const int cidx = (lane % 12) - 8;
    constexpr int NB = 2;
    for (int R0 = w.gw; R0 < M_ALL; R0 += NB * w.NGW) {
        u32x4 ra[NB], rb[NB], kr[NB]; bool ok[NB];
#pragma unroll
        for (int q = 0; q < NB; ++q) { const int R = R0 + q * w.NGW; ok[q] = R < M_ALL; const int Rr = ok[q] ? R : R0; const bf16* row = MLAQ + (size_t)Rr * 1024;
            ra[q] = *(const u32x4*)(row + 8 * lane); rb[q] = *(const u32x4*)(row + 512 + 8 * lane);
            kr[q] = (lane >= 48) ? *(const u32x4*)(PROJ + (size_t)Rr * PROJ_W + C_KR + 8 * ((lane - 48) & 3)) : (u32x4){0u, 0u, 0u, 0u}; }
        u32x4 oa[NB], obv[NB];
#pragma unroll
        for (int q = 0; q < NB; ++q) { const int Rr = ok[q] ? R0 + q * w.NGW : R0; const int qq = Rr % TP; const bool lat = qq >= CTX; const int t = qq - CTX;
            float xa[8], xb[8], ssA = 0.f, ssB = 0.f;
#pragma unroll
            for (int j = 0; j < 8; ++j) { xa[j] = bf2f((bf16)(ra[q][j >> 1] >> ((j & 1) * 16))); xb[j] = bf2f((bf16)(rb[q][j >> 1] >> ((j & 1) * 16))); ssA += xa[j] * xa[j]; ssB += xb[j] * xb[j]; }
            float sA = 0.f, sB = 0.f;
#pragma unroll
            for (int i = 0; i < 8; ++i) { const float v = __shfl(ssA, (baseA + i) & 63); if (i < nA) sA += v; sB += __shfl(ssB, (baseB + i) & 63); }
            const float rsA = normA ? rsqrt_fast(sA / (float)(8 * nA) + EPS) : 1.0f, rsB = normB ? rsqrt_fast(sB * (1.0f / 64.0f) + EPS) : 1.0f;
#pragma unroll
            for (int j = 0; j < 8; ++j) { xa[j] = normA ? xa[j] * rsA * gAv[j] : xa[j]; xb[j] = normB ? xb[j] * rsB * gBv[j] : xb[j]; }
            const float* ct = (const float*)(p.ws + WS_ROPE) + ((size_t)(lat ? ((cidx & 3) < 2 ? t / GRID_W : t % GRID_W) : 0) * 24 + 16) * 2;
            const f32x4 t0 = *(const f32x4*)ct, t1 = *(const f32x4*)(ct + 4), t2 = *(const f32x4*)(ct + 8), t3 = *(const f32x4*)(ct + 12);
            const float csv[8] = {t0[0], t0[2], t1[0], t1[2], t2[0], t2[2], t3[0], t3[2]}, snv[8] = {t0[1], t0[3], t1[1], t1[3], t2[1], t2[3], t3[1], t3[3]};
#pragma unroll
            for (int j = 0; j < 8; ++j) { const float pt = SHX(xa[j], 1, lane);
                if (ropeA && lat) xa[j] = (cidx & 1) ? xa[j] * csv[j] + pt * snv[j] : xa[j] * csv[j] - pt * snv[j]; }
            if (lane < 48) {
#pragma unroll
                for (int j = 0; j < 8; ++j) xa[j] *= QSCALE_L; }
            oa[q].x = pk2(xa[0], xa[1]); oa[q].y = pk2(xa[2], xa[3]); oa[q].z = pk2(xa[4], xa[5]); oa[q].w = pk2(xa[6], xa[7]);
            obv[q].x = pk2(xb[0], xb[1]); obv[q].y = pk2(xb[2], xb[3]); obv[q].z = pk2(xb[4], xb[5]); obv[q].w = pk2(xb[6], xb[7]); }
        wave_sync();
#pragma unroll
        for (int q = 0; q < NB; ++q) if (ok[q]) { bf16* row = MLAQ + (size_t)(R0 + q * w.NGW) * 1024;
            if (lane < 48) *(u32x4*)(row + dstA) = oa[q];
            else { const int i = lane - 48; *(u32x4*)(row + 384 + 96 * (i >> 2) + 64 + 8 * (i & 3)) = kr[q]; }
            *(u32x4*)(row + dstB) = obv[q]; }
        wave_sync();
    }
}

template <int DQK>
DEV void attn_unit(const bf16* Q, int ldq, const bf16* K, int ldk, const bf16* V, int ldv, bf16* O, int ldo, int nkeys, Wg& w) {
    constexpr int KS = DQK + 8, NKD = DQK / 16, CPR = DQK / 8, NKC = 64 * CPR, VS = 72;
    bf16* Ks = (bf16*)w.lds;
    bf16* Vs = (bf16*)(w.lds + 2 * 64 * KS * 2);
    const int tid = w.tid, lane = w.lane, r = lane & 31, h = lane >> 5;
    bf16x8 qr[NKD];
    { const bf16* qp = Q + (size_t)(w.wave * 32 + r) * ldq + 8 * h;
#pragma unroll
      for (int d0 = 0; d0 < NKD; ++d0) qr[d0] = *(const bf16x8*)(qp + 16 * d0); }
    const int kr0 = tid / CPR, kc0 = tid % CPR, kr1 = (tid + NTHR) / CPR, kc1 = (tid + NTHR) % CPR; const bool k1 = (tid + NTHR) < NKC;
    const int vr = tid >> 3, vc = tid & 7;
    u32x4 rk0, rk1 = (u32x4){0u, 0u, 0u, 0u}, rv;
    const int NT = nkeys / 64;
    const int vtr_off = (4 * h + ((lane & 15) >> 2)) * VS + 16 * ((lane >> 4) & 1) + 4 * (lane & 3);
#define AT_LOAD(kt) do { rk0 = *(const u32x4*)(K + (size_t)((kt) * 64 + kr0) * ldk + 8 * kc0); if (k1) rk1 = *(const u32x4*)(K + (size_t)((kt) * 64 + kr1) * ldk + 8 * kc1); \
        rv = *(const u32x4*)(V + (size_t)((kt) * 64 + vr) * ldv + 8 * vc); } while (0)
#define AT_STORE(buf) do { *(u32x4*)(Ks + ((buf) * 64 + kr0) * KS + 8 * kc0) = rk0; if (k1) *(u32x4*)(Ks + ((buf) * 64 + kr1) * KS + 8 * kc1) = rk1; \
        *(u32x4*)(Vs + ((buf) * 64 + vr) * VS + 8 * vc) = rv; } while (0)
    AT_LOAD(0); AT_STORE(0);
    __syncthreads();
    float m_run = 0.f, l_run = 0.f; f32x16 o[2], negm;
#pragma unroll
    for (int i = 0; i < 16; ++i) { o[0][i] = 0.f; o[1][i] = 0.f; negm[i] = 0.f; }
    for (int kt = 0; kt < NT; ++kt) {
        const int buf = kt & 1;
        if (kt + 1 < NT) AT_LOAD(kt + 1);
        f32x16 pt[2];
        { bf16x8 kf[2][NKD];
#pragma unroll
          for (int kh = 0; kh < 2; ++kh)
#pragma unroll
              for (int d0 = 0; d0 < NKD; ++d0) kf[kh][d0] = *(const bf16x8*)(Ks + (buf * 64 + 32 * kh + r) * KS + 16 * d0 + 8 * h);
          SCHED_FENCE();
          pt[0] = negm; pt[1] = negm;
#pragma unroll
          for (int d0 = 0; d0 < NKD; ++d0) { pt[0] = mfma32(kf[0][d0], qr[d0], pt[0]); pt[1] = mfma32(kf[1][d0], qr[d0], pt[1]); } }
        bf16x8 vf[2][2][2];
#pragma unroll
        for (int et = 0; et < 2; ++et)
#pragma unroll
            for (int kh = 0; kh < 2; ++kh)
#pragma unroll
                for (int sp = 0; sp < 2; ++sp) { const bf16* vp = Vs + (buf * 64 + 32 * kh + 16 * sp) * VS + 32 * et + vtr_off;
                    const s16x4 lo = lds_tr_read(vp), hi = lds_tr_read(vp + 8 * VS);
                    vf[et][kh][sp] = (bf16x8){lo[0], lo[1], lo[2], lo[3], hi[0], hi[1], hi[2], hi[3]}; }
        SCHED_FENCE();
        float mq[4];
#pragma unroll
        for (int c = 0; c < 4; ++c) mq[c] = fmaxf(pt[0][c], pt[1][c]);
#pragma unroll
        for (int i = 4; i < 16; ++i) mq[i & 3] = fmaxf(mq[i & 3], fmaxf(pt[0][i], pt[1][i]));
        float mt = fmaxf(fmaxf(mq[0], mq[1]), fmaxf(mq[2], mq[3]));
        if (__any(kt == 0 || mt > 8.0f)) {
            mt = fmaxf(mt, SHX(mt, 32, lane));
            const float dl = (kt == 0) ? mt : fmaxf(mt, 0.f), alpha = exp2_fast(-dl);
            m_run += dl; l_run *= alpha;
#pragma unroll
            for (int i = 0; i < 16; ++i) { pt[0][i] -= dl; pt[1][i] -= dl; o[0][i] *= alpha; o[1][i] *= alpha; negm[i] = -m_run; }
        }
        float rq[4] = {0.f, 0.f, 0.f, 0.f};
#pragma unroll
        for (int kh = 0; kh < 2; ++kh)
#pragma unroll
            for (int i = 0; i < 16; ++i) { const float e = exp2_fast(pt[kh][i]); pt[kh][i] = e; rq[i & 3] += e; }
        l_run += (rq[0] + rq[1]) + (rq[2] + rq[3]);
        bf16x8 pb[2][2];
#pragma unroll
        for (int kh = 0; kh < 2; ++kh)
#pragma unroll
            for (int sp = 0; sp < 2; ++sp) { u32x4 u; u.x = pk2(pt[kh][8 * sp], pt[kh][8 * sp + 1]); u.y = pk2(pt[kh][8 * sp + 2], pt[kh][8 * sp + 3]); u.z = pk2(pt[kh][8 * sp + 4], pt[kh][8 * sp + 5]); u.w = pk2(pt[kh][8 * sp + 6], pt[kh][8 * sp + 7]);
                pb[kh][sp] = __builtin_bit_cast(bf16x8, u); }
        SCHED_FENCE();
#pragma unroll
        for (int kh = 0; kh < 2; ++kh)
#pragma unroll
            for (int sp = 0; sp < 2; ++sp)
#pragma unroll
                for (int et = 0; et < 2; ++et) o[et] = mfma32(vf[et][kh][sp], pb[kh][sp], o[et]);
        if (kt + 1 < NT) AT_STORE(buf ^ 1);
        __syncthreads();
    }
#undef AT_LOAD
#undef AT_STORE
    l_run += SHX(l_run, 32, lane);
    const float inv = 1.0f / l_run;
    bf16* op = O + (size_t)(w.wave * 32 + r) * ldo + 4 * h;
#pragma unroll
    for (int et = 0; et < 2; ++et)
#pragma unroll
        for (int g = 0; g < 4; ++g) { u32x2 ov; ov.x = pk2(o[et][4 * g] * inv, o[et][4 * g + 1] * inv); ov.y = pk2(o[et][4 * g + 2] * inv, o[et][4 * g + 3] * inv); *(u32x2*)(op + 32 * et + 8 * g) = ov; }
}
#ifndef REP_ATT
#define REP_ATT 1
#endif
#ifndef REP_ML3
#define REP_ML3 1
#endif
DEV void relaunder(Wg& w) { int t_ = w.tid; OPAQUE_V(t_); w.tid = t_; w.lane = t_ & 63; }
DEV void phase_mix(const P& p, Wg& w, int l) {
    const bf16* PROJ = (const bf16*)(p.ws + WS_PROJ); const bf16* MLAQ = (const bf16*)(p.ws + WS_MLAQ); bf16* MIX = (bf16*)(p.ws + WS_H);
    unsigned* ctr = (unsigned*)(p.ws + WS_CTL) + CW_Q + 1024 * l;
    const int n_ml3 = BATCH * 4 * NCH;
    for (int rep = 0; rep < REP_ATT; ++rep) {
        { const int n_lat = BATCH * 4 * NQL, n_all = n_lat + ((l == 0) ? BATCH * 4 : 0);
          for (;;) {
            int idx = q_next(w, ctr + 64 * rep);
            if (idx >= n_all) break;
            int b, head, qb, nkeys;
            if (idx < n_lat) { b = idx / (4 * NQL); head = (idx / NQL) % 4; qb = 1 + idx % NQL; nkeys = TP; }
            else { idx -= n_lat; b = idx / 4; head = idx % 4; qb = 0; nkeys = CTX; }
            const size_t Rq = (size_t)b * TP + qb * 256, Rk = (size_t)b * TP;
            attn_unit<96>(MLAQ + Rq * 1024 + head * 96, 1024, MLAQ + Rk * 1024 + 384 + head * 96, 1024, MLAQ + Rk * 1024 + 768 + head * 64, 1024, MIX + Rq * MIXW + 768 + head * 64, MIXW, nkeys, w);
          } }
        relaunder(w);
        { const int n_lat = BATCH * 6 * NQL, n_all = n_lat + ((l == 0) ? BATCH * 6 : 0);
          for (;;) {
            int idx = q_next(w, ctr + 256 + 64 * rep);
            if (idx >= n_all) break;
            int b, head, qb, nkeys;
            if (idx < n_lat) { b = idx / (6 * NQL); const int rem = idx % (6 * NQL); head = (rem / (3 * NQL)) * 3 + rem % 3; qb = 1 + (rem % (3 * NQL)) / 3; nkeys = TP; }
            else { idx -= n_lat; b = idx / 6; head = idx % 6; qb = 0; nkeys = CTX; }
            const size_t Rq = (size_t)b * TP + qb * 256, Rk = (size_t)b * TP;
            attn_unit<64>(PROJ + Rq * PROJ_W + C_AQ + head * 64, PROJ_W, PROJ + Rk * PROJ_W + C_AK + (head / 3) * 64, PROJ_W, PROJ + Rk * PROJ_W + C_AV + (head / 3) * 64, PROJ_W, MIX + Rq * MIXW + 384 + head * 64, MIXW, nkeys, w);
          } }
        relaunder(w);
    }
    for (int rep = 0; rep < REP_ML3; ++rep)
    for (;;) {
        const int idx = q_next(w, ctr + 512 + 64 * rep);
        if (idx >= n_ml3) break;
        if (l == 1 && idx % NCH < NC_CTX) continue;
        ml3_item(p, w, l, idx);
    }
}

DEV void moe_seg_table(const P& p, Wg& w) {
    const int* cntg = (const int*)(p.ws + WS_CNTG); int* part = (int*)w.lds;
    { const int e = w.tid & 7; int tot = 0, pre = 0;
      for (int g = w.tid >> 3; g < w.G; g += NTHR / 8) { const int c = cntg[g * NEXP + e]; tot += c; pre += (g < w.wg) ? c : 0; }
      part[2 * w.tid] = tot; part[2 * w.tid + 1] = pre; }
    __syncthreads();
    if (w.tid < NEXP) { int tot = 0, pre = 0; for (int i = 0; i < NTHR / 8; ++i) { tot += part[2 * (8 * i + w.tid)]; pre += part[2 * (8 * i + w.tid) + 1]; } w.misc[32 + w.tid] = (unsigned)tot; w.misc[48 + w.tid] = (unsigned)pre; }
    __syncthreads();
    if (w.tid == 0) { int s = 0; for (int e = 0; e < NEXP; ++e) { w.misc[16 + e] = (unsigned)s; s += ((int)w.misc[32 + e] + 255) / 256; } w.misc[16 + NEXP] = (unsigned)s; }
    __syncthreads();
}
DEV void phase_gather(const P& p, Wg& w) {
    moe_seg_table(p, w);
    const int* topi = (const int*)(p.ws + WS_TOPI); const float* topw = (const float*)(p.ws + WS_TOPW);
    int* stok = (int*)(p.ws + WS_STOK); float* sw = (float*)(p.ws + WS_SW);
    const bf16* H = (const bf16*)(p.ws + WS_H); bf16* AG = (bf16*)(p.ws + WS_AG);
    int* lc = (int*)w.lds;
    if (w.lane == 0) { for (int e = 0; e < NEXP; ++e) lc[w.wave * NEXP + e] = 0;
        for (int R = w.gw; R < M_ALL; R += w.NGW) { const int q = R % TP; if (q < CTX) continue; const int tok = (R / TP) * SEQ + q - CTX; lc[w.wave * NEXP + topi[2 * tok]]++; lc[w.wave * NEXP + topi[2 * tok + 1]]++; } }
    __syncthreads();
    if (w.tid < NEXP) { int s = (int)w.misc[16 + w.tid] * 256 + (int)w.misc[48 + w.tid]; for (int ww = 0; ww < NWAVE; ++ww) { const int c = lc[ww * NEXP + w.tid]; lc[ww * NEXP + w.tid] = s; s += c; } }
    __syncthreads();
    constexpr int NJ8 = (D_MODEL + 511) / 512;
    for (int R0 = w.gw; R0 < M_ALL; R0 += 4 * w.NGW) {
        int s0[4], s1[4]; bool ok[4];
#pragma unroll
        for (int qq = 0; qq < 4; ++qq) { const int R = R0 + qq * w.NGW; const int q = R % TP; ok[qq] = R < M_ALL && q >= CTX; const int tok = (R / TP) * SEQ + q - CTX;
            int a0 = 0, a1 = 0;
            if (w.lane == 0 && ok[qq]) { const int e0 = topi[2 * tok], e1 = topi[2 * tok + 1]; a0 = lc[w.wave * NEXP + e0]; lc[w.wave * NEXP + e0] = a0 + 1; a1 = lc[w.wave * NEXP + e1]; lc[w.wave * NEXP + e1] = a1 + 1;
                stok[a0] = tok; stok[a1] = tok; sw[a0] = topw[2 * tok]; sw[a1] = topw[2 * tok + 1]; int* tsl = (int*)(p.ws + WS_TSL) + 2 * tok; tsl[0] = a0; tsl[1] = a1; }
            s0[qq] = __shfl(a0, 0); s1[qq] = __shfl(a1, 0); }
        u32x4 v[4][NJ8];
#pragma unroll
        for (int qq = 0; qq < 4; ++qq)
#pragma unroll
            for (int j = 0; j < NJ8; ++j) { const int c = 8 * w.lane + 512 * j; if (ok[qq] && c < D_MODEL) v[qq][j] = *(const u32x4*)(H + (size_t)(R0 + qq * w.NGW) * D_MODEL + c); }
#pragma unroll
        for (int qq = 0; qq < 4; ++qq)
#pragma unroll
            for (int j = 0; j < NJ8; ++j) { const int c = 8 * w.lane + 512 * j; if (ok[qq] && c < D_MODEL) { *(u32x4*)(AG + (size_t)s0[qq] * D_MODEL + c) = v[qq][j]; *(u32x4*)(AG + (size_t)s1[qq] * D_MODEL + c) = v[qq][j]; } }
    }
    for (int e = w.wg; e < NEXP; e += w.G) { const int lo = (int)w.misc[16 + e] * 256 + (int)w.misc[32 + e], hi = (int)w.misc[16 + e + 1] * 256;
        for (int s = lo + w.wave; s < hi; s += NWAVE) { if (w.lane == 0) { stok[s] = -1; sw[s] = 0.f; }
            for (int c = 8 * w.lane; c < D_MODEL; c += 512) *(u32x4*)(AG + (size_t)s * D_MODEL + c) = (u32x4){0u, 0u, 0u, 0u}; } }
}

DEV void phase_moe_combine(const P& p, Wg& w, int c) {
    const int* tsl = (const int*)(p.ws + WS_TSL); const float* topw = (const float*)(p.ws + WS_TOPW); const bf16* YC = (const bf16*)(p.ws + WS_YC);
    const int lo = c * MOE_PCH * 256, hi = lo + MOE_PCH * 256;
    const int ptot = (int)w.misc[16 + NEXP], np = (ptot - c * MOE_PCH) < MOE_PCH ? (ptot - c * MOE_PCH) : MOE_PCH;
    if (np <= 0) return;
    const int nsp = (np * NSPLIT > MOE_PCH) ? 1 : NSPLIT; const size_t pstr = (size_t)np * 256 * D_MODEL;
    constexpr int CB = 2;
    for (int tok0 = w.gw; tok0 < NTOK; tok0 += CB * w.NGW) {
        const bf16* y0[CB]; const bf16* y1[CB]; float w0[CB], w1[CB]; bool act[CB]; bf16* xr[CB]; const float* gv[CB];
#pragma unroll
        for (int q = 0; q < CB; ++q) { const int tok = tok0 + q * w.NGW; const bool ok = tok < NTOK; const int tk = ok ? tok : 0;
            const int s0 = tsl[2 * tk], s1 = tsl[2 * tk + 1]; const bool in0 = ok && s0 >= lo && s0 < hi, in1 = ok && s1 >= lo && s1 < hi;
            act[q] = in0 || in1; w0[q] = in0 ? topw[2 * tk] : 0.f; w1[q] = in1 ? topw[2 * tk + 1] : 0.f;
            y0[q] = YC + (size_t)(in0 ? s0 - lo : 0) * D_MODEL; y1[q] = YC + (size_t)(in1 ? s1 - lo : 0) * D_MODEL;
            xr[q] = (bf16*)(p.out + (size_t)tk * D_MODEL); gv[q] = (const float*)(p.ws + WS_MODV) + (size_t)(1 * NV + tk / SEQ) * 6 * D_MODEL + 5 * D_MODEL; }
#pragma unroll
        for (int j = 0; j < D_MODEL / 256; ++j) { const int col = 4 * w.lane + 256 * j;
            f32x4 ya[CB], g[CB]; u32x2 x[CB];
#pragma unroll
            for (int q = 0; q < CB; ++q) if (act[q]) { g[q] = *(const f32x4*)(gv[q] + col); x[q] = *(const u32x2*)(xr[q] + col); ya[q] = (f32x4){0.f, 0.f, 0.f, 0.f};
                for (int ks = 0; ks < nsp; ++ks) { const u32x2 a = *(const u32x2*)(y0[q] + ks * pstr + col), bq = *(const u32x2*)(y1[q] + ks * pstr + col);
                    ya[q][0] += w0[q] * bf2f((bf16)a.x) + w1[q] * bf2f((bf16)bq.x); ya[q][1] += w0[q] * bf2f((bf16)(a.x >> 16)) + w1[q] * bf2f((bf16)(bq.x >> 16));
                    ya[q][2] += w0[q] * bf2f((bf16)a.y) + w1[q] * bf2f((bf16)bq.y); ya[q][3] += w0[q] * bf2f((bf16)(a.y >> 16)) + w1[q] * bf2f((bf16)(bq.y >> 16)); } }
#pragma unroll
            for (int q = 0; q < CB; ++q) if (act[q]) { u32x2 o;
                o.x = pk2(bf2f((bf16)x[q].x) + g[q][0] * ya[q][0], bf2f((bf16)(x[q].x >> 16)) + g[q][1] * ya[q][1]); o.y = pk2(bf2f((bf16)x[q].y) + g[q][2] * ya[q][2], bf2f((bf16)(x[q].y >> 16)) + g[q][3] * ya[q][3]);
                *(u32x2*)(xr[q] + col) = o; } }
    }
}
DEV void phase_moe_final(const P& p, Wg& w) {
    constexpr int c = MOE_NCH - 1, NJ = D_MODEL / 256;
    const int* tsl = (const int*)(p.ws + WS_TSL); const float* topw = (const float*)(p.ws + WS_TOPW); const bf16* YC = (const bf16*)(p.ws + WS_YC);
    const int lo = c * MOE_PCH * 256, hi = lo + MOE_PCH * 256;
    const int ptot = (int)w.misc[16 + NEXP], np = (ptot - c * MOE_PCH) < MOE_PCH ? (ptot - c * MOE_PCH) : MOE_PCH;
    const int nsp = (np * NSPLIT > MOE_PCH) ? 1 : NSPLIT; const size_t pstr = (size_t)(np > 0 ? np : 0) * 256 * D_MODEL;
    for (int tok0 = w.gw; tok0 < NTOK; tok0 += 2 * w.NGW) {
        f32x4 xo[2][NJ]; bool ok[2];
#pragma unroll
        for (int q = 0; q < 2; ++q) { const int tok = tok0 + q * w.NGW; ok[q] = tok < NTOK; const int tk = ok[q] ? tok : 0;
            const int s0 = tsl[2 * tk], s1 = tsl[2 * tk + 1]; const bool in0 = np > 0 && s0 >= lo && s0 < hi, in1 = np > 0 && s1 >= lo && s1 < hi;
            const float w0 = in0 ? topw[2 * tk] : 0.f, w1 = in1 ? topw[2 * tk + 1] : 0.f;
            const bf16* y0 = YC + (size_t)(in0 ? s0 - lo : 0) * D_MODEL; const bf16* y1 = YC + (size_t)(in1 ? s1 - lo : 0) * D_MODEL;
            const bf16* xr = (const bf16*)(p.out + (size_t)tk * D_MODEL); const float* gv = (const float*)(p.ws + WS_MODV) + (size_t)(1 * NV + tk / SEQ) * 6 * D_MODEL + 5 * D_MODEL;
#pragma unroll
            for (int j = 0; j < NJ; ++j) { const int col = 4 * w.lane + 256 * j; const u32x2 t = *(const u32x2*)(xr + col);
                xo[q][j] = (f32x4){bf2f((bf16)t.x), bf2f((bf16)(t.x >> 16)), bf2f((bf16)t.y), bf2f((bf16)(t.y >> 16))};
                if (in0 || in1) { f32x4 ya = (f32x4){0.f, 0.f, 0.f, 0.f};
                    for (int ks = 0; ks < nsp; ++ks) { const u32x2 a = *(const u32x2*)(y0 + ks * pstr + col), bq = *(const u32x2*)(y1 + ks * pstr + col);
                        ya[0] += w0 * bf2f((bf16)a.x) + w1 * bf2f((bf16)bq.x); ya[1] += w0 * bf2f((bf16)(a.x >> 16)) + w1 * bf2f((bf16)(bq.x >> 16));
                        ya[2] += w0 * bf2f((bf16)a.y) + w1 * bf2f((bf16)bq.y); ya[3] += w0 * bf2f((bf16)(a.y >> 16)) + w1 * bf2f((bf16)(bq.y >> 16)); }
                    xo[q][j] = xo[q][j] + *(const f32x4*)(gv + col) * ya; } } }
        wave_sync();
#pragma unroll
        for (int q = 0; q < 2; ++q) if (ok[q]) { float* orow = p.out + (size_t)(tok0 + q * w.NGW) * D_MODEL;
#pragma unroll
            for (int j = 0; j < NJ; ++j) *(f32x4*)(orow + 4 * w.lane + 256 * j) = xo[q][j]; }
    }
}

constexpr int PH_L = 24;
constexpr int N_PHASES = 1 + 2 * PH_L;
#ifndef PROBE_MUL
#define PROBE_MUL 1
#endif
#ifdef EMU
#define GRID_BAR() do {} while (0)
#define DYN_LDS() unsigned char* lds = EMU_DYN_LDS()
#else
#define GRID_BAR() xcd_barrier(bar)
#define DYN_LDS() extern __shared__ __attribute__((aligned(16))) unsigned char lds[]
#endif
__global__ void __launch_bounds__(NTHR, 2) fwd(P p_in) {
    DYN_LDS();
    Wg w; w.tid = threadIdx.x; w.lane = w.tid & 63;
#ifndef EMU
    w.wave = __builtin_amdgcn_readfirstlane(w.tid >> 6);
#else
    w.wave = w.tid >> 6;
#endif
    w.G = gridDim.x; w.wg = blockIdx.x; w.gw = w.wg * NWAVE + w.wave; w.NGW = w.G * NWAVE; w.lds = lds; w.misc = (unsigned*)(lds + LDS_MISC);
    if (w.tid < 64) w.misc[w.tid] = 0u;
    __syncthreads();
#ifndef EMU
    XcdBarrier bar = xcd_barrier_post((unsigned*)(p_in.ws + WS_CTL) + CW_BAR, (volatile LAS unsigned*)(w.misc));
#endif
    const int lo = p_in.ph_lo, hi = p_in.ph_hi; const int wave_s = w.wave; (void)wave_s;
#ifndef PH_MASK
#define PH_MASK 0xffffffffu
#endif
#if defined(PROBE_SET) && !defined(EMU)
#define PROBE_T0(k) if (blockIdx.x == 0 && threadIdx.x == 0) { ((unsigned*)(lds + LDS_MISC))[64 + 2 * (k)] = (unsigned)wall_clock64(); }
#define PROBE_T1(k) if (blockIdx.x == 0 && threadIdx.x == 0) { ((unsigned*)(lds + LDS_MISC))[65 + 2 * (k)] = (unsigned)wall_clock64(); }
#define PROBE_SPLIT(k, vk) { GRID_BAR(); if (blockIdx.x == 0 && threadIdx.x == 0) { unsigned* m_ = (unsigned*)(lds + LDS_MISC); m_[64 + 2 * (vk)] = m_[64 + 2 * (k)]; m_[65 + 2 * (vk)] = (unsigned)wall_clock64(); } }
#else
#define PROBE_T0(k)
#define PROBE_T1(k)
#define PROBE_SPLIT(k, vk)
#endif
#ifndef EMU
#define TID_NOW() (wave_s * 64 + lane_fresh())
#define WAVE_OF(t) __builtin_amdgcn_readfirstlane((t) >> 6)
#else
#define TID_NOW() ((int)threadIdx.x)
#define WAVE_OF(t) ((t) >> 6)
#endif
#ifndef EMU
#define LOAD_P() const __attribute__((address_space(4))) P* pq_ = (const __attribute__((address_space(4))) P*)__builtin_amdgcn_kernarg_segment_ptr(); asm volatile("" : "+s"(pq_)); const P p = *(const P*)pq_;
#else
#define LOAD_P() const P& p = p_in;
#endif
#define PH_BEGIN(k) if (((PH_MASK >> ((k) - pb_)) & 1u) && lo <= (k) && (k) < hi) { LOAD_P() { int t_ = TID_NOW(); OPAQUE_V(t_); w.tid = t_; w.lane = t_ & 63; w.wave = WAVE_OF(t_); w.gw = w.wg * NWAVE + w.wave; } PROBE_T0(k)
#define PH_END(k) if ((k) + 1 < hi) GRID_BAR(); PROBE_T1(k) }
    { const int pb_ = -31; PH_BEGIN(0) phase0(p, w); PH_END(0) }
    for (int l = 0; l < 2; ++l) {
        const int pb = 1 + PH_L * l, pb_ = pb;
        PH_BEGIN(pb + 0) phase_modulate<4>(p, w, l, 0, l == 0, false, false, l == 1); PH_END(pb + 0)
        PH_BEGIN(pb + 1) {
            pg8::Gemm g{(const bf16*)(p.ws + WS_H), (const bf16*)(p.ws + WS_WIN_T) + (size_t)l * PROJ_W * D_MODEL, D_MODEL, D_MODEL, D_MODEL, 0};
            Sched<0> S; S.o.init(NPAN, PROJ_W / 256, w.G, w.wg, SITE_WGM(0)); S.pm_base = 0; S.seg = nullptr; S.nNc = 0; S.kper = 0;
            EpiStore E{(bf16*)(p.ws + WS_PROJ), PROJ_W, (float*)(p.ws + WS_GATES)};
            { const TabSched T_ = build_units(w.misc, w.tid, S); pg8::gemm_phase<EpiStore, TabSched>(w.lds, w.tid, g, T_, E); } } PH_END(pb + 1)
        PH_BEGIN(pb + 2) phase_prep(p, w, l); PH_END(pb + 2)
        PH_BEGIN(pb + 3) {
            pg8::Gemm g{(const bf16*)(p.ws + WS_PROJ) + C_CQ, (const bf16*)(p.ws + WS_MLA_T) + (size_t)l * 1024 * 512, PROJ_W, 512, 256, 0};
            Sched<6> S; S.o.init(NPAN, 4, w.G, w.wg, SITE_WGM(1)); S.pm_base = 0; S.seg = nullptr; S.nNc = 0; S.kper = 0;
            EpiStore E{(bf16*)(p.ws + WS_MLAQ), 1024, nullptr};
            { const TabSched T_ = build_units(w.misc, w.tid, S); pg8::gemm_phase<EpiStore, TabSched>(w.lds, w.tid, g, T_, E); }
            __syncthreads();
            PROBE_SPLIT(pb + 3, 49 + 3 * l)
#ifndef NO_ML1
            for (int it = w.G - 1 - w.wg; it < BATCH * 4 * NCH; it += w.G) ml1_item(p, w, l, it);
#endif
            } PH_END(pb + 3)
        PH_BEGIN(pb + 4) phase_mla_post(p, w, l); PROBE_SPLIT(pb + 4, 50 + 3 * l) phase_ml2(p, w); PH_END(pb + 4)
        PH_BEGIN(pb + 5) phase_mix(p, w, l); PH_END(pb + 5)
        PH_BEGIN(pb + 6) {
            pg8::Gemm g{(const bf16*)(p.ws + WS_H), (const bf16*)(p.ws + WS_WOUT_T) + (size_t)l * D_MODEL * MIXW, MIXW, MIXW, MIXW, 0};
            Sched<0> S0; Sched<1> S1; S0.o.init(NPAN, D_MODEL / 256, w.G, w.wg, SITE_WGM(2)); S1.o.init(BATCH * NQL, D_MODEL / 256, w.G, w.wg, SITE_WGM(3)); S0.pm_base = 0; S0.seg = nullptr; S0.nNc = 0; S0.kper = 0; S1.pm_base = 0; S1.seg = nullptr; S1.nNc = 0; S1.kper = 0;
            if (l == 0) { EpiResid<true> E{p, l, 2 * D_MODEL}; const TabSched T_ = build_units(w.misc, w.tid, S0); pg8::gemm_phase<EpiResid<true>, TabSched>(w.lds, w.tid, g, T_, E); }
            else { EpiResid<false> E{p, l, 2 * D_MODEL}; const TabSched T_ = build_units(w.misc, w.tid, S1); pg8::gemm_phase<EpiResid<false>, TabSched>(w.lds, w.tid, g, T_, E); } } PH_END(pb + 6)
        if (l == 0) {
            PH_BEGIN(pb + 7) phase_modulate<4>(p, w, 0, 1, false, false, false, false); PH_END(pb + 7)
            PH_BEGIN(pb + 8) {
                pg8::Gemm g{(const bf16*)(p.ws + WS_H), (const bf16*)(p.ws + WS_WGU_T), D_MODEL, D_MODEL, D_MODEL, 0};
                Sched<0> S; S.o.init(NPAN, 2 * D_FF / 256, w.G, w.wg, SITE_WGM(4)); S.pm_base = 0; S.seg = nullptr; S.nNc = 0; S.kper = 0;
                EpiSwiglu E{(bf16*)(p.ws + WS_ACT), 0};
                { const TabSched T_ = build_units(w.misc, w.tid, S); pg8::gemm_phase<EpiSwiglu, TabSched>(w.lds, w.tid, g, T_, E); } } PH_END(pb + 8)
            PH_BEGIN(pb + 9) {
                { pg8::Gemm g{(const bf16*)(p.ws + WS_ACT), (const bf16*)(p.ws + WS_WD_T), D_FF, D_FF, D_FF, 0};
                  Sched<1> S; S.o.init(BATCH * NQL, D_MODEL / 256, w.G, w.wg, SITE_WGM(5)); S.pm_base = 0; S.seg = nullptr; S.nNc = 0; S.kper = 0;
                  EpiResid<false> E{p, 0, 5 * D_MODEL};
                  { const TabSched T_ = build_units(w.misc, w.tid, S); pg8::gemm_phase<EpiResid<false>, TabSched>(w.lds, w.tid, g, T_, E); } }
                __syncthreads();
                { pg8::Gemm g{(const bf16*)(p.ws + WS_ACT), (const bf16*)(p.ws + WS_WD_T), D_FF, D_FF, KSPLIT, 0};
                  Sched<4> S; S.o.init(BATCH, (D_MODEL / 256) * NSPLIT, w.G, w.wg, SITE_WGM(6)); S.pm_base = 0; S.seg = nullptr; S.nNc = D_MODEL / 256; S.kper = KSPLIT;
                  EpiStoreRel E{(bf16*)(p.ws + WS_MLAQ), D_MODEL, 0};
                  { const TabSched T_ = build_units(w.misc, w.tid, S); pg8::gemm_phase<EpiStoreRel, TabSched>(w.lds, w.tid, g, T_, E); } } } PH_END(pb + 9)
        } else {
            PH_BEGIN(pb + 7) phase_modulate<1>(p, w, 1, 1, false, true, true, false); PROBE_SPLIT(pb + 7, 51 + 3 * l) phase_moe_weights(p, w); PH_END(pb + 7)
            PH_BEGIN(pb + 8) phase_gather(p, w); PH_END(pb + 8)
            for (int c = 0; c < MOE_NCH; ++c) {
                PH_BEGIN(pb + 9 + 2 * c) {
                    moe_seg_table(p, w);
                    const int ptot = (int)w.misc[16 + NEXP], pm0 = c * MOE_PCH, np = (ptot - pm0) < MOE_PCH ? (ptot - pm0) : MOE_PCH;
                    if (c > 0 && (w.wg & 1)) phase_moe_combine(p, w, c - 1);
                    if (np > 0) {
                        pg8::Gemm g{(const bf16*)(p.ws + WS_AG), (const bf16*)(p.ws + WS_MOEW), D_MODEL, D_MODEL, D_MODEL, MOEW_E};
                        Sched<2> S; S.o.init(np, 2 * D_FF / 256, w.G, w.wg, SITE_WGM(7)); S.pm_base = pm0; S.seg = (const int*)(w.misc + 16); S.nNc = 0; S.kper = 0;
                        EpiSwiglu E{(bf16*)(p.ws + WS_ACT2), pm0};
                        { const TabSched T_ = build_units(w.misc, w.tid, S); pg8::gemm_phase<EpiSwiglu, TabSched>(w.lds, w.tid, g, T_, E); } }
                    if (c > 0 && !(w.wg & 1)) phase_moe_combine(p, w, c - 1); } PH_END(pb + 9 + 2 * c)
                PH_BEGIN(pb + 10 + 2 * c) {
                    moe_seg_table(p, w);
                    const int ptot = (int)w.misc[16 + NEXP], pm0 = c * MOE_PCH, np = (ptot - pm0) < MOE_PCH ? (ptot - pm0) : MOE_PCH;
                    if (np > 0 && np * NSPLIT > MOE_PCH) {
                        pg8::Gemm g{(const bf16*)(p.ws + WS_ACT2), (const bf16*)(p.ws + WS_MOEW) + (size_t)2 * D_FF * D_MODEL, D_FF, D_FF, D_FF, MOEW_E};
                        Sched<3> S; S.o.init(np, D_MODEL / 256, w.G, w.wg, SITE_WGM(8)); S.pm_base = pm0; S.seg = (const int*)(w.misc + 16); S.nNc = 0; S.kper = 0;
                        EpiStoreRel E{(bf16*)(p.ws + WS_YC), D_MODEL, 0};
                        { const TabSched T_ = build_units(w.misc, w.tid, S); pg8::gemm_phase<EpiStoreRel, TabSched>(w.lds, w.tid, g, T_, E); } }
                    else if (np > 0) {
                        pg8::Gemm g{(const bf16*)(p.ws + WS_ACT2), (const bf16*)(p.ws + WS_MOEW) + (size_t)2 * D_FF * D_MODEL, D_FF, D_FF, KSPLIT, MOEW_E};
                        Sched<5> S; S.o.init(np, (D_MODEL / 256) * NSPLIT, w.G, w.wg, SITE_WGM(9)); S.pm_base = pm0; S.seg = (const int*)(w.misc + 16); S.nNc = D_MODEL / 256; S.kper = KSPLIT;
                        EpiStoreRel E{(bf16*)(p.ws + WS_YC), D_MODEL, 0};
                        { const TabSched T_ = build_units(w.misc, w.tid, S); pg8::gemm_phase<EpiStoreRel, TabSched>(w.lds, w.tid, g, T_, E); } } } PH_END(pb + 10 + 2 * c)
            }
            PH_BEGIN(pb + 9 + 2 * MOE_NCH) moe_seg_table(p, w); phase_moe_final(p, w); PH_END(pb + 9 + 2 * MOE_NCH)
        }
    }
#if defined(PROBE_SET) && !defined(EMU)
    if (blockIdx.x == 0 && threadIdx.x == 0) {
        unsigned tot = 0; for (int k = 0; k < 56; ++k) if ((PROBE_SET >> k) & 1ull) tot += ((unsigned*)(lds + LDS_MISC))[65 + 2 * k] - ((unsigned*)(lds + LDS_MISC))[64 + 2 * k];
        const unsigned long long t0 = wall_clock64(); while (wall_clock64() - t0 < (unsigned long long)tot * PROBE_MUL) __builtin_amdgcn_s_sleep(8);
    }
#endif
}

#ifndef MK_PER_PHASE
#define MK_PER_PHASE 0
#endif
extern "C" void kernel_launch(void* const* d_in, const int* in_sizes, int n_in, void* d_out, int out_size, void* d_ws, size_t ws_size, hipStream_t stream) {
    static int grid = 0;
    if (grid == 0) {
        if (n_in != 28 || in_sizes[0] != BATCH * SEQ * D_MODEL || out_size != BATCH * SEQ * D_MODEL || ws_size < WS_TOTAL) {
            fprintf(stderr, "kernel_launch: unexpected problem (n_in %d, x %d, out %d, ws %zu < %zu)\n", n_in, n_in > 0 ? in_sizes[0] : -1, out_size, ws_size, (size_t)WS_TOTAL); grid = -1; return; }
#ifndef EMU
        int dev = 0, cus = 0;
        if (hipGetDevice(&dev) != hipSuccess || hipDeviceGetAttribute(&cus, hipDeviceAttributeMultiprocessorCount, dev) != hipSuccess) { grid = -1; return; }
        if (hipFuncSetAttribute((const void*)fwd, hipFuncAttributeMaxDynamicSharedMemorySize, LDS_BYTES) != hipSuccess) { fprintf(stderr, "kernel_launch: hipFuncSetAttribute failed\n"); grid = -1; return; }
        int per_cu = 0;
        if (hipOccupancyMaxActiveBlocksPerMultiprocessor(&per_cu, (const void*)fwd, NTHR, LDS_BYTES) != hipSuccess || per_cu < 1) { fprintf(stderr, "kernel_launch: occupancy query says %d\n", per_cu); (void)hipGetLastError(); }
        grid = cus;
#else
        grid = 8;
#endif
    }
    if (grid < 0) return;
    (void)hipMemsetAsync((char*)d_ws + WS_CTL, 0, CTL_BYTES, stream);
    P p{};
    const float** pp = (const float**)&p;
    for (int i = 0; i < 28; ++i) pp[i] = (const float*)d_in[i];
    p.out = (float*)d_out; p.ws = (unsigned char*)d_ws;
#if MK_PER_PHASE
    for (int k = 0; k < N_PHASES; ++k) {
        if (k >= 1 + 10 && k < 1 + PH_L) continue;
        if (k >= 1 + PH_L + 10 + 2 * MOE_NCH) continue;
        p.ph_lo = k; p.ph_hi = k + 1;
        hipLaunchKernelGGL(fwd, dim3(grid), dim3(NTHR), LDS_BYTES, stream, p);
    }
#else
    p.ph_lo = 0; p.ph_hi = N_PHASES;
    hipLaunchKernelGGL(fwd, dim3(grid), dim3(NTHR), LDS_BYTES, stream, p);
#endif
}
```

```cpp
#ifndef EMU
#include <hip/hip_runtime.h>
#endif
#include <cstdio>
#include <cstdint>
#include <cmath>

#ifdef CFG_TINY
constexpr int D_MODEL = 256, BATCH = 2, SEQ = 512, CTX = 256, GRID_W = 16, D_FF = 512;
constexpr int MOE_PCH = 4, NSPLIT = 2;
#else
constexpr int D_MODEL = 1024, BATCH = 8, SEQ = 4096, CTX = 256, GRID_W = 64, D_FF = 3584;
constexpr int MOE_PCH = 64, NSPLIT = 7;
#endif
constexpr int TP = CTX + SEQ, M_ALL = BATCH * TP, NPAN = M_ALL / 256, PAN_B = TP / 256, NQL = SEQ / 256;
constexpr int MCH = 128;
constexpr int NCH = TP / MCH, NC_CTX = CTX / MCH, NQB = MCH / 32;
constexpr int PROJ_W = 2816, MIXW = 1024, NEXP = 8;
constexpr int C_MQ = 0, C_MK = 384, C_MV = 768, C_MO = 1152, C_G = 1536, C_AQ = 1552, C_AK = 1936, C_AV = 2064, C_CQ = 2192, C_CKV = 2448, C_KR = 2576, IN_W = 2608;
constexpr int NV = BATCH + 1;
constexpr int NCHAIN = BATCH * 4 * 2, NITEM = NCHAIN * NCH;
constexpr int NTOK = BATCH * SEQ, NSLOTP = NTOK * 2 + NEXP * 256;
constexpr int MOE_NCH = (NSLOTP / 256 + MOE_PCH - 1) / MOE_PCH;
constexpr float EPS = 1e-6f, LOG2E = 1.4426950408889634f;
constexpr float QSCALE_A = 0.125f * LOG2E, QSCALE_L = 0.10206207261596575f * LOG2E, KSCALE_M = 0.10206207261596575f;
constexpr int NTHR = 512, NWAVE = 8;
constexpr int KSPLIT = D_FF / NSPLIT;
static_assert(KSPLIT % 128 == 0 && KSPLIT >= 256 && NSPLIT * BATCH * 256 * D_MODEL * 2 <= M_ALL * 1024 * 2, "split-K geometry");
constexpr int NPOS = (SEQ / GRID_W > GRID_W) ? SEQ / GRID_W : GRID_W;

typedef unsigned short bf16;
#ifndef EMU
typedef short bf16x8 __attribute__((ext_vector_type(8)));
typedef short s16x4 __attribute__((ext_vector_type(4)));
typedef float f32x4 __attribute__((ext_vector_type(4)));
typedef float f32x2 __attribute__((ext_vector_type(2)));
typedef float f32x16 __attribute__((ext_vector_type(16)));
typedef unsigned u32x4 __attribute__((ext_vector_type(4)));
typedef unsigned u32x2 __attribute__((ext_vector_type(2)));
#define DEV __device__ __forceinline__
DEV f32x16 mfma32(bf16x8 a, bf16x8 b, f32x16 c) { return __builtin_amdgcn_mfma_f32_32x32x16_bf16(a, b, c, 0, 0, 0); }
DEV void wave_sync() { asm volatile("s_waitcnt vmcnt(0) lgkmcnt(0)" ::: "memory"); __builtin_amdgcn_wave_barrier(); }
typedef __bf16 bf16x2_hw __attribute__((ext_vector_type(2)));
typedef short v4i16_t __attribute__((ext_vector_type(4)));
DEV unsigned pk2_hw(float lo, float hi) { f32x2 v = {lo, hi}; bf16x2_hw b = __builtin_convertvector(v, bf16x2_hw); return __builtin_bit_cast(unsigned, b); }
DEV s16x4 lds_tr_read(const unsigned short* a) { return __builtin_bit_cast(s16x4, __builtin_amdgcn_ds_read_tr16_b64_v4i16((__attribute__((address_space(3))) v4i16_t*)(a))); }
DEV float exp2_fast(float x) { return __builtin_amdgcn_exp2f(x); }
DEV float rcp_fast(float x) { return __builtin_amdgcn_rcpf(x); }
DEV float rsqrt_fast(float x) { return __builtin_amdgcn_rsqf(x); }
DEV void atomic_addf(float* p, float v) { unsafeAtomicAdd(p, v); }
#define OPAQUE_V(x) asm volatile("" : "+v"(x))
#define SCHED_FENCE() __builtin_amdgcn_sched_barrier(0)
#define UNIFORM_I(x) __builtin_amdgcn_readfirstlane(x)
DEV unsigned fau(float f) { return __float_as_uint(f); }
DEV float uaf(unsigned u) { return __uint_as_float(u); }
DEV float my_shfl_xor(float v, int m, int lane) { return __int_as_float(__builtin_amdgcn_ds_bpermute((lane ^ m) << 2, __float_as_int(v))); }
#define SHX(v, m, lane) my_shfl_xor((v), (m), (lane))
DEV float my_shfl(float v, int src) { return __int_as_float(__builtin_amdgcn_ds_bpermute((src & 63) << 2, __float_as_int(v))); }
DEV int my_shfl(int v, int src) { return __builtin_amdgcn_ds_bpermute((src & 63) << 2, v); }
#define __shfl my_shfl
DEV int lane_fresh() { int l_; asm volatile("v_mbcnt_lo_u32_b32 %0, -1, 0\n\tv_mbcnt_hi_u32_b32 %0, -1, %0" : "=v"(l_)); return l_; }
#else
#define DEV inline
#define OPAQUE_V(x) do {} while (0)
#define SCHED_FENCE() do {} while (0)
#define UNIFORM_I(x) (x)
#define SHX(v, m, lane) __shfl_xor((v), (m))
DEV void wave_sync() { (void)emu_shfl_u(0u, emu::B->cur & 63); }
DEV void atomic_addf(float* p, float v) { atomicAdd(p, v); }
DEV float rsqrt_fast(float x) { return 1.0f / sqrtf(x); }
DEV unsigned fau(float f) { unsigned u; memcpy(&u, &f, 4); return u; }
DEV float uaf(unsigned u) { float f; memcpy(&f, &u, 4); return f; }
#endif
DEV bf16 f2bf(float f) { unsigned u = fau(f); u += 0x7fffu + ((u >> 16) & 1u); return (bf16)(u >> 16); }
DEV float bf2f(bf16 h) { return uaf(((unsigned)h) << 16); }
#ifndef EMU
DEV unsigned pk2(float lo, float hi) { return pk2_hw(lo, hi); }
#else
DEV unsigned pk2(float lo, float hi) { return (unsigned)f2bf(lo) | ((unsigned)f2bf(hi) << 16); }
#endif
DEV float wave_sum(float v, int lane) {
#pragma unroll
    for (int o = 1; o < 64; o <<= 1) v += SHX(v, o, lane);
    return v;
}
DEV float wave_max(float v, int lane) {
#pragma unroll
    for (int o = 1; o < 64; o <<= 1) v = fmaxf(v, SHX(v, o, lane));
    return v;
}
DEV float silu_f(float x) { return x / (1.0f + __expf(-x)); }
DEV float silu_fast(float x) { return x * rcp_fast(1.0f + exp2_fast(-x * LOG2E)); }
DEV float sigmoid_f(float x) { return rcp_fast(1.0f + exp2_fast(-x * LOG2E)); }
DEV float log_sigmoid_f(float x) { return x >= 0.f ? -log1pf(expf(-x)) : x - log1pf(expf(x)); }
DEV int crow(int i, int h) { return (i & 3) + 8 * (i >> 2) + 4 * h; }

constexpr size_t al256(size_t x) { return (x + 255) & ~(size_t)255; }
constexpr size_t WS_CTL = 0, CTL_BYTES = 65536;
constexpr int CW_Q = 0;
constexpr int CW_BAR = 4096;
constexpr size_t WS_MODV = WS_CTL + CTL_BYTES;
constexpr size_t WS_WIN_T = al256(WS_MODV + (size_t)2 * NV * 6 * D_MODEL * 4);
constexpr size_t WS_WOUT_T = al256(WS_WIN_T + (size_t)2 * PROJ_W * D_MODEL * 2);
constexpr size_t WS_MLA_T = al256(WS_WOUT_T + (size_t)2 * D_MODEL * MIXW * 2);
constexpr size_t WS_WGU_T = al256(WS_MLA_T + (size_t)2 * 1024 * 512 * 2);
constexpr size_t WS_WD_T = al256(WS_WGU_T + (size_t)2 * D_FF * D_MODEL * 2);
constexpr size_t WS_CX = al256(WS_WD_T + (size_t)D_MODEL * D_FF * 2);
constexpr size_t WS_GATES = al256(WS_CX + (size_t)BATCH * CTX * D_MODEL * 4);
constexpr size_t WS_NL = al256(WS_GATES + (size_t)M_ALL * 16 * 4);
constexpr size_t WS_FS = al256(WS_NL + (size_t)NITEM * 96 * 4);
constexpr size_t WS_PML = al256(WS_FS + (size_t)NITEM * 4);
constexpr size_t WS_MST = al256(WS_PML + (size_t)NITEM * 4);
constexpr size_t WS_TOPI = al256(WS_MST + (size_t)NITEM * 4);
constexpr size_t WS_TOPW = al256(WS_TOPI + (size_t)NTOK * 2 * 4);
constexpr size_t WS_CNTG = al256(WS_TOPW + (size_t)NTOK * 2 * 4);
constexpr size_t WS_STOK = al256(WS_CNTG + (size_t)1024 * 8 * 4);
constexpr size_t WS_SW = al256(WS_STOK + (size_t)NSLOTP * 4);
constexpr size_t WS_TSL = al256(WS_SW + (size_t)NSLOTP * 4);
constexpr size_t WS_ROPE = al256(WS_TSL + (size_t)NTOK * 2 * 4);
constexpr size_t WS_PROJ = al256(WS_ROPE + (size_t)NPOS * 24 * 2 * 4);
constexpr size_t WS_MQK = al256(WS_PROJ + (size_t)M_ALL * PROJ_W * 2);
constexpr size_t WS_MLAQ = al256(WS_MQK + (size_t)M_ALL * 768 * 2);
constexpr size_t WS_UC = al256(WS_MLAQ + (size_t)M_ALL * 1024 * 2);
constexpr size_t WS_H = al256(WS_UC + (size_t)NITEM * 9216 * 2);
constexpr size_t WS_END0 = al256(WS_H + (size_t)M_ALL * 1024 * 2);
constexpr size_t WS_ACT = WS_PROJ;
constexpr size_t WS_MOEW = WS_PROJ;
constexpr size_t MOEW_E = (size_t)3 * D_FF * D_MODEL * 2;
constexpr size_t WS_AG = al256(WS_MOEW + NEXP * MOEW_E);
constexpr size_t WS_ACT2 = al256(WS_AG + (size_t)NSLOTP * D_MODEL * 2);
constexpr size_t WS_YC = al256(WS_ACT2 + (size_t)MOE_PCH * 256 * D_FF * 2);
#ifdef CFG_TINY
constexpr size_t WS_TOTAL = WS_END0 + (4u << 20);
#else
constexpr size_t WS_TOTAL = (size_t)512 << 20;
#endif
static_assert(WS_END0 <= WS_TOTAL, "ws map");
constexpr int ML2_U = (NCH % 17 == 0) ? 17 : ((NCH % 4 == 0) ? 4 : 2);
static_assert(NCH % ML2_U == 0, "ML2 unroll");
static_assert(WS_ACT + (size_t)M_ALL * D_FF * 2 <= WS_MLAQ, "dense ACT overlays PROJ+MQK only");
static_assert(WS_MOEW + NEXP * MOEW_E <= WS_MQK, "MoE weights overlay PROJ only");
static_assert(WS_YC + (size_t)MOE_PCH * 256 * D_MODEL * 2 <= WS_TOTAL, "MoE chunk buffers");

constexpr int LDS_STAGE = 131072;
constexpr int LDS_MISC = LDS_STAGE;
constexpr int LDS_BYTES = LDS_STAGE + 4096;

struct P {
    const float *x, *c, *ctx, *c_ctx, *mod_w, *mod_b, *norm_mix, *norm_ffn, *w_in, *m_conv, *m_gate_b, *m_norm, *a_qnorm, *a_knorm, *l_cq_norm, *l_ckv_norm,
        *l_wuq, *l_wukv, *l_qnorm, *l_knorm, *w_out, *ffn_wg, *ffn_wu, *ffn_wd, *moe_router, *moe_wg, *moe_wu, *moe_wd;
    float* out; unsigned char* ws; int ph_lo, ph_hi;
};
constexpr int RPITCH = 2 * D_MODEL;
DEV bf16* resid_row(const P& p, int R) {
    const int b = R / TP, q = R % TP;
    return q < CTX ? (bf16*)(p.ws + WS_CX) + (size_t)(b * CTX + q) * RPITCH : (bf16*)(p.out + (size_t)(b * SEQ + q - CTX) * D_MODEL);
}
DEV const float* modv(const P& p, int l, int R) { const int b = R / TP, q = R % TP; return (const float*)(p.ws + WS_MODV) + (size_t)(l * NV + (q < CTX ? BATCH : b)) * 6 * D_MODEL; }

namespace pg8 {
constexpr int BM = 256, BK = 64, HALF = 128, HTB = HALF * BK * 2, STAGE_BYTES = 8 * HTB, NXCD = 8, WGM = 8;
struct Unit { int pm, pn, e, k0, po; };
struct Gemm { const bf16* A; const bf16* Bt; int lda, ldb, K; size_t bstride; };
DEV int lds_byte(int r, int c) { const int st = (r >> 4) * 2 + (c >> 5), rr = r & 15, cc = c & 31, ob = rr * 64 + cc * 2; return st * 1024 + (ob ^ (((ob >> 9) & 1) << 5)); }
DEV void stage_rc(int b, int& R, int& C) { const int st = b / 1024, sb = b % 1024, swz = sb ^ (((sb >> 9) & 1) << 5); R = (st >> 1) * 16 + swz / 64; C = (st & 1) * 32 + (swz % 64) / 2; }
DEV int perm32(int rho) { const int n = rho >> 4, i = rho & 15; return 8 * (i >> 2) + 4 * n + (i & 3); }
struct Order {
    int nM, nN, nwg, G, c, wgm;
    DEV void init(int nM_, int nN_, int G_, int c_, int wgm_ = WGM) { nM = nM_; nN = nN_; nwg = nM * nN; G = G_; c = c_; wgm = wgm_; }
    DEV bool nextL(int i, int& lm, int& ln) const {
        const long L = (long)i * G + c; if (L >= nwg) return false;
        int wgid = (int)L; { const int q = nwg / NXCD, r = nwg % NXCD, xcd = wgid % NXCD, off = wgid / NXCD; wgid = (xcd < r ? xcd * (q + 1) : r * (q + 1) + (xcd - r) * q) + off; }
        const int nig = wgm * nN, gid = wgid / nig, fm = gid * wgm, gsz = (nM - fm) < wgm ? (nM - fm) : wgm;
        lm = fm + ((wgid % nig) % gsz); ln = (wgid % nig) / gsz; return true;
    }
};
#ifndef EMU
#define PG8_LAS __attribute__((address_space(3)))
DEV unsigned cvt_pk_bf16(float lo, float hi) { unsigned r; asm volatile("v_cvt_pk_bf16_f32 %0, %1, %2" : "=v"(r) : "v"(lo), "v"(hi)); return r; }
template <class Epi, class Sched>
DEV void gemm_phase(unsigned char* lds_, const int tid, const Gemm g, const Sched& S, const Epi& E) {
    PG8_LAS unsigned char* lds = (PG8_LAS unsigned char*)lds_;
    const int wid = __builtin_amdgcn_readfirstlane(tid >> 6), lane = tid & 63, wr = wid >> 2, wc = wid & 3, fr = lane & 15, fq = lane >> 4;
    const int K = g.K, nt = K / BK, lda = g.lda, ldb = g.ldb;
    unsigned voffA[2], voffB[2];
#pragma unroll
    for (int i = 0; i < 2; ++i) { int R, C; stage_rc(tid * 16 + i * 8192, R, C); const int Rb = Epi::PERM ? ((R & ~31) + perm32(R & 31)) : R;
        voffA[i] = (unsigned)(R * lda + C) * 2u; voffB[i] = (unsigned)(Rb * ldb + C) * 2u; }
    const size_t kstep = (size_t)(BK * 2);
    const size_t hstepA = (size_t)HALF * lda * 2, hstepB = (size_t)HALF * ldb * 2;
    const size_t tstepA = 2 * hstepA, tstepB = 2 * hstepB;
    const unsigned ldsw = (unsigned)wid * 1024u;
    const int aoff = lds_byte(wr * 64 + fr, fq * 8), boff = lds_byte(wc * 32 + fr, fq * 8);
#define PG8_SA(b, h) (((b) * 2 + (h)) * HTB)
#define PG8_SB(b, h) ((4 + (b) * 2 + (h)) * HTB)
#define PG8_STAGE(bufoff, gbase, voff) do { _Pragma("unroll") for (int _i = 0; _i < 2; ++_i) \
        __builtin_amdgcn_global_load_lds((const unsigned*)((const char*)(gbase) + (voff)[_i]), (PG8_LAS unsigned*)(lds + (bufoff) + ldsw + _i * 8192), 16, 0, 0); } while (0)
#define PG8_LDA(dst, b, h) do { _Pragma("unroll") for (int m = 0; m < 4; ++m) _Pragma("unroll") for (int k = 0; k < 2; ++k) dst[m][k] = *(const PG8_LAS bf16x8*)(lds + PG8_SA(b, h) + aoff + m * 2048 + k * 1024); } while (0)
#define PG8_LDB(dst, b, h) do { _Pragma("unroll") for (int n = 0; n < 2; ++n) _Pragma("unroll") for (int k = 0; k < 2; ++k) dst[n][k] = *(const PG8_LAS bf16x8*)(lds + PG8_SB(b, h) + boff + n * 2048 + k * 1024); } while (0)
#define PG8_MMA(ai, bj, At, Bt) do { __builtin_amdgcn_s_setprio(1); _Pragma("unroll") for (int m = 0; m < 4; ++m) _Pragma("unroll") for (int n = 0; n < 2; ++n) _Pragma("unroll") for (int k = 0; k < 2; ++k) \
        acc[ai][bj][m][n] = __builtin_amdgcn_mfma_f32_16x16x32_bf16(Bt[n][k], At[m][k], acc[ai][bj][m][n], 0, 0, 0); __builtin_amdgcn_s_setprio(0); } while (0)
#define PG8_WAIT_V(n) asm volatile("s_waitcnt vmcnt(" #n ")" ::: "memory")
#define PG8_WAIT_L(n) asm volatile("s_waitcnt lgkmcnt(" #n ")" ::: "memory")
#define PG8_BAR __builtin_amdgcn_s_barrier()
#define PG8_SCHED __builtin_amdgcn_sched_barrier(0)
    Unit cur, nxt; int ui = 0;
    if (!S.next(0, cur)) return;
    f32x4 acc[2][2][4][2];
#pragma unroll
    for (int a = 0; a < 2; ++a)
#pragma unroll
        for (int b = 0; b < 2; ++b)
#pragma unroll
            for (int m = 0; m < 4; ++m)
#pragma unroll
                for (int n = 0; n < 2; ++n) acc[a][b][m][n] = (f32x4){0.f, 0.f, 0.f, 0.f};
    bf16x8 At[4][2], B0[2][2], B1[2][2];
    const char* cA = (const char*)g.A + (size_t)cur.pm * tstepA + (size_t)cur.k0 * 2; const char* cB = (const char*)g.Bt + (size_t)cur.e * g.bstride + (size_t)cur.pn * tstepB + (size_t)cur.k0 * 2;
    PG8_STAGE(PG8_SB(0, 0), cB, voffB); PG8_STAGE(PG8_SB(0, 1), cB + hstepB, voffB); PG8_STAGE(PG8_SA(0, 0), cA, voffA); PG8_STAGE(PG8_SA(0, 1), cA + hstepA, voffA);
    if (wr == 1) PG8_BAR;
    PG8_WAIT_V(2); PG8_BAR;
    PG8_STAGE(PG8_SB(1, 0), cB + kstep, voffB); PG8_STAGE(PG8_SA(1, 0), cA + kstep, voffA); PG8_STAGE(PG8_SB(1, 1), cB + hstepB + kstep, voffB);
    PG8_WAIT_V(6); PG8_BAR;
    for (;;) {
        const bool has_next = S.next(ui + 1, nxt);
        const char* nA = has_next ? (const char*)g.A + (size_t)nxt.pm * tstepA + (size_t)nxt.k0 * 2 : cA; const char* nB = has_next ? (const char*)g.Bt + (size_t)nxt.e * g.bstride + (size_t)nxt.pn * tstepB + (size_t)nxt.k0 * 2 : cB;
#pragma unroll 1
        for (int t = 0; t < nt; t += 2) {
            const bool last = (t == nt - 2);
            const char* a1 = cA + (size_t)(t + 1) * kstep;
            const char* a2 = last ? nA : cA + (size_t)(t + 2) * kstep; const char* b2 = last ? nB : cB + (size_t)(t + 2) * kstep;
            const char* a3 = a2 + kstep; const char* b3 = b2 + kstep;
            PG8_LDB(B0, 0, 0); PG8_LDB(B1, 0, 1); PG8_SCHED; PG8_LDA(At, 0, 0); PG8_STAGE(PG8_SA(1, 1), a1 + hstepA, voffA);
            PG8_WAIT_V(8); PG8_WAIT_L(0); PG8_BAR; PG8_MMA(0, 0, At, B0); PG8_MMA(0, 1, At, B1); PG8_BAR; PG8_SCHED;
            PG8_LDA(At, 0, 1); PG8_STAGE(PG8_SB(0, 0), b2, voffB); PG8_STAGE(PG8_SB(0, 1), b2 + hstepB, voffB); PG8_STAGE(PG8_SA(0, 0), a2, voffA);
            PG8_WAIT_V(8); PG8_WAIT_L(0); PG8_BAR; PG8_MMA(1, 0, At, B0); PG8_MMA(1, 1, At, B1); PG8_BAR; PG8_SCHED;
            PG8_LDB(B0, 1, 0); PG8_LDB(B1, 1, 1); PG8_SCHED; PG8_LDA(At, 1, 0); PG8_STAGE(PG8_SA(0, 1), a2 + hstepA, voffA);
            PG8_WAIT_V(8); PG8_WAIT_L(0); PG8_BAR; PG8_MMA(0, 0, At, B0); PG8_MMA(0, 1, At, B1); PG8_BAR; PG8_SCHED;
            PG8_LDA(At, 1, 1); PG8_STAGE(PG8_SB(1, 0), b3, voffB); PG8_STAGE(PG8_SB(1, 1), b3 + hstepB, voffB); PG8_STAGE(PG8_SA(1, 0), a3, voffA);
            PG8_WAIT_V(8); PG8_WAIT_L(0); PG8_BAR; PG8_MMA(1, 0, At, B0); PG8_MMA(1, 1, At, B1); PG8_BAR; PG8_SCHED;
        }
        if (wr == 0) PG8_BAR;
        E(acc, cur, wr, wc, fr, fq);
        if (!has_next) break;
#pragma unroll
        for (int a = 0; a < 2; ++a)
#pragma unroll
            for (int b = 0; b < 2; ++b)
#pragma unroll
                for (int m = 0; m < 4; ++m)
#pragma unroll
                    for (int n = 0; n < 2; ++n) acc[a][b][m][n] = (f32x4){0.f, 0.f, 0.f, 0.f};
        cur = nxt; cA = nA; cB = nB; ++ui;
        if (wr == 1) PG8_BAR;
    }
    PG8_WAIT_V(0);
    PG8_BAR;
#undef PG8_SA
#undef PG8_SB
#undef PG8_STAGE
#undef PG8_LDA
#undef PG8_LDB
#undef PG8_MMA
#undef PG8_WAIT_V
#undef PG8_WAIT_L
#undef PG8_BAR
#undef PG8_SCHED
}
#else
DEV unsigned cvt_pk_bf16(float lo, float hi) { return pk2(lo, hi); }
template <class Epi, class Sched>
DEV void gemm_phase(unsigned char*, const int tid, const Gemm g, const Sched& S, const Epi& E) {
    const int wid = tid >> 6, lane = tid & 63, wr = wid >> 2, wc = wid & 3, fr = lane & 15, fq = lane >> 4;
    Unit u;
    for (int ui = 0; S.next(ui, u); ++ui) {
        f32x4 acc[2][2][4][2];
        const bf16* Bt = (const bf16*)((const char*)g.Bt + (size_t)u.e * g.bstride);
        for (int ai = 0; ai < 2; ++ai) for (int bj = 0; bj < 2; ++bj) for (int m = 0; m < 4; ++m) for (int n = 0; n < 2; ++n) for (int j = 0; j < 4; ++j) {
            const size_t row = (size_t)u.pm * 256 + 128 * ai + 64 * wr + 16 * m + fr;
            const size_t col = (size_t)u.pn * 256 + 128 * bj + 32 * wc + (Epi::PERM ? 8 * fq + 4 * n + j : 16 * n + 4 * fq + j);
            const bf16* a = g.A + row * g.lda + u.k0; const bf16* b = Bt + col * g.ldb + u.k0; float s = 0.f;
            for (int k = 0; k < g.K; ++k) s += bf2f(a[k]) * bf2f(b[k]);
            acc[ai][bj][m][n][j] = s; }
        E(acc, u, wr, wc, fr, fq);
    }
}
#endif
}

using pg8::Unit;
struct EpiStore {
    static constexpr bool PERM = true;
    bf16* O; int ldc; float* gates;
    DEV void operator()(const f32x4 (&acc)[2][2][4][2], const Unit& u, int wr, int wc, int fr, int fq) const {
        const int row0 = u.pm * 256 + wr * 64 + fr, col0 = u.pn * 256 + wc * 32 + 8 * fq;
        const bool dog = gates != nullptr && u.pn == C_G / 256 && wc == 0 && fq < 2;
#pragma unroll
        for (int ai = 0; ai < 2; ++ai)
#pragma unroll
            for (int m = 0; m < 4; ++m) { const int row = row0 + ai * 128 + m * 16; bf16* rowp = O + (size_t)row * ldc + col0;
#pragma unroll
                for (int bj = 0; bj < 2; ++bj) { const f32x4 v0 = acc[ai][bj][m][0], v1 = acc[ai][bj][m][1];
                    u32x4 w; w.x = pg8::cvt_pk_bf16(v0[0], v0[1]); w.y = pg8::cvt_pk_bf16(v0[2], v0[3]); w.z = pg8::cvt_pk_bf16(v1[0], v1[1]); w.w = pg8::cvt_pk_bf16(v1[2], v1[3]);
                    *(u32x4*)(rowp + bj * 128) = w;
                    if (bj == 0 && dog) { float* gp = gates + (size_t)row * 16 + 8 * fq; *(f32x4*)gp = v0; *(f32x4*)(gp + 4) = v1; } } }
    }
};
template <bool from_input> struct EpiResid {
    static constexpr bool PERM = true;
    P p; int l, goff;
    DEV void operator()(const f32x4 (&acc)[2][2][4][2], const Unit& u, int wr, int wc, int fr, int fq) const {
        const int R0 = u.pm * 256, bb = R0 / TP, q0 = R0 % TP; const bool isctx = q0 < CTX;
        bf16* xb = resid_row(p, R0); constexpr size_t rs = RPITCH;
        const float* xin = isctx ? p.ctx + (size_t)(bb * CTX + q0) * D_MODEL : p.x + (size_t)(bb * SEQ + q0 - CTX) * D_MODEL;
        const float* gv = modv(p, l, R0) + goff;
        const int col0 = u.pn * 256 + wc * 32 + 8 * fq;
        constexpr int MB = from_input ? 2 : 4;
#pragma unroll
        for (int bj = 0; bj < 2; ++bj) { const int col = col0 + bj * 128; const f32x4 g0 = *(const f32x4*)(gv + col), g1 = *(const f32x4*)(gv + col + 4);
#pragma unroll
            for (int ai = 0; ai < 2; ++ai)
#pragma unroll
                for (int mb = 0; mb < 4; mb += MB) { f32x4 a0[MB], a1[MB];
#pragma unroll
                    for (int mm = 0; mm < MB; ++mm) { const size_t rl = (size_t)(wr * 64 + fr + ai * 128 + (mb + mm) * 16);
                        if (from_input) { a0[mm] = *(const f32x4*)(xin + rl * D_MODEL + col); a1[mm] = *(const f32x4*)(xin + rl * D_MODEL + col + 4); }
                        else { const u32x4 t = *(const u32x4*)(xb + rl * rs + col);
                            a0[mm] = (f32x4){bf2f((bf16)t.x), bf2f((bf16)(t.x >> 16)), bf2f((bf16)t.y), bf2f((bf16)(t.y >> 16))}; a1[mm] = (f32x4){bf2f((bf16)t.z), bf2f((bf16)(t.z >> 16)), bf2f((bf16)t.w), bf2f((bf16)(t.w >> 16))}; } }
#pragma unroll
                    for (int mm = 0; mm < MB; ++mm) { const size_t rl = (size_t)(wr * 64 + fr + ai * 128 + (mb + mm) * 16);
                        const f32x4 o0 = a0[mm] + g0 * acc[ai][bj][mb + mm][0], o1 = a1[mm] + g1 * acc[ai][bj][mb + mm][1];
                        u32x4 wv; wv.x = pg8::cvt_pk_bf16(o0[0], o0[1]); wv.y = pg8::cvt_pk_bf16(o0[2], o0[3]); wv.z = pg8::cvt_pk_bf16(o1[0], o1[1]); wv.w = pg8::cvt_pk_bf16(o1[2], o1[3]);
                        *(u32x4*)(xb + rl * rs + col) = wv; } } }
    }
};
struct EpiSwiglu {
    static constexpr bool PERM = true;
    bf16* O; int pm_base;
    DEV void operator()(const f32x4 (&acc)[2][2][4][2], const Unit& u, int wr, int wc, int fr, int fq) const {
        const int row0 = u.po * 256 + wr * 64 + fr, col0 = u.pn * 128 + wc * 32 + 8 * fq;
#pragma unroll
        for (int ai = 0; ai < 2; ++ai)
#pragma unroll
            for (int m = 0; m < 4; ++m) { float r[8];
#pragma unroll
                for (int n = 0; n < 2; ++n)
#pragma unroll
                    for (int j = 0; j < 4; ++j) r[4 * n + j] = silu_fast(acc[ai][0][m][n][j]) * acc[ai][1][m][n][j];
                u32x4 w; w.x = pg8::cvt_pk_bf16(r[0], r[1]); w.y = pg8::cvt_pk_bf16(r[2], r[3]); w.z = pg8::cvt_pk_bf16(r[4], r[5]); w.w = pg8::cvt_pk_bf16(r[6], r[7]);
                *(u32x4*)(O + (size_t)(row0 + ai * 128 + m * 16) * D_FF + col0) = w; }
    }
};
struct EpiStoreRel {
    static constexpr bool PERM = true;
    bf16* O; int ldc, pm_base;
    DEV void operator()(const f32x4 (&acc)[2][2][4][2], const Unit& u, int wr, int wc, int fr, int fq) const {
        const int row0 = u.po * 256 + wr * 64 + fr, col0 = u.pn * 256 + wc * 32 + 8 * fq;
#pragma unroll
        for (int ai = 0; ai < 2; ++ai)
#pragma unroll
            for (int m = 0; m < 4; ++m) { bf16* rowp = O + (size_t)(row0 + ai * 128 + m * 16) * ldc + col0;
#pragma unroll
                for (int bj = 0; bj < 2; ++bj) { const f32x4 v0 = acc[ai][bj][m][0], v1 = acc[ai][bj][m][1];
                    u32x4 w; w.x = pg8::cvt_pk_bf16(v0[0], v0[1]); w.y = pg8::cvt_pk_bf16(v0[2], v0[3]); w.z = pg8::cvt_pk_bf16(v1[0], v1[1]); w.w = pg8::cvt_pk_bf16(v1[2], v1[3]);
                    *(u32x4*)(rowp + bj * 128) = w; } }
    }
};
template <int mode> struct Sched {
    pg8::Order o; int pm_base; const int* seg; int nNc, kper;
    DEV bool next(int i, Unit& u) const {
        int lm, ln; if (!o.nextL(i, lm, ln)) return false;
        u.pn = ln; u.e = 0; u.k0 = 0; u.po = lm;
        if (mode == 0) u.pm = lm;
        else if (mode == 1) u.pm = (lm / NQL) * PAN_B + 1 + lm % NQL;
        else if (mode == 6) { u.pm = lm; u.k0 = (ln >= 2) ? 256 : 0; }
        else if (mode == 4) { u.pm = lm * PAN_B; u.pn = ln % nNc; u.k0 = (ln / nNc) * kper; u.po = (ln / nNc) * o.nM + lm; }
        else { const int gp = pm_base + lm; int e = 0;
#pragma unroll
            for (int k = 1; k < NEXP; ++k) e += (seg[k] <= gp) ? 1 : 0;
            u.e = e; u.pm = (mode == 2) ? gp : lm;
            if (mode == 5) { u.pn = ln % nNc; u.k0 = (ln / nNc) * kper; u.po = (ln / nNc) * o.nM + lm; } }
        return true;
    }
};

#ifndef WGM_MASK
#define WGM_MASK 0x01f
#endif
#define SITE_WGM(k) (((WGM_MASK >> (k)) & 1) ? 4 : 8)
struct TabSched {
    const int* tab; int n;
    DEV bool next(int i, Unit& u) const {
        if (i >= n) return false;
        u.pm = UNIFORM_I(tab[5 * i]); u.pn = UNIFORM_I(tab[5 * i + 1]); u.e = UNIFORM_I(tab[5 * i + 2]); u.k0 = UNIFORM_I(tab[5 * i + 3]); u.po = UNIFORM_I(tab[5 * i + 4]);
        return true;
    }
};
constexpr int MAX_UNITS = 150;
template <class S> DEV TabSched build_units(unsigned* misc, int tid, const S& sch) {
    int* tab = (int*)(misc + 256);
    __syncthreads();
    if (tid < MAX_UNITS) { Unit u; if (sch.next(tid, u)) { tab[5 * tid] = u.pm; tab[5 * tid + 1] = u.pn; tab[5 * tid + 2] = u.e; tab[5 * tid + 3] = u.k0; tab[5 * tid + 4] = u.po; } }
    __syncthreads();
    const int nwg = sch.o.nwg, c = sch.o.c, G = sch.o.G;
    TabSched t; t.tab = tab; t.n = (c < nwg) ? (nwg - c + G - 1) / G : 0;
    return t;
}

#ifndef EMU
#define XB_TMO      128
#define XB_XCNT(j)  (256  + 64 * (j))
#define XB_XSUB(j)  (1280 + 64 * (j))
#define XB_XGEN(j)  (2304 + 64 * (j))
#define XB_TOP      3328
#define XB_TOPGEN   3392
#define XCD_BAR_WORDS 3456
#define XB_SPIN_CAP (1u << 22)
#define LAS __attribute__((address_space(3)))
__device__ __forceinline__ unsigned xb_ld(unsigned* p)              { return __hip_atomic_load(p, __ATOMIC_RELAXED, __HIP_MEMORY_SCOPE_AGENT); }
__device__ __forceinline__ unsigned xb_add(unsigned* p, unsigned v) { return __hip_atomic_fetch_add(p, v, __ATOMIC_RELAXED, __HIP_MEMORY_SCOPE_AGENT); }
__device__ __forceinline__ unsigned xb_xcc_id() { return (unsigned)__builtin_amdgcn_s_getreg((3 << 11) | 20) & 0xFu; }
#define XB_SPIN(cond, bar) do { unsigned _sp = 0; while (cond) { __builtin_amdgcn_s_sleep(1); \
    if ((++_sp & 255u) == 0u) { if (xb_ld(&(bar)[XB_TMO])) break; if (_sp > XB_SPIN_CAP) { atomicAdd(&(bar)[XB_TMO], 1u); break; } } } } while (0)
struct XcdBarrier { unsigned* bar; unsigned x; volatile LAS unsigned* st; };
__device__ __forceinline__ XcdBarrier xcd_barrier_post(unsigned* bar, volatile LAS unsigned* st) {
    XcdBarrier b; b.bar = bar; b.x = xb_xcc_id(); b.st = st;
    if (threadIdx.x == 0) (void)xb_add(&bar[XB_XCNT(b.x)], 1u);
    return b;
}
__device__ __forceinline__ void xcd_barrier_complete(unsigned* bar, unsigned x, unsigned& nloc, unsigned& nx) {
    const unsigned G = gridDim.x * gridDim.y * gridDim.z;
    unsigned sum, cnt, mine, sp = 0u;
    for (;;) {
        sum = 0u; cnt = 0u; mine = 0u;
#pragma unroll
        for (unsigned j = 0; j < 16; ++j) { const unsigned c = xb_ld(&bar[XB_XCNT(j)]); sum += c; cnt += (c > 0u) ? 1u : 0u; mine = (j == x) ? c : mine; }
        if (sum == G) break;
        __builtin_amdgcn_s_sleep(1);
        if ((++sp & 255u) == 0u) { if (xb_ld(&bar[XB_TMO])) break; if (sp > XB_SPIN_CAP) { atomicAdd(&bar[XB_TMO], 1u); break; } }
    }
    nloc = mine > 0u ? mine : 1u; nx = cnt > 0u ? cnt : 1u;
}
__device__ __forceinline__ void xcd_barrier(const XcdBarrier& b) {
    asm volatile("s_waitcnt vmcnt(0)" ::: "memory");
    __syncthreads();
    if (threadIdx.x == 0) {
        unsigned* bar = b.bar;
        __builtin_amdgcn_s_waitcnt(0);
        unsigned nloc = b.st[0], nx = b.st[1];
        if (nloc == 0u) { xcd_barrier_complete(bar, b.x, nloc, nx); b.st[0] = nloc; b.st[1] = nx; }
        const unsigned old = xb_add(&bar[XB_XSUB(b.x)], 1u);
        const unsigned gen = old / nloc;
        if (old + 1u == (gen + 1u) * nloc) {
            __builtin_amdgcn_fence(__ATOMIC_RELEASE, "agent");
            asm volatile("s_waitcnt vmcnt(0)" ::: "memory");
            const unsigned og = xb_add(&bar[XB_TOP], 1u);
            const unsigned tg = og / nx;
            if (og + 1u == (tg + 1u) * nx) xb_add(&bar[XB_TOPGEN], 1u);
            else XB_SPIN(xb_ld(&bar[XB_TOPGEN]) == tg, bar);
            __builtin_amdgcn_fence(__ATOMIC_ACQUIRE, "agent");
            xb_add(&bar[XB_XGEN(b.x)], 1u);
            asm volatile("s_waitcnt vmcnt(0)" ::: "memory");
        } else {
            XB_SPIN(xb_ld(&bar[XB_XGEN(b.x)]) == gen, bar);
            __builtin_amdgcn_fence(__ATOMIC_ACQUIRE, "agent");
            asm volatile("s_waitcnt vmcnt(0)" ::: "memory");
        }
    }
    __syncthreads();
}
#endif

struct Wg { int tid, lane, wave, G, wg, gw, NGW; unsigned char* lds; unsigned* misc; };
DEV int q_next(Wg& w, unsigned* ctr) {
    if (w.tid == 0) w.misc[2] = atomicAdd(ctr, 1u);
    __syncthreads();
    const int v = (int)w.misc[2];
    __syncthreads();
    return v;
}

struct ConvJob { const float* src; int K, N, Npad; bf16* dst; int ldk, kdst0, rowofs, mode; };
struct ConvTile { const float* src; int N, k0, n0; bf16* dst; int ldk, kdst0, rowofs, mode; bool valid; };
DEV bool conv_job_pick(const ConvJob& j, int& it, ConvTile& t) {
    const int nkb = j.K / 64, nnb = j.Npad / 128, tot = nkb * nnb;
    if (it >= tot) { it -= tot; return false; }
    t.src = j.src; t.N = j.N; t.k0 = (it / nnb) * 64; t.n0 = (it % nnb) * 128; t.dst = j.dst; t.ldk = j.ldk; t.kdst0 = j.kdst0; t.rowofs = j.rowofs; t.mode = j.mode; t.valid = true;
    return true;
}
DEV void conv_load(const ConvTile& t, f32x4 (&v)[4], int tid) {
#pragma unroll
    for (int i = 0; i < 4; ++i) { const int kk = i * 16 + (tid >> 5), c4 = tid & 31; v[i] = (t.valid && t.n0 + 4 * c4 < t.N) ? *(const f32x4*)(t.src + (size_t)(t.k0 + kk) * t.N + t.n0 + 4 * c4) : (f32x4){0.f, 0.f, 0.f, 0.f}; }
}
DEV void conv_store(const ConvTile& t, const f32x4 (&v)[4], float* scr, int tid) {
#pragma unroll
    for (int i = 0; i < 4; ++i) { const int kk = i * 16 + (tid >> 5), c4 = tid & 31; *(f32x4*)(scr + kk * 132 + 4 * c4) = v[i]; }
    __syncthreads();
#pragma unroll
    for (int i = 0; i < 2; ++i) { const int idx = tid + NTHR * i, n = idx >> 3, c = idx & 7, ng = t.n0 + n; const float* s = scr + (8 * c) * 132 + n;
      const int row = t.rowofs + (t.mode == 0 ? ng : (ng / 128) * 256 + (ng % 128) + (t.mode == 2 ? 128 : 0));
      u32x4 o; o.x = pk2(s[0], s[132]); o.y = pk2(s[2 * 132], s[3 * 132]); o.z = pk2(s[4 * 132], s[5 * 132]); o.w = pk2(s[6 * 132], s[7 * 132]);
      *(u32x4*)(t.dst + (size_t)row * t.ldk + t.kdst0 + t.k0 + 8 * c) = o; }
    __syncthreads();
}
DEV void zero_rect(bf16* dst, int ld, int r0, int r1, int c0, int c1, int gtid, int gn) {
    const int cw = (c1 - c0) / 8; const long tot = (long)(r1 - r0) * cw;
    for (long i = gtid; i < tot; i += gn) { const int r = r0 + (int)(i / cw), c = c0 + 8 * (int)(i % cw); *(u32x4*)(dst + (size_t)r * ld + c) = (u32x4){0u, 0u, 0u, 0u}; }
}
DEV void phase0(const P& p, Wg& w) {
    float* scr = (float*)w.lds;
    {
        bf16* WIN = (bf16*)(p.ws + WS_WIN_T); bf16* WOUT = (bf16*)(p.ws + WS_WOUT_T); bf16* MLT = (bf16*)(p.ws + WS_MLA_T);
#define JOB_WIN(l) ConvJob{p.w_in + (size_t)(l) * D_MODEL * IN_W, D_MODEL, IN_W, PROJ_W, WIN + (size_t)(l) * PROJ_W * D_MODEL, D_MODEL, 0, 0, 0}
#define JOB_WOUT(l) ConvJob{p.w_out + (size_t)(l) * MIXW * D_MODEL, MIXW, D_MODEL, D_MODEL, WOUT + (size_t)(l) * D_MODEL * MIXW, MIXW, 0, 0, 0}
#define JOB_WUQ(l) ConvJob{p.l_wuq + (size_t)(l) * 256 * 384, 256, 384, 384, MLT + (size_t)(l) * 1024 * 512, 512, 0, 0, 0}
#define JOB_WUKV(l) ConvJob{p.l_wukv + (size_t)(l) * 128 * 512, 128, 512, 512, MLT + (size_t)(l) * 1024 * 512, 512, 256, 512, 0}
        constexpr int total = 2 * ((D_MODEL / 64) * (PROJ_W / 128) + (MIXW / 64) * (D_MODEL / 128) + 4 * 3 + 2 * 4) + 2 * (D_MODEL / 64) * (D_FF / 128) + (D_FF / 64) * (D_MODEL / 128);
        ConvTile cur, nxt; f32x4 vc[4], vn[4]; cur.valid = false;
#define PICK0(it0_, T) do { int it = (it0_); T.valid = false; if ((it0_) < total) { \
            if (!conv_job_pick(JOB_WIN(0), it, T)) if (!conv_job_pick(JOB_WIN(1), it, T)) if (!conv_job_pick(JOB_WOUT(0), it, T)) if (!conv_job_pick(JOB_WOUT(1), it, T)) \
            if (!conv_job_pick(JOB_WUQ(0), it, T)) if (!conv_job_pick(JOB_WUQ(1), it, T)) if (!conv_job_pick(JOB_WUKV(0), it, T)) if (!conv_job_pick(JOB_WUKV(1), it, T)) \
            if (!conv_job_pick(ConvJob{p.ffn_wg, D_MODEL, D_FF, D_FF, (bf16*)(p.ws + WS_WGU_T), D_MODEL, 0, 0, 1}, it, T)) \
            if (!conv_job_pick(ConvJob{p.ffn_wu, D_MODEL, D_FF, D_FF, (bf16*)(p.ws + WS_WGU_T), D_MODEL, 0, 0, 2}, it, T)) \
            conv_job_pick(ConvJob{p.ffn_wd, D_FF, D_MODEL, D_MODEL, (bf16*)(p.ws + WS_WD_T), D_FF, 0, 0, 0}, it, T); } } while (0)
        PICK0(w.wg, cur); if (cur.valid) conv_load(cur, vc, w.tid);
        for (int it0 = w.wg; it0 < total; it0 += w.G) {
            PICK0(it0 + w.G, nxt); if (nxt.valid) conv_load(nxt, vn, w.tid);
            conv_store(cur, vc, scr, w.tid);
            cur = nxt;
#pragma unroll
            for (int i = 0; i < 4; ++i) vc[i] = vn[i];
        }
#undef PICK0
    }
    for (int l = 0; l < 2; ++l) { bf16* mt = (bf16*)(p.ws + WS_MLA_T) + (size_t)l * 1024 * 512; const int gt = w.wg * NTHR + w.tid, gn = w.G * NTHR;
        zero_rect(mt, 512, 384, 512, 0, 256, gt, gn); zero_rect(mt, 512, 512, 1024, 384, 512, gt, gn); }
    if (w.wg == w.G - 1) for (int i = w.tid; i < NPOS * 24; i += NTHR) { const int pos = i / 24, f = i % 24;
        const float inv = f < 16 ? exp2f(-(float)f * (13.287712379549449f / 16.0f)) : exp2f(-(float)(f - 16) * (13.287712379549449f / 8.0f));
        float sn, cs; sincosf((float)pos * inv, &sn, &cs); float* rt = (float*)(p.ws + WS_ROPE) + 2 * i; rt[0] = cs; rt[1] = sn; }
    {
        float* sS = (float*)w.lds;
        float* part = sS + NV * D_MODEL;
        const int nitem = 2 * (6 * D_MODEL / 64);
        bool loaded = false;
        for (int it = w.wg; it < nitem; it += w.G) {
            if (!loaded) { for (int i = w.tid; i < NV * D_MODEL; i += NTHR) { const int v = i / D_MODEL, k = i % D_MODEL; sS[i] = silu_f(v < BATCH ? p.c[v * D_MODEL + k] : p.c_ctx[k]); } loaded = true; __syncthreads(); }
            const int l = it / (6 * D_MODEL / 64), cb = it % (6 * D_MODEL / 64), col = cb * 64 + w.lane;
            float acc[NV];
#pragma unroll
            for (int v = 0; v < NV; ++v) acc[v] = 0.f;
            const float* mw = p.mod_w + (size_t)l * D_MODEL * 6 * D_MODEL + col;
            for (int k0 = w.wave * (D_MODEL / 8); k0 < (w.wave + 1) * (D_MODEL / 8); k0 += 16) { float wv[16];
#pragma unroll
                for (int kk = 0; kk < 16; ++kk) wv[kk] = mw[(size_t)(k0 + kk) * 6 * D_MODEL];
#pragma unroll
                for (int kk = 0; kk < 16; ++kk)
#pragma unroll
                    for (int v = 0; v < NV; ++v) acc[v] += sS[v * D_MODEL + k0 + kk] * wv[kk]; }
#pragma unroll
            for (int v = 0; v < NV; ++v) part[(w.wave * NV + v) * 64 + w.lane] = acc[v];
            __syncthreads();
            for (int i = w.tid; i < NV * 64; i += NTHR) { const int v = i / 64, cc = i % 64; float s = p.mod_b[(size_t)l * 6 * D_MODEL + cb * 64 + cc];
#pragma unroll
                for (int ww = 0; ww < 8; ++ww) s += part[(ww * NV + v) * 64 + cc];
                ((float*)(p.ws + WS_MODV))[(size_t)(l * NV + v) * 6 * D_MODEL + cb * 64 + cc] = s; }
            __syncthreads();
        }
    }
}
DEV void phase_moe_weights(const P& p, Wg& w) {
    float* scr = (float*)w.lds;
    const int t_gu = (D_MODEL / 64) * (D_FF / 128), t_d = (D_FF / 64) * (D_MODEL / 128), per_e = 2 * t_gu + t_d;
    ConvTile cur, nxt; f32x4 vc[4], vn[4];
#define PICKM(it0_, T) do { T.valid = false; if ((it0_) < NEXP * per_e) { const int e = (it0_) / per_e; int it = (it0_) % per_e; bf16* base = (bf16*)(p.ws + WS_MOEW + (size_t)e * MOEW_E); \
        if (!conv_job_pick(ConvJob{p.moe_wg + (size_t)e * D_MODEL * D_FF, D_MODEL, D_FF, D_FF, base, D_MODEL, 0, 0, 1}, it, T)) \
        if (!conv_job_pick(ConvJob{p.moe_wu + (size_t)e * D_MODEL * D_FF, D_MODEL, D_FF, D_FF, base, D_MODEL, 0, 0, 2}, it, T)) \
        conv_job_pick(ConvJob{p.moe_wd + (size_t)e * D_FF * D_MODEL, D_FF, D_MODEL, D_MODEL, base + (size_t)2 * D_FF * D_MODEL, D_FF, 0, 0, 0}, it, T); } } while (0)
    PICKM(w.wg, cur); if (cur.valid) conv_load(cur, vc, w.tid);
    for (int it0 = w.wg; it0 < NEXP * per_e; it0 += w.G) {
        PICKM(it0 + w.G, nxt); if (nxt.valid) conv_load(nxt, vn, w.tid);
        conv_store(cur, vc, scr, w.tid);
        cur = nxt;
#pragma unroll
        for (int i = 0; i < 4; ++i) vc[i] = vn[i];
    }
#undef PICKM
}

template <int NB> DEV void phase_modulate(const P& p, Wg& w, int l, int which, bool first, bool skip_ctx, bool moe, bool ctx_part) {
    constexpr int NJ = D_MODEL / 256;
    bf16* H = (bf16*)(p.ws + WS_H);
    const float* gn = (which ? p.norm_ffn : p.norm_mix) + (size_t)l * D_MODEL;
    int cnt[NEXP];
#pragma unroll
    for (int e = 0; e < NEXP; ++e) cnt[e] = 0;
    f32x4 rw[NJ * 4][2];
    if (moe) {
#pragma unroll
        for (int j = 0; j < NJ; ++j)
#pragma unroll
            for (int k = 0; k < 4; ++k) { const float* rr = p.moe_router + (size_t)(4 * w.lane + 256 * j + k) * NEXP; rw[4 * j + k][0] = *(const f32x4*)rr; rw[4 * j + k][1] = *(const f32x4*)(rr + 4); } }
    f32x4 gnv[NJ];
#pragma unroll
    for (int j = 0; j < NJ; ++j) gnv[j] = *(const f32x4*)(gn + 4 * w.lane + 256 * j);
    static_assert(TP % NB == 0 && CTX % NB == 0 && M_ALL % NB == 0, "a group of NB consecutive rows never straddles a batch / context boundary");
    const int step = NB * w.NGW;
    u32x2 nraw[NB][NJ];
#define MOD_PF(Rg_) do { _Pragma("unroll") for (int qq = 0; qq < NB; ++qq) { const bf16* xr_ = resid_row(p, (Rg_) + qq); \
        _Pragma("unroll") for (int j = 0; j < NJ; ++j) nraw[qq][j] = *(const u32x2*)(xr_ + 4 * w.lane + 256 * j); } } while (0)
    f32x4 nrawf[NB][NJ];
#define MOD_PFF(Rg_) do { _Pragma("unroll") for (int qq = 0; qq < NB; ++qq) { const int R_ = (Rg_) + qq, b_ = R_ / TP, q_ = R_ % TP; \
        const float* src_ = q_ < CTX ? p.ctx + (size_t)(b_ * CTX + q_) * D_MODEL : p.x + (size_t)(b_ * SEQ + q_ - CTX) * D_MODEL; \
        _Pragma("unroll") for (int j = 0; j < NJ; ++j) nrawf[qq][j] = *(const f32x4*)(src_ + 4 * w.lane + 256 * j); } } while (0)
    if (first) MOD_PFF(NB * w.gw); else MOD_PF(NB * w.gw);
    for (int Rb = NB * w.gw; Rb < M_ALL; Rb += step) {
        f32x4 vv[NB][NJ];
        if (first) {
#pragma unroll
            for (int qq = 0; qq < NB; ++qq)
#pragma unroll
                for (int j = 0; j < NJ; ++j) vv[qq][j] = nrawf[qq][j]; }
        else {
#pragma unroll
            for (int qq = 0; qq < NB; ++qq)
#pragma unroll
                for (int j = 0; j < NJ; ++j) { const u32x2 t = nraw[qq][j]; vv[qq][j] = (f32x4){bf2f((bf16)t.x), bf2f((bf16)(t.x >> 16)), bf2f((bf16)t.y), bf2f((bf16)(t.y >> 16))}; } }
        f32x4 gs[NJ], s0v[NJ];
        { const float* mv = modv(p, l, Rb); const float* sh = mv + (which ? 3 : 0) * D_MODEL; const float* sc = mv + (which ? 4 : 1) * D_MODEL;
#pragma unroll
          for (int j = 0; j < NJ; ++j) { gs[j] = *(const f32x4*)(sc + 4 * w.lane + 256 * j); s0v[j] = *(const f32x4*)(sh + 4 * w.lane + 256 * j); } }
        if (Rb + step < M_ALL) { if (first) MOD_PFF(Rb + step); else MOD_PF(Rb + step); }
        if (skip_ctx && (Rb % TP) < CTX) continue;
#pragma unroll
        for (int j = 0; j < NJ; ++j) gs[j] = gnv[j] * (1.0f + gs[j]);
#pragma unroll
        for (int qq = 0; qq < NB; ++qq) {
        const int R = Rb + qq; const int b = R / TP, q = R % TP;
        bf16* xr = resid_row(p, R);
        f32x4 v[NJ]; float ss = 0.f;
#pragma unroll
        for (int j = 0; j < NJ; ++j) { v[j] = vv[qq][j]; ss += v[j][0] * v[j][0] + v[j][1] * v[j][1] + v[j][2] * v[j][2] + v[j][3] * v[j][3]; }
        if (ctx_part && q < CTX) {
            const bf16* cp = (const bf16*)(p.ws + WS_MLAQ) + (size_t)(b * CTX + q) * D_MODEL; const float* gf = (const float*)(p.ws + WS_MODV) + (size_t)((l - 1) * NV + BATCH) * 6 * D_MODEL + 5 * D_MODEL;
            ss = 0.f;
#pragma unroll
            for (int j = 0; j < NJ; ++j) { const int col = 4 * w.lane + 256 * j; f32x4 a = (f32x4){0.f, 0.f, 0.f, 0.f};
                for (int ks = 0; ks < NSPLIT; ++ks) { const u32x2 t = *(const u32x2*)(cp + (size_t)ks * BATCH * CTX * D_MODEL + col);
                    a[0] += bf2f((bf16)t.x); a[1] += bf2f((bf16)(t.x >> 16)); a[2] += bf2f((bf16)t.y); a[3] += bf2f((bf16)(t.y >> 16)); }
                const f32x4 g = *(const f32x4*)(gf + col); v[j] = v[j] + g * a; { u32x2 wb; wb.x = pk2(v[j][0], v[j][1]); wb.y = pk2(v[j][2], v[j][3]); *(u32x2*)(xr + col) = wb; }
                ss += v[j][0] * v[j][0] + v[j][1] * v[j][1] + v[j][2] * v[j][2] + v[j][3] * v[j][3]; } }
        ss = wave_sum(ss, w.lane);
        const float rstd = rsqrt_fast(ss * (1.0f / D_MODEL) + EPS);
        float lg[NEXP];
#pragma unroll
        for (int e = 0; e < NEXP; ++e) lg[e] = 0.f;
#pragma unroll
        for (int j = 0; j < NJ; ++j) { const int col = 4 * w.lane + 256 * j;
            f32x4 h;
#pragma unroll
            for (int k = 0; k < 4; ++k) h[k] = v[j][k] * rstd * gs[j][k] + s0v[j][k];
            u32x2 o; o.x = pk2(h[0], h[1]); o.y = pk2(h[2], h[3]);
            *(u32x2*)(H + (size_t)R * D_MODEL + col) = o;
            if (moe) {
#pragma unroll
                for (int k = 0; k < 4; ++k) {
#pragma unroll
                    for (int e = 0; e < NEXP; ++e) lg[e] += h[k] * rw[4 * j + k][e >> 2][e & 3]; } } }
        if (moe) {
#pragma unroll
            for (int e = 0; e < NEXP; ++e) lg[e] = wave_sum(lg[e], w.lane);
            int i1 = 0; float v1 = lg[0];
#pragma unroll
            for (int e = 1; e < NEXP; ++e) if (lg[e] > v1) { v1 = lg[e]; i1 = e; }
            int i2 = -1; float v2 = -3.0e38f;
#pragma unroll
            for (int e = 0; e < NEXP; ++e) if (e != i1 && lg[e] > v2) { v2 = lg[e]; i2 = e; }
            const float w1 = 1.0f / (1.0f + expf(v2 - v1)), w2 = 1.0f - w1;
            const int tok = b * SEQ + q - CTX;
            if (w.lane == 0) { int* ti = (int*)(p.ws + WS_TOPI) + 2 * tok; float* tw = (float*)(p.ws + WS_TOPW) + 2 * tok; ti[0] = i1; ti[1] = i2; tw[0] = w1; tw[1] = w2; }
#pragma unroll
            for (int e = 0; e < NEXP; ++e) cnt[e] += (e == i1 || e == i2) ? 1 : 0;
        }
        }
    }
    if (moe) {
        int* lc = (int*)w.lds;
        if (w.lane == 0) {
#pragma unroll
            for (int e = 0; e < NEXP; ++e) lc[w.wave * NEXP + e] = cnt[e]; }
        __syncthreads();
        if (w.tid < NEXP) { int s = 0; for (int ww = 0; ww < NWAVE; ++ww) s += lc[ww * NEXP + w.tid]; ((int*)(p.ws + WS_CNTG))[w.wg * NEXP + w.tid] = s; }
        __syncthreads();
    }
}

#undef MOD_PF
#undef MOD_PFF
DEV void phase_prep(const P& p, Wg& w, int l) {
    bf16* PROJ = (bf16*)(p.ws + WS_PROJ); bf16* MQK = (bf16*)(p.ws + WS_MQK);
    const float* cw = p.m_conv + (size_t)l * 3 * 768;
    const int lane = w.lane;
    const float gkr = p.l_knorm[l * 96 + 64 + (lane & 31)];
    const f32x4 gcq = *(const f32x4*)(p.l_cq_norm + l * 256 + 4 * lane); const float gkv0 = p.l_ckv_norm[l * 128 + 2 * lane], gkv1 = p.l_ckv_norm[l * 128 + 2 * lane + 1];
    const int hq = lane >> 3, hi8 = lane & 7, hbase = (hq < 6 ? C_AQ + hq * 64 : C_AK + (hq - 6) * 64) + 8 * hi8;
    f32x4 cwv[3][3];
#pragma unroll
    for (int j = 0; j < 3; ++j)
#pragma unroll
        for (int tp = 0; tp < 3; ++tp) cwv[j][tp] = *(const f32x4*)(cw + tp * 768 + 4 * lane + 256 * j);
    float gh[8];
    { const float* gp = (hq < 6 ? p.a_qnorm : p.a_knorm) + l * 64 + 8 * hi8;
#pragma unroll
      for (int j = 0; j < 8; ++j) gh[j] = gp[j] * (hq < 6 ? QSCALE_A : 1.0f); }
    const float* rtab = (const float*)(p.ws + WS_ROPE);
    constexpr int NB = 4;
    const int RPW = (M_ALL + w.NGW - 1) / w.NGW, Rend = ((w.gw + 1) * RPW < M_ALL) ? (w.gw + 1) * RPW : M_ALL;
    for (int R0 = w.gw * RPW; R0 < Rend; R0 += NB) {
        u32x2 c0[NB][3], cp[NB][3], cn[NB][3], cprev[3], cnext[3]; u32x4 hraw[NB]; u32x2 cqv[NB]; unsigned ckvv[NB]; bf16 krv[NB]; bool ok[NB];
        { const bool hpv = R0 > 0, hnv = R0 + NB < M_ALL;
#pragma unroll
          for (int j = 0; j < 3; ++j) { const int col = 4 * lane + 256 * j;
              cprev[j] = hpv ? *(const u32x2*)(PROJ + (size_t)(R0 - 1) * PROJ_W + col) : (u32x2){0u, 0u}; cnext[j] = hnv ? *(const u32x2*)(PROJ + (size_t)(R0 + NB) * PROJ_W + col) : (u32x2){0u, 0u}; } }
#pragma unroll
        for (int q = 0; q < NB; ++q) { const int R = R0 + q; ok[q] = R < Rend; const int Rr = R < M_ALL ? R : R0;
            const bf16* pr = PROJ + (size_t)Rr * PROJ_W;
#pragma unroll
            for (int j = 0; j < 3; ++j) c0[q][j] = *(const u32x2*)(pr + 4 * lane + 256 * j);
            hraw[q] = *(const u32x4*)(pr + hbase); cqv[q] = *(const u32x2*)(pr + C_CQ + 4 * lane); ckvv[q] = *(const unsigned*)(pr + C_CKV + 2 * lane); krv[q] = pr[C_KR + (lane & 31)]; }
#pragma unroll
        for (int q = 0; q < NB; ++q) { const int qq = (R0 + q) % TP; const bool hp = !(qq == 0 || qq == CTX), hn = !(qq == CTX - 1 || qq == TP - 1);
#pragma unroll
            for (int j = 0; j < 3; ++j) { const u32x2 a = (q == 0) ? cprev[j] : c0[q > 0 ? q - 1 : 0][j], n = (q == NB - 1) ? cnext[j] : c0[q < NB - 1 ? q + 1 : 0][j];
                cp[q][j] = hp ? a : (u32x2){0u, 0u}; cn[q][j] = hn ? n : (u32x2){0u, 0u}; } }
#pragma unroll
        for (int q = 0; q < NB; ++q) { const int Rr = (R0 + q < M_ALL) ? R0 + q : R0; const int qq = Rr % TP; const bool lat = qq >= CTX; const int t = qq - CTX;
            bf16* pr = PROJ + (size_t)Rr * PROJ_W;
            u32x2 ov[3];
#pragma unroll
            for (int j = 0; j < 3; ++j) { const int col = 4 * lane + 256 * j; float o[4];
#pragma unroll
                for (int k = 0; k < 4; ++k) { const unsigned sh = (k & 1) * 16; const unsigned a = (k < 2 ? cp[q][j].x : cp[q][j].y) >> sh, c = (k < 2 ? c0[q][j].x : c0[q][j].y) >> sh, n = (k < 2 ? cn[q][j].x : cn[q][j].y) >> sh;
                    const float sv = bf2f((bf16)a) * cwv[j][0][k] + bf2f((bf16)c) * cwv[j][1][k] + bf2f((bf16)n) * cwv[j][2][k]; o[k] = silu_fast(sv) * (col >= 384 ? KSCALE_M : 1.0f); }
                ov[j].x = pk2(o[0], o[1]); ov[j].y = pk2(o[2], o[3]); }
            u32x4 oh;
            { float x[8], ss = 0.f;
#pragma unroll
              for (int j = 0; j < 8; ++j) { x[j] = bf2f((bf16)(hraw[q][j >> 1] >> ((j & 1) * 16))); ss += x[j] * x[j]; }
              ss += SHX(ss, 1, lane); ss += SHX(ss, 2, lane); ss += SHX(ss, 4, lane);
              const float rs = rsqrt_fast(ss * (1.0f / 64.0f) + EPS);
#pragma unroll
              for (int j = 0; j < 8; ++j) x[j] *= rs * gh[j];
              const float* ct = rtab + ((size_t)(lat ? (hi8 < 4 ? t / GRID_W : t % GRID_W) : 0) * 24 + 8 * (hi8 & 1)) * 2;
              const f32x4 t0 = *(const f32x4*)ct, t1 = *(const f32x4*)(ct + 4), t2 = *(const f32x4*)(ct + 8), t3 = *(const f32x4*)(ct + 12);
              const float csv[8] = {t0[0], t0[2], t1[0], t1[2], t2[0], t2[2], t3[0], t3[2]}, snv[8] = {t0[1], t0[3], t1[1], t1[3], t2[1], t2[3], t3[1], t3[3]};
#pragma unroll
              for (int j = 0; j < 8; ++j) { const float pt = SHX(x[j], 2, lane);
                  if (lat) x[j] = (hi8 & 2) ? x[j] * csv[j] + pt * snv[j] : x[j] * csv[j] - pt * snv[j]; }
              oh.x = pk2(x[0], x[1]); oh.y = pk2(x[2], x[3]); oh.z = pk2(x[4], x[5]); oh.w = pk2(x[6], x[7]); }
            float csL = 1.f, snL = 0.f;
            if (lat) { const int d = lane & 31; const float* ct = rtab + ((size_t)(d < 16 ? t / GRID_W : t % GRID_W) * 24 + 16 + (d & 7)) * 2; csL = ct[0]; snL = ct[1]; }
            u32x2 ocq; unsigned ockv; float ykr;
            { float x[4] = {bf2f((bf16)cqv[q].x), bf2f((bf16)(cqv[q].x >> 16)), bf2f((bf16)cqv[q].y), bf2f((bf16)(cqv[q].y >> 16))};
              const float x0 = bf2f((bf16)ckvv[q]), x1 = bf2f((bf16)(ckvv[q] >> 16)); const float vk = lane < 32 ? bf2f(krv[q]) : 0.f;
              float s1 = x[0] * x[0] + x[1] * x[1] + x[2] * x[2] + x[3] * x[3], s2 = x0 * x0 + x1 * x1, s3 = vk * vk;
#pragma unroll
              for (int o = 1; o < 64; o <<= 1) { s1 += SHX(s1, o, lane); s2 += SHX(s2, o, lane); s3 += SHX(s3, o, lane); }
              const float r1 = rsqrt_fast(s1 * (1.0f / 256.0f) + EPS), r2 = rsqrt_fast(s2 * (1.0f / 128.0f) + EPS), r3 = rsqrt_fast(s3 * (1.0f / 32.0f) + EPS);
              ocq.x = pk2(x[0] * r1 * gcq[0], x[1] * r1 * gcq[1]); ocq.y = pk2(x[2] * r1 * gcq[2], x[3] * r1 * gcq[3]);
              ockv = pk2(x0 * r2 * gkv0, x1 * r2 * gkv1);
              float y = vk * r3 * gkr; const float pt = SHX(y, 8, lane);
              if (lat) y = (lane & 8) ? y * csL + pt * snL : y * csL - pt * snL;
              ykr = y; }
            if (ok[q]) {
#pragma unroll
                for (int j = 0; j < 3; ++j) *(u32x2*)(MQK + (size_t)Rr * 768 + 4 * lane + 256 * j) = ov[j];
                *(u32x4*)(pr + hbase) = oh;
                *(u32x2*)(pr + C_CQ + 4 * lane) = ocq; *(unsigned*)(pr + C_CKV + 2 * lane) = ockv;
                if (lane < 32) pr[C_KR + lane] = f2bf(ykr); }
        }
    }
}

DEV float scan_add(float v, int lane) {
#pragma unroll
    for (int d = 1; d < 64; d <<= 1) { const float t = __shfl(v, lane >= d ? lane - d : lane); if (lane >= d) v += t; }
    return v;
}
DEV float scan_max(float v, int lane) {
#pragma unroll
    for (int d = 1; d < 64; d <<= 1) { const float t = __shfl(v, lane >= d ? lane - d : lane); if (lane >= d) v = fmaxf(v, t); }
    return v;
}
DEV int chain_step(int dir, int cl) { return dir == 0 ? cl : (cl < NC_CTX ? NC_CTX - 1 - cl : NCH + NC_CTX - 1 - cl); }
DEV void gate_scan2(const P& p, int l, int R0, int hh, int dir, int lane, float* al, float* pm, float* bcl, float& F, float& pml) {
    static_assert(MCH == 128, "two positions per lane");
    const float* gb = p.m_gate_b + l * 16; float gi[2], lf[2];
#pragma unroll
    for (int e = 0; e < 2; ++e) { const int j = 2 * lane + e, o = dir ? MCH - 1 - j : j;
        const float* G = (const float*)(p.ws + WS_GATES) + (size_t)(R0 + o) * 16;
        gi[e] = G[dir * 8 + hh] + gb[dir * 8 + hh]; lf[e] = log_sigmoid_f(G[dir * 8 + 4 + hh] + gb[dir * 8 + 4 + hh]); }
    const float incl = scan_add(lf[0] + lf[1], lane);
    const float up1 = __shfl(incl, lane ? lane - 1 : 0), excl = lane ? up1 : 0.f;
    const float bc0 = excl + lf[0], bc1 = incl, a0 = gi[0] - bc0, a1 = gi[1] - bc1;
    const float pin = scan_max(fmaxf(a0, a1), lane);
    const float pu = __shfl(pin, lane ? lane - 1 : 0), px0 = lane ? fmaxf(pu, a0) : a0;
    F = __shfl(incl, 63); pml = __shfl(pin, 63);
    { const int o0 = dir ? MCH - 1 - 2 * lane : 2 * lane, o1 = dir ? o0 - 1 : o0 + 1;
      al[o0] = a0; pm[o0] = px0; bcl[o0] = bc0; al[o1] = a1; pm[o1] = pin; bcl[o1] = bc1; }
}
DEV void ml1_item(const P& p, Wg& w, int l, int item) {
    const int b = item / (4 * NCH), hh = (item / NCH) % 4, cl = item % NCH, R0 = b * TP + cl * MCH;
    float* wgt = (float*)w.lds;
    float* scr = wgt + 2 * MCH;
    bf16* Ks = (bf16*)(w.lds + 4096);
    bf16* Vw = Ks + MCH * 104;
    const bf16* MQK = (const bf16*)(p.ws + WS_MQK); const bf16* PROJ = (const bf16*)(p.ws + WS_PROJ);
    bf16* UC = (bf16*)(p.ws + WS_UC); float* NL = (float*)(p.ws + WS_NL);
    const int lane = w.lane, r = lane & 31, h = lane >> 5;
    static_assert(MCH * 12 == 3 * NTHR, "three k/v vectors per thread");
    u32x4 kq[3], vq[3];
#pragma unroll
    for (int q = 0; q < 3; ++q) { const int idx = w.tid + q * NTHR, s = idx / 12, c = idx % 12;
        kq[q] = *(const u32x4*)(MQK + (size_t)(R0 + s) * 768 + 384 + hh * 96 + 8 * c); vq[q] = *(const u32x4*)(PROJ + (size_t)(R0 + s) * PROJ_W + C_MV + hh * 96 + 8 * c); }
    if (w.wave < 2) { const int dir = w.wave; float F, pml; float* sc = scr + dir * 3 * MCH;
        gate_scan2(p, l, R0, hh, dir, lane, sc, sc + MCH, sc + 2 * MCH, F, pml);
        wave_sync();
#pragma unroll
        for (int hf = 0; hf < 2; ++hf) wgt[dir * MCH + lane + 64 * hf] = __expf(sc[lane + 64 * hf] - pml);
        const int ci = ((b * 4 + hh) * 2 + dir) * NCH + chain_step(dir, cl);
        if (lane == 0) { ((float*)(p.ws + WS_FS))[ci] = F; ((float*)(p.ws + WS_PML))[ci] = pml; } }
    __syncthreads();
#pragma unroll
    for (int q = 0; q < 3; ++q) { const int idx = w.tid + q * NTHR, s = idx / 12, c = idx % 12;
        const u32x4 kr = kq[q], vr = vq[q];
        *(u32x4*)(Ks + s * 104 + 8 * c) = kr;
#pragma unroll
        for (int dir = 0; dir < 2; ++dir) { const float wd = wgt[dir * MCH + s]; u32x4 o;
            o.x = pk2(wd * bf2f((bf16)vr.x), wd * bf2f((bf16)(vr.x >> 16))); o.y = pk2(wd * bf2f((bf16)vr.y), wd * bf2f((bf16)(vr.y >> 16)));
            o.z = pk2(wd * bf2f((bf16)vr.z), wd * bf2f((bf16)(vr.z >> 16))); o.w = pk2(wd * bf2f((bf16)vr.w), wd * bf2f((bf16)(vr.w >> 16)));
            *(u32x4*)(Vw + (dir * MCH + s) * 104 + 8 * c) = o;
            if (c == 0) Vw[(dir * MCH + s) * 104 + 96] = f2bf(wd); } }
    __syncthreads();
    const int toff = (8 * h + ((lane & 15) >> 2)) * 104 + 16 * ((lane >> 4) & 1) + 4 * (lane & 3);
    for (int task = w.wave; task < 24; task += NWAVE) {
        const bool nt = task >= 18; const int tt = nt ? task - 18 : task;
        const int dir = nt ? tt / 3 : tt / 9, dt = nt ? tt % 3 : (tt % 9) / 3, et = nt ? 3 : tt % 3;
        f32x16 acc;
#pragma unroll
        for (int i = 0; i < 16; ++i) acc[i] = 0.f;
#pragma unroll
        for (int ks = 0; ks < MCH / 16; ++ks) { const bf16* ap = Ks + (16 * ks) * 104 + 32 * dt + toff; const bf16* bp = Vw + (dir * MCH + 16 * ks) * 104 + 32 * et + toff;
            const s16x4 al = lds_tr_read(ap), ah = lds_tr_read(ap + 4 * 104), bl = lds_tr_read(bp), bh = lds_tr_read(bp + 4 * 104);
            const bf16x8 af = (bf16x8){al[0], al[1], al[2], al[3], ah[0], ah[1], ah[2], ah[3]}, bfr = (bf16x8){bl[0], bl[1], bl[2], bl[3], bh[0], bh[1], bh[2], bh[3]};
            acc = mfma32(af, bfr, acc); }
        const int ci = ((b * 4 + hh) * 2 + dir) * NCH + chain_step(dir, cl);
        if (!nt) { bf16* up = UC + (size_t)ci * 9216 + (32 * et + r) * 96 + 32 * dt + 4 * h;
#pragma unroll
            for (int g = 0; g < 4; ++g) { u32x2 o; o.x = pk2(acc[4 * g], acc[4 * g + 1]); o.y = pk2(acc[4 * g + 2], acc[4 * g + 3]); *(u32x2*)(up + 8 * g) = o; } }
        else if (r == 0) { float* np = NL + (size_t)ci * 96 + 32 * dt + 4 * h;
#pragma unroll
            for (int g = 0; g < 4; ++g) *(f32x4*)(np + 8 * g) = (f32x4){acc[4 * g], acc[4 * g + 1], acc[4 * g + 2], acc[4 * g + 3]}; } }
    __syncthreads();
}
DEV void phase_ml2(const P& p, Wg& w) {
    constexpr int GPC = 1152 + 12;
    bf16* UC = (bf16*)(p.ws + WS_UC); float* NL = (float*)(p.ws + WS_NL);
    const float* FS = (const float*)(p.ws + WS_FS); const float* PML = (const float*)(p.ws + WS_PML); float* MST = (float*)(p.ws + WS_MST);
    for (int j = w.wg * NTHR + w.tid; j < NCHAIN * GPC; j += w.G * NTHR) {
        const int chain = j / GPC, g = j % GPC;
        float C[8], m = 0.f;
#pragma unroll
        for (int i = 0; i < 8; ++i) C[i] = 0.f;
        for (int k0 = 0; k0 < NCH; k0 += ML2_U) {
            float Fv[ML2_U], pv[ML2_U];
#pragma unroll
            for (int q = 0; q < ML2_U; ++q) { Fv[q] = FS[chain * NCH + k0 + q]; pv[q] = PML[chain * NCH + k0 + q]; }
            if (g < 1152) { u32x4 raw[ML2_U];
#pragma unroll
                for (int q = 0; q < ML2_U; ++q) raw[q] = *(const u32x4*)(UC + (size_t)(chain * NCH + k0 + q) * 9216 + 8 * g);
#pragma unroll
                for (int q = 0; q < ML2_U; ++q) { const int ci = chain * NCH + k0 + q; const float mx = fmaxf(m, pv[q]), dec = __expf(m - mx), sc = __expf(pv[q] - mx);
                    u32x4 st; st.x = pk2(C[0], C[1]); st.y = pk2(C[2], C[3]); st.z = pk2(C[4], C[5]); st.w = pk2(C[6], C[7]); *(u32x4*)(UC + (size_t)ci * 9216 + 8 * g) = st;
#pragma unroll
                    for (int i = 0; i < 8; ++i) C[i] = dec * C[i] + sc * bf2f((bf16)(raw[q][i >> 1] >> ((i & 1) * 16)));
                    if (g == 0) MST[ci] = m;
                    m = Fv[q] + mx; } }
            else {
                for (int q = 0; q < ML2_U; ++q) { float* nl = NL + (size_t)(chain * NCH + k0 + q) * 96 + 8 * (g - 1152); const f32x4 r0 = *(const f32x4*)nl, r1 = *(const f32x4*)(nl + 4);
                    const float mx = fmaxf(m, pv[q]), dec = __expf(m - mx), sc = __expf(pv[q] - mx);
                    *(f32x4*)nl = (f32x4){C[0], C[1], C[2], C[3]}; *(f32x4*)(nl + 4) = (f32x4){C[4], C[5], C[6], C[7]};
#pragma unroll
                    for (int i = 0; i < 4; ++i) { C[i] = dec * C[i] + sc * r0[i]; C[4 + i] = dec * C[4 + i] + sc * r1[i]; }
                    m = Fv[q] + mx; } }
        }
    }
}
DEV void ml3_item(const P& p, Wg& w, int l, int item) {
    const int lane = w.lane, r = lane & 31, h = lane >> 5, dir = w.wave >> 2, tq = w.wave & 3;
    const int b = item / (4 * NCH), hh = (item / NCH) % 4, cl = item % NCH, R0 = b * TP + cl * MCH;
    const int ci = ((b * 4 + hh) * 2 + dir) * NCH + chain_step(dir, cl);
    bf16* Qs = (bf16*)w.lds;
    bf16* Ksm = Qs + MCH * 104;
    bf16* Vs = Ksm + MCH * 104;
    float* nls = (float*)(w.lds + 3 * MCH * 104 * 2);
    float* scn = nls + 192;
    float* hx = (float*)w.lds;
    const bf16* MQK = (const bf16*)(p.ws + WS_MQK); const bf16* PROJ = (const bf16*)(p.ws + WS_PROJ);
    const bf16* UCi = (const bf16*)(p.ws + WS_UC) + (size_t)ci * 9216;
    for (int idx = w.tid; idx < MCH * 12; idx += NTHR) { const int s = idx / 12, c = idx % 12;
        const u32x4 qv = *(const u32x4*)(MQK + (size_t)(R0 + s) * 768 + hh * 96 + 8 * c), kv = *(const u32x4*)(MQK + (size_t)(R0 + s) * 768 + 384 + hh * 96 + 8 * c),
                    vv = *(const u32x4*)(PROJ + (size_t)(R0 + s) * PROJ_W + C_MV + hh * 96 + 8 * c);
        *(u32x4*)(Qs + s * 104 + 8 * c) = qv; *(u32x4*)(Ksm + s * 104 + 8 * c) = kv; *(u32x4*)(Vs + s * 104 + 8 * c) = vv; }
    if (w.tid < 192) { const int dd = w.tid / 96; nls[w.tid] = ((const float*)(p.ws + WS_NL))[(size_t)(((b * 4 + hh) * 2 + dd) * NCH + chain_step(dd, cl)) * 96 + w.tid % 96]; }
    if (tq == 0) { float F, pml; float* sc = scn + dir * 3 * MCH; gate_scan2(p, l, R0, hh, dir, lane, sc, sc + MCH, sc + 2 * MCH, F, pml); }
    const float m_st = ((const float*)(p.ws + WS_MST))[ci];
    __syncthreads();
    const float* al = scn + dir * 3 * MCH; const float* pmv = al + MCH; const float* bcl = al + 2 * MCH;
    const int t = 32 * tq + r;
    const float mx_t = fmaxf(m_st, pmv[t]), bc_t = bcl[t];
    bf16x8 qf[6]; float qn = 0.f;
#pragma unroll
    for (int ks = 0; ks < 6; ++ks) { qf[ks] = *(const bf16x8*)(Qs + t * 104 + 16 * ks + 8 * h);
        const f32x4 n0 = *(const f32x4*)(nls + dir * 96 + 16 * ks + 8 * h), n1 = *(const f32x4*)(nls + dir * 96 + 16 * ks + 8 * h + 4);
#pragma unroll
        for (int j = 0; j < 4; ++j) { qn += bf2f((bf16)qf[ks][j]) * n0[j]; qn += bf2f((bf16)qf[ks][4 + j]) * n1[j]; } }
    qn += SHX(qn, 32, lane);
    f32x16 o[3]; float rs = 0.f;
#pragma unroll
    for (int et = 0; et < 3; ++et)
#pragma unroll
        for (int i = 0; i < 16; ++i) o[et][i] = 0.f;
    for (int kb = dir ? tq : 0; kb < (dir ? NQB : tq + 1); ++kb) {
        f32x16 pw;
#pragma unroll
        for (int i = 0; i < 16; ++i) pw[i] = 0.f;
#pragma unroll
        for (int ks = 0; ks < 6; ++ks) { const bf16x8 kf = *(const bf16x8*)(Ksm + (32 * kb + r) * 104 + 16 * ks + 8 * h); pw = mfma32(kf, qf[ks], pw); }
#pragma unroll
        for (int g = 0; g < 4; ++g) { const int s0 = 32 * kb + 8 * g + 4 * h; const f32x4 av = *(const f32x4*)(al + s0);
#pragma unroll
            for (int j = 0; j < 4; ++j) { const int sidx = s0 + j; const bool okk = dir ? (sidx >= t) : (sidx <= t);
                const float wv = okk ? __expf(av[j] - mx_t) * pw[4 * g + j] : 0.f; pw[4 * g + j] = wv; rs += wv; } }
        bf16x8 pb[2];
#pragma unroll
        for (int sp = 0; sp < 2; ++sp) { u32x4 u; u.x = pk2(pw[8 * sp], pw[8 * sp + 1]); u.y = pk2(pw[8 * sp + 2], pw[8 * sp + 3]); u.z = pk2(pw[8 * sp + 4], pw[8 * sp + 5]); u.w = pk2(pw[8 * sp + 6], pw[8 * sp + 7]);
            pb[sp] = __builtin_bit_cast(bf16x8, u); }
#pragma unroll
        for (int et = 0; et < 3; ++et)
#pragma unroll
            for (int sp = 0; sp < 2; ++sp) { const bf16* vp = Vs + (32 * kb + 16 * sp + 4 * h + ((lane & 15) >> 2)) * 104 + 32 * et + 16 * ((lane >> 4) & 1) + 4 * (lane & 3);
                const s16x4 lo = lds_tr_read(vp), hi = lds_tr_read(vp + 8 * 104);
                const bf16x8 vf = (bf16x8){lo[0], lo[1], lo[2], lo[3], hi[0], hi[1], hi[2], hi[3]};
                o[et] = mfma32(vf, pb[sp], o[et]); }
    }
    rs += SHX(rs, 32, lane);
    const float a_int = __expf(m_st - mx_t), den = a_int * qn + rs, inv = 1.0f / fmaxf(fabsf(den), __expf(-(bc_t + mx_t)));
#pragma unroll
    for (int et = 0; et < 3; ++et) { f32x16 oi;
#pragma unroll
        for (int i = 0; i < 16; ++i) oi[i] = 0.f;
#pragma unroll
        for (int ks = 0; ks < 6; ++ks) { const bf16x8 cf = *(const bf16x8*)(UCi + (32 * et + r) * 96 + 16 * ks + 8 * h); oi = mfma32(cf, qf[ks], oi); }
#pragma unroll
        for (int i = 0; i < 16; ++i) o[et][i] = (a_int * oi[i] + o[et][i]) * inv; }
    __syncthreads();
    if (dir == 1) {
#pragma unroll
        for (int et = 0; et < 3; ++et)
#pragma unroll
            for (int i = 0; i < 16; ++i) hx[t * 97 + 32 * et + crow(i, h)] = o[et][i]; }
    __syncthreads();
    if (dir == 0) { float ss = 0.f;
#pragma unroll
        for (int et = 0; et < 3; ++et)
#pragma unroll
            for (int i = 0; i < 16; ++i) { o[et][i] += hx[t * 97 + 32 * et + crow(i, h)]; ss += o[et][i] * o[et][i]; }
        ss += SHX(ss, 32, lane);
        const float rstd = rsqrt_fast(ss * (1.0f / 96.0f) + EPS);
        bf16* MIX = (bf16*)(p.ws + WS_H);
#pragma unroll
        for (int et = 0; et < 3; ++et)
#pragma unroll
            for (int g = 0; g < 4; ++g) { const int e = 32 * et + 8 * g + 4 * h;
                const u32x2 og = *(const u32x2*)(PROJ + (size_t)(R0 + t) * PROJ_W + C_MO + hh * 96 + e); const f32x4 mn = *(const f32x4*)(p.m_norm + l * 384 + hh * 96 + e);
                float o4[4];
#pragma unroll
                for (int j = 0; j < 4; ++j) { const float gate = bf2f((bf16)((j < 2 ? og.x : og.y) >> ((j & 1) * 16))); o4[j] = o[et][4 * g + j] * rstd * mn[j] * sigmoid_f(gate); }
                u32x2 ov; ov.x = pk2(o4[0], o4[1]); ov.y = pk2(o4[2], o4[3]);
                *(u32x2*)(MIX + (size_t)(R0 + t) * MIXW + hh * 96 + e) = ov; } }
    __syncthreads();
}

DEV void phase_mla_post(const P& p, Wg& w, int l) {
    bf16* MLAQ = (bf16*)(p.ws + WS_MLAQ); const bf16* PROJ = (const bf16*)(p.ws + WS_PROJ);
    const int lane = w.lane;
    int baseA = 0, nA = 8, dstA = 8 * lane; bool normA = true, ropeA = false; const float* gA = p.l_qnorm + l * 96;
    if (lane < 48) { const int hh = lane / 12, o = lane % 12;
        if (o < 8) { baseA = 12 * hh; nA = 8; gA = p.l_qnorm + l * 96 + 8 * o; }
        else { baseA = 12 * hh + 8; nA = 4; gA = p.l_qnorm + l * 96 + 64 + 8 * (o - 8); ropeA = true; } }
    else { normA = false; }
    const int hb = lane / 16, ob = lane % 16; const bool normB = ob < 8;
    const int baseB = (16 * (lane / 16)) & 63;
    const int dstB = normB ? 384 + 96 * hb + 8 * ob : 768 + 64 * hb + 8 * (ob - 8);
    const float* gB = p.l_knorm + l * 96 + 8 * (ob & 7);
    float gAv[8], gBv[8];
#pragma unroll
    for (int j = 0; j < 8; ++j) { gAv[j] = gA[j]; gBv[j] = gB[j]; }
    const int cidx = (lane % 12) - 8;
    constexpr int NB = 2;
    for (int R0 = w.gw; R0 < M_ALL; R0 += NB * w.NGW) {
        u32x4 ra[NB], rb[NB], kr[NB]; bool ok[NB];
#pragma unroll
        for (int q = 0; q < NB; ++q) { const int R = R0 + q * w.NGW; ok[q] = R < M_ALL; const int Rr = ok[q] ? R : R0; const bf16* row = MLAQ + (size_t)Rr * 1024;
            ra[q] = *(const u32x4*)(row + 8 * lane); rb[q] = *(const u32x4*)(row + 512 + 8 * lane);
            kr[q] = (lane >= 48) ? *(const u32x4*)(PROJ + (size_t)Rr * PROJ_W + C_KR + 8 * ((lane - 48) & 3)) : (u32x4){0u, 0u, 0u, 0u}; }
        u32x4 oa[NB], obv[NB];
#pragma unroll
        for (int q = 0; q < NB; ++q) { const int Rr = ok[q] ? R0 + q * w.NGW : R0; const int qq = Rr % TP; const bool lat = qq >= CTX; const int t = qq - CTX;
            float xa[8], xb[8], ssA = 0.f, ssB = 0.f;
#pragma unroll
            for (int j = 0; j < 8; ++j) { xa[j] = bf2f((bf16)(ra[q][j >> 1] >> ((j & 1) * 16))); xb[j] = bf2f((bf16)(rb[q][j >> 1] >> ((j & 1) * 16))); ssA += xa[j] * xa[j]; ssB += xb[j] * xb[j]; }
            float sA = 0.f, sB = 0.f;
#pragma unroll
            for (int i = 0; i < 8; ++i) { const float v = __shfl(ssA, (baseA + i) & 63); if (i < nA) sA += v; sB += __shfl(ssB, (baseB + i) & 63); }
            const float rsA = normA ? rsqrt_fast(sA / (float)(8 * nA) + EPS) : 1.0f, rsB = normB ? rsqrt_fast(sB * (1.0f / 64.0f) + EPS) : 1.0f;
#pragma unroll
            for (int j = 0; j < 8; ++j) { xa[j] = normA ? xa[j] * rsA * gAv[j] : xa[j]; xb[j] = normB ? xb[j] * rsB * gBv[j] : xb[j]; }
            const float* ct = (const float*)(p.ws + WS_ROPE) + ((size_t)(lat ? ((cidx & 3) < 2 ? t / GRID_W : t % GRID_W) : 0) * 24 + 16) * 2;
            const f32x4 t0 = *(const f32x4*)ct, t1 = *(const f32x4*)(ct + 4), t2 = *(const f32x4*)(ct + 8), t3 = *(const f32x4*)(ct + 12);
            const float csv[8] = {t0[0], t0[2], t1[0], t1[2], t2[0], t2[2], t3[0], t3[2]}, snv[8] = {t0[1], t0[3], t1[1], t1[3], t2[1], t2[3], t3[1], t3[3]};
#pragma unroll
            for (int j = 0; j < 8; ++j) { const float pt = SHX(xa[j], 1, lane);
                if (ropeA && lat) xa[j] = (cidx & 1) ? xa[j] * csv[j] + pt * snv[j] : xa[j] * csv[j] - pt * snv[j]; }
            if (lane < 48) {
#pragma unroll
                for (int j = 0; j < 8; ++j) xa[j] *= QSCALE_L; }
            oa[q].x = pk2(xa[0], xa[1]); oa[q].y = pk2(xa[2], xa[3]); oa[q].z = pk2(xa[4], xa[5]); oa[q].w = pk2(xa[6], xa[7]);
            obv[q].x = pk2(xb[0], xb[1]); obv[q].y = pk2(xb[2], xb[3]); obv[q].z = pk2(xb[4], xb[5]); obv[q].w = pk2(xb[6], xb[7]); }
        wave_sync();
#pragma unroll
        for (int q = 0; q < NB; ++q) if (ok[q]) { bf16* row = MLAQ + (size_t)(R0 + q * w.NGW) * 1024;
            if (lane < 48) *(u32x4*)(row + dstA) = oa[q];
            else { const int i = lane - 48; *(u32x4*)(row + 384 + 96 * (i >> 2) + 64 + 8 * (i & 3)) = kr[q]; }
            *(u32x4*)(row + dstB) = obv[q]; }
        wave_sync();
    }
}

template <int DQK>
DEV void attn_unit(const bf16* Q, int ldq, const bf16* K, int ldk, const bf16* V, int ldv, bf16* O, int ldo, int nkeys, Wg& w) {
    constexpr int KS = DQK + 8, NKD = DQK / 16, CPR = DQK / 8, NKC = 64 * CPR, VS = 72;
    bf16* Ks = (bf16*)w.lds;
    bf16* Vs = (bf16*)(w.lds + 2 * 64 * KS * 2);
    const int tid = w.tid, lane = w.lane, r = lane & 31, h = lane >> 5;
    bf16x8 qr[NKD];
    { const bf16* qp = Q + (size_t)(w.wave * 32 + r) * ldq + 8 * h;
#pragma unroll
      for (int d0 = 0; d0 < NKD; ++d0) qr[d0] = *(const bf16x8*)(qp + 16 * d0); }
    const int kr0 = tid / CPR, kc0 = tid % CPR, kr1 = (tid + NTHR) / CPR, kc1 = (tid + NTHR) % CPR; const bool k1 = (tid + NTHR) < NKC;
    const int vr = tid >> 3, vc = tid & 7;
    u32x4 rk0, rk1 = (u32x4){0u, 0u, 0u, 0u}, rv;
    const int NT = nkeys / 64;
    const int vtr_off = (4 * h + ((lane & 15) >> 2)) * VS + 16 * ((lane >> 4) & 1) + 4 * (lane & 3);
#define AT_LOAD(kt) do { rk0 = *(const u32x4*)(K + (size_t)((kt) * 64 + kr0) * ldk + 8 * kc0); if (k1) rk1 = *(const u32x4*)(K + (size_t)((kt) * 64 + kr1) * ldk + 8 * kc1); \
        rv = *(const u32x4*)(V + (size_t)((kt) * 64 + vr) * ldv + 8 * vc); } while (0)
#define AT_STORE(buf) do { *(u32x4*)(Ks + ((buf) * 64 + kr0) * KS + 8 * kc0) = rk0; if (k1) *(u32x4*)(Ks + ((buf) * 64 + kr1) * KS + 8 * kc1) = rk1; \
        *(u32x4*)(Vs + ((buf) * 64 + vr) * VS + 8 * vc) = rv; } while (0)
    AT_LOAD(0); AT_STORE(0);
    __syncthreads();
    float m_run = 0.f, l_run = 0.f; f32x16 o[2], negm;
#pragma unroll
    for (int i = 0; i < 16; ++i) { o[0][i] = 0.f; o[1][i] = 0.f; negm[i] = 0.f; }
    for (int kt = 0; kt < NT; ++kt) {
        const int buf = kt & 1;
        if (kt + 1 < NT) AT_LOAD(kt + 1);
        f32x16 pt[2];
        { bf16x8 kf[2][NKD];
#pragma unroll
          for (int kh = 0; kh < 2; ++kh)
#pragma unroll
              for (int d0 = 0; d0 < NKD; ++d0) kf[kh][d0] = *(const bf16x8*)(Ks + (buf * 64 + 32 * kh + r) * KS + 16 * d0 + 8 * h);
          SCHED_FENCE();
          pt[0] = negm; pt[1] = negm;
#pragma unroll
          for (int d0 = 0; d0 < NKD; ++d0) { pt[0] = mfma32(kf[0][d0], qr[d0], pt[0]); pt[1] = mfma32(kf[1][d0], qr[d0], pt[1]); } }
        bf16x8 vf[2][2][2];
#pragma unroll
        for (int et = 0; et < 2; ++et)
#pragma unroll
            for (int kh = 0; kh < 2; ++kh)
#pragma unroll
                for (int sp = 0; sp < 2; ++sp) { const bf16* vp = Vs + (buf * 64 + 32 * kh + 16 * sp) * VS + 32 * et + vtr_off;
                    const s16x4 lo = lds_tr_read(vp), hi = lds_tr_read(vp + 8 * VS);
                    vf[et][kh][sp] = (bf16x8){lo[0], lo[1], lo[2], lo[3], hi[0], hi[1], hi[2], hi[3]}; }
        SCHED_FENCE();
        float mq[4];
#pragma unroll
        for (int c = 0; c < 4; ++c) mq[c] = fmaxf(pt[0][c], pt[1][c]);
#pragma unroll
        for (int i = 4; i < 16; ++i) mq[i & 3] = fmaxf(mq[i & 3], fmaxf(pt[0][i], pt[1][i]));
        float mt = fmaxf(fmaxf(mq[0], mq[1]), fmaxf(mq[2], mq[3]));
        if (__any(kt == 0 || mt > 8.0f)) {
            mt = fmaxf(mt, SHX(mt, 32, lane));
            const float dl = (kt == 0) ? mt : fmaxf(mt, 0.f), alpha = exp2_fast(-dl);
            m_run += dl; l_run *= alpha;
#pragma unroll
            for (int i = 0; i < 16; ++i) { pt[0][i] -= dl; pt[1][i] -= dl; o[0][i] *= alpha; o[1][i] *= alpha; negm[i] = -m_run; }
        }
        float rq[4] = {0.f, 0.f, 0.f, 0.f};
#pragma unroll
        for (int kh = 0; kh < 2; ++kh)
#pragma unroll
            for (int i = 0; i < 16; ++i) { const float e = exp2_fast(pt[kh][i]); pt[kh][i] = e; rq[i & 3] += e; }
        l_run += (rq[0] + rq[1]) + (rq[2] + rq[3]);
        bf16x8 pb[2][2];
#pragma unroll
        for (int kh = 0; kh < 2; ++kh)
#pragma unroll
            for (int sp = 0; sp < 2; ++sp) { u32x4 u; u.x = pk2(pt[kh][8 * sp], pt[kh][8 * sp + 1]); u.y = pk2(pt[kh][8 * sp + 2], pt[kh][8 * sp + 3]); u.z = pk2(pt[kh][8 * sp + 4], pt[kh][8 * sp + 5]); u.w = pk2(pt[kh][8 * sp + 6], pt[kh][8 * sp + 7]);
                pb[kh][sp] = __builtin_bit_cast(bf16x8, u); }
        SCHED_FENCE();
#pragma unroll
        for (int kh = 0; kh < 2; ++kh)
#pragma unroll
            for (int sp = 0; sp < 2; ++sp)
#pragma unroll
                for (int et = 0; et < 2; ++et) o[et] = mfma32(vf[et][kh][sp], pb[kh][sp], o[et]);
        if (kt + 1 < NT) AT_STORE(buf ^ 1);
        __syncthreads();
    }
#undef AT_LOAD
#undef AT_STORE
    l_run += SHX(l_run, 32, lane);
    const float inv = 1.0f / l_run;
    bf16* op = O + (size_t)(w.wave * 32 + r) * ldo + 4 * h;
#pragma unroll
    for (int et = 0; et < 2; ++et)
#pragma unroll
        for (int g = 0; g < 4; ++g) { u32x2 ov; ov.x = pk2(o[et][4 * g] * inv, o[et][4 * g + 1] * inv); ov.y = pk2(o[et][4 * g + 2] * inv, o[et][4 * g + 3] * inv); *(u32x2*)(op + 32 * et + 8 * g) = ov; }
}
#ifndef REP_ATT
#define REP_ATT 1
#endif
#ifndef REP_ML3
#define REP_ML3 1
#endif
DEV void relaunder(Wg& w) { int t_ = w.tid; OPAQUE_V(t_); w.tid = t_; w.lane = t_ & 63; }
DEV void phase_mix(const P& p, Wg& w, int l) {
    const bf16* PROJ = (const bf16*)(p.ws + WS_PROJ); const bf16* MLAQ = (const bf16*)(p.ws + WS_MLAQ); bf16* MIX = (bf16*)(p.ws + WS_H);
    unsigned* ctr = (unsigned*)(p.ws + WS_CTL) + CW_Q + 1024 * l;
    const int n_ml3 = BATCH * 4 * NCH;
    for (int rep = 0; rep < REP_ATT; ++rep) {
        { const int n_lat = BATCH * 4 * NQL, n_all = n_lat + ((l == 0) ? BATCH * 4 : 0);
          for (;;) {
            int idx = q_next(w, ctr + 64 * rep);
            if (idx >= n_all) break;
            int b, head, qb, nkeys;
            if (idx < n_lat) { b = idx / (4 * NQL); head = (idx / NQL) % 4; qb = 1 + idx % NQL; nkeys = TP; }
            else { idx -= n_lat; b = idx / 4; head = idx % 4; qb = 0; nkeys = CTX; }
            const size_t Rq = (size_t)b * TP + qb * 256, Rk = (size_t)b * TP;
            attn_unit<96>(MLAQ + Rq * 1024 + head * 96, 1024, MLAQ + Rk * 1024 + 384 + head * 96, 1024, MLAQ + Rk * 1024 + 768 + head * 64, 1024, MIX + Rq * MIXW + 768 + head * 64, MIXW, nkeys, w);
          } }
        relaunder(w);
        { const int n_lat = BATCH * 6 * NQL, n_all = n_lat + ((l == 0) ? BATCH * 6 : 0);
          for (;;) {
            int idx = q_next(w, ctr + 256 + 64 * rep);
            if (idx >= n_all) break;
            int b, head, qb, nkeys;
            if (idx < n_lat) { b = idx / (6 * NQL); const int rem = idx % (6 * NQL); head = (rem / (3 * NQL)) * 3 + rem % 3; qb = 1 + (rem % (3 * NQL)) / 3; nkeys = TP; }
            else { idx -= n_lat; b = idx / 6; head = idx % 6; qb = 0; nkeys = CTX; }
            const size_t Rq = (size_t)b * TP + qb * 256, Rk = (size_t)b * TP;
            attn_unit<64>(PROJ + Rq * PROJ_W + C_AQ + head * 64, PROJ_W, PROJ + Rk * PROJ_W + C_AK + (head / 3) * 64, PROJ_W, PROJ + Rk * PROJ_W + C_AV + (head / 3) * 64, PROJ_W, MIX + Rq * MIXW + 384 + head * 64, MIXW, nkeys, w);
          } }
        relaunder(w);
    }
    for (int rep = 0; rep < REP_ML3; ++rep)
    for (;;) {
        const int idx = q_next(w, ctr + 512 + 64 * rep);
        if (idx >= n_ml3) break;
        if (l == 1 && idx % NCH < NC_CTX) continue;
        ml3_item(p, w, l, idx);
    }
}

DEV void moe_seg_table(const P& p, Wg& w) {
    const int* cntg = (const int*)(p.ws + WS_CNTG); int* part = (int*)w.lds;
    { const int e = w.tid & 7; int tot = 0, pre = 0;
      for (int g = w.tid >> 3; g < w.G; g += NTHR / 8) { const int c = cntg[g * NEXP + e]; tot += c; pre += (g < w.wg) ? c : 0; }
      part[2 * w.tid] = tot; part[2 * w.tid + 1] = pre; }
    __syncthreads();
    if (w.tid < NEXP) { int tot = 0, pre = 0; for (int i = 0; i < NTHR / 8; ++i) { tot += part[2 * (8 * i + w.tid)]; pre += part[2 * (8 * i + w.tid) + 1]; } w.misc[32 + w.tid] = (unsigned)tot; w.misc[48 + w.tid] = (unsigned)pre; }
    __syncthreads();
    if (w.tid == 0) { int s = 0; for (int e = 0; e < NEXP; ++e) { w.misc[16 + e] = (unsigned)s; s += ((int)w.misc[32 + e] + 255) / 256; } w.misc[16 + NEXP] = (unsigned)s; }
    __syncthreads();
}
DEV void phase_gather(const P& p, Wg& w) {
    moe_seg_table(p, w);
    const int* topi = (const int*)(p.ws + WS_TOPI); const float* topw = (const float*)(p.ws + WS_TOPW);
    int* stok = (int*)(p.ws + WS_STOK); float* sw = (float*)(p.ws + WS_SW);
    const bf16* H = (const bf16*)(p.ws + WS_H); bf16* AG = (bf16*)(p.ws + WS_AG);
    int* lc = (int*)w.lds;
    if (w.lane == 0) { for (int e = 0; e < NEXP; ++e) lc[w.wave * NEXP + e] = 0;
        for (int R = w.gw; R < M_ALL; R += w.NGW) { const int q = R % TP; if (q < CTX) continue; const int tok = (R / TP) * SEQ + q - CTX; lc[w.wave * NEXP + topi[2 * tok]]++; lc[w.wave * NEXP + topi[2 * tok + 1]]++; } }
    __syncthreads();
    if (w.tid < NEXP) { int s = (int)w.misc[16 + w.tid] * 256 + (int)w.misc[48 + w.tid]; for (int ww = 0; ww < NWAVE; ++ww) { const int c = lc[ww * NEXP + w.tid]; lc[ww * NEXP + w.tid] = s; s += c; } }
    __syncthreads();
    constexpr int NJ8 = (D_MODEL + 511) / 512;
    for (int R0 = w.gw; R0 < M_ALL; R0 += 4 * w.NGW) {
        int s0[4], s1[4]; bool ok[4];
#pragma unroll
        for (int qq = 0; qq < 4; ++qq) { const int R = R0 + qq * w.NGW; const int q = R % TP; ok[qq] = R < M_ALL && q >= CTX; const int tok = (R / TP) * SEQ + q - CTX;
            int a0 = 0, a1 = 0;
            if (w.lane == 0 && ok[qq]) { const int e0 = topi[2 * tok], e1 = topi[2 * tok + 1]; a0 = lc[w.wave * NEXP + e0]; lc[w.wave * NEXP + e0] = a0 + 1; a1 = lc[w.wave * NEXP + e1]; lc[w.wave * NEXP + e1] = a1 + 1;
                stok[a0] = tok; stok[a1] = tok; sw[a0] = topw[2 * tok]; sw[a1] = topw[2 * tok + 1]; int* tsl = (int*)(p.ws + WS_TSL) + 2 * tok; tsl[0] = a0; tsl[1] = a1; }
            s0[qq] = __shfl(a0, 0); s1[qq] = __shfl(a1, 0); }
        u32x4 v[4][NJ8];
#pragma unroll
        for (int qq = 0; qq < 4; ++qq)
#pragma unroll
            for (int j = 0; j < NJ8; ++j) { const int c = 8 * w.lane + 512 * j; if (ok[qq] && c < D_MODEL) v[qq][j] = *(const u32x4*)(H + (size_t)(R0 + qq * w.NGW) * D_MODEL + c); }
#pragma unroll
        for (int qq = 0; qq < 4; ++qq)
#pragma unroll
            for (int j = 0; j < NJ8; ++j) { const int c = 8 * w.lane + 512 * j; if (ok[qq] && c < D_MODEL) { *(u32x4*)(AG + (size_t)s0[qq] * D_MODEL + c) = v[qq][j]; *(u32x4*)(AG + (size_t)s1[qq] * D_MODEL + c) = v[qq][j]; } }
    }
    for (int e = w.wg; e < NEXP; e += w.G) { const int lo = (int)w.misc[16 + e] * 256 + (int)w.misc[32 + e], hi = (int)w.misc[16 + e + 1] * 256;
        for (int s = lo + w.wave; s < hi; s += NWAVE) { if (w.lane == 0) { stok[s] = -1; sw[s] = 0.f; }
            for (int c = 8 * w.lane; c < D_MODEL; c += 512) *(u32x4*)(AG + (size_t)s * D_MODEL + c) = (u32x4){0u, 0u, 0u, 0u}; } }
}

DEV void phase_moe_combine(const P& p, Wg& w, int c) {
    const int* tsl = (const int*)(p.ws + WS_TSL); const float* topw = (const float*)(p.ws + WS_TOPW); const bf16* YC = (const bf16*)(p.ws + WS_YC);
    const int lo = c * MOE_PCH * 256, hi = lo + MOE_PCH * 256;
    const int ptot = (int)w.misc[16 + NEXP], np = (ptot - c * MOE_PCH) < MOE_PCH ? (ptot - c * MOE_PCH) : MOE_PCH;
    if (np <= 0) return;
    const int nsp = (np * NSPLIT > MOE_PCH) ? 1 : NSPLIT; const size_t pstr = (size_t)np * 256 * D_MODEL;
    constexpr int CB = 2;
    for (int tok0 = w.gw; tok0 < NTOK; tok0 += CB * w.NGW) {
        const bf16* y0[CB]; const bf16* y1[CB]; float w0[CB], w1[CB]; bool act[CB]; bf16* xr[CB]; const float* gv[CB];
#pragma unroll
        for (int q = 0; q < CB; ++q) { const int tok = tok0 + q * w.NGW; const bool ok = tok < NTOK; const int tk = ok ? tok : 0;
            const int s0 = tsl[2 * tk], s1 = tsl[2 * tk + 1]; const bool in0 = ok && s0 >= lo && s0 < hi, in1 = ok && s1 >= lo && s1 < hi;
            act[q] = in0 || in1; w0[q] = in0 ? topw[2 * tk] : 0.f; w1[q] = in1 ? topw[2 * tk + 1] : 0.f;
            y0[q] = YC + (size_t)(in0 ? s0 - lo : 0) * D_MODEL; y1[q] = YC + (size_t)(in1 ? s1 - lo : 0) * D_MODEL;
            xr[q] = (bf16*)(p.out + (size_t)tk * D_MODEL); gv[q] = (const float*)(p.ws + WS_MODV) + (size_t)(1 * NV + tk / SEQ) * 6 * D_MODEL + 5 * D_MODEL; }
#pragma unroll
        for (int j = 0; j < D_MODEL / 256; ++j) { const int col = 4 * w.lane + 256 * j;
            f32x4 ya[CB], g[CB]; u32x2 x[CB];
#pragma unroll
            for (int q = 0; q < CB; ++q) if (act[q]) { g[q] = *(const f32x4*)(gv[q] + col); x[q] = *(const u32x2*)(xr[q] + col); ya[q] = (f32x4){0.f, 0.f, 0.f, 0.f};
                for (int ks = 0; ks < nsp; ++ks) { const u32x2 a = *(const u32x2*)(y0[q] + ks * pstr + col), bq = *(const u32x2*)(y1[q] + ks * pstr + col);
                    ya[q][0] += w0[q] * bf2f((bf16)a.x) + w1[q] * bf2f((bf16)bq.x); ya[q][1] += w0[q] * bf2f((bf16)(a.x >> 16)) + w1[q] * bf2f((bf16)(bq.x >> 16));
                    ya[q][2] += w0[q] * bf2f((bf16)a.y) + w1[q] * bf2f((bf16)bq.y); ya[q][3] += w0[q] * bf2f((bf16)(a.y >> 16)) + w1[q] * bf2f((bf16)(bq.y >> 16)); } }
#pragma unroll
            for (int q = 0; q < CB; ++q) if (act[q]) { u32x2 o;
                o.x = pk2(bf2f((bf16)x[q].x) + g[q][0] * ya[q][0], bf2f((bf16)(x[q].x >> 16)) + g[q][1] * ya[q][1]); o.y = pk2(bf2f((bf16)x[q].y) + g[q][2] * ya[q][2], bf2f((bf16)(x[q].y >> 16)) + g[q][3] * ya[q][3]);
                *(u32x2*)(xr[q] + col) = o; } }
    }
}
DEV void phase_moe_final(const P& p, Wg& w) {
    constexpr int c = MOE_NCH - 1, NJ = D_MODEL / 256;
    const int* tsl = (const int*)(p.ws + WS_TSL); const float* topw = (const float*)(p.ws + WS_TOPW); const bf16* YC = (const bf16*)(p.ws + WS_YC);
    const int lo = c * MOE_PCH * 256, hi = lo + MOE_PCH * 256;
    const int ptot = (int)w.misc[16 + NEXP], np = (ptot - c * MOE_PCH) < MOE_PCH ? (ptot - c * MOE_PCH) : MOE_PCH;
    const int nsp = (np * NSPLIT > MOE_PCH) ? 1 : NSPLIT; const size_t pstr = (size_t)(np > 0 ? np : 0) * 256 * D_MODEL;
    for (int tok0 = w.gw; tok0 < NTOK; tok0 += 2 * w.NGW) {
        f32x4 xo[2][NJ]; bool ok[2];
#pragma unroll
        for (int q = 0; q < 2; ++q) { const int tok = tok0 + q * w.NGW; ok[q] = tok < NTOK; const int tk = ok[q] ? tok : 0;
            const int s0 = tsl[2 * tk], s1 = tsl[2 * tk + 1]; const bool in0 = np > 0 && s0 >= lo && s0 < hi, in1 = np > 0 && s1 >= lo && s1 < hi;
            const float w0 = in0 ? topw[2 * tk] : 0.f, w1 = in1 ? topw[2 * tk + 1] : 0.f;
            const bf16* y0 = YC + (size_t)(in0 ? s0 - lo : 0) * D_MODEL; const bf16* y1 = YC + (size_t)(in1 ? s1 - lo : 0) * D_MODEL;
            const bf16* xr = (const bf16*)(p.out + (size_t)tk * D_MODEL); const float* gv = (const float*)(p.ws + WS_MODV) + (size_t)(1 * NV + tk / SEQ) * 6 * D_MODEL + 5 * D_MODEL;
#pragma unroll
            for (int j = 0; j < NJ; ++j) { const int col = 4 * w.lane + 256 * j; const u32x2 t = *(const u32x2*)(xr + col);
                xo[q][j] = (f32x4){bf2f((bf16)t.x), bf2f((bf16)(t.x >> 16)), bf2f((bf16)t.y), bf2f((bf16)(t.y >> 16))};
                if (in0 || in1) { f32x4 ya = (f32x4){0.f, 0.f, 0.f, 0.f};
                    for (int ks = 0; ks < nsp; ++ks) { const u32x2 a = *(const u32x2*)(y0 + ks * pstr + col), bq = *(const u32x2*)(y1 + ks * pstr + col);
                        ya[0] += w0 * bf2f((bf16)a.x) + w1 * bf2f((bf16)bq.x); ya[1] += w0 * bf2f((bf16)(a.x >> 16)) + w1 * bf2f((bf16)(bq.x >> 16));
                        ya[2] += w0 * bf2f((bf16)a.y) + w1 * bf2f((bf16)bq.y); ya[3] += w0 * bf2f((bf16)(a.y >> 16)) + w1 * bf2f((bf16)(bq.y >> 16)); }
                    xo[q][j] = xo[q][j] + *(const f32x4*)(gv + col) * ya; } } }
        wave_sync();
#pragma unroll
        for (int q = 0; q < 2; ++q) if (ok[q]) { float* orow = p.out + (size_t)(tok0 + q * w.NGW) * D_MODEL;
#pragma unroll
            for (int j = 0; j < NJ; ++j) *(f32x4*)(orow + 4 * w.lane + 256 * j) = xo[q][j]; }
    }
}

constexpr int PH_L = 24;
constexpr int N_PHASES = 1 + 2 * PH_L;
#ifndef PROBE_MUL
#define PROBE_MUL 1
#endif
#ifdef EMU
#define GRID_BAR() do {} while (0)
#define DYN_LDS() unsigned char* lds = EMU_DYN_LDS()
#else
#define GRID_BAR() xcd_barrier(bar)
#define DYN_LDS() extern __shared__ __attribute__((aligned(16))) unsigned char lds[]
#endif
__global__ void __launch_bounds__(NTHR, 2) fwd(P p_in) {
    DYN_LDS();
    Wg w; w.tid = threadIdx.x; w.lane = w.tid & 63;
#ifndef EMU
    w.wave = __builtin_amdgcn_readfirstlane(w.tid >> 6);
#else
    w.wave = w.tid >> 6;
#endif
    w.G = gridDim.x; w.wg = blockIdx.x; w.gw = w.wg * NWAVE + w.wave; w.NGW = w.G * NWAVE; w.lds = lds; w.misc = (unsigned*)(lds + LDS_MISC);
    if (w.tid < 64) w.misc[w.tid] = 0u;
    __syncthreads();
#ifndef EMU
    XcdBarrier bar = xcd_barrier_post((unsigned*)(p_in.ws + WS_CTL) + CW_BAR, (volatile LAS unsigned*)(w.misc));
#endif
    const int lo = p_in.ph_lo, hi = p_in.ph_hi; const int wave_s = w.wave; (void)wave_s;
#ifndef PH_MASK
#define PH_MASK 0xffffffffu
#endif
#if defined(PROBE_SET) && !defined(EMU)
#define PROBE_T0(k) if (blockIdx.x == 0 && threadIdx.x == 0) { ((unsigned*)(lds + LDS_MISC))[64 + 2 * (k)] = (unsigned)wall_clock64(); }
#define PROBE_T1(k) if (blockIdx.x == 0 && threadIdx.x == 0) { ((unsigned*)(lds + LDS_MISC))[65 + 2 * (k)] = (unsigned)wall_clock64(); }
#define PROBE_SPLIT(k, vk) { GRID_BAR(); if (blockIdx.x == 0 && threadIdx.x == 0) { unsigned* m_ = (unsigned*)(lds + LDS_MISC); m_[64 + 2 * (vk)] = m_[64 + 2 * (k)]; m_[65 + 2 * (vk)] = (unsigned)wall_clock64(); } }
#else
#define PROBE_T0(k)
#define PROBE_T1(k)
#define PROBE_SPLIT(k, vk)
#endif
#ifndef EMU
#define TID_NOW() (wave_s * 64 + lane_fresh())
#define WAVE_OF(t) __builtin_amdgcn_readfirstlane((t) >> 6)
#else
#define TID_NOW() ((int)threadIdx.x)
#define WAVE_OF(t) ((t) >> 6)
#endif
#ifndef EMU
#define LOAD_P() const __attribute__((address_space(4))) P* pq_ = (const __attribute__((address_space(4))) P*)__builtin_amdgcn_kernarg_segment_ptr(); asm volatile("" : "+s"(pq_)); const P p = *(const P*)pq_;
#else
#define LOAD_P() const P& p = p_in;
#endif
#define PH_BEGIN(k) if (((PH_MASK >> ((k) - pb_)) & 1u) && lo <= (k) && (k) < hi) { LOAD_P() { int t_ = TID_NOW(); OPAQUE_V(t_); w.tid = t_; w.lane = t_ & 63; w.wave = WAVE_OF(t_); w.gw = w.wg * NWAVE + w.wave; } PROBE_T0(k)
#define PH_END(k) if ((k) + 1 < hi) GRID_BAR(); PROBE_T1(k) }
    { const int pb_ = -31; PH_BEGIN(0) phase0(p, w); PH_END(0) }
    for (int l = 0; l < 2; ++l) {
        const int pb = 1 + PH_L * l, pb_ = pb;
        PH_BEGIN(pb + 0) if (l == 0) phase_modulate<2>(p, w, 0, 0, true, false, false, false); else phase_modulate<4>(p, w, 1, 0, false, false, false, true); PH_END(pb + 0)
        PH_BEGIN(pb + 1) {
            pg8::Gemm g{(const bf16*)(p.ws + WS_H), (const bf16*)(p.ws + WS_WIN_T) + (size_t)l * PROJ_W * D_MODEL, D_MODEL, D_MODEL, D_MODEL, 0};
            Sched<0> S; S.o.init(NPAN, PROJ_W / 256, w.G, w.wg, SITE_WGM(0)); S.pm_base = 0; S.seg = nullptr; S.nNc = 0; S.kper = 0;
            EpiStore E{(bf16*)(p.ws + WS_PROJ), PROJ_W, (float*)(p.ws + WS_GATES)};
            { const TabSched T_ = build_units(w.misc, w.tid, S); pg8::gemm_phase<EpiStore, TabSched>(w.lds, w.tid, g, T_, E); } } PH_END(pb + 1)
        PH_BEGIN(pb + 2) phase_prep(p, w, l); PH_END(pb + 2)
        PH_BEGIN(pb + 3) {
            pg8::Gemm g{(const bf16*)(p.ws + WS_PROJ) + C_CQ, (const bf16*)(p.ws + WS_MLA_T) + (size_t)l * 1024 * 512, PROJ_W, 512, 256, 0};
            Sched<6> S; S.o.init(NPAN, 4, w.G, w.wg, SITE_WGM(1)); S.pm_base = 0; S.seg = nullptr; S.nNc = 0; S.kper = 0;
            EpiStore E{(bf16*)(p.ws + WS_MLAQ), 1024, nullptr};
            { const TabSched T_ = build_units(w.misc, w.tid, S); pg8::gemm_phase<EpiStore, TabSched>(w.lds, w.tid, g, T_, E); }
            __syncthreads();
            PROBE_SPLIT(pb + 3, 49 + 3 * l)
#ifndef NO_ML1
            for (int it = w.G - 1 - w.wg; it < BATCH * 4 * NCH; it += w.G) ml1_item(p, w, l, it);
#endif
            } PH_END(pb + 3)
        PH_BEGIN(pb + 4) phase_mla_post(p, w, l); PROBE_SPLIT(pb + 4, 50 + 3 * l) phase_ml2(p, w); PH_END(pb + 4)
        PH_BEGIN(pb + 5) phase_mix(p, w, l); PH_END(pb + 5)
        PH_BEGIN(pb + 6) {
            pg8::Gemm g{(const bf16*)(p.ws + WS_H), (const bf16*)(p.ws + WS_WOUT_T) + (size_t)l * D_MODEL * MIXW, MIXW, MIXW, MIXW, 0};
            Sched<0> S0; Sched<1> S1; S0.o.init(NPAN, D_MODEL / 256, w.G, w.wg, SITE_WGM(2)); S1.o.init(BATCH * NQL, D_MODEL / 256, w.G, w.wg, SITE_WGM(3)); S0.pm_base = 0; S0.seg = nullptr; S0.nNc = 0; S0.kper = 0; S1.pm_base = 0; S1.seg = nullptr; S1.nNc = 0; S1.kper = 0;
            if (l == 0) { EpiResid<true> E{p, l, 2 * D_MODEL}; const TabSched T_ = build_units(w.misc, w.tid, S0); pg8::gemm_phase<EpiResid<true>, TabSched>(w.lds, w.tid, g, T_, E); }
            else { EpiResid<false> E{p, l, 2 * D_MODEL}; const TabSched T_ = build_units(w.misc, w.tid, S1); pg8::gemm_phase<EpiResid<false>, TabSched>(w.lds, w.tid, g, T_, E); } } PH_END(pb + 6)
        if (l == 0) {
            PH_BEGIN(pb + 7) phase_modulate<4>(p, w, 0, 1, false, false, false, false); PH_END(pb + 7)
            PH_BEGIN(pb + 8) {
                pg8::Gemm g{(const bf16*)(p.ws + WS_H), (const bf16*)(p.ws + WS_WGU_T), D_MODEL, D_MODEL, D_MODEL, 0};
                Sched<0> S; S.o.init(NPAN, 2 * D_FF / 256, w.G, w.wg, SITE_WGM(4)); S.pm_base = 0; S.seg = nullptr; S.nNc = 0; S.kper = 0;
                EpiSwiglu E{(bf16*)(p.ws + WS_ACT), 0};
                { const TabSched T_ = build_units(w.misc, w.tid, S); pg8::gemm_phase<EpiSwiglu, TabSched>(w.lds, w.tid, g, T_, E); } } PH_END(pb + 8)
            PH_BEGIN(pb + 9) {
                { pg8::Gemm g{(const bf16*)(p.ws + WS_ACT), (const bf16*)(p.ws + WS_WD_T), D_FF, D_FF, D_FF, 0};
                  Sched<1> S; S.o.init(BATCH * NQL, D_MODEL / 256, w.G, w.wg, SITE_WGM(5)); S.pm_base = 0; S.seg = nullptr; S.nNc = 0; S.kper = 0;
                  EpiResid<false> E{p, 0, 5 * D_MODEL};
                  { const TabSched T_ = build_units(w.misc, w.tid, S); pg8::gemm_phase<EpiResid<false>, TabSched>(w.lds, w.tid, g, T_, E); } }
                __syncthreads();
                { pg8::Gemm g{(const bf16*)(p.ws + WS_ACT), (const bf16*)(p.ws + WS_WD_T), D_FF, D_FF, KSPLIT, 0};
                  Sched<4> S; S.o.init(BATCH, (D_MODEL / 256) * NSPLIT, w.G, w.wg, SITE_WGM(6)); S.pm_base = 0; S.seg = nullptr; S.nNc = D_MODEL / 256; S.kper = KSPLIT;
                  EpiStoreRel E{(bf16*)(p.ws + WS_MLAQ), D_MODEL, 0};
                  { const TabSched T_ = build_units(w.misc, w.tid, S); pg8::gemm_phase<EpiStoreRel, TabSched>(w.lds, w.tid, g, T_, E); } } } PH_END(pb + 9)
        } else {
            PH_BEGIN(pb + 7) phase_modulate<1>(p, w, 1, 1, false, true, true, false); PROBE_SPLIT(pb + 7, 51 + 3 * l) phase_moe_weights(p, w); PH_END(pb + 7)
            PH_BEGIN(pb + 8) phase_gather(p, w); PH_END(pb + 8)
            for (int c = 0; c < MOE_NCH; ++c) {
                PH_BEGIN(pb + 9 + 2 * c) {
                    moe_seg_table(p, w);
                    const int ptot = (int)w.misc[16 + NEXP], pm0 = c * MOE_PCH, np = (ptot - pm0) < MOE_PCH ? (ptot - pm0) : MOE_PCH;
                    if (c > 0 && (w.wg & 1)) phase_moe_combine(p, w, c - 1);
                    if (np > 0) {
                        pg8::Gemm g{(const bf16*)(p.ws + WS_AG), (const bf16*)(p.ws + WS_MOEW), D_MODEL, D_MODEL, D_MODEL, MOEW_E};
                        Sched<2> S; S.o.init(np, 2 * D_FF / 256, w.G, w.wg, SITE_WGM(7)); S.pm_base = pm0; S.seg = (const int*)(w.misc + 16); S.nNc = 0; S.kper = 0;
                        EpiSwiglu E{(bf16*)(p.ws + WS_ACT2), pm0};
                        { const TabSched T_ = build_units(w.misc, w.tid, S); pg8::gemm_phase<EpiSwiglu, TabSched>(w.lds, w.tid, g, T_, E); } }
                    if (c > 0 && !(w.wg & 1)) phase_moe_combine(p, w, c - 1); } PH_END(pb + 9 + 2 * c)
                PH_BEGIN(pb + 10 + 2 * c) {
                    moe_seg_table(p, w);
                    const int ptot = (int)w.misc[16 + NEXP], pm0 = c * MOE_PCH, np = (ptot - pm0) < MOE_PCH ? (ptot - pm0) : MOE_PCH;
                    if (np > 0 && np * NSPLIT > MOE_PCH) {
                        pg8::Gemm g{(const bf16*)(p.ws + WS_ACT2), (const bf16*)(p.ws + WS_MOEW) + (size_t)2 * D_FF * D_MODEL, D_FF, D_FF, D_FF, MOEW_E};
                        Sched<3> S; S.o.init(np, D_MODEL / 256, w.G, w.wg, SITE_WGM(8)); S.pm_base = pm0; S.seg = (const int*)(w.misc + 16); S.nNc = 0; S.kper = 0;
                        EpiStoreRel E{(bf16*)(p.ws + WS_YC), D_MODEL, 0};
                        { const TabSched T_ = build_units(w.misc, w.tid, S); pg8::gemm_phase<EpiStoreRel, TabSched>(w.lds, w.tid, g, T_, E); } }
                    else if (np > 0) {
                        pg8::Gemm g{(const bf16*)(p.ws + WS_ACT2), (const bf16*)(p.ws + WS_MOEW) + (size_t)2 * D_FF * D_MODEL, D_FF, D_FF, KSPLIT, MOEW_E};
                        Sched<5> S; S.o.init(np, (D_MODEL / 256) * NSPLIT, w.G, w.wg, SITE_WGM(9)); S.pm_base = pm0; S.seg = (const int*)(w.misc + 16); S.nNc = D_MODEL / 256; S.kper = KSPLIT;
                        EpiStoreRel E{(bf16*)(p.ws + WS_YC), D_MODEL, 0};
                        { const TabSched T_ = build_units(w.misc, w.tid, S); pg8::gemm_phase<EpiStoreRel, TabSched>(w.lds, w.tid, g, T_, E); } } } PH_END(pb + 10 + 2 * c)
            }
            PH_BEGIN(pb + 9 + 2 * MOE_NCH) moe_seg_table(p, w); phase_moe_final(p, w); PH_END(pb + 9 + 2 * MOE_NCH)
        }
    }
#if defined(PROBE_SET) && !defined(EMU)
    if (blockIdx.x == 0 && threadIdx.x == 0) {
        unsigned tot = 0; for (int k = 0; k < 56; ++k) if ((PROBE_SET >> k) & 1ull) tot += ((unsigned*)(lds + LDS_MISC))[65 + 2 * k] - ((unsigned*)(lds + LDS_MISC))[64 + 2 * k];
        const unsigned long long t0 = wall_clock64(); while (wall_clock64() - t0 < (unsigned long long)tot * PROBE_MUL) __builtin_amdgcn_s_sleep(8);
    }
#endif
}

#ifndef MK_PER_PHASE
#define MK_PER_PHASE 0
#endif
extern "C" void kernel_launch(void* const* d_in, const int* in_sizes, int n_in, void* d_out, int out_size, void* d_ws, size_t ws_size, hipStream_t stream) {
    static int grid = 0;
    if (grid == 0) {
        if (n_in != 28 || in_sizes[0] != BATCH * SEQ * D_MODEL || out_size != BATCH * SEQ * D_MODEL || ws_size < WS_TOTAL) {
            fprintf(stderr, "kernel_launch: unexpected problem (n_in %d, x %d, out %d, ws %zu < %zu)\n", n_in, n_in > 0 ? in_sizes[0] : -1, out_size, ws_size, (size_t)WS_TOTAL); grid = -1; return; }
#ifndef EMU
        int dev = 0, cus = 0;
        if (hipGetDevice(&dev) != hipSuccess || hipDeviceGetAttribute(&cus, hipDeviceAttributeMultiprocessorCount, dev) != hipSuccess) { grid = -1; return; }
        if (hipFuncSetAttribute((const void*)fwd, hipFuncAttributeMaxDynamicSharedMemorySize, LDS_BYTES) != hipSuccess) { fprintf(stderr, "kernel_launch: hipFuncSetAttribute failed\n"); grid = -1; return; }
        int per_cu = 0;
        if (hipOccupancyMaxActiveBlocksPerMultiprocessor(&per_cu, (const void*)fwd, NTHR, LDS_BYTES) != hipSuccess || per_cu < 1) { fprintf(stderr, "kernel_launch: occupancy query says %d\n", per_cu); (void)hipGetLastError(); }
        grid = cus;
#else
        grid = 8;
#endif
    }
    if (grid < 0) return;
    (void)hipMemsetAsync((char*)d_ws + WS_CTL, 0, CTL_BYTES, stream);
    P p{};
    const float** pp = (const float**)&p;
    for (int i = 0; i < 28; ++i) pp[i] = (const float*)d_in[i];
    p.out = (float*)d_out; p.ws = (unsigned char*)d_ws;
#if MK_PER_PHASE
    for (int k = 0; k < N_PHASES; ++k) {
        if (k >= 1 + 10 && k < 1 + PH_L) continue;
        if (k >= 1 + PH_L + 10 + 2 * MOE_NCH) continue;
        p.ph_lo = k; p.ph_hi = k + 1;
        hipLaunchKernelGGL(fwd, dim3(grid), dim3(NTHR), LDS_BYTES, stream, p);
    }
#else
    p.ph_lo = 0; p.ph_hi = N_PHASES;
    hipLaunchKernelGGL(fwd, dim3(grid), dim3(NTHR), LDS_BYTES, stream, p);
#endif
}
```

```cpp
#ifndef EMU
#include <hip/hip_runtime.h>
#endif
#include <cstdio>
#include <cstdint>
#include <cmath>

#ifdef CFG_TINY
constexpr int D_MODEL = 256, BATCH = 2, SEQ = 512, CTX = 256, GRID_W = 16, D_FF = 512;
constexpr int MOE_PCH = 4, NSPLIT = 2;
#else
constexpr int D_MODEL = 1024, BATCH = 8, SEQ = 4096, CTX = 256, GRID_W = 64, D_FF = 3584;
constexpr int MOE_PCH = 64, NSPLIT = 7;
#endif
constexpr int TP = CTX + SEQ, M_ALL = BATCH * TP, NPAN = M_ALL / 256, PAN_B = TP / 256, NQL = SEQ / 256;
constexpr int MCH = 128;
constexpr int NCH = TP / MCH, NC_CTX = CTX / MCH, NQB = MCH / 32;
constexpr int PROJ_W = 2816, MIXW = 1024, NEXP = 8;
constexpr int C_MQ = 0, C_MK = 384, C_MV = 768, C_MO = 1152, C_G = 1536, C_AQ = 1552, C_AK = 1936, C_AV = 2064, C_CQ = 2192, C_CKV = 2448, C_KR = 2576, IN_W = 2608;
constexpr int NV = BATCH + 1;
constexpr int NCHAIN = BATCH * 4 * 2, NITEM = NCHAIN * NCH;
constexpr int NTOK = BATCH * SEQ, NSLOTP = NTOK * 2 + NEXP * 256;
constexpr int MOE_NCH = (NSLOTP / 256 + MOE_PCH - 1) / MOE_PCH;
constexpr float EPS = 1e-6f, LOG2E = 1.4426950408889634f;
constexpr float QSCALE_A = 0.125f * LOG2E, QSCALE_L = 0.10206207261596575f * LOG2E, KSCALE_M = 0.10206207261596575f;
constexpr int NTHR = 512, NWAVE = 8;
constexpr int KSPLIT = D_FF / NSPLIT;
static_assert(KSPLIT % 128 == 0 && KSPLIT >= 256 && NSPLIT * BATCH * 256 * D_MODEL * 2 <= M_ALL * 1024 * 2, "split-K geometry");
constexpr int NPOS = (SEQ / GRID_W > GRID_W) ? SEQ / GRID_W : GRID_W;

typedef unsigned short bf16;
#ifndef EMU
typedef short bf16x8 __attribute__((ext_vector_type(8)));
typedef short s16x4 __attribute__((ext_vector_type(4)));
typedef float f32x4 __attribute__((ext_vector_type(4)));
typedef float f32x2 __attribute__((ext_vector_type(2)));
typedef float f32x16 __attribute__((ext_vector_type(16)));
typedef unsigned u32x4 __attribute__((ext_vector_type(4)));
typedef unsigned u32x2 __attribute__((ext_vector_type(2)));
#define DEV __device__ __forceinline__
DEV f32x16 mfma32(bf16x8 a, bf16x8 b, f32x16 c) { return __builtin_amdgcn_mfma_f32_32x32x16_bf16(a, b, c, 0, 0, 0); }
DEV void wave_sync() { asm volatile("s_waitcnt vmcnt(0) lgkmcnt(0)" ::: "memory"); __builtin_amdgcn_wave_barrier(); }
typedef __bf16 bf16x2_hw __attribute__((ext_vector_type(2)));
typedef short v4i16_t __attribute__((ext_vector_type(4)));
DEV unsigned pk2_hw(float lo, float hi) { f32x2 v = {lo, hi}; bf16x2_hw b = __builtin_convertvector(v, bf16x2_hw); return __builtin_bit_cast(unsigned, b); }
DEV s16x4 lds_tr_read(const unsigned short* a) { return __builtin_bit_cast(s16x4, __builtin_amdgcn_ds_read_tr16_b64_v4i16((__attribute__((address_space(3))) v4i16_t*)(a))); }
DEV float exp2_fast(float x) { return __builtin_amdgcn_exp2f(x); }
DEV float rcp_fast(float x) { return __builtin_amdgcn_rcpf(x); }
DEV float rsqrt_fast(float x) { return __builtin_amdgcn_rsqf(x); }
DEV void atomic_addf(float* p, float v) { unsafeAtomicAdd(p, v); }
#define OPAQUE_V(x) asm volatile("" : "+v"(x))
#define SCHED_FENCE() __builtin_amdgcn_sched_barrier(0)
#define UNIFORM_I(x) __builtin_amdgcn_readfirstlane(x)
DEV unsigned fau(float f) { return __float_as_uint(f); }
DEV float uaf(unsigned u) { return __uint_as_float(u); }
DEV float my_shfl_xor(float v, int m, int lane) { return __int_as_float(__builtin_amdgcn_ds_bpermute((lane ^ m) << 2, __float_as_int(v))); }
#define SHX(v, m, lane) my_shfl_xor((v), (m), (lane))
DEV float my_shfl(float v, int src) { return __int_as_float(__builtin_amdgcn_ds_bpermute((src & 63) << 2, __float_as_int(v))); }
DEV int my_shfl(int v, int src) { return __builtin_amdgcn_ds_bpermute((src & 63) << 2, v); }
#define __shfl my_shfl
DEV int lane_fresh() { int l_; asm volatile("v_mbcnt_lo_u32_b32 %0, -1, 0\n\tv_mbcnt_hi_u32_b32 %0, -1, %0" : "=v"(l_)); return l_; }
#else
#define DEV inline
#define OPAQUE_V(x) do {} while (0)
#define SCHED_FENCE() do {} while (0)
#define UNIFORM_I(x) (x)
#define SHX(v, m, lane) __shfl_xor((v), (m))
DEV void wave_sync() { (void)emu_shfl_u(0u, emu::B->cur & 63); }
DEV void atomic_addf(float* p, float v) { atomicAdd(p, v); }
DEV float rsqrt_fast(float x) { return 1.0f / sqrtf(x); }
DEV unsigned fau(float f) { unsigned u; memcpy(&u, &f, 4); return u; }
DEV float uaf(unsigned u) { float f; memcpy(&f, &u, 4); return f; }
#endif
DEV bf16 f2bf(float f) { unsigned u = fau(f); u += 0x7fffu + ((u >> 16) & 1u); return (bf16)(u >> 16); }
DEV float bf2f(bf16 h) { return uaf(((unsigned)h) << 16); }
#ifndef EMU
DEV unsigned pk2(float lo, float hi) { return pk2_hw(lo, hi); }
#else
DEV unsigned pk2(float lo, float hi) { return (unsigned)f2bf(lo) | ((unsigned)f2bf(hi) << 16); }
#endif
DEV float wave_sum(float v, int lane) {
#pragma unroll
    for (int o = 1; o < 64; o <<= 1) v += SHX(v, o, lane);
    return v;
}
DEV float wave_max(float v, int lane) {
#pragma unroll
    for (int o = 1; o < 64; o <<= 1) v = fmaxf(v, SHX(v, o, lane));
    return v;
}
DEV float silu_f(float x) { return x / (1.0f + __expf(-x)); }
DEV float silu_fast(float x) { return x * rcp_fast(1.0f + exp2_fast(-x * LOG2E)); }
DEV float sigmoid_f(float x) { return rcp_fast(1.0f + exp2_fast(-x * LOG2E)); }
DEV float log_sigmoid_f(float x) { return x >= 0.f ? -log1pf(expf(-x)) : x - log1pf(expf(x)); }
DEV int crow(int i, int h) { return (i & 3) + 8 * (i >> 2) + 4 * h; }

constexpr size_t al256(size_t x) { return (x + 255) & ~(size_t)255; }
constexpr size_t WS_CTL = 0, CTL_BYTES = 65536;
constexpr int CW_Q = 0;
constexpr int CW_BAR = 4096;
constexpr size_t WS_MODV = WS_CTL + CTL_BYTES;
constexpr size_t WS_WIN_T = al256(WS_MODV + (size_t)2 * NV * 6 * D_MODEL * 4);
constexpr size_t WS_WOUT_T = al256(WS_WIN_T + (size_t)2 * PROJ_W * D_MODEL * 2);
constexpr size_t WS_MLA_T = al256(WS_WOUT_T + (size_t)2 * D_MODEL * MIXW * 2);
constexpr size_t WS_WGU_T = al256(WS_MLA_T + (size_t)2 * 1024 * 512 * 2);
constexpr size_t WS_WD_T = al256(WS_WGU_T + (size_t)2 * D_FF * D_MODEL * 2);
constexpr size_t WS_CX = al256(WS_WD_T + (size_t)D_MODEL * D_FF * 2);
constexpr size_t WS_GATES = al256(WS_CX + (size_t)BATCH * CTX * D_MODEL * 4);
constexpr size_t WS_NL = al256(WS_GATES + (size_t)M_ALL * 16 * 4);
constexpr size_t WS_FS = al256(WS_NL + (size_t)NITEM * 96 * 4);
constexpr size_t WS_PML = al256(WS_FS + (size_t)NITEM * 4);
constexpr size_t WS_MST = al256(WS_PML + (size_t)NITEM * 4);
constexpr size_t WS_TOPI = al256(WS_MST + (size_t)NITEM * 4);
constexpr size_t WS_TOPW = al256(WS_TOPI + (size_t)NTOK * 2 * 4);
constexpr size_t WS_CNTG = al256(WS_TOPW + (size_t)NTOK * 2 * 4);
constexpr size_t WS_STOK = al256(WS_CNTG + (size_t)1024 * 8 * 4);
constexpr size_t WS_SW = al256(WS_STOK + (size_t)NSLOTP * 4);
constexpr size_t WS_TSL = al256(WS_SW + (size_t)NSLOTP * 4);
constexpr size_t WS_ROPE = al256(WS_TSL + (size_t)NTOK * 2 * 4);
constexpr size_t WS_PROJ = al256(WS_ROPE + (size_t)NPOS * 24 * 2 * 4);
constexpr size_t WS_MQK = al256(WS_PROJ + (size_t)M_ALL * PROJ_W * 2);
constexpr size_t WS_MLAQ = al256(WS_MQK + (size_t)M_ALL * 768 * 2);
constexpr size_t WS_UC = al256(WS_MLAQ + (size_t)M_ALL * 1024 * 2);
constexpr size_t WS_H = al256(WS_UC + (size_t)NITEM * 9216 * 2);
constexpr size_t WS_END0 = al256(WS_H + (size_t)M_ALL * 1024 * 2);
constexpr size_t WS_ACT = WS_PROJ;
constexpr size_t WS_MOEW = WS_PROJ;
constexpr size_t MOEW_E = (size_t)3 * D_FF * D_MODEL * 2;
constexpr size_t WS_AG = al256(WS_MOEW + NEXP * MOEW_E);
constexpr size_t WS_ACT2 = al256(WS_AG + (size_t)NSLOTP * D_MODEL * 2);
constexpr size_t WS_YC = al256(WS_ACT2 + (size_t)MOE_PCH * 256 * D_FF * 2);
#ifdef CFG_TINY
constexpr size_t WS_TOTAL = WS_END0 + (4u << 20);
#else
constexpr size_t WS_TOTAL = (size_t)512 << 20;
#endif
static_assert(WS_END0 <= WS_TOTAL, "ws map");
constexpr int ML2_U = (NCH % 17 == 0) ? 17 : ((NCH % 4 == 0) ? 4 : 2);
static_assert(NCH % ML2_U == 0, "ML2 unroll");
static_assert(WS_ACT + (size_t)M_ALL * D_FF * 2 <= WS_MLAQ, "dense ACT overlays PROJ+MQK only");
static_assert(WS_MOEW + NEXP * MOEW_E <= WS_MQK, "MoE weights overlay PROJ only");
static_assert(WS_YC + (size_t)MOE_PCH * 256 * D_MODEL * 2 <= WS_TOTAL, "MoE chunk buffers");

constexpr int LDS_STAGE = 131072;
constexpr int LDS_MISC = LDS_STAGE;
constexpr int LDS_BYTES = LDS_STAGE + 4096;

struct P {
    const float *x, *c, *ctx, *c_ctx, *mod_w, *mod_b, *norm_mix, *norm_ffn, *w_in, *m_conv, *m_gate_b, *m_norm, *a_qnorm, *a_knorm, *l_cq_norm, *l_ckv_norm,
        *l_wuq, *l_wukv, *l_qnorm, *l_knorm, *w_out, *ffn_wg, *ffn_wu, *ffn_wd, *moe_router, *moe_wg, *moe_wu, *moe_wd;
    float* out; unsigned char* ws; int ph_lo, ph_hi;
};
constexpr int RPITCH = 2 * D_MODEL;
DEV bf16* resid_row(const P& p, int R) {
    const int b = R / TP, q = R % TP;
    return q < CTX ? (bf16*)(p.ws + WS_CX) + (size_t)(b * CTX + q) * RPITCH : (bf16*)(p.out + (size_t)(b * SEQ + q - CTX) * D_MODEL);
}
DEV const float* modv(const P& p, int l, int R) { const int b = R / TP, q = R % TP; return (const float*)(p.ws + WS_MODV) + (size_t)(l * NV + (q < CTX ? BATCH : b)) * 6 * D_MODEL; }

namespace pg8 {
constexpr int BM = 256, BK = 64, HALF = 128, HTB = HALF * BK * 2, STAGE_BYTES = 8 * HTB, NXCD = 8, WGM = 8;
struct Unit { int pm, pn, e, k0, po; };
struct Gemm { const bf16* A; const bf16* Bt; int lda, ldb, K; size_t bstride; };
DEV int lds_byte(int r, int c) { const int st = (r >> 4) * 2 + (c >> 5), rr = r & 15, cc = c & 31, ob = rr * 64 + cc * 2; return st * 1024 + (ob ^ (((ob >> 9) & 1) << 5)); }
DEV void stage_rc(int b, int& R, int& C) { const int st = b / 1024, sb = b % 1024, swz = sb ^ (((sb >> 9) & 1) << 5); R = (st >> 1) * 16 + swz / 64; C = (st & 1) * 32 + (swz % 64) / 2; }
DEV int perm32(int rho) { const int n = rho >> 4, i = rho & 15; return 8 * (i >> 2) + 4 * n + (i & 3); }
struct Order {
    int nM, nN, nwg, G, c, wgm;
    DEV void init(int nM_, int nN_, int G_, int c_, int wgm_ = WGM) { nM = nM_; nN = nN_; nwg = nM * nN; G = G_; c = c_; wgm = wgm_; }
    DEV bool nextL(int i, int& lm, int& ln) const {
        const long L = (long)i * G + c; if (L >= nwg) return false;
        int wgid = (int)L; { const int q = nwg / NXCD, r = nwg % NXCD, xcd = wgid % NXCD, off = wgid / NXCD; wgid = (xcd < r ? xcd * (q + 1) : r * (q + 1) + (xcd - r) * q) + off; }
        const int nig = wgm * nN, gid = wgid / nig, fm = gid * wgm, gsz = (nM - fm) < wgm ? (nM - fm) : wgm;
        lm = fm + ((wgid % nig) % gsz); ln = (wgid % nig) / gsz; return true;
    }
};
#ifndef EMU
#define PG8_LAS __attribute__((address_space(3)))
DEV unsigned cvt_pk_bf16(float lo, float hi) { unsigned r; asm volatile("v_cvt_pk_bf16_f32 %0, %1, %2" : "=v"(r) : "v"(lo), "v"(hi)); return r; }
template <class Epi, class Sched>
DEV void gemm_phase(unsigned char* lds_, const int tid, const Gemm g, const Sched& S, const Epi& E) {
    PG8_LAS unsigned char* lds = (PG8_LAS unsigned char*)lds_;
    const int wid = __builtin_amdgcn_readfirstlane(tid >> 6), lane = tid & 63, wr = wid >> 2, wc = wid & 3, fr = lane & 15, fq = lane >> 4;
    const int K = g.K, nt = K / BK, lda = g.lda, ldb = g.ldb;
    unsigned voffA[2], voffB[2];
#pragma unroll
    for (int i = 0; i < 2; ++i) { int R, C; stage_rc(tid * 16 + i * 8192, R, C); const int Rb = Epi::PERM ? ((R & ~31) + perm32(R & 31)) : R;
        voffA[i] = (unsigned)(R * lda + C) * 2u; voffB[i] = (unsigned)(Rb * ldb + C) * 2u; }
    const size_t kstep = (size_t)(BK * 2);
    const size_t hstepA = (size_t)HALF * lda * 2, hstepB = (size_t)HALF * ldb * 2;
    const size_t tstepA = 2 * hstepA, tstepB = 2 * hstepB;
    const unsigned ldsw = (unsigned)wid * 1024u;
    const int aoff = lds_byte(wr * 64 + fr, fq * 8), boff = lds_byte(wc * 32 + fr, fq * 8);
#define PG8_SA(b, h) (((b) * 2 + (h)) * HTB)
#define PG8_SB(b, h) ((4 + (b) * 2 + (h)) * HTB)
#define PG8_STAGE(bufoff, gbase, voff) do { _Pragma("unroll") for (int _i = 0; _i < 2; ++_i) \
        __builtin_amdgcn_global_load_lds((const unsigned*)((const char*)(gbase) + (voff)[_i]), (PG8_LAS unsigned*)(lds + (bufoff) + ldsw + _i * 8192), 16, 0, 0); } while (0)
#define PG8_LDA(dst, b, h) do { _Pragma("unroll") for (int m = 0; m < 4; ++m) _Pragma("unroll") for (int k = 0; k < 2; ++k) dst[m][k] = *(const PG8_LAS bf16x8*)(lds + PG8_SA(b, h) + aoff + m * 2048 + k * 1024); } while (0)
#define PG8_LDB(dst, b, h) do { _Pragma("unroll") for (int n = 0; n < 2; ++n) _Pragma("unroll") for (int k = 0; k < 2; ++k) dst[n][k] = *(const PG8_LAS bf16x8*)(lds + PG8_SB(b, h) + boff + n * 2048 + k * 1024); } while (0)
#define PG8_MMA(ai, bj, At, Bt) do { __builtin_amdgcn_s_setprio(1); _Pragma("unroll") for (int m = 0; m < 4; ++m) _Pragma("unroll") for (int n = 0; n < 2; ++n) _Pragma("unroll") for (int k = 0; k < 2; ++k) \
        acc[ai][bj][m][n] = __builtin_amdgcn_mfma_f32_16x16x32_bf16(Bt[n][k], At[m][k], acc[ai][bj][m][n], 0, 0, 0); __builtin_amdgcn_s_setprio(0); } while (0)
#define PG8_WAIT_V(n) asm volatile("s_waitcnt vmcnt(" #n ")" ::: "memory")
#define PG8_WAIT_L(n) asm volatile("s_waitcnt lgkmcnt(" #n ")" ::: "memory")
#define PG8_BAR __builtin_amdgcn_s_barrier()
#define PG8_SCHED __builtin_amdgcn_sched_barrier(0)
    Unit cur, nxt; int ui = 0;
    if (!S.next(0, cur)) return;
    f32x4 acc[2][2][4][2];
#pragma unroll
    for (int a = 0; a < 2; ++a)
#pragma unroll
        for (int b = 0; b < 2; ++b)
#pragma unroll
            for (int m = 0; m < 4; ++m)
#pragma unroll
                for (int n = 0; n < 2; ++n) acc[a][b][m][n] = (f32x4){0.f, 0.f, 0.f, 0.f};
    bf16x8 At[4][2], B0[2][2], B1[2][2];
    const char* cA = (const char*)g.A + (size_t)cur.pm * tstepA + (size_t)cur.k0 * 2; const char* cB = (const char*)g.Bt + (size_t)cur.e * g.bstride + (size_t)cur.pn * tstepB + (size_t)cur.k0 * 2;
    PG8_STAGE(PG8_SB(0, 0), cB, voffB); PG8_STAGE(PG8_SB(0, 1), cB + hstepB, voffB); PG8_STAGE(PG8_SA(0, 0), cA, voffA); PG8_STAGE(PG8_SA(0, 1), cA + hstepA, voffA);
    if (wr == 1) PG8_BAR;
    PG8_WAIT_V(2); PG8_BAR;
    PG8_STAGE(PG8_SB(1, 0), cB + kstep, voffB); PG8_STAGE(PG8_SA(1, 0), cA + kstep, voffA); PG8_STAGE(PG8_SB(1, 1), cB + hstepB + kstep, voffB);
    PG8_WAIT_V(6); PG8_BAR;
    for (;;) {
        const bool has_next = S.next(ui + 1, nxt);
        const char* nA = has_next ? (const char*)g.A + (size_t)nxt.pm * tstepA + (size_t)nxt.k0 * 2 : cA; const char* nB = has_next ? (const char*)g.Bt + (size_t)nxt.e * g.bstride + (size_t)nxt.pn * tstepB + (size_t)nxt.k0 * 2 : cB;
#pragma unroll 1
        for (int t = 0; t < nt; t += 2) {
            const bool last = (t == nt - 2);
            const char* a1 = cA + (size_t)(t + 1) * kstep;
            const char* a2 = last ? nA : cA + (size_t)(t + 2) * kstep; const char* b2 = last ? nB : cB + (size_t)(t + 2) * kstep;
            const char* a3 = a2 + kstep; const char* b3 = b2 + kstep;
            PG8_LDB(B0, 0, 0); PG8_LDB(B1, 0, 1); PG8_SCHED; PG8_LDA(At, 0, 0); PG8_STAGE(PG8_SA(1, 1), a1 + hstepA, voffA);
            PG8_WAIT_V(8); PG8_WAIT_L(0); PG8_BAR; PG8_MMA(0, 0, At, B0); PG8_MMA(0, 1, At, B1); PG8_BAR; PG8_SCHED;
            PG8_LDA(At, 0, 1); PG8_STAGE(PG8_SB(0, 0), b2, voffB); PG8_STAGE(PG8_SB(0, 1), b2 + hstepB, voffB); PG8_STAGE(PG8_SA(0, 0), a2, voffA);
            PG8_WAIT_V(8); PG8_WAIT_L(0); PG8_BAR; PG8_MMA(1, 0, At, B0); PG8_MMA(1, 1, At, B1); PG8_BAR; PG8_SCHED;
            PG8_LDB(B0, 1, 0); PG8_LDB(B1, 1, 1); PG8_SCHED; PG8_LDA(At, 1, 0); PG8_STAGE(PG8_SA(0, 1), a2 + hstepA, voffA);
            PG8_WAIT_V(8); PG8_WAIT_L(0); PG8_BAR; PG8_MMA(0, 0, At, B0); PG8_MMA(0, 1, At, B1); PG8_BAR; PG8_SCHED;
            PG8_LDA(At, 1, 1); PG8_STAGE(PG8_SB(1, 0), b3, voffB); PG8_STAGE(PG8_SB(1, 1), b3 + hstepB, voffB); PG8_STAGE(PG8_SA(1, 0), a3, voffA);
            PG8_WAIT_V(8); PG8_WAIT_L(0); PG8_BAR; PG8_MMA(1, 0, At, B0); PG8_MMA(1, 1, At, B1); PG8_BAR; PG8_SCHED;
        }
        if (wr == 0) PG8_BAR;
        E(acc, cur, wr, wc, fr, fq);
        if (!has_next) break;
#pragma unroll
        for (int a = 0; a < 2; ++a)
#pragma unroll
            for (int b = 0; b < 2; ++b)
#pragma unroll
                for (int m = 0; m < 4; ++m)
#pragma unroll
                    for (int n = 0; n < 2; ++n) acc[a][b][m][n] = (f32x4){0.f, 0.f, 0.f, 0.f};
        cur = nxt; cA = nA; cB = nB; ++ui;
        if (wr == 1) PG8_BAR;
    }
    PG8_WAIT_V(0);
    PG8_BAR;
#undef PG8_SA
#undef PG8_SB
#undef PG8_STAGE
#undef PG8_LDA
#undef PG8_LDB
#undef PG8_MMA
#undef PG8_WAIT_V
#undef PG8_WAIT_L
#undef PG8_BAR
#undef PG8_SCHED
}
#else
DEV unsigned cvt_pk_bf16(float lo, float hi) { return pk2(lo, hi); }
template <class Epi, class Sched>
DEV void gemm_phase(unsigned char*, const int tid, const Gemm g, const Sched& S, const Epi& E) {
    const int wid = tid >> 6, lane = tid & 63, wr = wid >> 2, wc = wid & 3, fr = lane & 15, fq = lane >> 4;
    Unit u;
    for (int ui = 0; S.next(ui, u); ++ui) {
        f32x4 acc[2][2][4][2];
        const bf16* Bt = (const bf16*)((const char*)g.Bt + (size_t)u.e * g.bstride);
        for (int ai = 0; ai < 2; ++ai) for (int bj = 0; bj < 2; ++bj) for (int m = 0; m < 4; ++m) for (int n = 0; n < 2; ++n) for (int j = 0; j < 4; ++j) {
            const size_t row = (size_t)u.pm * 256 + 128 * ai + 64 * wr + 16 * m + fr;
            const size_t col = (size_t)u.pn * 256 + 128 * bj + 32 * wc + (Epi::PERM ? 8 * fq + 4 * n + j : 16 * n + 4 * fq + j);
            const bf16* a = g.A + row * g.lda + u.k0; const bf16* b = Bt + col * g.ldb + u.k0; float s = 0.f;
            for (int k = 0; k < g.K; ++k) s += bf2f(a[k]) * bf2f(b[k]);
            acc[ai][bj][m][n][j] = s; }
        E(acc, u, wr, wc, fr, fq);
    }
}
#endif
}

using pg8::Unit;
struct EpiStore {
    static constexpr bool PERM = true;
    bf16* O; int ldc; float* gates;
    DEV void operator()(const f32x4 (&acc)[2][2][4][2], const Unit& u, int wr, int wc, int fr, int fq) const {
        const int row0 = u.pm * 256 + wr * 64 + fr, col0 = u.pn * 256 + wc * 32 + 8 * fq;
        const bool dog = gates != nullptr && u.pn == C_G / 256 && wc == 0 && fq < 2;
#pragma unroll
        for (int ai = 0; ai < 2; ++ai)
#pragma unroll
            for (int m = 0; m < 4; ++m) { const int row = row0 + ai * 128 + m * 16; bf16* rowp = O + (size_t)row * ldc + col0;
#pragma unroll
                for (int bj = 0; bj < 2; ++bj) { const f32x4 v0 = acc[ai][bj][m][0], v1 = acc[ai][bj][m][1];
                    u32x4 w; w.x = pg8::cvt_pk_bf16(v0[0], v0[1]); w.y = pg8::cvt_pk_bf16(v0[2], v0[3]); w.z = pg8::cvt_pk_bf16(v1[0], v1[1]); w.w = pg8::cvt_pk_bf16(v1[2], v1[3]);
                    *(u32x4*)(rowp + bj * 128) = w;
                    if (bj == 0 && dog) { float* gp = gates + (size_t)row * 16 + 8 * fq; *(f32x4*)gp = v0; *(f32x4*)(gp + 4) = v1; } } }
    }
};
template <bool from_input> struct EpiResid {
    static constexpr bool PERM = true;
    P p; int l, goff;
    DEV void operator()(const f32x4 (&acc)[2][2][4][2], const Unit& u, int wr, int wc, int fr, int fq) const {
        const int R0 = u.pm * 256, bb = R0 / TP, q0 = R0 % TP; const bool isctx = q0 < CTX;
        bf16* xb = resid_row(p, R0); constexpr size_t rs = RPITCH;
        const float* xin = isctx ? p.ctx + (size_t)(bb * CTX + q0) * D_MODEL : p.x + (size_t)(bb * SEQ + q0 - CTX) * D_MODEL;
        const float* gv = modv(p, l, R0) + goff;
        const int col0 = u.pn * 256 + wc * 32 + 8 * fq;
        constexpr int MB = from_input ? 2 : 4;
#pragma unroll
        for (int bj = 0; bj < 2; ++bj) { const int col = col0 + bj * 128; const f32x4 g0 = *(const f32x4*)(gv + col), g1 = *(const f32x4*)(gv + col + 4);
#pragma unroll
            for (int ai = 0; ai < 2; ++ai)
#pragma unroll
                for (int mb = 0; mb < 4; mb += MB) { f32x4 a0[MB], a1[MB];
#pragma unroll
                    for (int mm = 0; mm < MB; ++mm) { const size_t rl = (size_t)(wr * 64 + fr + ai * 128 + (mb + mm) * 16);
                        if (from_input) { a0[mm] = *(const f32x4*)(xin + rl * D_MODEL + col); a1[mm] = *(const f32x4*)(xin + rl * D_MODEL + col + 4); }
                        else { const u32x4 t = *(const u32x4*)(xb + rl * rs + col);
                            a0[mm] = (f32x4){bf2f((bf16)t.x), bf2f((bf16)(t.x >> 16)), bf2f((bf16)t.y), bf2f((bf16)(t.y >> 16))}; a1[mm] = (f32x4){bf2f((bf16)t.z), bf2f((bf16)(t.z >> 16)), bf2f((bf16)t.w), bf2f((bf16)(t.w >> 16))}; } }
#pragma unroll
                    for (int mm = 0; mm < MB; ++mm) { const size_t rl = (size_t)(wr * 64 + fr + ai * 128 + (mb + mm) * 16);
                        const f32x4 o0 = a0[mm] + g0 * acc[ai][bj][mb + mm][0], o1 = a1[mm] + g1 * acc[ai][bj][mb + mm][1];
                        u32x4 wv; wv.x = pg8::cvt_pk_bf16(o0[0], o0[1]); wv.y = pg8::cvt_pk_bf16(o0[2], o0[3]); wv.z = pg8::cvt_pk_bf16(o1[0], o1[1]); wv.w = pg8::cvt_pk_bf16(o1[2], o1[3]);
                        *(u32x4*)(xb + rl * rs + col) = wv; } } }
    }
};
struct EpiSwiglu {
    static constexpr bool PERM = true;
    bf16* O; int pm_base;
    DEV void operator()(const f32x4 (&acc)[2][2][4][2], const Unit& u, int wr, int wc, int fr, int fq) const {
        const int row0 = u.po * 256 + wr * 64 + fr, col0 = u.pn * 128 + wc * 32 + 8 * fq;
#pragma unroll
        for (int ai = 0; ai < 2; ++ai)
#pragma unroll
            for (int m = 0; m < 4; ++m) { float r[8];
#pragma unroll
                for (int n = 0; n < 2; ++n)
#pragma unroll
                    for (int j = 0; j < 4; ++j) r[4 * n + j] = silu_fast(acc[ai][0][m][n][j]) * acc[ai][1][m][n][j];
                u32x4 w; w.x = pg8::cvt_pk_bf16(r[0], r[1]); w.y = pg8::cvt_pk_bf16(r[2], r[3]); w.z = pg8::cvt_pk_bf16(r[4], r[5]); w.w = pg8::cvt_pk_bf16(r[6], r[7]);
                *(u32x4*)(O + (size_t)(row0 + ai * 128 + m * 16) * D_FF + col0) = w; }
    }
};
struct EpiStoreRel {
    static constexpr bool PERM = true;
    bf16* O; int ldc, pm_base;
    DEV void operator()(const f32x4 (&acc)[2][2][4][2], const Unit& u, int wr, int wc, int fr, int fq) const {
        const int row0 = u.po * 256 + wr * 64 + fr, col0 = u.pn * 256 + wc * 32 + 8 * fq;
#pragma unroll
        for (int ai = 0; ai < 2; ++ai)
#pragma unroll
            for (int m = 0; m < 4; ++m) { bf16* rowp = O + (size_t)(row0 + ai * 128 + m * 16) * ldc + col0;
#pragma unroll
                for (int bj = 0; bj < 2; ++bj) { const f32x4 v0 = acc[ai][bj][m][0], v1 = acc[ai][bj][m][1];
                    u32x4 w; w.x = pg8::cvt_pk_bf16(v0[0], v0[1]); w.y = pg8::cvt_pk_bf16(v0[2], v0[3]); w.z = pg8::cvt_pk_bf16(v1[0], v1[1]); w.w = pg8::cvt_pk_bf16(v1[2], v1[3]);
                    *(u32x4*)(rowp + bj * 128) = w; } }
    }
};
template <int mode> struct Sched {
    pg8::Order o; int pm_base; const int* seg; int nNc, kper;
    DEV bool next(int i, Unit& u) const {
        int lm, ln; if (!o.nextL(i, lm, ln)) return false;
        u.pn = ln; u.e = 0; u.k0 = 0; u.po = lm;
        if (mode == 0) u.pm = lm;
        else if (mode == 1) u.pm = (lm / NQL) * PAN_B + 1 + lm % NQL;
        else if (mode == 6) { u.pm = lm; u.k0 = (ln >= 2) ? 256 : 0; }
        else if (mode == 4) { u.pm = lm * PAN_B; u.pn = ln % nNc; u.k0 = (ln / nNc) * kper; u.po = (ln / nNc) * o.nM + lm; }
        else { const int gp = pm_base + lm; int e = 0;
#pragma unroll
            for (int k = 1; k < NEXP; ++k) e += (seg[k] <= gp) ? 1 : 0;
            u.e = e; u.pm = (mode == 2) ? gp : lm;
            if (mode == 5) { u.pn = ln % nNc; u.k0 = (ln / nNc) * kper; u.po = (ln / nNc) * o.nM + lm; } }
        return true;
    }
};

#ifndef WGM_MASK
#define WGM_MASK 0x01f
#endif
#define SITE_WGM(k) (((WGM_MASK >> (k)) & 1) ? 4 : 8)
struct TabSched {
    const int* tab; int n;
    DEV bool next(int i, Unit& u) const {
        if (i >= n) return false;
        u.pm = UNIFORM_I(tab[5 * i]); u.pn = UNIFORM_I(tab[5 * i + 1]); u.e = UNIFORM_I(tab[5 * i + 2]); u.k0 = UNIFORM_I(tab[5 * i + 3]); u.po = UNIFORM_I(tab[5 * i + 4]);
        return true;
    }
};
constexpr int MAX_UNITS = 150;
template <class S> DEV TabSched build_units(unsigned* misc, int tid, const S& sch) {
    int* tab = (int*)(misc + 256);
    __syncthreads();
    if (tid < MAX_UNITS) { Unit u; if (sch.next(tid, u)) { tab[5 * tid] = u.pm; tab[5 * tid + 1] = u.pn; tab[5 * tid + 2] = u.e; tab[5 * tid + 3] = u.k0; tab[5 * tid + 4] = u.po; } }
    __syncthreads();
    const int nwg = sch.o.nwg, c = sch.o.c, G = sch.o.G;
    TabSched t; t.tab = tab; t.n = (c < nwg) ? (nwg - c + G - 1) / G : 0;
    return t;
}

#ifndef EMU
#define XB_TMO      128
#define XB_XCNT(j)  (256  + 64 * (j))
#define XB_XSUB(j)  (1280 + 64 * (j))
#define XB_XGEN(j)  (2304 + 64 * (j))
#define XB_TOP      3328
#define XB_TOPGEN   3392
#define XCD_BAR_WORDS 3456
#define XB_SPIN_CAP (1u << 22)
#define LAS __attribute__((address_space(3)))
__device__ __forceinline__ unsigned xb_ld(unsigned* p)              { return __hip_atomic_load(p, __ATOMIC_RELAXED, __HIP_MEMORY_SCOPE_AGENT); }
__device__ __forceinline__ unsigned xb_add(unsigned* p, unsigned v) { return __hip_atomic_fetch_add(p, v, __ATOMIC_RELAXED, __HIP_MEMORY_SCOPE_AGENT); }
__device__ __forceinline__ unsigned xb_xcc_id() { return (unsigned)__builtin_amdgcn_s_getreg((3 << 11) | 20) & 0xFu; }
#define XB_SPIN(cond, bar) do { unsigned _sp = 0; while (cond) { __builtin_amdgcn_s_sleep(1); \
    if ((++_sp & 255u) == 0u) { if (xb_ld(&(bar)[XB_TMO])) break; if (_sp > XB_SPIN_CAP) { atomicAdd(&(bar)[XB_TMO], 1u); break; } } } } while (0)
struct XcdBarrier { unsigned* bar; unsigned x; volatile LAS unsigned* st; };
__device__ __forceinline__ XcdBarrier xcd_barrier_post(unsigned* bar, volatile LAS unsigned* st) {
    XcdBarrier b; b.bar = bar; b.x = xb_xcc_id(); b.st = st;
    if (threadIdx.x == 0) (void)xb_add(&bar[XB_XCNT(b.x)], 1u);
    return b;
}
__device__ __forceinline__ void xcd_barrier_complete(unsigned* bar, unsigned x, unsigned& nloc, unsigned& nx) {
    const unsigned G = gridDim.x * gridDim.y * gridDim.z;
    unsigned sum, cnt, mine, sp = 0u;
    for (;;) {
        sum = 0u; cnt = 0u; mine = 0u;
#pragma unroll
        for (unsigned j = 0; j < 16; ++j) { const unsigned c = xb_ld(&bar[XB_XCNT(j)]); sum += c; cnt += (c > 0u) ? 1u : 0u; mine = (j == x) ? c : mine; }
        if (sum == G) break;
        __builtin_amdgcn_s_sleep(1);
        if ((++sp & 255u) == 0u) { if (xb_ld(&bar[XB_TMO])) break; if (sp > XB_SPIN_CAP) { atomicAdd(&bar[XB_TMO], 1u); break; } }
    }
    nloc = mine > 0u ? mine : 1u; nx = cnt > 0u ? cnt : 1u;
}
__device__ __forceinline__ void xcd_barrier(const XcdBarrier& b) {
    asm volatile("s_waitcnt vmcnt(0)" ::: "memory");
    __syncthreads();
    if (threadIdx.x == 0) {
        unsigned* bar = b.bar;
        __builtin_amdgcn_s_waitcnt(0);
        unsigned nloc = b.st[0], nx = b.st[1];
        if (nloc == 0u) { xcd_barrier_complete(bar, b.x, nloc, nx); b.st[0] = nloc; b.st[1] = nx; }
        const unsigned old = xb_add(&bar[XB_XSUB(b.x)], 1u);
        const unsigned gen = old / nloc;
        if (old + 1u == (gen + 1u) * nloc) {
            __builtin_amdgcn_fence(__ATOMIC_RELEASE, "agent");
            asm volatile("s_waitcnt vmcnt(0)" ::: "memory");
            const unsigned og = xb_add(&bar[XB_TOP], 1u);
            const unsigned tg = og / nx;
            if (og + 1u == (tg + 1u) * nx) xb_add(&bar[XB_TOPGEN], 1u);
            else XB_SPIN(xb_ld(&bar[XB_TOPGEN]) == tg, bar);
            __builtin_amdgcn_fence(__ATOMIC_ACQUIRE, "agent");
            xb_add(&bar[XB_XGEN(b.x)], 1u);
            asm volatile("s_waitcnt vmcnt(0)" ::: "memory");
        } else {
            XB_SPIN(xb_ld(&bar[XB_XGEN(b.x)]) == gen, bar);
            __builtin_amdgcn_fence(__ATOMIC_ACQUIRE, "agent");
            asm volatile("s_waitcnt vmcnt(0)" ::: "memory");
        }
    }
    __syncthreads();
}
#endif

struct Wg { int tid, lane, wave, G, wg, gw, NGW; unsigned char* lds; unsigned* misc; };
DEV int q_next(Wg& w, unsigned* ctr) {
    if (w.tid == 0) w.misc[2] = atomicAdd(ctr, 1u);
    __syncthreads();
    const int v = (int)w.misc[2];
    __syncthreads();
    return v;
}

struct ConvJob { const float* src; int K, N, Npad; bf16* dst; int ldk, kdst0, rowofs, mode; };
struct ConvTile { const float* src; int N, k0, n0; bf16* dst; int ldk, kdst0, rowofs, mode; bool valid; };
DEV bool conv_job_pick(const ConvJob& j, int& it, ConvTile& t) {
    const int nkb = j.K / 64, nnb = j.Npad / 128, tot = nkb * nnb;
    if (it >= tot) { it -= tot; return false; }
    t.src = j.src; t.N = j.N; t.k0 = (it / nnb) * 64; t.n0 = (it % nnb) * 128; t.dst = j.dst; t.ldk = j.ldk; t.kdst0 = j.kdst0; t.rowofs = j.rowofs; t.mode = j.mode; t.valid = true;
    return true;
}
DEV void conv_load(const ConvTile& t, f32x4 (&v)[4], int tid) {
#pragma unroll
    for (int i = 0; i < 4; ++i) { const int kk = i * 16 + (tid >> 5), c4 = tid & 31; v[i] = (t.valid && t.n0 + 4 * c4 < t.N) ? *(const f32x4*)(t.src + (size_t)(t.k0 + kk) * t.N + t.n0 + 4 * c4) : (f32x4){0.f, 0.f, 0.f, 0.f}; }
}
DEV void conv_store(const ConvTile& t, const f32x4 (&v)[4], float* scr, int tid) {
#pragma unroll
    for (int i = 0; i < 4; ++i) { const int kk = i * 16 + (tid >> 5), c4 = tid & 31; *(f32x4*)(scr + kk * 132 + 4 * c4) = v[i]; }
    __syncthreads();
#pragma unroll
    for (int i = 0; i < 2; ++i) { const int idx = tid + NTHR * i, n = idx >> 3, c = idx & 7, ng = t.n0 + n; const float* s = scr + (8 * c) * 132 + n;
      const int row = t.rowofs + (t.mode == 0 ? ng : (ng / 128) * 256 + (ng % 128) + (t.mode == 2 ? 128 : 0));
      u32x4 o; o.x = pk2(s[0], s[132]); o.y = pk2(s[2 * 132], s[3 * 132]); o.z = pk2(s[4 * 132], s[5 * 132]); o.w = pk2(s[6 * 132], s[7 * 132]);
      *(u32x4*)(t.dst + (size_t)row * t.ldk + t.kdst0 + t.k0 + 8 * c) = o; }
    __syncthreads();
}
DEV void zero_rect(bf16* dst, int ld, int r0, int r1, int c0, int c1, int gtid, int gn) {
    const int cw = (c1 - c0) / 8; const long tot = (long)(r1 - r0) * cw;
    for (long i = gtid; i < tot; i += gn) { const int r = r0 + (int)(i / cw), c = c0 + 8 * (int)(i % cw); *(u32x4*)(dst + (size_t)r * ld + c) = (u32x4){0u, 0u, 0u, 0u}; }
}
DEV void phase0(const P& p, Wg& w) {
    float* scr = (float*)w.lds;
    {
        bf16* WIN = (bf16*)(p.ws + WS_WIN_T); bf16* WOUT = (bf16*)(p.ws + WS_WOUT_T); bf16* MLT = (bf16*)(p.ws + WS_MLA_T);
#define JOB_WIN(l) ConvJob{p.w_in + (size_t)(l) * D_MODEL * IN_W, D_MODEL, IN_W, PROJ_W, WIN + (size_t)(l) * PROJ_W * D_MODEL, D_MODEL, 0, 0, 0}
#define JOB_WOUT(l) ConvJob{p.w_out + (size_t)(l) * MIXW * D_MODEL, MIXW, D_MODEL, D_MODEL, WOUT + (size_t)(l) * D_MODEL * MIXW, MIXW, 0, 0, 0}
#define JOB_WUQ(l) ConvJob{p.l_wuq + (size_t)(l) * 256 * 384, 256, 384, 384, MLT + (size_t)(l) * 1024 * 512, 512, 0, 0, 0}
#define JOB_WUKV(l) ConvJob{p.l_wukv + (size_t)(l) * 128 * 512, 128, 512, 512, MLT + (size_t)(l) * 1024 * 512, 512, 256, 512, 0}
        constexpr int total = 2 * ((D_MODEL / 64) * (PROJ_W / 128) + (MIXW / 64) * (D_MODEL / 128) + 4 * 3 + 2 * 4) + 2 * (D_MODEL / 64) * (D_FF / 128) + (D_FF / 64) * (D_MODEL / 128);
        ConvTile cur, nxt; f32x4 vc[4], vn[4]; cur.valid = false;
#define PICK0(it0_, T) do { int it = (it0_); T.valid = false; if ((it0_) < total) { \
            if (!conv_job_pick(JOB_WIN(0), it, T)) if (!conv_job_pick(JOB_WIN(1), it, T)) if (!conv_job_pick(JOB_WOUT(0), it, T)) if (!conv_job_pick(JOB_WOUT(1), it, T)) \
            if (!conv_job_pick(JOB_WUQ(0), it, T)) if (!conv_job_pick(JOB_WUQ(1), it, T)) if (!conv_job_pick(JOB_WUKV(0), it, T)) if (!conv_job_pick(JOB_WUKV(1), it, T)) \
            if (!conv_job_pick(ConvJob{p.ffn_wg, D_MODEL, D_FF, D_FF, (bf16*)(p.ws + WS_WGU_T), D_MODEL, 0, 0, 1}, it, T)) \
            if (!conv_job_pick(ConvJob{p.ffn_wu, D_MODEL, D_FF, D_FF, (bf16*)(p.ws + WS_WGU_T), D_MODEL, 0, 0, 2}, it, T)) \
            conv_job_pick(ConvJob{p.ffn_wd, D_FF, D_MODEL, D_MODEL, (bf16*)(p.ws + WS_WD_T), D_FF, 0, 0, 0}, it, T); } } while (0)
        PICK0(w.wg, cur); if (cur.valid) conv_load(cur, vc, w.tid);
        for (int it0 = w.wg; it0 < total; it0 += w.G) {
            PICK0(it0 + w.G, nxt); if (nxt.valid) conv_load(nxt, vn, w.tid);
            conv_store(cur, vc, scr, w.tid);
            cur = nxt;
#pragma unroll
            for (int i = 0; i < 4; ++i) vc[i] = vn[i];
        }
#undef PICK0
    }
    for (int l = 0; l < 2; ++l) { bf16* mt = (bf16*)(p.ws + WS_MLA_T) + (size_t)l * 1024 * 512; const int gt = w.wg * NTHR + w.tid, gn = w.G * NTHR;
        zero_rect(mt, 512, 384, 512, 0, 256, gt, gn); zero_rect(mt, 512, 512, 1024, 384, 512, gt, gn); }
    if (w.wg == w.G - 1) for (int i = w.tid; i < NPOS * 24; i += NTHR) { const int pos = i / 24, f = i % 24;
        const float inv = f < 16 ? exp2f(-(float)f * (13.287712379549449f / 16.0f)) : exp2f(-(float)(f - 16) * (13.287712379549449f / 8.0f));
        float sn, cs; sincosf((float)pos * inv, &sn, &cs); float* rt = (float*)(p.ws + WS_ROPE) + 2 * i; rt[0] = cs; rt[1] = sn; }
    {
        float* sS = (float*)w.lds;
        float* part = sS + NV * D_MODEL;
        const int nitem = 2 * (6 * D_MODEL / 64);
        bool loaded = false;
        for (int it = w.wg; it < nitem; it += w.G) {
            if (!loaded) { for (int i = w.tid; i < NV * D_MODEL; i += NTHR) { const int v = i / D_MODEL, k = i % D_MODEL; sS[i] = silu_f(v < BATCH ? p.c[v * D_MODEL + k] : p.c_ctx[k]); } loaded = true; __syncthreads(); }
            const int l = it / (6 * D_MODEL / 64), cb = it % (6 * D_MODEL / 64), col = cb * 64 + w.lane;
            float acc[NV];
#pragma unroll
            for (int v = 0; v < NV; ++v) acc[v] = 0.f;
            const float* mw = p.mod_w + (size_t)l * D_MODEL * 6 * D_MODEL + col;
            for (int k0 = w.wave * (D_MODEL / 8); k0 < (w.wave + 1) * (D_MODEL / 8); k0 += 16) { float wv[16];
#pragma unroll
                for (int kk = 0; kk < 16; ++kk) wv[kk] = mw[(size_t)(k0 + kk) * 6 * D_MODEL];
#pragma unroll
                for (int kk = 0; kk < 16; ++kk)
#pragma unroll
                    for (int v = 0; v < NV; ++v) acc[v] += sS[v * D_MODEL + k0 + kk] * wv[kk]; }
#pragma unroll
            for (int v = 0; v < NV; ++v) part[(w.wave * NV + v) * 64 + w.lane] = acc[v];
            __syncthreads();
            for (int i = w.tid; i < NV * 64; i += NTHR) { const int v = i / 64, cc = i % 64; float s = p.mod_b[(size_t)l * 6 * D_MODEL + cb * 64 + cc];
#pragma unroll
                for (int ww = 0; ww < 8; ++ww) s += part[(ww * NV + v) * 64 + cc];
                ((float*)(p.ws + WS_MODV))[(size_t)(l * NV + v) * 6 * D_MODEL + cb * 64 + cc] = s; }
            __syncthreads();
        }
    }
}
DEV void phase_moe_weights(const P& p, Wg& w) {
    float* scr = (float*)w.lds;
    const int t_gu = (D_MODEL / 64) * (D_FF / 128), t_d = (D_FF / 64) * (D_MODEL / 128), per_e = 2 * t_gu + t_d;
    ConvTile cur, nxt; f32x4 vc[4], vn[4];
#define PICKM(it0_, T) do { T.valid = false; if ((it0_) < NEXP * per_e) { const int e = (it0_) / per_e; int it = (it0_) % per_e; bf16* base = (bf16*)(p.ws + WS_MOEW + (size_t)e * MOEW_E); \
        if (!conv_job_pick(ConvJob{p.moe_wg + (size_t)e * D_MODEL * D_FF, D_MODEL, D_FF, D_FF, base, D_MODEL, 0, 0, 1}, it, T)) \
        if (!conv_job_pick(ConvJob{p.moe_wu + (size_t)e * D_MODEL * D_FF, D_MODEL, D_FF, D_FF, base, D_MODEL, 0, 0, 2}, it, T)) \
        conv_job_pick(ConvJob{p.moe_wd + (size_t)e * D_FF * D_MODEL, D_FF, D_MODEL, D_MODEL, base + (size_t)2 * D_FF * D_MODEL, D_FF, 0, 0, 0}, it, T); } } while (0)
    PICKM(w.wg, cur); if (cur.valid) conv_load(cur, vc, w.tid);
    for (int it0 = w.wg; it0 < NEXP * per_e; it0 += w.G) {
        PICKM(it0 + w.G, nxt); if (nxt.valid) conv_load(nxt, vn, w.tid);
        conv_store(cur, vc, scr, w.tid);
        cur = nxt;
#pragma unroll
        for (int i = 0; i < 4; ++i) vc[i] = vn[i];
    }
#undef PICKM
}

template <int NB> DEV void phase_modulate(const P& p, Wg& w, int l, int which, bool first, bool skip_ctx, bool moe, bool ctx_part) {
    constexpr int NJ = D_MODEL / 256;
    bf16* H = (bf16*)(p.ws + WS_H);
    const float* gn = (which ? p.norm_ffn : p.norm_mix) + (size_t)l * D_MODEL;
    int cnt[NEXP];
#pragma unroll
    for (int e = 0; e < NEXP; ++e) cnt[e] = 0;
    f32x4 rw[NJ * 4][2];
    if (moe) {
#pragma unroll
        for (int j = 0; j < NJ; ++j)
#pragma unroll
            for (int k = 0; k < 4; ++k) { const float* rr = p.moe_router + (size_t)(4 * w.lane + 256 * j + k) * NEXP; rw[4 * j + k][0] = *(const f32x4*)rr; rw[4 * j + k][1] = *(const f32x4*)(rr + 4); } }
    f32x4 gnv[NJ];
#pragma unroll
    for (int j = 0; j < NJ; ++j) gnv[j] = *(const f32x4*)(gn + 4 * w.lane + 256 * j);
    static_assert(TP % NB == 0 && CTX % NB == 0 && M_ALL % NB == 0, "a group of NB consecutive rows never straddles a batch / context boundary");
    const int step = NB * w.NGW;
    u32x2 nraw[NB][NJ];
#define MOD_PF(Rg_) do { _Pragma("unroll") for (int qq = 0; qq < NB; ++qq) { const bf16* xr_ = resid_row(p, (Rg_) + qq); \
        _Pragma("unroll") for (int j = 0; j < NJ; ++j) nraw[qq][j] = *(const u32x2*)(xr_ + 4 * w.lane + 256 * j); } } while (0)
    f32x4 nrawf[NB][NJ];
#define MOD_PFF(Rg_) do { _Pragma("unroll") for (int qq = 0; qq < NB; ++qq) { const int R_ = (Rg_) + qq, b_ = R_ / TP, q_ = R_ % TP; \
        const float* src_ = q_ < CTX ? p.ctx + (size_t)(b_ * CTX + q_) * D_MODEL : p.x + (size_t)(b_ * SEQ + q_ - CTX) * D_MODEL; \
        _Pragma("unroll") for (int j = 0; j < NJ; ++j) nrawf[qq][j] = *(const f32x4*)(src_ + 4 * w.lane + 256 * j); } } while (0)
    if (first) MOD_PFF(NB * w.gw); else MOD_PF(NB * w.gw);
    for (int Rb = NB * w.gw; Rb < M_ALL; Rb += step) {
        f32x4 vv[NB][NJ];
        if (first) {
#pragma unroll
            for (int qq = 0; qq < NB; ++qq)
#pragma unroll
                for (int j = 0; j < NJ; ++j) vv[qq][j] = nrawf[qq][j]; }
        else {
#pragma unroll
            for (int qq = 0; qq < NB; ++qq)
#pragma unroll
                for (int j = 0; j < NJ; ++j) { const u32x2 t = nraw[qq][j]; vv[qq][j] = (f32x4){bf2f((bf16)t.x), bf2f((bf16)(t.x >> 16)), bf2f((bf16)t.y), bf2f((bf16)(t.y >> 16))}; } }
        f32x4 gs[NJ], s0v[NJ];
        { const float* mv = modv(p, l, Rb); const float* sh = mv + (which ? 3 : 0) * D_MODEL; const float* sc = mv + (which ? 4 : 1) * D_MODEL;
#pragma unroll
          for (int j = 0; j < NJ; ++j) { gs[j] = *(const f32x4*)(sc + 4 * w.lane + 256 * j); s0v[j] = *(const f32x4*)(sh + 4 * w.lane + 256 * j); } }
        if (Rb + step < M_ALL) { if (first) MOD_PFF(Rb + step); else MOD_PF(Rb + step); }
        if (skip_ctx && (Rb % TP) < CTX) continue;
#pragma unroll
        for (int j = 0; j < NJ; ++j) gs[j] = gnv[j] * (1.0f + gs[j]);
#pragma unroll
        for (int qq = 0; qq < NB; ++qq) {
        const int R = Rb + qq; const int b = R / TP, q = R % TP;
        bf16* xr = resid_row(p, R);
        f32x4 v[NJ]; float ss = 0.f;
#pragma unroll
        for (int j = 0; j < NJ; ++j) { v[j] = vv[qq][j]; ss += v[j][0] * v[j][0] + v[j][1] * v[j][1] + v[j][2] * v[j][2] + v[j][3] * v[j][3]; }
        if (ctx_part && q < CTX) {
            const bf16* cp = (const bf16*)(p.ws + WS_MLAQ) + (size_t)(b * CTX + q) * D_MODEL; const float* gf = (const float*)(p.ws + WS_MODV) + (size_t)((l - 1) * NV + BATCH) * 6 * D_MODEL + 5 * D_MODEL;
            ss = 0.f;
#pragma unroll
            for (int j = 0; j < NJ; ++j) { const int col = 4 * w.lane + 256 * j; f32x4 a = (f32x4){0.f, 0.f, 0.f, 0.f};
                for (int ks = 0; ks < NSPLIT; ++ks) { const u32x2 t = *(const u32x2*)(cp + (size_t)ks * BATCH * CTX * D_MODEL + col);
                    a[0] += bf2f((bf16)t.x); a[1] += bf2f((bf16)(t.x >> 16)); a[2] += bf2f((bf16)t.y); a[3] += bf2f((bf16)(t.y >> 16)); }
                const f32x4 g = *(const f32x4*)(gf + col); v[j] = v[j] + g * a; { u32x2 wb; wb.x = pk2(v[j][0], v[j][1]); wb.y = pk2(v[j][2], v[j][3]); *(u32x2*)(xr + col) = wb; }
                ss += v[j][0] * v[j][0] + v[j][1] * v[j][1] + v[j][2] * v[j][2] + v[j][3] * v[j][3]; } }
        ss = wave_sum(ss, w.lane);
        const float rstd = rsqrt_fast(ss * (1.0f / D_MODEL) + EPS);
        float lg[NEXP];
#pragma unroll
        for (int e = 0; e < NEXP; ++e) lg[e] = 0.f;
#pragma unroll
        for (int j = 0; j < NJ; ++j) { const int col = 4 * w.lane + 256 * j;
            f32x4 h;
#pragma unroll
            for (int k = 0; k < 4; ++k) h[k] = v[j][k] * rstd * gs[j][k] + s0v[j][k];
            u32x2 o; o.x = pk2(h[0], h[1]); o.y = pk2(h[2], h[3]);
            *(u32x2*)(H + (size_t)R * D_MODEL + col) = o;
            if (moe) {
#pragma unroll
                for (int k = 0; k < 4; ++k) {
#pragma unroll
                    for (int e = 0; e < NEXP; ++e) lg[e] += h[k] * rw[4 * j + k][e >> 2][e & 3]; } } }
        if (moe) {
#pragma unroll
            for (int e = 0; e < NEXP; ++e) lg[e] = wave_sum(lg[e], w.lane);
            int i1 = 0; float v1 = lg[0];
#pragma unroll
            for (int e = 1; e < NEXP; ++e) if (lg[e] > v1) { v1 = lg[e]; i1 = e; }
            int i2 = -1; float v2 = -3.0e38f;
#pragma unroll
            for (int e = 0; e < NEXP; ++e) if (e != i1 && lg[e] > v2) { v2 = lg[e]; i2 = e; }
            const float w1 = 1.0f / (1.0f + expf(v2 - v1)), w2 = 1.0f - w1;
            const int tok = b * SEQ + q - CTX;
            if (w.lane == 0) { int* ti = (int*)(p.ws + WS_TOPI) + 2 * tok; float* tw = (float*)(p.ws + WS_TOPW) + 2 * tok; ti[0] = i1; ti[1] = i2; tw[0] = w1; tw[1] = w2; }
#pragma unroll
            for (int e = 0; e < NEXP; ++e) cnt[e] += (e == i1 || e == i2) ? 1 : 0;
        }
        }
    }
    if (moe) {
        int* lc = (int*)w.lds;
        if (w.lane == 0) {
#pragma unroll
            for (int e = 0; e < NEXP; ++e) lc[w.wave * NEXP + e] = cnt[e]; }
        __syncthreads();
        if (w.tid < NEXP) { int s = 0; for (int ww = 0; ww < NWAVE; ++ww) s += lc[ww * NEXP + w.tid]; ((int*)(p.ws + WS_CNTG))[w.wg * NEXP + w.tid] = s; }
        __syncthreads();
    }
}

#undef MOD_PF
#undef MOD_PFF
DEV void phase_prep(const P& p, Wg& w, int l) {
    bf16* PROJ = (bf16*)(p.ws + WS_PROJ); bf16* MQK = (bf16*)(p.ws + WS_MQK);
    const float* cw = p.m_conv + (size_t)l * 3 * 768;
    const int lane = w.lane;
    const float gkr = p.l_knorm[l * 96 + 64 + (lane & 31)];
    const f32x4 gcq = *(const f32x4*)(p.l_cq_norm + l * 256 + 4 * lane); const float gkv0 = p.l_ckv_norm[l * 128 + 2 * lane], gkv1 = p.l_ckv_norm[l * 128 + 2 * lane + 1];
    const int hq = lane >> 3, hi8 = lane & 7, hbase = (hq < 6 ? C_AQ + hq * 64 : C_AK + (hq - 6) * 64) + 8 * hi8;
    f32x4 cwv[3][3];
#pragma unroll
    for (int j = 0; j < 3; ++j)
#pragma unroll
        for (int tp = 0; tp < 3; ++tp) cwv[j][tp] = *(const f32x4*)(cw + tp * 768 + 4 * lane + 256 * j);
    float gh[8];
    { const float* gp = (hq < 6 ? p.a_qnorm : p.a_knorm) + l * 64 + 8 * hi8;
#pragma unroll
      for (int j = 0; j < 8; ++j) gh[j] = gp[j] * (hq < 6 ? QSCALE_A : 1.0f); }
    const float* rtab = (const float*)(p.ws + WS_ROPE);
    constexpr int NB = 4;
    const int RPW = (M_ALL + w.NGW - 1) / w.NGW, Rend = ((w.gw + 1) * RPW < M_ALL) ? (w.gw + 1) * RPW : M_ALL;
    for (int R0 = w.gw * RPW; R0 < Rend; R0 += NB) {
        u32x2 c0[NB][3], cp[NB][3], cn[NB][3], cprev[3], cnext[3]; u32x4 hraw[NB]; u32x2 cqv[NB]; unsigned ckvv[NB]; bf16 krv[NB]; bool ok[NB];
        { const bool hpv = R0 > 0, hnv = R0 + NB < M_ALL;
#pragma unroll
          for (int j = 0; j < 3; ++j) { const int col = 4 * lane + 256 * j;
              cprev[j] = hpv ? *(const u32x2*)(PROJ + (size_t)(R0 - 1) * PROJ_W + col) : (u32x2){0u, 0u}; cnext[j] = hnv ? *(const u32x2*)(PROJ + (size_t)(R0 + NB) * PROJ_W + col) : (u32x2){0u, 0u}; } }
#pragma unroll
        for (int q = 0; q < NB; ++q) { const int R = R0 + q; ok[q] = R < Rend; const int Rr = R < M_ALL ? R : R0;
            const bf16* pr = PROJ + (size_t)Rr * PROJ_W;
#pragma unroll
            for (int j = 0; j < 3; ++j) c0[q][j] = *(const u32x2*)(pr + 4 * lane + 256 * j);
            hraw[q] = *(const u32x4*)(pr + hbase); cqv[q] = *(const u32x2*)(pr + C_CQ + 4 * lane); ckvv[q] = *(const unsigned*)(pr + C_CKV + 2 * lane); krv[q] = pr[C_KR + (lane & 31)]; }
#pragma unroll
        for (int q = 0; q < NB; ++q) { const int qq = (R0 + q) % TP; const bool hp = !(qq == 0 || qq == CTX), hn = !(qq == CTX - 1 || qq == TP - 1);
#pragma unroll
            for (int j = 0; j < 3; ++j) { const u32x2 a = (q == 0) ? cprev[j] : c0[q > 0 ? q - 1 : 0][j], n = (q == NB - 1) ? cnext[j] : c0[q < NB - 1 ? q + 1 : 0][j];
                cp[q][j] = hp ? a : (u32x2){0u, 0u}; cn[q][j] = hn ? n : (u32x2){0u, 0u}; } }
#pragma unroll
        for (int q = 0; q < NB; ++q) { const int Rr = (R0 + q < M_ALL) ? R0 + q : R0; const int qq = Rr % TP; const bool lat = qq >= CTX; const int t = qq - CTX;
            bf16* pr = PROJ + (size_t)Rr * PROJ_W;
            u32x2 ov[3];
#pragma unroll
            for (int j = 0; j < 3; ++j) { const int col = 4 * lane + 256 * j; float o[4];
#pragma unroll
                for (int k = 0; k < 4; ++k) { const unsigned sh = (k & 1) * 16; const unsigned a = (k < 2 ? cp[q][j].x : cp[q][j].y) >> sh, c = (k < 2 ? c0[q][j].x : c0[q][j].y) >> sh, n = (k < 2 ? cn[q][j].x : cn[q][j].y) >> sh;
                    const float sv = bf2f((bf16)a) * cwv[j][0][k] + bf2f((bf16)c) * cwv[j][1][k] + bf2f((bf16)n) * cwv[j][2][k]; o[k] = silu_fast(sv) * (col >= 384 ? KSCALE_M : 1.0f); }
                ov[j].x = pk2(o[0], o[1]); ov[j].y = pk2(o[2], o[3]); }
            u32x4 oh;
            { float x[8], ss = 0.f;
#pragma unroll
              for (int j = 0; j < 8; ++j) { x[j] = bf2f((bf16)(hraw[q][j >> 1] >> ((j & 1) * 16))); ss += x[j] * x[j]; }
              ss += SHX(ss, 1, lane); ss += SHX(ss, 2, lane); ss += SHX(ss, 4, lane);
              const float rs = rsqrt_fast(ss * (1.0f / 64.0f) + EPS);
#pragma unroll
              for (int j = 0; j < 8; ++j) x[j] *= rs * gh[j];
              const float* ct = rtab + ((size_t)(lat ? (hi8 < 4 ? t / GRID_W : t % GRID_W) : 0) * 24 + 8 * (hi8 & 1)) * 2;
              const f32x4 t0 = *(const f32x4*)ct, t1 = *(const f32x4*)(ct + 4), t2 = *(const f32x4*)(ct + 8), t3 = *(const f32x4*)(ct + 12);
              const float csv[8] = {t0[0], t0[2], t1[0], t1[2], t2[0], t2[2], t3[0], t3[2]}, snv[8] = {t0[1], t0[3], t1[1], t1[3], t2[1], t2[3], t3[1], t3[3]};
#pragma unroll
              for (int j = 0; j < 8; ++j) { const float pt = SHX(x[j], 2, lane);
                  if (lat) x[j] = (hi8 & 2) ? x[j] * csv[j] + pt * snv[j] : x[j] * csv[j] - pt * snv[j]; }
              oh.x = pk2(x[0], x[1]); oh.y = pk2(x[2], x[3]); oh.z = pk2(x[4], x[5]); oh.w = pk2(x[6], x[7]); }
            float csL = 1.f, snL = 0.f;
            if (lat) { const int d = lane & 31; const float* ct = rtab + ((size_t)(d < 16 ? t / GRID_W : t % GRID_W) * 24 + 16 + (d & 7)) * 2; csL = ct[0]; snL = ct[1]; }
            u32x2 ocq; unsigned ockv; float ykr;
            { float x[4] = {bf2f((bf16)cqv[q].x), bf2f((bf16)(cqv[q].x >> 16)), bf2f((bf16)cqv[q].y), bf2f((bf16)(cqv[q].y >> 16))};
              const float x0 = bf2f((bf16)ckvv[q]), x1 = bf2f((bf16)(ckvv[q] >> 16)); const float vk = lane < 32 ? bf2f(krv[q]) : 0.f;
              float s1 = x[0] * x[0] + x[1] * x[1] + x[2] * x[2] + x[3] * x[3], s2 = x0 * x0 + x1 * x1, s3 = vk * vk;
#pragma unroll
              for (int o = 1; o < 64; o <<= 1) { s1 += SHX(s1, o, lane); s2 += SHX(s2, o, lane); s3 += SHX(s3, o, lane); }
              const float r1 = rsqrt_fast(s1 * (1.0f / 256.0f) + EPS), r2 = rsqrt_fast(s2 * (1.0f / 128.0f) + EPS), r3 = rsqrt_fast(s3 * (1.0f / 32.0f) + EPS);
              ocq.x = pk2(x[0] * r1 * gcq[0], x[1] * r1 * gcq[1]); ocq.y = pk2(x[2] * r1 * gcq[2], x[3] * r1 * gcq[3]);
              ockv = pk2(x0 * r2 * gkv0, x1 * r2 * gkv1);
              float y = vk * r3 * gkr; const float pt = SHX(y, 8, lane);
              if (lat) y = (lane & 8) ? y * csL + pt * snL : y * csL - pt * snL;
              ykr = y; }
            if (ok[q]) {
#pragma unroll
                for (int j = 0; j < 3; ++j) *(u32x2*)(MQK + (size_t)Rr * 768 + 4 * lane + 256 * j) = ov[j];
                *(u32x4*)(pr + hbase) = oh;
                *(u32x2*)(pr + C_CQ + 4 * lane) = ocq; *(unsigned*)(pr + C_CKV + 2 * lane) = ockv;
                if (lane < 32) pr[C_KR + lane] = f2bf(ykr); }
        }
    }
}

DEV float scan_add(float v, int lane) {
#pragma unroll
    for (int d = 1; d < 64; d <<= 1) { const float t = __shfl(v, lane >= d ? lane - d : lane); if (lane >= d) v += t; }
    return v;
}
DEV float scan_max(float v, int lane) {
#pragma unroll
    for (int d = 1; d < 64; d <<= 1) { const float t = __shfl(v, lane >= d ? lane - d : lane); if (lane >= d) v = fmaxf(v, t); }
    return v;
}
DEV int chain_step(int dir, int cl) { return dir == 0 ? cl : (cl < NC_CTX ? NC_CTX - 1 - cl : NCH + NC_CTX - 1 - cl); }
DEV void gate_scan2(const P& p, int l, int R0, int hh, int dir, int lane, float* al, float* pm, float* bcl, float& F, float& pml) {
    static_assert(MCH == 128, "two positions per lane");
    const float* gb = p.m_gate_b + l * 16; float gi[2], lf[2];
#pragma unroll
    for (int e = 0; e < 2; ++e) { const int j = 2 * lane + e, o = dir ? MCH - 1 - j : j;
        const float* G = (const float*)(p.ws + WS_GATES) + (size_t)(R0 + o) * 16;
        gi[e] = G[dir * 8 + hh] + gb[dir * 8 + hh]; lf[e] = log_sigmoid_f(G[dir * 8 + 4 + hh] + gb[dir * 8 + 4 + hh]); }
    const float incl = scan_add(lf[0] + lf[1], lane);
    const float up1 = __shfl(incl, lane ? lane - 1 : 0), excl = lane ? up1 : 0.f;
    const float bc0 = excl + lf[0], bc1 = incl, a0 = gi[0] - bc0, a1 = gi[1] - bc1;
    const float pin = scan_max(fmaxf(a0, a1), lane);
    const float pu = __shfl(pin, lane ? lane - 1 : 0), px0 = lane ? fmaxf(pu, a0) : a0;
    F = __shfl(incl, 63); pml = __shfl(pin, 63);
    { const int o0 = dir ? MCH - 1 - 2 * lane : 2 * lane, o1 = dir ? o0 - 1 : o0 + 1;
      al[o0] = a0; pm[o0] = px0; bcl[o0] = bc0; al[o1] = a1; pm[o1] = pin; bcl[o1] = bc1; }
}
DEV void ml1_item(const P& p, Wg& w, int l, int item) {
    const int b = item / (4 * NCH), hh = (item / NCH) % 4, cl = item % NCH, R0 = b * TP + cl * MCH;
    float* wgt = (float*)w.lds;
    float* scr = wgt + 2 * MCH;
    bf16* Ks = (bf16*)(w.lds + 4096);
    bf16* Vw = Ks + MCH * 104;
    const bf16* MQK = (const bf16*)(p.ws + WS_MQK); const bf16* PROJ = (const bf16*)(p.ws + WS_PROJ);
    bf16* UC = (bf16*)(p.ws + WS_UC); float* NL = (float*)(p.ws + WS_NL);
    const int lane = w.lane, r = lane & 31, h = lane >> 5;
    static_assert(MCH * 12 == 3 * NTHR, "three k/v vectors per thread");
    u32x4 kq[3], vq[3];
#pragma unroll
    for (int q = 0; q < 3; ++q) { const int idx = w.tid + q * NTHR, s = idx / 12, c = idx % 12;
        kq[q] = *(const u32x4*)(MQK + (size_t)(R0 + s) * 768 + 384 + hh * 96 + 8 * c); vq[q] = *(const u32x4*)(PROJ + (size_t)(R0 + s) * PROJ_W + C_MV + hh * 96 + 8 * c); }
    if (w.wave < 2) { const int dir = w.wave; float F, pml; float* sc = scr + dir * 3 * MCH;
        gate_scan2(p, l, R0, hh, dir, lane, sc, sc + MCH, sc + 2 * MCH, F, pml);
        wave_sync();
#pragma unroll
        for (int hf = 0; hf < 2; ++hf) wgt[dir * MCH + lane + 64 * hf] = __expf(sc[lane + 64 * hf] - pml);
        const int ci = ((b * 4 + hh) * 2 + dir) * NCH + chain_step(dir, cl);
        if (lane == 0) { ((float*)(p.ws + WS_FS))[ci] = F; ((float*)(p.ws + WS_PML))[ci] = pml; } }
    __syncthreads();
#pragma unroll
    for (int q = 0; q < 3; ++q) { const int idx = w.tid + q * NTHR, s = idx / 12, c = idx % 12;
        const u32x4 kr = kq[q], vr = vq[q];
        *(u32x4*)(Ks + s * 104 + 8 * c) = kr;
#pragma unroll
        for (int dir = 0; dir < 2; ++dir) { const float wd = wgt[dir * MCH + s]; u32x4 o;
            o.x = pk2(wd * bf2f((bf16)vr.x), wd * bf2f((bf16)(vr.x >> 16))); o.y = pk2(wd * bf2f((bf16)vr.y), wd * bf2f((bf16)(vr.y >> 16)));
            o.z = pk2(wd * bf2f((bf16)vr.z), wd * bf2f((bf16)(vr.z >> 16))); o.w = pk2(wd * bf2f((bf16)vr.w), wd * bf2f((bf16)(vr.w >> 16)));
            *(u32x4*)(Vw + (dir * MCH + s) * 104 + 8 * c) = o;
            if (c == 0) Vw[(dir * MCH + s) * 104 + 96] = f2bf(wd); } }
    __syncthreads();
    const int toff = (8 * h + ((lane & 15) >> 2)) * 104 + 16 * ((lane >> 4) & 1) + 4 * (lane & 3);
    for (int task = w.wave; task < 24; task += NWAVE) {
        const bool nt = task >= 18; const int tt = nt ? task - 18 : task;
        const int dir = nt ? tt / 3 : tt / 9, dt = nt ? tt % 3 : (tt % 9) / 3, et = nt ? 3 : tt % 3;
        f32x16 acc;
#pragma unroll
        for (int i = 0; i < 16; ++i) acc[i] = 0.f;
#pragma unroll
        for (int ks = 0; ks < MCH / 16; ++ks) { const bf16* ap = Ks + (16 * ks) * 104 + 32 * dt + toff; const bf16* bp = Vw + (dir * MCH + 16 * ks) * 104 + 32 * et + toff;
            const s16x4 al = lds_tr_read(ap), ah = lds_tr_read(ap + 4 * 104), bl = lds_tr_read(bp), bh = lds_tr_read(bp + 4 * 104);
            const bf16x8 af = (bf16x8){al[0], al[1], al[2], al[3], ah[0], ah[1], ah[2], ah[3]}, bfr = (bf16x8){bl[0], bl[1], bl[2], bl[3], bh[0], bh[1], bh[2], bh[3]};
            acc = mfma32(af, bfr, acc); }
        const int ci = ((b * 4 + hh) * 2 + dir) * NCH + chain_step(dir, cl);
        if (!nt) { bf16* up = UC + (size_t)ci * 9216 + (32 * et + r) * 96 + 32 * dt + 4 * h;
#pragma unroll
            for (int g = 0; g < 4; ++g) { u32x2 o; o.x = pk2(acc[4 * g], acc[4 * g + 1]); o.y = pk2(acc[4 * g + 2], acc[4 * g + 3]); *(u32x2*)(up + 8 * g) = o; } }
        else if (r == 0) { float* np = NL + (size_t)ci * 96 + 32 * dt + 4 * h;
#pragma unroll
            for (int g = 0; g < 4; ++g) *(f32x4*)(np + 8 * g) = (f32x4){acc[4 * g], acc[4 * g + 1], acc[4 * g + 2], acc[4 * g + 3]}; } }
    __syncthreads();
}
DEV void phase_ml2(const P& p, Wg& w) {
    constexpr int GPC = 1152 + 12;
    bf16* UC = (bf16*)(p.ws + WS_UC); float* NL = (float*)(p.ws + WS_NL);
    const float* FS = (const float*)(p.ws + WS_FS); const float* PML = (const float*)(p.ws + WS_PML); float* MST = (float*)(p.ws + WS_MST);
    for (int j = w.wg * NTHR + w.tid; j < NCHAIN * GPC; j += w.G * NTHR) {
        const int chain = j / GPC, g = j % GPC;
        float C[8], m = 0.f;
#pragma unroll
        for (int i = 0; i < 8; ++i) C[i] = 0.f;
        for (int k0 = 0; k0 < NCH; k0 += ML2_U) {
            float Fv[ML2_U], pv[ML2_U];
#pragma unroll
            for (int q = 0; q < ML2_U; ++q) { Fv[q] = FS[chain * NCH + k0 + q]; pv[q] = PML[chain * NCH + k0 + q]; }
            if (g < 1152) { u32x4 raw[ML2_U];
#pragma unroll
                for (int q = 0; q < ML2_U; ++q) raw[q] = *(const u32x4*)(UC + (size_t)(chain * NCH + k0 + q) * 9216 + 8 * g);
#pragma unroll
                for (int q = 0; q < ML2_U; ++q) { const int ci = chain * NCH + k0 + q; const float mx = fmaxf(m, pv[q]), dec = __expf(m - mx), sc = __expf(pv[q] - mx);
                    u32x4 st; st.x = pk2(C[0], C[1]); st.y = pk2(C[2], C[3]); st.z = pk2(C[4], C[5]); st.w = pk2(C[6], C[7]); *(u32x4*)(UC + (size_t)ci * 9216 + 8 * g) = st;
#pragma unroll
                    for (int i = 0; i < 8; ++i) C[i] = dec * C[i] + sc * bf2f((bf16)(raw[q][i >> 1] >> ((i & 1) * 16)));
                    if (g == 0) MST[ci] = m;
                    m = Fv[q] + mx; } }
            else {
                for (int q = 0; q < ML2_U; ++q) { float* nl = NL + (size_t)(chain * NCH + k0 + q) * 96 + 8 * (g - 1152); const f32x4 r0 = *(const f32x4*)nl, r1 = *(const f32x4*)(nl + 4);
                    const float mx = fmaxf(m, pv[q]), dec = __expf(m - mx), sc = __expf(pv[q] - mx);
                    *(f32x4*)nl = (f32x4){C[0], C[1], C[2], C[3]}; *(f32x4*)(nl + 4) = (f32x4){C[4], C[5], C[6], C[7]};
#pragma unroll
                    for (int i = 0; i < 4; ++i) { C[i] = dec * C[i] + sc * r0[i]; C[4 + i] = dec * C[4 + i] + sc * r1[i]; }
                    m = Fv[q] + mx; } }
        }
    }
}
DEV void ml3_item(const P& p, Wg& w, int l, int item) {
    const int lane = w.lane, r = lane & 31, h = lane >> 5, dir = w.wave >> 2, tq = w.wave & 3;
    const int b = item / (4 * NCH), hh = (item / NCH) % 4, cl = item % NCH, R0 = b * TP + cl * MCH;
    const int ci = ((b * 4 + hh) * 2 + dir) * NCH + chain_step(dir, cl);
    bf16* Qs = (bf16*)w.lds;
    bf16* Ksm = Qs + MCH * 104;
    bf16* Vs = Ksm + MCH * 104;
    float* nls = (float*)(w.lds + 3 * MCH * 104 * 2);
    float* scn = nls + 192;
    float* hx = (float*)w.lds;
    const bf16* MQK = (const bf16*)(p.ws + WS_MQK); const bf16* PROJ = (const bf16*)(p.ws + WS_PROJ);
    const bf16* UCi = (const bf16*)(p.ws + WS_UC) + (size_t)ci * 9216;
    for (int idx = w.tid; idx < MCH * 12; idx += NTHR) { const int s = idx / 12, c = idx % 12;
        const u32x4 qv = *(const u32x4*)(MQK + (size_t)(R0 + s) * 768 + hh * 96 + 8 * c), kv = *(const u32x4*)(MQK + (size_t)(R0 + s) * 768 + 384 + hh * 96 + 8 * c),
                    vv = *(const u32x4*)(PROJ + (size_t)(R0 + s) * PROJ_W + C_MV + hh * 96 + 8 * c);
        *(u32x4*)(Qs + s * 104 + 8 * c) = qv; *(u32x4*)(Ksm + s * 104 + 8 * c) = kv; *(u32x4*)(Vs + s * 104 + 8 * c) = vv; }
    if (w.tid < 192) { const int dd = w.tid / 96; nls[w.tid] = ((const float*)(p.ws + WS_NL))[(size_t)(((b * 4 + hh) * 2 + dd) * NCH + chain_step(dd, cl)) * 96 + w.tid % 96]; }
    if (tq == 0) { float F, pml; float* sc = scn + dir * 3 * MCH; gate_scan2(p, l, R0, hh, dir, lane, sc, sc + MCH, sc + 2 * MCH, F, pml); }
    const float m_st = ((const float*)(p.ws + WS_MST))[ci];
    __syncthreads();
    const float* al = scn + dir * 3 * MCH; const float* pmv = al + MCH; const float* bcl = al + 2 * MCH;
    const int t = 32 * tq + r;
    const float mx_t = fmaxf(m_st, pmv[t]), bc_t = bcl[t];
    bf16x8 qf[6]; float qn = 0.f;
#pragma unroll
    for (int ks = 0; ks < 6; ++ks) { qf[ks] = *(const bf16x8*)(Qs + t * 104 + 16 * ks + 8 * h);
        const f32x4 n0 = *(const f32x4*)(nls + dir * 96 + 16 * ks + 8 * h), n1 = *(const f32x4*)(nls + dir * 96 + 16 * ks + 8 * h + 4);
#pragma unroll
        for (int j = 0; j < 4; ++j) { qn += bf2f((bf16)qf[ks][j]) * n0[j]; qn += bf2f((bf16)qf[ks][4 + j]) * n1[j]; } }
    qn += SHX(qn, 32, lane);
    f32x16 o[3]; float rs = 0.f;
#pragma unroll
    for (int et = 0; et < 3; ++et)
#pragma unroll
        for (int i = 0; i < 16; ++i) o[et][i] = 0.f;
    for (int kb = dir ? tq : 0; kb < (dir ? NQB : tq + 1); ++kb) {
        f32x16 pw;
#pragma unroll
        for (int i = 0; i < 16; ++i) pw[i] = 0.f;
#pragma unroll
        for (int ks = 0; ks < 6; ++ks) { const bf16x8 kf = *(const bf16x8*)(Ksm + (32 * kb + r) * 104 + 16 * ks + 8 * h); pw = mfma32(kf, qf[ks], pw); }
#pragma unroll
        for (int g = 0; g < 4; ++g) { const int s0 = 32 * kb + 8 * g + 4 * h; const f32x4 av = *(const f32x4*)(al + s0);
#pragma unroll
            for (int j = 0; j < 4; ++j) { const int sidx = s0 + j; const bool okk = dir ? (sidx >= t) : (sidx <= t);
                const float wv = okk ? __expf(av[j] - mx_t) * pw[4 * g + j] : 0.f; pw[4 * g + j] = wv; rs += wv; } }
        bf16x8 pb[2];
#pragma unroll
        for (int sp = 0; sp < 2; ++sp) { u32x4 u; u.x = pk2(pw[8 * sp], pw[8 * sp + 1]); u.y = pk2(pw[8 * sp + 2], pw[8 * sp + 3]); u.z = pk2(pw[8 * sp + 4], pw[8 * sp + 5]); u.w = pk2(pw[8 * sp + 6], pw[8 * sp + 7]);
            pb[sp] = __builtin_bit_cast(bf16x8, u); }
#pragma unroll
        for (int et = 0; et < 3; ++et)
#pragma unroll
            for (int sp = 0; sp < 2; ++sp) { const bf16* vp = Vs + (32 * kb + 16 * sp + 4 * h + ((lane & 15) >> 2)) * 104 + 32 * et + 16 * ((lane >> 4) & 1) + 4 * (lane & 3);
                const s16x4 lo = lds_tr_read(vp), hi = lds_tr_read(vp + 8 * 104);
                const bf16x8 vf = (bf16x8){lo[0], lo[1], lo[2], lo[3], hi[0], hi[1], hi[2], hi[3]};
                o[et] = mfma32(vf, pb[sp], o[et]); }
    }
    rs += SHX(rs, 32, lane);
    const float a_int = __expf(m_st - mx_t), den = a_int * qn + rs, inv = 1.0f / fmaxf(fabsf(den), __expf(-(bc_t + mx_t)));
#pragma unroll
    for (int et = 0; et < 3; ++et) { f32x16 oi;
#pragma unroll
        for (int i = 0; i < 16; ++i) oi[i] = 0.f;
#pragma unroll
        for (int ks = 0; ks < 6; ++ks) { const bf16x8 cf = *(const bf16x8*)(UCi + (32 * et + r) * 96 + 16 * ks + 8 * h); oi = mfma32(cf, qf[ks], oi); }
#pragma unroll
        for (int i = 0; i < 16; ++i) o[et][i] = (a_int * oi[i] + o[et][i]) * inv; }
    __syncthreads();
    if (dir == 1) {
#pragma unroll
        for (int et = 0; et < 3; ++et)
#pragma unroll
            for (int i = 0; i < 16; ++i) hx[t * 97 + 32 * et + crow(i, h)] = o[et][i]; }
    __syncthreads();
    if (dir == 0) { float ss = 0.f;
#pragma unroll
        for (int et = 0; et < 3; ++et)
#pragma unroll
            for (int i = 0; i < 16; ++i) { o[et][i] += hx[t * 97 + 32 * et + crow(i, h)]; ss += o[et][i] * o[et][i]; }
        ss += SHX(ss, 32, lane);
        const float rstd = rsqrt_fast(ss * (1.0f / 96.0f) + EPS);
        bf16* MIX = (bf16*)(p.ws + WS_H);
#pragma unroll
        for (int et = 0; et < 3; ++et)
#pragma unroll
            for (int g = 0; g < 4; ++g) { const int e = 32 * et + 8 * g + 4 * h;
                const u32x2 og = *(const u32x2*)(PROJ + (size_t)(R0 + t) * PROJ_W + C_MO + hh * 96 + e); const f32x4 mn = *(const f32x4*)(p.m_norm + l * 384 + hh * 96 + e);
                float o4[4];
#pragma unroll
                for (int j = 0; j < 4; ++j) { const float gate = bf2f((bf16)((j < 2 ? og.x : og.y) >> ((j & 1) * 16))); o4[j] = o[et][4 * g + j] * rstd * mn[j] * sigmoid_f(gate); }
                u32x2 ov; ov.x = pk2(o4[0], o4[1]); ov.y = pk2(o4[2], o4[3]);
                *(u32x2*)(MIX + (size_t)(R0 + t) * MIXW + hh * 96 + e) = ov; } }
    __syncthreads();
}

DEV void phase_mla_post(const P& p, Wg& w, int l) {
    bf16* MLAQ = (bf16*)(p.ws + WS_MLAQ); const bf16* PROJ = (const bf16*)(p.ws + WS_PROJ);
    const int lane = w.lane;
    int baseA = 0, nA = 8, dstA = 8 * lane; bool normA = true, ropeA = false; const float* gA = p.l_qnorm + l * 96;
    if (lane < 48) { const int hh = lane / 12, o = lane % 12;
        if (o < 8) { baseA = 12 * hh; nA = 8; gA = p.l_qnorm + l * 96 + 8 * o; }
        else { baseA = 12 * hh + 8; nA = 4; gA = p.l_qnorm + l * 96 + 64 + 8 * (o - 8); ropeA = true; } }
    else { normA = false; }
    const int hb = lane / 16, ob = lane % 16; const bool normB = ob < 8;
    const int baseB = (16 * (lane / 16)) & 63;
    const int dstB = normB ? 384 + 96 * hb + 8 * ob : 768 + 64 * hb + 8 * (ob - 8);
    const float* gB = p.l_knorm + l * 96 + 8 * (ob & 7);
    float gAv[8], gBv[8];
#pragma unroll
    for (int j = 0; j < 8; ++j) { gAv[j] = gA[j]; gBv[j] = gB[j]; }
    const int cidx = (lane % 12) - 8;
    constexpr int NB = 2;
    u32x4 na[NB], nb[NB], nk[NB];
#define POST_PF(R0_) do { _Pragma("unroll") for (int q = 0; q < NB; ++q) { const int R_ = (R0_) + q * w.NGW; const int Rr_ = R_ < M_ALL ? R_ : (R0_); const bf16* row_ = MLAQ + (size_t)Rr_ * 1024; \
        na[q] = *(const u32x4*)(row_ + 8 * lane); nb[q] = *(const u32x4*)(row_ + 512 + 8 * lane); \
        nk[q] = (lane >= 48) ? *(const u32x4*)(PROJ + (size_t)Rr_ * PROJ_W + C_KR + 8 * ((lane - 48) & 3)) : (u32x4){0u, 0u, 0u, 0u}; } } while (0)
    POST_PF(w.gw);
    for (int R0 = w.gw; R0 < M_ALL; R0 += NB * w.NGW) {
        u32x4 ra[NB], rb[NB], kr[NB]; bool ok[NB]; f32x4 tb[NB][4];
#pragma unroll
        for (int q = 0; q < NB; ++q) { ok[q] = R0 + q * w.NGW < M_ALL; ra[q] = na[q]; rb[q] = nb[q]; kr[q] = nk[q];
            const int Rr = ok[q] ? R0 + q * w.NGW : R0; const int qq = Rr % TP; const bool lat = qq >= CTX; const int t = qq - CTX;
            const float* ct = (const float*)(p.ws + WS_ROPE) + ((size_t)(lat ? ((cidx & 3) < 2 ? t / GRID_W : t % GRID_W) : 0) * 24 + 16) * 2;
            tb[q][0] = *(const f32x4*)ct; tb[q][1] = *(const f32x4*)(ct + 4); tb[q][2] = *(const f32x4*)(ct + 8); tb[q][3] = *(const f32x4*)(ct + 12); }
        if (R0 + NB * w.NGW < M_ALL) POST_PF(R0 + NB * w.NGW);
        u32x4 oa[NB], obv[NB];
#pragma unroll
        for (int q = 0; q < NB; ++q) { const int Rr = ok[q] ? R0 + q * w.NGW : R0; const int qq = Rr % TP; const bool lat = qq >= CTX;
            float xa[8], xb[8], ssA = 0.f, ssB = 0.f;
#pragma unroll
            for (int j = 0; j < 8; ++j) { xa[j] = bf2f((bf16)(ra[q][j >> 1] >> ((j & 1) * 16))); xb[j] = bf2f((bf16)(rb[q][j >> 1] >> ((j & 1) * 16))); ssA += xa[j] * xa[j]; ssB += xb[j] * xb[j]; }
            float sA = 0.f, sB = 0.f;
#pragma unroll
            for (int i = 0; i < 8; ++i) { const float v = __shfl(ssA, (baseA + i) & 63); if (i < nA) sA += v; sB += __shfl(ssB, (baseB + i) & 63); }
            const float rsA = normA ? rsqrt_fast(sA / (float)(8 * nA) + EPS) : 1.0f, rsB = normB ? rsqrt_fast(sB * (1.0f / 64.0f) + EPS) : 1.0f;
#pragma unroll
            for (int j = 0; j < 8; ++j) { xa[j] = normA ? xa[j] * rsA * gAv[j] : xa[j]; xb[j] = normB ? xb[j] * rsB * gBv[j] : xb[j]; }
            const f32x4 t0 = tb[q][0], t1 = tb[q][1], t2 = tb[q][2], t3 = tb[q][3];
            const float csv[8] = {t0[0], t0[2], t1[0], t1[2], t2[0], t2[2], t3[0], t3[2]}, snv[8] = {t0[1], t0[3], t1[1], t1[3], t2[1], t2[3], t3[1], t3[3]};
#pragma unroll
            for (int j = 0; j < 8; ++j) { const float pt = SHX(xa[j], 1, lane);
                if (ropeA && lat) xa[j] = (cidx & 1) ? xa[j] * csv[j] + pt * snv[j] : xa[j] * csv[j] - pt * snv[j]; }
            if (lane < 48) {
#pragma unroll
                for (int j = 0; j < 8; ++j) xa[j] *= QSCALE_L; }
            oa[q].x = pk2(xa[0], xa[1]); oa[q].y = pk2(xa[2], xa[3]); oa[q].z = pk2(xa[4], xa[5]); oa[q].w = pk2(xa[6], xa[7]);
            obv[q].x = pk2(xb[0], xb[1]); obv[q].y = pk2(xb[2], xb[3]); obv[q].z = pk2(xb[4], xb[5]); obv[q].w = pk2(xb[6], xb[7]); }
        wave_sync();
#pragma unroll
        for (int q = 0; q < NB; ++q) if (ok[q]) { bf16* row = MLAQ + (size_t)(R0 + q * w.NGW) * 1024;
            if (lane < 48) *(u32x4*)(row + dstA) = oa[q];
            else { const int i = lane - 48; *(u32x4*)(row + 384 + 96 * (i >> 2) + 64 + 8 * (i & 3)) = kr[q]; }
            *(u32x4*)(row + dstB) = obv[q]; }
        wave_sync();
    }
}

#undef POST_PF
template <int DQK>
DEV void attn_unit(const bf16* Q, int ldq, const bf16* K, int ldk, const bf16* V, int ldv, bf16* O, int ldo, int nkeys, Wg& w) {
    constexpr int KS = DQK + 8, NKD = DQK / 16, CPR = DQK / 8, NKC = 64 * CPR, VS = 72;
    bf16* Ks = (bf16*)w.lds;
    bf16* Vs = (bf16*)(w.lds + 2 * 64 * KS * 2);
    const int tid = w.tid, lane = w.lane, r = lane & 31, h = lane >> 5;
    bf16x8 qr[NKD];
    { const bf16* qp = Q + (size_t)(w.wave * 32 + r) * ldq + 8 * h;
#pragma unroll
      for (int d0 = 0; d0 < NKD; ++d0) qr[d0] = *(const bf16x8*)(qp + 16 * d0); }
    const int kr0 = tid / CPR, kc0 = tid % CPR, kr1 = (tid + NTHR) / CPR, kc1 = (tid + NTHR) % CPR; const bool k1 = (tid + NTHR) < NKC;
    const int vr = tid >> 3, vc = tid & 7;
    u32x4 rk0, rk1 = (u32x4){0u, 0u, 0u, 0u}, rv;
    const int NT = nkeys / 64;
    const int vtr_off = (4 * h + ((lane & 15) >> 2)) * VS + 16 * ((lane >> 4) & 1) + 4 * (lane & 3);
#define AT_LOAD(kt) do { rk0 = *(const u32x4*)(K + (size_t)((kt) * 64 + kr0) * ldk + 8 * kc0); if (k1) rk1 = *(const u32x4*)(K + (size_t)((kt) * 64 + kr1) * ldk + 8 * kc1); \
        rv = *(const u32x4*)(V + (size_t)((kt) * 64 + vr) * ldv + 8 * vc); } while (0)
#define AT_STORE(buf) do { *(u32x4*)(Ks + ((buf) * 64 + kr0) * KS + 8 * kc0) = rk0; if (k1) *(u32x4*)(Ks + ((buf) * 64 + kr1) * KS + 8 * kc1) = rk1; \
        *(u32x4*)(Vs + ((buf) * 64 + vr) * VS + 8 * vc) = rv; } while (0)
    AT_LOAD(0); AT_STORE(0);
    __syncthreads();
    float m_run = 0.f, l_run = 0.f; f32x16 o[2], negm;
#pragma unroll
    for (int i = 0; i < 16; ++i) { o[0][i] = 0.f; o[1][i] = 0.f; negm[i] = 0.f; }
    for (int kt = 0; kt < NT; ++kt) {
        const int buf = kt & 1;
        if (kt + 1 < NT) AT_LOAD(kt + 1);
        f32x16 pt[2];
        { bf16x8 kf[2][NKD];
#pragma unroll
          for (int kh = 0; kh < 2; ++kh)
#pragma unroll
              for (int d0 = 0; d0 < NKD; ++d0) kf[kh][d0] = *(const bf16x8*)(Ks + (buf * 64 + 32 * kh + r) * KS + 16 * d0 + 8 * h);
          SCHED_FENCE();
          pt[0] = negm; pt[1] = negm;
#pragma unroll
          for (int d0 = 0; d0 < NKD; ++d0) { pt[0] = mfma32(kf[0][d0], qr[d0], pt[0]); pt[1] = mfma32(kf[1][d0], qr[d0], pt[1]); } }
        bf16x8 vf[2][2][2];
#pragma unroll
        for (int et = 0; et < 2; ++et)
#pragma unroll
            for (int kh = 0; kh < 2; ++kh)
#pragma unroll
                for (int sp = 0; sp < 2; ++sp) { const bf16* vp = Vs + (buf * 64 + 32 * kh + 16 * sp) * VS + 32 * et + vtr_off;
                    const s16x4 lo = lds_tr_read(vp), hi = lds_tr_read(vp + 8 * VS);
                    vf[et][kh][sp] = (bf16x8){lo[0], lo[1], lo[2], lo[3], hi[0], hi[1], hi[2], hi[3]}; }
        SCHED_FENCE();
        float mq[4];
#pragma unroll
        for (int c = 0; c < 4; ++c) mq[c] = fmaxf(pt[0][c], pt[1][c]);
#pragma unroll
        for (int i = 4; i < 16; ++i) mq[i & 3] = fmaxf(mq[i & 3], fmaxf(pt[0][i], pt[1][i]));
        float mt = fmaxf(fmaxf(mq[0], mq[1]), fmaxf(mq[2], mq[3]));
        if (__any(kt == 0 || mt > 8.0f)) {
            mt = fmaxf(mt, SHX(mt, 32, lane));
            const float dl = (kt == 0) ? mt : fmaxf(mt, 0.f), alpha = exp2_fast(-dl);
            m_run += dl; l_run *= alpha;
#pragma unroll
            for (int i = 0; i < 16; ++i) { pt[0][i] -= dl; pt[1][i] -= dl; o[0][i] *= alpha; o[1][i] *= alpha; negm[i] = -m_run; }
        }
        float rq[4] = {0.f, 0.f, 0.f, 0.f};
#pragma unroll
        for (int kh = 0; kh < 2; ++kh)
#pragma unroll
            for (int i = 0; i < 16; ++i) { const float e = exp2_fast(pt[kh][i]); pt[kh][i] = e; rq[i & 3] += e; }
        l_run += (rq[0] + rq[1]) + (rq[2] + rq[3]);
        bf16x8 pb[2][2];
#pragma unroll
        for (int kh = 0; kh < 2; ++kh)
#pragma unroll
            for (int sp = 0; sp < 2; ++sp) { u32x4 u; u.x = pk2(pt[kh][8 * sp], pt[kh][8 * sp + 1]); u.y = pk2(pt[kh][8 * sp + 2], pt[kh][8 * sp + 3]); u.z = pk2(pt[kh][8 * sp + 4], pt[kh][8 * sp + 5]); u.w = pk2(pt[kh][8 * sp + 6], pt[kh][8 * sp + 7]);
                pb[kh][sp] = __builtin_bit_cast(bf16x8, u); }
        SCHED_FENCE();
#pragma unroll
        for (int kh = 0; kh < 2; ++kh)
#pragma unroll
            for (int sp = 0; sp < 2; ++sp)
#pragma unroll
                for (int et = 0; et < 2; ++et) o[et] = mfma32(vf[et][kh][sp], pb[kh][sp], o[et]);
        if (kt + 1 < NT) AT_STORE(buf ^ 1);
        __syncthreads();
    }
#undef AT_LOAD
#undef AT_STORE
    l_run += SHX(l_run, 32, lane);
    const float inv = 1.0f / l_run;
    bf16* op = O + (size_t)(w.wave * 32 + r) * ldo + 4 * h;
#pragma unroll
    for (int et = 0; et < 2; ++et)
#pragma unroll
        for (int g = 0; g < 4; ++g) { u32x2 ov; ov.x = pk2(o[et][4 * g] * inv, o[et][4 * g + 1] * inv); ov.y = pk2(o[et][4 * g + 2] * inv, o[et][4 * g + 3] * inv); *(u32x2*)(op + 32 * et + 8 * g) = ov; }
}
#ifndef REP_ATT
#define REP_ATT 1
#endif
#ifndef REP_ML3
#define REP_ML3 1
#endif
DEV void relaunder(Wg& w) { int t_ = w.tid; OPAQUE_V(t_); w.tid = t_; w.lane = t_ & 63; }
DEV void phase_mix(const P& p, Wg& w, int l) {
    const bf16* PROJ = (const bf16*)(p.ws + WS_PROJ); const bf16* MLAQ = (const bf16*)(p.ws + WS_MLAQ); bf16* MIX = (bf16*)(p.ws + WS_H);
    unsigned* ctr = (unsigned*)(p.ws + WS_CTL) + CW_Q + 1024 * l;
    const int n_ml3 = BATCH * 4 * NCH;
    for (int rep = 0; rep < REP_ATT; ++rep) {
        { const int n_lat = BATCH * 4 * NQL, n_all = n_lat + ((l == 0) ? BATCH * 4 : 0);
          for (;;) {
            int idx = q_next(w, ctr + 64 * rep);
            if (idx >= n_all) break;
            int b, head, qb, nkeys;
            if (idx < n_lat) { b = idx / (4 * NQL); head = (idx / NQL) % 4; qb = 1 + idx % NQL; nkeys = TP; }
            else { idx -= n_lat; b = idx / 4; head = idx % 4; qb = 0; nkeys = CTX; }
            const size_t Rq = (size_t)b * TP + qb * 256, Rk = (size_t)b * TP;
            attn_unit<96>(MLAQ + Rq * 1024 + head * 96, 1024, MLAQ + Rk * 1024 + 384 + head * 96, 1024, MLAQ + Rk * 1024 + 768 + head * 64, 1024, MIX + Rq * MIXW + 768 + head * 64, MIXW, nkeys, w);
          } }
        relaunder(w);
        { const int n_lat = BATCH * 6 * NQL, n_all = n_lat + ((l == 0) ? BATCH * 6 : 0);
          for (;;) {
            int idx = q_next(w, ctr + 256 + 64 * rep);
            if (idx >= n_all) break;
            int b, head, qb, nkeys;
            if (idx < n_lat) { b = idx / (6 * NQL); const int rem = idx % (6 * NQL); head = (rem / (3 * NQL)) * 3 + rem % 3; qb = 1 + (rem % (3 * NQL)) / 3; nkeys = TP; }
            else { idx -= n_lat; b = idx / 6; head = idx % 6; qb = 0; nkeys = CTX; }
            const size_t Rq = (size_t)b * TP + qb * 256, Rk = (size_t)b * TP;
            attn_unit<64>(PROJ + Rq * PROJ_W + C_AQ + head * 64, PROJ_W, PROJ + Rk * PROJ_W + C_AK + (head / 3) * 64, PROJ_W, PROJ + Rk * PROJ_W + C_AV + (head / 3) * 64, PROJ_W, MIX + Rq * MIXW + 384 + head * 64, MIXW, nkeys, w);
          } }
        relaunder(w);
    }
    for (int rep = 0; rep < REP_ML3; ++rep)
    for (;;) {
        const int idx = q_next(w, ctr + 512 + 64 * rep);
        if (idx >= n_ml3) break;
        if (l == 1 && idx % NCH < NC_CTX) continue;
        ml3_item(p, w, l, idx);
    }
}

DEV void moe_seg_table(const P& p, Wg& w) {
    const int* cntg = (const int*)(p.ws + WS_CNTG); int* part = (int*)w.lds;
    { const int e = w.tid & 7; int tot = 0, pre = 0;
      for (int g = w.tid >> 3; g < w.G; g += NTHR / 8) { const int c = cntg[g * NEXP + e]; tot += c; pre += (g < w.wg) ? c : 0; }
      part[2 * w.tid] = tot; part[2 * w.tid + 1] = pre; }
    __syncthreads();
    if (w.tid < NEXP) { int tot = 0, pre = 0; for (int i = 0; i < NTHR / 8; ++i) { tot += part[2 * (8 * i + w.tid)]; pre += part[2 * (8 * i + w.tid) + 1]; } w.misc[32 + w.tid] = (unsigned)tot; w.misc[48 + w.tid] = (unsigned)pre; }
    __syncthreads();
    if (w.tid == 0) { int s = 0; for (int e = 0; e < NEXP; ++e) { w.misc[16 + e] = (unsigned)s; s += ((int)w.misc[32 + e] + 255) / 256; } w.misc[16 + NEXP] = (unsigned)s; }
    __syncthreads();
}
DEV void phase_gather(const P& p, Wg& w) {
    moe_seg_table(p, w);
    const int* topi = (const int*)(p.ws + WS_TOPI); const float* topw = (const float*)(p.ws + WS_TOPW);
    int* stok = (int*)(p.ws + WS_STOK); float* sw = (float*)(p.ws + WS_SW);
    const bf16* H = (const bf16*)(p.ws + WS_H); bf16* AG = (bf16*)(p.ws + WS_AG);
    int* lc = (int*)w.lds;
    if (w.lane == 0) { for (int e = 0; e < NEXP; ++e) lc[w.wave * NEXP + e] = 0;
        for (int R = w.gw; R < M_ALL; R += w.NGW) { const int q = R % TP; if (q < CTX) continue; const int tok = (R / TP) * SEQ + q - CTX; lc[w.wave * NEXP + topi[2 * tok]]++; lc[w.wave * NEXP + topi[2 * tok + 1]]++; } }
    __syncthreads();
    if (w.tid < NEXP) { int s = (int)w.misc[16 + w.tid] * 256 + (int)w.misc[48 + w.tid]; for (int ww = 0; ww < NWAVE; ++ww) { const int c = lc[ww * NEXP + w.tid]; lc[ww * NEXP + w.tid] = s; s += c; } }
    __syncthreads();
    constexpr int NJ8 = (D_MODEL + 511) / 512;
    for (int R0 = w.gw; R0 < M_ALL; R0 += 4 * w.NGW) {
        int s0[4], s1[4]; bool ok[4];
#pragma unroll
        for (int qq = 0; qq < 4; ++qq) { const int R = R0 + qq * w.NGW; const int q = R % TP; ok[qq] = R < M_ALL && q >= CTX; const int tok = (R / TP) * SEQ + q - CTX;
            int a0 = 0, a1 = 0;
            if (w.lane == 0 && ok[qq]) { const int e0 = topi[2 * tok], e1 = topi[2 * tok + 1]; a0 = lc[w.wave * NEXP + e0]; lc[w.wave * NEXP + e0] = a0 + 1; a1 = lc[w.wave * NEXP + e1]; lc[w.wave * NEXP + e1] = a1 + 1;
                stok[a0] = tok; stok[a1] = tok; sw[a0] = topw[2 * tok]; sw[a1] = topw[2 * tok + 1]; int* tsl = (int*)(p.ws + WS_TSL) + 2 * tok; tsl[0] = a0; tsl[1] = a1; }
            s0[qq] = __shfl(a0, 0); s1[qq] = __shfl(a1, 0); }
        u32x4 v[4][NJ8];
#pragma unroll
        for (int qq = 0; qq < 4; ++qq)
#pragma unroll
            for (int j = 0; j < NJ8; ++j) { const int c = 8 * w.lane + 512 * j; if (ok[qq] && c < D_MODEL) v[qq][j] = *(const u32x4*)(H + (size_t)(R0 + qq * w.NGW) * D_MODEL + c); }
#pragma unroll
        for (int qq = 0; qq < 4; ++qq)
#pragma unroll
            for (int j = 0; j < NJ8; ++j) { const int c = 8 * w.lane + 512 * j; if (ok[qq] && c < D_MODEL) { *(u32x4*)(AG + (size_t)s0[qq] * D_MODEL + c) = v[qq][j]; *(u32x4*)(AG + (size_t)s1[qq] * D_MODEL + c) = v[qq][j]; } }
    }
    for (int e = w.wg; e < NEXP; e += w.G) { const int lo = (int)w.misc[16 + e] * 256 + (int)w.misc[32 + e], hi = (int)w.misc[16 + e + 1] * 256;
        for (int s = lo + w.wave; s < hi; s += NWAVE) { if (w.lane == 0) { stok[s] = -1; sw[s] = 0.f; }
            for (int c = 8 * w.lane; c < D_MODEL; c += 512) *(u32x4*)(AG + (size_t)s * D_MODEL + c) = (u32x4){0u, 0u, 0u, 0u}; } }
}

DEV void phase_moe_combine(const P& p, Wg& w, int c) {
    const int* tsl = (const int*)(p.ws + WS_TSL); const float* topw = (const float*)(p.ws + WS_TOPW); const bf16* YC = (const bf16*)(p.ws + WS_YC);
    const int lo = c * MOE_PCH * 256, hi = lo + MOE_PCH * 256;
    const int ptot = (int)w.misc[16 + NEXP], np = (ptot - c * MOE_PCH) < MOE_PCH ? (ptot - c * MOE_PCH) : MOE_PCH;
    if (np <= 0) return;
    const int nsp = (np * NSPLIT > MOE_PCH) ? 1 : NSPLIT; const size_t pstr = (size_t)np * 256 * D_MODEL;
    constexpr int CB = 2;
    for (int tok0 = w.gw; tok0 < NTOK; tok0 += CB * w.NGW) {
        const bf16* y0[CB]; const bf16* y1[CB]; float w0[CB], w1[CB]; bool act[CB]; bf16* xr[CB]; const float* gv[CB];
#pragma unroll
        for (int q = 0; q < CB; ++q) { const int tok = tok0 + q * w.NGW; const bool ok = tok < NTOK; const int tk = ok ? tok : 0;
            const int s0 = tsl[2 * tk], s1 = tsl[2 * tk + 1]; const bool in0 = ok && s0 >= lo && s0 < hi, in1 = ok && s1 >= lo && s1 < hi;
            act[q] = in0 || in1; w0[q] = in0 ? topw[2 * tk] : 0.f; w1[q] = in1 ? topw[2 * tk + 1] : 0.f;
            y0[q] = YC + (size_t)(in0 ? s0 - lo : 0) * D_MODEL; y1[q] = YC + (size_t)(in1 ? s1 - lo : 0) * D_MODEL;
            xr[q] = (bf16*)(p.out + (size_t)tk * D_MODEL); gv[q] = (const float*)(p.ws + WS_MODV) + (size_t)(1 * NV + tk / SEQ) * 6 * D_MODEL + 5 * D_MODEL; }
#pragma unroll
        for (int j = 0; j < D_MODEL / 256; ++j) { const int col = 4 * w.lane + 256 * j;
            f32x4 ya[CB], g[CB]; u32x2 x[CB];
#pragma unroll
            for (int q = 0; q < CB; ++q) if (act[q]) { g[q] = *(const f32x4*)(gv[q] + col); x[q] = *(const u32x2*)(xr[q] + col); ya[q] = (f32x4){0.f, 0.f, 0.f, 0.f};
                for (int ks = 0; ks < nsp; ++ks) { const u32x2 a = *(const u32x2*)(y0[q] + ks * pstr + col), bq = *(const u32x2*)(y1[q] + ks * pstr + col);
                    ya[q][0] += w0[q] * bf2f((bf16)a.x) + w1[q] * bf2f((bf16)bq.x); ya[q][1] += w0[q] * bf2f((bf16)(a.x >> 16)) + w1[q] * bf2f((bf16)(bq.x >> 16));
                    ya[q][2] += w0[q] * bf2f((bf16)a.y) + w1[q] * bf2f((bf16)bq.y); ya[q][3] += w0[q] * bf2f((bf16)(a.y >> 16)) + w1[q] * bf2f((bf16)(bq.y >> 16)); } }
#pragma unroll
            for (int q = 0; q < CB; ++q) if (act[q]) { u32x2 o;
                o.x = pk2(bf2f((bf16)x[q].x) + g[q][0] * ya[q][0], bf2f((bf16)(x[q].x >> 16)) + g[q][1] * ya[q][1]); o.y = pk2(bf2f((bf16)x[q].y) + g[q][2] * ya[q][2], bf2f((bf16)(x[q].y >> 16)) + g[q][3] * ya[q][3]);
                *(u32x2*)(xr[q] + col) = o; } }
    }
}
DEV void phase_moe_final(const P& p, Wg& w) {
    constexpr int c = MOE_NCH - 1, NJ = D_MODEL / 256;
    const int* tsl = (const int*)(p.ws + WS_TSL); const float* topw = (const float*)(p.ws + WS_TOPW); const bf16* YC = (const bf16*)(p.ws + WS_YC);
    const int lo = c * MOE_PCH * 256, hi = lo + MOE_PCH * 256;
    const int ptot = (int)w.misc[16 + NEXP], np = (ptot - c * MOE_PCH) < MOE_PCH ? (ptot - c * MOE_PCH) : MOE_PCH;
    const int nsp = (np * NSPLIT > MOE_PCH) ? 1 : NSPLIT; const size_t pstr = (size_t)(np > 0 ? np : 0) * 256 * D_MODEL;
    for (int tok0 = w.gw; tok0 < NTOK; tok0 += 2 * w.NGW) {
        f32x4 xo[2][NJ]; bool ok[2];
#pragma unroll
        for (int q = 0; q < 2; ++q) { const int tok = tok0 + q * w.NGW; ok[q] = tok < NTOK; const int tk = ok[q] ? tok : 0;
            const int s0 = tsl[2 * tk], s1 = tsl[2 * tk + 1]; const bool in0 = np > 0 && s0 >= lo && s0 < hi, in1 = np > 0 && s1 >= lo && s1 < hi;
            const float w0 = in0 ? topw[2 * tk] : 0.f, w1 = in1 ? topw[2 * tk + 1] : 0.f;
            const bf16* y0 = YC + (size_t)(in0 ? s0 - lo : 0) * D_MODEL; const bf16* y1 = YC + (size_t)(in1 ? s1 - lo : 0) * D_MODEL;
            const bf16* xr = (const bf16*)(p.out + (size_t)tk * D_MODEL); const float* gv = (const float*)(p.ws + WS_MODV) + (size_t)(1 * NV + tk / SEQ) * 6 * D_MODEL + 5 * D_MODEL;
#pragma unroll
            for (int j = 0; j < NJ; ++j) { const int col = 4 * w.lane + 256 * j; const u32x2 t = *(const u32x2*)(xr + col);
                xo[q][j] = (f32x4){bf2f((bf16)t.x), bf2f((bf16)(t.x >> 16)), bf2f((bf16)t.y), bf2f((bf16)(t.y >> 16))};
                if (in0 || in1) { f32x4 ya = (f32x4){0.f, 0.f, 0.f, 0.f};
                    for (int ks = 0; ks < nsp; ++ks) { const u32x2 a = *(const u32x2*)(y0 + ks * pstr + col), bq = *(const u32x2*)(y1 + ks * pstr + col);
                        ya[0] += w0 * bf2f((bf16)a.x) + w1 * bf2f((bf16)bq.x); ya[1] += w0 * bf2f((bf16)(a.x >> 16)) + w1 * bf2f((bf16)(bq.x >> 16));
                        ya[2] += w0 * bf2f((bf16)a.y) + w1 * bf2f((bf16)bq.y); ya[3] += w0 * bf2f((bf16)(a.y >> 16)) + w1 * bf2f((bf16)(bq.y >> 16)); }
                    xo[q][j] = xo[q][j] + *(const f32x4*)(gv + col) * ya; } } }
        wave_sync();
#pragma unroll
        for (int q = 0; q < 2; ++q) if (ok[q]) { float* orow = p.out + (size_t)(tok0 + q * w.NGW) * D_MODEL;
#pragma unroll
            for (int j = 0; j < NJ; ++j) *(f32x4*)(orow + 4 * w.lane + 256 * j) = xo[q][j]; }
    }
}

constexpr int PH_L = 24;
constexpr int N_PHASES = 1 + 2 * PH_L;
#ifndef PROBE_MUL
#define PROBE_MUL 1
#endif
#ifdef EMU
#define GRID_BAR() do {} while (0)
#define DYN_LDS() unsigned char* lds = EMU_DYN_LDS()
#else
#define GRID_BAR() xcd_barrier(bar)
#define DYN_LDS() extern __shared__ __attribute__((aligned(16))) unsigned char lds[]
#endif
__global__ void __launch_bounds__(NTHR, 2) fwd(P p_in) {
    DYN_LDS();
    Wg w; w.tid = threadIdx.x; w.lane = w.tid & 63;
#ifndef EMU
    w.wave = __builtin_amdgcn_readfirstlane(w.tid >> 6);
#else
    w.wave = w.tid >> 6;
#endif
    w.G = gridDim.x; w.wg = blockIdx.x; w.gw = w.wg * NWAVE + w.wave; w.NGW = w.G * NWAVE; w.lds = lds; w.misc = (unsigned*)(lds + LDS_MISC);
    if (w.tid < 64) w.misc[w.tid] = 0u;
    __syncthreads();
#ifndef EMU
    XcdBarrier bar = xcd_barrier_post((unsigned*)(p_in.ws + WS_CTL) + CW_BAR, (volatile LAS unsigned*)(w.misc));
#endif
    const int lo = p_in.ph_lo, hi = p_in.ph_hi; const int wave_s = w.wave; (void)wave_s;
#ifndef PH_MASK
#define PH_MASK 0xffffffffu
#endif
#if defined(PROBE_SET) && !defined(EMU)
#define PROBE_T0(k) if (blockIdx.x == 0 && threadIdx.x == 0) { ((unsigned*)(lds + LDS_MISC))[64 + 2 * (k)] = (unsigned)wall_clock64(); }
#define PROBE_T1(k) if (blockIdx.x == 0 && threadIdx.x == 0) { ((unsigned*)(lds + LDS_MISC))[65 + 2 * (k)] = (unsigned)wall_clock64(); }
#define PROBE_SPLIT(k, vk) { GRID_BAR(); if (blockIdx.x == 0 && threadIdx.x == 0) { unsigned* m_ = (unsigned*)(lds + LDS_MISC); m_[64 + 2 * (vk)] = m_[64 + 2 * (k)]; m_[65 + 2 * (vk)] = (unsigned)wall_clock64(); } }
#else
#define PROBE_T0(k)
#define PROBE_T1(k)
#define PROBE_SPLIT(k, vk)
#endif
#ifndef EMU
#define TID_NOW() (wave_s * 64 + lane_fresh())
#define WAVE_OF(t) __builtin_amdgcn_readfirstlane((t) >> 6)
#else
#define TID_NOW() ((int)threadIdx.x)
#define WAVE_OF(t) ((t) >> 6)
#endif
#ifndef EMU
#define LOAD_P() const __attribute__((address_space(4))) P* pq_ = (const __attribute__((address_space(4))) P*)__builtin_amdgcn_kernarg_segment_ptr(); asm volatile("" : "+s"(pq_)); const P p = *(const P*)pq_;
#else
#define LOAD_P() const P& p = p_in;
#endif
#define PH_BEGIN(k) if (((PH_MASK >> ((k) - pb_)) & 1u) && lo <= (k) && (k) < hi) { LOAD_P() { int t_ = TID_NOW(); OPAQUE_V(t_); w.tid = t_; w.lane = t_ & 63; w.wave = WAVE_OF(t_); w.gw = w.wg * NWAVE + w.wave; } PROBE_T0(k)
#define PH_END(k) if ((k) + 1 < hi) GRID_BAR(); PROBE_T1(k) }
    { const int pb_ = -31; PH_BEGIN(0) phase0(p, w); PH_END(0) }
    for (int l = 0; l < 2; ++l) {
        const int pb = 1 + PH_L * l, pb_ = pb;
        PH_BEGIN(pb + 0) if (l == 0) phase_modulate<2>(p, w, 0, 0, true, false, false, false); else phase_modulate<4>(p, w, 1, 0, false, false, false, true); PH_END(pb + 0)
        PH_BEGIN(pb + 1) {
            pg8::Gemm g{(const bf16*)(p.ws + WS_H), (const bf16*)(p.ws + WS_WIN_T) + (size_t)l * PROJ_W * D_MODEL, D_MODEL, D_MODEL, D_MODEL, 0};
            Sched<0> S; S.o.init(NPAN, PROJ_W / 256, w.G, w.wg, SITE_WGM(0)); S.pm_base = 0; S.seg = nullptr; S.nNc = 0; S.kper = 0;
            EpiStore E{(bf16*)(p.ws + WS_PROJ), PROJ_W, (float*)(p.ws + WS_GATES)};
            { const TabSched T_ = build_units(w.misc, w.tid, S); pg8::gemm_phase<EpiStore, TabSched>(w.lds, w.tid, g, T_, E); } } PH_END(pb + 1)
        PH_BEGIN(pb + 2) phase_prep(p, w, l); PH_END(pb + 2)
        PH_BEGIN(pb + 3) {
            pg8::Gemm g{(const bf16*)(p.ws + WS_PROJ) + C_CQ, (const bf16*)(p.ws + WS_MLA_T) + (size_t)l * 1024 * 512, PROJ_W, 512, 256, 0};
            Sched<6> S; S.o.init(NPAN, 4, w.G, w.wg, SITE_WGM(1)); S.pm_base = 0; S.seg = nullptr; S.nNc = 0; S.kper = 0;
            EpiStore E{(bf16*)(p.ws + WS_MLAQ), 1024, nullptr};
            { const TabSched T_ = build_units(w.misc, w.tid, S); pg8::gemm_phase<EpiStore, TabSched>(w.lds, w.tid, g, T_, E); }
            __syncthreads();
            PROBE_SPLIT(pb + 3, 49 + 3 * l)
#ifndef NO_ML1
            for (int it = w.G - 1 - w.wg; it < BATCH * 4 * NCH; it += w.G) ml1_item(p, w, l, it);
#endif
            } PH_END(pb + 3)
        PH_BEGIN(pb + 4) phase_mla_post(p, w, l); PROBE_SPLIT(pb + 4, 50 + 3 * l) phase_ml2(p, w); PH_END(pb + 4)
        PH_BEGIN(pb + 5) phase_mix(p, w, l); PH_END(pb + 5)
        PH_BEGIN(pb + 6) {
            pg8::Gemm g{(const bf16*)(p.ws + WS_H), (const bf16*)(p.ws + WS_WOUT_T) + (size_t)l * D_MODEL * MIXW, MIXW, MIXW, MIXW, 0};
            Sched<0> S0; Sched<1> S1; S0.o.init(NPAN, D_MODEL / 256, w.G, w.wg, SITE_WGM(2)); S1.o.init(BATCH * NQL, D_MODEL / 256, w.G, w.wg, SITE_WGM(3)); S0.pm_base = 0; S0.seg = nullptr; S0.nNc = 0; S0.kper = 0; S1.pm_base = 0; S1.seg = nullptr; S1.nNc = 0; S1.kper = 0;
            if (l == 0) { EpiResid<true> E{p, l, 2 * D_MODEL}; const TabSched T_ = build_units(w.misc, w.tid, S0); pg8::gemm_phase<EpiResid<true>, TabSched>(w.lds, w.tid, g, T_, E); }
            else { EpiResid<false> E{p, l, 2 * D_MODEL}; const TabSched T_ = build_units(w.misc, w.tid, S1); pg8::gemm_phase<EpiResid<false>, TabSched>(w.lds, w.tid, g, T_, E); } } PH_END(pb + 6)
        if (l == 0) {
            PH_BEGIN(pb + 7) phase_modulate<4>(p, w, 0, 1, false, false, false, false); PH_END(pb + 7)
            PH_BEGIN(pb + 8) {
                pg8::Gemm g{(const bf16*)(p.ws + WS_H), (const bf16*)(p.ws + WS_WGU_T), D_MODEL, D_MODEL, D_MODEL, 0};
                Sched<0> S; S.o.init(NPAN, 2 * D_FF / 256, w.G, w.wg, SITE_WGM(4)); S.pm_base = 0; S.seg = nullptr; S.nNc = 0; S.kper = 0;
                EpiSwiglu E{(bf16*)(p.ws + WS_ACT), 0};
                { const TabSched T_ = build_units(w.misc, w.tid, S); pg8::gemm_phase<EpiSwiglu, TabSched>(w.lds, w.tid, g, T_, E); } } PH_END(pb + 8)
            PH_BEGIN(pb + 9) {
                { pg8::Gemm g{(const bf16*)(p.ws + WS_ACT), (const bf16*)(p.ws + WS_WD_T), D_FF, D_FF, D_FF, 0};
                  Sched<1> S; S.o.init(BATCH * NQL, D_MODEL / 256, w.G, w.wg, SITE_WGM(5)); S.pm_base = 0; S.seg = nullptr; S.nNc = 0; S.kper = 0;
                  EpiResid<false> E{p, 0, 5 * D_MODEL};
                  { const TabSched T_ = build_units(w.misc, w.tid, S); pg8::gemm_phase<EpiResid<false>, TabSched>(w.lds, w.tid, g, T_, E); } }
                __syncthreads();
                { pg8::Gemm g{(const bf16*)(p.ws + WS_ACT), (const bf16*)(p.ws + WS_WD_T), D_FF, D_FF, KSPLIT, 0};
                  Sched<4> S; S.o.init(BATCH, (D_MODEL / 256) * NSPLIT, w.G, w.wg, SITE_WGM(6)); S.pm_base = 0; S.seg = nullptr; S.nNc = D_MODEL / 256; S.kper = KSPLIT;
                  EpiStoreRel E{(bf16*)(p.ws + WS_MLAQ), D_MODEL, 0};
                  { const TabSched T_ = build_units(w.misc, w.tid, S); pg8::gemm_phase<EpiStoreRel, TabSched>(w.lds, w.tid, g, T_, E); } } } PH_END(pb + 9)
        } else {
            PH_BEGIN(pb + 7) phase_modulate<1>(p, w, 1, 1, false, true, true, false); PROBE_SPLIT(pb + 7, 51 + 3 * l) phase_moe_weights(p, w); PH_END(pb + 7)
            PH_BEGIN(pb + 8) phase_gather(p, w); PH_END(pb + 8)
            for (int c = 0; c < MOE_NCH; ++c) {
                PH_BEGIN(pb + 9 + 2 * c) {
                    moe_seg_table(p, w);
                    const int ptot = (int)w.misc[16 + NEXP], pm0 = c * MOE_PCH, np = (ptot - pm0) < MOE_PCH ? (ptot - pm0) : MOE_PCH;
                    if (c > 0 && (w.wg & 1)) phase_moe_combine(p, w, c - 1);
                    if (np > 0) {
                        pg8::Gemm g{(const bf16*)(p.ws + WS_AG), (const bf16*)(p.ws + WS_MOEW), D_MODEL, D_MODEL, D_MODEL, MOEW_E};
                        Sched<2> S; S.o.init(np, 2 * D_FF / 256, w.G, w.wg, SITE_WGM(7)); S.pm_base = pm0; S.seg = (const int*)(w.misc + 16); S.nNc = 0; S.kper = 0;
                        EpiSwiglu E{(bf16*)(p.ws + WS_ACT2), pm0};
                        { const TabSched T_ = build_units(w.misc, w.tid, S); pg8::gemm_phase<EpiSwiglu, TabSched>(w.lds, w.tid, g, T_, E); } }
                    if (c > 0 && !(w.wg & 1)) phase_moe_combine(p, w, c - 1); } PH_END(pb + 9 + 2 * c)
                PH_BEGIN(pb + 10 + 2 * c) {
                    moe_seg_table(p, w);
                    const int ptot = (int)w.misc[16 + NEXP], pm0 = c * MOE_PCH, np = (ptot - pm0) < MOE_PCH ? (ptot - pm0) : MOE_PCH;
                    if (np > 0 && np * NSPLIT > MOE_PCH) {
                        pg8::Gemm g{(const bf16*)(p.ws + WS_ACT2), (const bf16*)(p.ws + WS_MOEW) + (size_t)2 * D_FF * D_MODEL, D_FF, D_FF, D_FF, MOEW_E};
                        Sched<3> S; S.o.init(np, D_MODEL / 256, w.G, w.wg, SITE_WGM(8)); S.pm_base = pm0; S.seg = (const int*)(w.misc + 16); S.nNc = 0; S.kper = 0;
                        EpiStoreRel E{(bf16*)(p.ws + WS_YC), D_MODEL, 0};
                        { const TabSched T_ = build_units(w.misc, w.tid, S); pg8::gemm_phase<EpiStoreRel, TabSched>(w.lds, w.tid, g, T_, E); } }
                    else if (np > 0) {
                        pg8::Gemm g{(const bf16*)(p.ws + WS_ACT2), (const bf16*)(p.ws + WS_MOEW) + (size_t)2 * D_FF * D_MODEL, D_FF, D_FF, KSPLIT, MOEW_E};
                        Sched<5> S; S.o.init(np, (D_MODEL / 256) * NSPLIT, w.G, w.wg, SITE_WGM(9)); S.pm_base = pm0; S.seg = (const int*)(w.misc + 16); S.nNc = D_MODEL / 256; S.kper = KSPLIT;
                        EpiStoreRel E{(bf16*)(p.ws + WS_YC), D_MODEL, 0};
                        { const TabSched T_ = build_units(w.misc, w.tid, S); pg8::gemm_phase<EpiStoreRel, TabSched>(w.lds, w.tid, g, T_, E); } } } PH_END(pb + 10 + 2 * c)
            }
            PH_BEGIN(pb + 9 + 2 * MOE_NCH) moe_seg_table(p, w); phase_moe_final(p, w); PH_END(pb + 9 + 2 * MOE_NCH)
        }
    }
#if defined(PROBE_SET) && !defined(EMU)
    if (blockIdx.x == 0 && threadIdx.x == 0) {
        unsigned tot = 0; for (int k = 0; k < 56; ++k) if ((PROBE_SET >> k) & 1ull) tot += ((unsigned*)(lds + LDS_MISC))[65 + 2 * k] - ((unsigned*)(lds + LDS_MISC))[64 + 2 * k];
        const unsigned long long t0 = wall_clock64(); while (wall_clock64() - t0 < (unsigned long long)tot * PROBE_MUL) __builtin_amdgcn_s_sleep(8);
    }
#endif
}

#ifndef MK_PER_PHASE
#define MK_PER_PHASE 0
#endif
extern "C" void kernel_launch(void* const* d_in, const int* in_sizes, int n_in, void* d_out, int out_size, void* d_ws, size_t ws_size, hipStream_t stream) {
    static int grid = 0;
    if (grid == 0) {
        if (n_in != 28 || in_sizes[0] != BATCH * SEQ * D_MODEL || out_size != BATCH * SEQ * D_MODEL || ws_size < WS_TOTAL) {
            fprintf(stderr, "kernel_launch: unexpected problem (n_in %d, x %d, out %d, ws %zu < %zu)\n", n_in, n_in > 0 ? in_sizes[0] : -1, out_size, ws_size, (size_t)WS_TOTAL); grid = -1; return; }
#ifndef EMU
        int dev = 0, cus = 0;
        if (hipGetDevice(&dev) != hipSuccess || hipDeviceGetAttribute(&cus, hipDeviceAttributeMultiprocessorCount, dev) != hipSuccess) { grid = -1; return; }
        if (hipFuncSetAttribute((const void*)fwd, hipFuncAttributeMaxDynamicSharedMemorySize, LDS_BYTES) != hipSuccess) { fprintf(stderr, "kernel_launch: hipFuncSetAttribute failed\n"); grid = -1; return; }
        int per_cu = 0;
        if (hipOccupancyMaxActiveBlocksPerMultiprocessor(&per_cu, (const void*)fwd, NTHR, LDS_BYTES) != hipSuccess || per_cu < 1) { fprintf(stderr, "kernel_launch: occupancy query says %d\n", per_cu); (void)hipGetLastError(); }
        grid = cus;
#else
        grid = 8;
#endif
    }
    if (grid < 0) return;
    (void)hipMemsetAsync((char*)d_ws + WS_CTL, 0, CTL_BYTES, stream);
    P p{};
    const float** pp = (const float**)&p;
    for (int i = 0; i < 28; ++i) pp[i] = (const float*)d_in[i];
    p.out = (float*)d_out; p.ws = (unsigned char*)d_ws;
#if MK_PER_PHASE
    for (int k = 0; k < N_PHASES; ++k) {
        if (k >= 1 + 10 && k < 1 + PH_L) continue;
        if (k >= 1 + PH_L + 10 + 2 * MOE_NCH) continue;
        p.ph_lo = k; p.ph_hi = k + 1;
        hipLaunchKernelGGL(fwd, dim3(grid), dim3(NTHR), LDS_BYTES, stream, p);
    }
#else
    p.ph_lo = 0; p.ph_hi = N_PHASES;
    hipLaunchKernelGGL(fwd, dim3(grid), dim3(NTHR), LDS_BYTES, stream, p);
#endif
}
```

```cpp
#ifndef EMU
#include <hip/hip_runtime.h>
#endif
#include <cstdio>
#include <cstdint>
#include <cmath>

#ifdef CFG_TINY
constexpr int D_MODEL = 256, BATCH = 2, SEQ = 512, CTX = 256, GRID_W = 16, D_FF = 512;
constexpr int MOE_PCH = 4, NSPLIT = 2;
#else
constexpr int D_MODEL = 1024, BATCH = 8, SEQ = 4096, CTX = 256, GRID_W = 64, D_FF = 3584;
constexpr int MOE_PCH = 64, NSPLIT = 7;
#endif
constexpr int TP = CTX + SEQ, M_ALL = BATCH * TP, NPAN = M_ALL / 256, PAN_B = TP / 256, NQL = SEQ / 256;
constexpr int MCH = 128;
constexpr int NCH = TP / MCH, NC_CTX = CTX / MCH, NQB = MCH / 32;
constexpr int PROJ_W = 2816, MIXW = 1024, NEXP = 8;
constexpr int C_MQ = 0, C_MK = 384, C_MV = 768, C_MO = 1152, C_G = 1536, C_AQ = 1552, C_AK = 1936, C_AV = 2064, C_CQ = 2192, C_CKV = 2448, C_KR = 2576, IN_W = 2608;
constexpr int NV = BATCH + 1;
constexpr int NCHAIN = BATCH * 4 * 2, NITEM = NCHAIN * NCH;
constexpr int NTOK = BATCH * SEQ, NSLOTP = NTOK * 2 + NEXP * 256;
constexpr int MOE_NCH = (NSLOTP / 256 + MOE_PCH - 1) / MOE_PCH;
constexpr float EPS = 1e-6f, LOG2E = 1.4426950408889634f;
constexpr float QSCALE_A = 0.125f * LOG2E, QSCALE_L = 0.10206207261596575f * LOG2E, KSCALE_M = 0.10206207261596575f;
constexpr int NTHR = 512, NWAVE = 8;
constexpr int KSPLIT = D_FF / NSPLIT;
constexpr int MLAP = 1024 + 64;
static_assert(KSPLIT % 128 == 0 && KSPLIT >= 256 && NSPLIT * BATCH * 256 * D_MODEL * 2 <= M_ALL * 1024 * 2, "split-K geometry");
constexpr int NPOS = (SEQ / GRID_W > GRID_W) ? SEQ / GRID_W : GRID_W;

typedef unsigned short bf16;
#ifndef EMU
typedef short bf16x8 __attribute__((ext_vector_type(8)));
typedef short s16x4 __attribute__((ext_vector_type(4)));
typedef float f32x4 __attribute__((ext_vector_type(4)));
typedef float f32x2 __attribute__((ext_vector_type(2)));
typedef float f32x16 __attribute__((ext_vector_type(16)));
typedef unsigned u32x4 __attribute__((ext_vector_type(4)));
typedef unsigned u32x2 __attribute__((ext_vector_type(2)));
#define DEV __device__ __forceinline__
DEV f32x16 mfma32(bf16x8 a, bf16x8 b, f32x16 c) { return __builtin_amdgcn_mfma_f32_32x32x16_bf16(a, b, c, 0, 0, 0); }
DEV void wave_sync() { asm volatile("s_waitcnt vmcnt(0) lgkmcnt(0)" ::: "memory"); __builtin_amdgcn_wave_barrier(); }
typedef __bf16 bf16x2_hw __attribute__((ext_vector_type(2)));
typedef short v4i16_t __attribute__((ext_vector_type(4)));
DEV unsigned pk2_hw(float lo, float hi) { f32x2 v = {lo, hi}; bf16x2_hw b = __builtin_convertvector(v, bf16x2_hw); return __builtin_bit_cast(unsigned, b); }
DEV s16x4 lds_tr_read(const unsigned short* a) { return __builtin_bit_cast(s16x4, __builtin_amdgcn_ds_read_tr16_b64_v4i16((__attribute__((address_space(3))) v4i16_t*)(a))); }
DEV float exp2_fast(float x) { return __builtin_amdgcn_exp2f(x); }
DEV float rcp_fast(float x) { return __builtin_amdgcn_rcpf(x); }
DEV float rsqrt_fast(float x) { return __builtin_amdgcn_rsqf(x); }
DEV void atomic_addf(float* p, float v) { unsafeAtomicAdd(p, v); }
#define OPAQUE_V(x) asm volatile("" : "+v"(x))
#define SCHED_FENCE() __builtin_amdgcn_sched_barrier(0)
#define UNIFORM_I(x) __builtin_amdgcn_readfirstlane(x)
DEV unsigned fau(float f) { return __float_as_uint(f); }
DEV float uaf(unsigned u) { return __uint_as_float(u); }
DEV float my_shfl_xor(float v, int m, int lane) { return __int_as_float(__builtin_amdgcn_ds_bpermute((lane ^ m) << 2, __float_as_int(v))); }
#define SHX(v, m, lane) my_shfl_xor((v), (m), (lane))
DEV float my_shfl(float v, int src) { return __int_as_float(__builtin_amdgcn_ds_bpermute((src & 63) << 2, __float_as_int(v))); }
DEV int my_shfl(int v, int src) { return __builtin_amdgcn_ds_bpermute((src & 63) << 2, v); }
#define __shfl my_shfl
DEV int lane_fresh() { int l_; asm volatile("v_mbcnt_lo_u32_b32 %0, -1, 0\n\tv_mbcnt_hi_u32_b32 %0, -1, %0" : "=v"(l_)); return l_; }
#else
#define DEV inline
#define OPAQUE_V(x) do {} while (0)
#define SCHED_FENCE() do {} while (0)
#define UNIFORM_I(x) (x)
#define SHX(v, m, lane) __shfl_xor((v), (m))
DEV void wave_sync() { (void)emu_shfl_u(0u, emu::B->cur & 63); }
DEV void atomic_addf(float* p, float v) { atomicAdd(p, v); }
DEV float rsqrt_fast(float x) { return 1.0f / sqrtf(x); }
DEV unsigned fau(float f) { unsigned u; memcpy(&u, &f, 4); return u; }
DEV float uaf(unsigned u) { float f; memcpy(&f, &u, 4); return f; }
#endif
DEV bf16 f2bf(float f) { unsigned u = fau(f); u += 0x7fffu + ((u >> 16) & 1u); return (bf16)(u >> 16); }
DEV float bf2f(bf16 h) { return uaf(((unsigned)h) << 16); }
#ifndef EMU
DEV unsigned pk2(float lo, float hi) { return pk2_hw(lo, hi); }
#else
DEV unsigned pk2(float lo, float hi) { return (unsigned)f2bf(lo) | ((unsigned)f2bf(hi) << 16); }
#endif
DEV float wave_sum(float v, int lane) {
#pragma unroll
    for (int o = 1; o < 64; o <<= 1) v += SHX(v, o, lane);
    return v;
}
DEV float wave_max(float v, int lane) {
#pragma unroll
    for (int o = 1; o < 64; o <<= 1) v = fmaxf(v, SHX(v, o, lane));
    return v;
}
DEV float silu_f(float x) { return x / (1.0f + __expf(-x)); }
DEV float silu_fast(float x) { return x * rcp_fast(1.0f + exp2_fast(-x * LOG2E)); }
DEV float sigmoid_f(float x) { return rcp_fast(1.0f + exp2_fast(-x * LOG2E)); }
DEV float log_sigmoid_f(float x) { return x >= 0.f ? -log1pf(expf(-x)) : x - log1pf(expf(x)); }
DEV int crow(int i, int h) { return (i & 3) + 8 * (i >> 2) + 4 * h; }

constexpr size_t al256(size_t x) { return (x + 255) & ~(size_t)255; }
constexpr size_t WS_CTL = 0, CTL_BYTES = 65536;
constexpr int CW_Q = 0;
constexpr int CW_BAR = 4096;
constexpr size_t WS_MODV = WS_CTL + CTL_BYTES;
constexpr size_t WS_WIN_T = al256(WS_MODV + (size_t)2 * NV * 6 * D_MODEL * 4);
constexpr size_t WS_WOUT_T = al256(WS_WIN_T + (size_t)2 * PROJ_W * D_MODEL * 2);
constexpr size_t WS_MLA_T = al256(WS_WOUT_T + (size_t)2 * D_MODEL * MIXW * 2);
constexpr size_t WS_WGU_T = al256(WS_MLA_T + (size_t)2 * 1024 * 512 * 2);
constexpr size_t WS_WD_T = al256(WS_WGU_T + (size_t)2 * D_FF * D_MODEL * 2);
constexpr size_t WS_CX = al256(WS_WD_T + (size_t)D_MODEL * D_FF * 2);
constexpr size_t WS_GATES = al256(WS_CX + (size_t)BATCH * CTX * D_MODEL * 4);
constexpr size_t WS_NL = al256(WS_GATES + (size_t)M_ALL * 16 * 4);
constexpr size_t WS_FS = al256(WS_NL + (size_t)NITEM * 96 * 4);
constexpr size_t WS_PML = al256(WS_FS + (size_t)NITEM * 4);
constexpr size_t WS_MST = al256(WS_PML + (size_t)NITEM * 4);
constexpr size_t WS_TOPI = al256(WS_MST + (size_t)NITEM * 4);
constexpr size_t WS_TOPW = al256(WS_TOPI + (size_t)NTOK * 2 * 4);
constexpr size_t WS_CNTG = al256(WS_TOPW + (size_t)NTOK * 2 * 4);
constexpr size_t WS_STOK = al256(WS_CNTG + (size_t)1024 * 8 * 4);
constexpr size_t WS_SW = al256(WS_STOK + (size_t)NSLOTP * 4);
constexpr size_t WS_TSL = al256(WS_SW + (size_t)NSLOTP * 4);
constexpr size_t WS_ROPE = al256(WS_TSL + (size_t)NTOK * 2 * 4);
constexpr size_t WS_PROJ = al256(WS_ROPE + (size_t)NPOS * 24 * 2 * 4);
constexpr size_t WS_MQK = al256(WS_PROJ + (size_t)M_ALL * PROJ_W * 2);
constexpr size_t WS_MLAQ = al256(WS_MQK + (size_t)M_ALL * 768 * 2);
constexpr size_t WS_UC = al256(WS_MLAQ + (size_t)M_ALL * MLAP * 2);
constexpr size_t WS_H = al256(WS_UC + (size_t)NITEM * 9216 * 2);
constexpr size_t WS_END0 = al256(WS_H + (size_t)M_ALL * 1024 * 2);
constexpr size_t WS_ACT = WS_PROJ;
constexpr size_t WS_MOEW = WS_PROJ;
constexpr size_t MOEW_E = (size_t)3 * D_FF * D_MODEL * 2;
constexpr size_t WS_ACT2 = al256(WS_MOEW + NEXP * MOEW_E);
constexpr size_t WS_YC = al256(WS_ACT2 + (size_t)MOE_PCH * 256 * D_FF * 2);
constexpr size_t WS_ROWMAP = al256(WS_YC + (size_t)MOE_PCH * 256 * D_MODEL * 2);
#ifdef CFG_TINY
constexpr size_t WS_TOTAL = WS_END0 + (4u << 20);
#else
constexpr size_t WS_TOTAL = (size_t)512 << 20;
#endif
static_assert(WS_END0 <= WS_TOTAL, "ws map");
constexpr int ML2_U = (NCH % 17 == 0) ? 17 : ((NCH % 4 == 0) ? 4 : 2);
static_assert(NCH % ML2_U == 0, "ML2 unroll");
static_assert(WS_ACT + (size_t)M_ALL * D_FF * 2 <= WS_MLAQ, "dense ACT overlays PROJ+MQK only");
static_assert(WS_MOEW + NEXP * MOEW_E <= WS_MQK, "MoE weights overlay PROJ only");
static_assert(WS_ROWMAP + (size_t)NSLOTP * 4 <= WS_H, "MoE chunk buffers and the row map end before H (the normalised rows the experts read)");

constexpr int LDS_STAGE = 131072;
constexpr int LDS_MISC = LDS_STAGE;
constexpr int LDS_ROWTAB = LDS_STAGE + 4096;
constexpr int LDS_BYTES = LDS_STAGE + 4096 + 8192;

struct P {
    const float *x, *c, *ctx, *c_ctx, *mod_w, *mod_b, *norm_mix, *norm_ffn, *w_in, *m_conv, *m_gate_b, *m_norm, *a_qnorm, *a_knorm, *l_cq_norm, *l_ckv_norm,
        *l_wuq, *l_wukv, *l_qnorm, *l_knorm, *w_out, *ffn_wg, *ffn_wu, *ffn_wd, *moe_router, *moe_wg, *moe_wu, *moe_wd;
    float* out; unsigned char* ws; int ph_lo, ph_hi;
};
constexpr int RPITCH = 2 * D_MODEL;
DEV bf16* resid_row(const P& p, int R) {
    const int b = R / TP, q = R % TP;
    return q < CTX ? (bf16*)(p.ws + WS_CX) + (size_t)(b * CTX + q) * RPITCH : (bf16*)(p.out + (size_t)(b * SEQ + q - CTX) * D_MODEL);
}
DEV const float* modv(const P& p, int l, int R) { const int b = R / TP, q = R % TP; return (const float*)(p.ws + WS_MODV) + (size_t)(l * NV + (q < CTX ? BATCH : b)) * 6 * D_MODEL; }

namespace pg8 {
constexpr int BM = 256, BK = 64, HALF = 128, HTB = HALF * BK * 2, STAGE_BYTES = 8 * HTB, NXCD = 8, WGM = 8;
struct Unit { int pm, pn, e, k0, po; };
struct Gemm { const bf16* A; const bf16* Bt; int lda, ldb, K; size_t bstride; const int* rowmap; };
DEV int lds_byte(int r, int c) { const int st = (r >> 4) * 2 + (c >> 5), rr = r & 15, cc = c & 31, ob = rr * 64 + cc * 2; return st * 1024 + (ob ^ (((ob >> 9) & 1) << 5)); }
DEV void stage_rc(int b, int& R, int& C) { const int st = b / 1024, sb = b % 1024, swz = sb ^ (((sb >> 9) & 1) << 5); R = (st >> 1) * 16 + swz / 64; C = (st & 1) * 32 + (swz % 64) / 2; }
DEV int perm32(int rho) { const int n = rho >> 4, i = rho & 15; return 8 * (i >> 2) + 4 * n + (i & 3); }
struct Order {
    int nM, nN, nwg, G, c, wgm;
    DEV void init(int nM_, int nN_, int G_, int c_, int wgm_ = WGM) { nM = nM_; nN = nN_; nwg = nM * nN; G = G_; c = c_; wgm = wgm_; }
    DEV bool nextL(int i, int& lm, int& ln) const {
        const long L = (long)i * G + c; if (L >= nwg) return false;
        int wgid = (int)L; { const int q = nwg / NXCD, r = nwg % NXCD, xcd = wgid % NXCD, off = wgid / NXCD; wgid = (xcd < r ? xcd * (q + 1) : r * (q + 1) + (xcd - r) * q) + off; }
        const int nig = wgm * nN, gid = wgid / nig, fm = gid * wgm, gsz = (nM - fm) < wgm ? (nM - fm) : wgm;
        lm = fm + ((wgid % nig) % gsz); ln = (wgid % nig) / gsz; return true;
    }
};
#ifndef EMU
#define PG8_LAS __attribute__((address_space(3)))
DEV unsigned cvt_pk_bf16(float lo, float hi) { unsigned r; asm volatile("v_cvt_pk_bf16_f32 %0, %1, %2" : "=v"(r) : "v"(lo), "v"(hi)); return r; }
template <class Epi, class Sched, bool GATHER = false>
DEV void gemm_phase(unsigned char* lds_, const int tid, const Gemm g, const Sched& S, const Epi& E) {
    PG8_LAS unsigned char* lds = (PG8_LAS unsigned char*)lds_;
    const int wid = __builtin_amdgcn_readfirstlane(tid >> 6), lane = tid & 63, wr = wid >> 2, wc = wid & 3, fr = lane & 15, fq = lane >> 4;
    const int K = g.K, nt = K / BK, lda = g.lda, ldb = g.ldb;
    unsigned voffA[2], voffB[2];
#pragma unroll
    for (int i = 0; i < 2; ++i) { int R, C; stage_rc(tid * 16 + i * 8192, R, C); const int Rb = Epi::PERM ? ((R & ~31) + perm32(R & 31)) : R;
        voffA[i] = (unsigned)(R * lda + C) * 2u; voffB[i] = (unsigned)(Rb * ldb + C) * 2u; }
    unsigned vgc0[2] = {0u, 0u}, vgc1[2] = {0u, 0u}, vgn0[2] = {0u, 0u}, vgn1[2] = {0u, 0u};
    const PG8_LAS int* rtab = (const PG8_LAS int*)(lds + LDS_ROWTAB);
#define PG8_GOFF(dst0, dst1, ui_) do { _Pragma("unroll") for (int _i = 0; _i < 2; ++_i) { int R_, C_; stage_rc(tid * 16 + _i * 8192, R_, C_); \
        dst0[_i] = (unsigned)(rtab[(ui_) * 256 + R_] * lda + C_) * 2u; dst1[_i] = (unsigned)(rtab[(ui_) * 256 + 128 + R_] * lda + C_) * 2u; } } while (0)
    const size_t kstep = (size_t)(BK * 2);
    const size_t hstepA = (size_t)HALF * lda * 2, hstepB = (size_t)HALF * ldb * 2;
    const size_t tstepA = 2 * hstepA, tstepB = 2 * hstepB;
    const unsigned ldsw = (unsigned)wid * 1024u;
    const int aoff = lds_byte(wr * 64 + fr, fq * 8), boff = lds_byte(wc * 32 + fr, fq * 8);
#define PG8_SA(b, h) (((b) * 2 + (h)) * HTB)
#define PG8_SB(b, h) ((4 + (b) * 2 + (h)) * HTB)
#define PG8_STAGE(bufoff, gbase, voff) do { _Pragma("unroll") for (int _i = 0; _i < 2; ++_i) \
        __builtin_amdgcn_global_load_lds((const unsigned*)((const char*)(gbase) + (voff)[_i]), (PG8_LAS unsigned*)(lds + (bufoff) + ldsw + _i * 8192), 16, 0, 0); } while (0)
#define PG8_LDA(dst, b, h) do { _Pragma("unroll") for (int m = 0; m < 4; ++m) _Pragma("unroll") for (int k = 0; k < 2; ++k) dst[m][k] = *(const PG8_LAS bf16x8*)(lds + PG8_SA(b, h) + aoff + m * 2048 + k * 1024); } while (0)
#define PG8_LDB(dst, b, h) do { _Pragma("unroll") for (int n = 0; n < 2; ++n) _Pragma("unroll") for (int k = 0; k < 2; ++k) dst[n][k] = *(const PG8_LAS bf16x8*)(lds + PG8_SB(b, h) + boff + n * 2048 + k * 1024); } while (0)
#define PG8_MMA(ai, bj, At, Bt) do { __builtin_amdgcn_s_setprio(1); _Pragma("unroll") for (int m = 0; m < 4; ++m) _Pragma("unroll") for (int n = 0; n < 2; ++n) _Pragma("unroll") for (int k = 0; k < 2; ++k) \
        acc[ai][bj][m][n] = __builtin_amdgcn_mfma_f32_16x16x32_bf16(Bt[n][k], At[m][k], acc[ai][bj][m][n], 0, 0, 0); __builtin_amdgcn_s_setprio(0); } while (0)
#define PG8_WAIT_V(n) asm volatile("s_waitcnt vmcnt(" #n ")" ::: "memory")
#define PG8_WAIT_L(n) asm volatile("s_waitcnt lgkmcnt(" #n ")" ::: "memory")
#define PG8_BAR __builtin_amdgcn_s_barrier()
#define PG8_SCHED __builtin_amdgcn_sched_barrier(0)
    Unit cur, nxt; int ui = 0;
    if (!S.next(0, cur)) return;
    f32x4 acc[2][2][4][2];
#pragma unroll
    for (int a = 0; a < 2; ++a)
#pragma unroll
        for (int b = 0; b < 2; ++b)
#pragma unroll
            for (int m = 0; m < 4; ++m)
#pragma unroll
                for (int n = 0; n < 2; ++n) acc[a][b][m][n] = (f32x4){0.f, 0.f, 0.f, 0.f};
    bf16x8 At[4][2], B0[2][2], B1[2][2];
    if (GATHER) PG8_GOFF(vgc0, vgc1, 0);
    const char* cA = (const char*)g.A + (GATHER ? (size_t)0 : (size_t)cur.pm * tstepA) + (size_t)cur.k0 * 2; const char* cB = (const char*)g.Bt + (size_t)cur.e * g.bstride + (size_t)cur.pn * tstepB + (size_t)cur.k0 * 2;
    PG8_STAGE(PG8_SB(0, 0), cB, voffB); PG8_STAGE(PG8_SB(0, 1), cB + hstepB, voffB); PG8_STAGE(PG8_SA(0, 0), cA, (GATHER ? vgc0 : voffA)); PG8_STAGE(PG8_SA(0, 1), (GATHER ? cA : cA + hstepA), (GATHER ? vgc1 : voffA));
    if (wr == 1) PG8_BAR;
    PG8_WAIT_V(2); PG8_BAR;
    PG8_STAGE(PG8_SB(1, 0), cB + kstep, voffB); PG8_STAGE(PG8_SA(1, 0), cA + kstep, (GATHER ? vgc0 : voffA)); PG8_STAGE(PG8_SB(1, 1), cB + hstepB + kstep, voffB);
    PG8_WAIT_V(6); PG8_BAR;
    for (;;) {
        const bool has_next = S.next(ui + 1, nxt);
        if (GATHER) { if (has_next) PG8_GOFF(vgn0, vgn1, ui + 1); else { vgn0[0] = vgc0[0]; vgn0[1] = vgc0[1]; vgn1[0] = vgc1[0]; vgn1[1] = vgc1[1]; } }
        const char* nA = has_next ? (const char*)g.A + (GATHER ? (size_t)0 : (size_t)nxt.pm * tstepA) + (size_t)nxt.k0 * 2 : cA; const char* nB = has_next ? (const char*)g.Bt + (size_t)nxt.e * g.bstride + (size_t)nxt.pn * tstepB + (size_t)nxt.k0 * 2 : cB;
#pragma unroll 1
        for (int t = 0; t < nt; t += 2) {
            const bool last = (t == nt - 2);
            const char* a1 = cA + (size_t)(t + 1) * kstep;
            const char* a2 = last ? nA : cA + (size_t)(t + 2) * kstep; const char* b2 = last ? nB : cB + (size_t)(t + 2) * kstep;
            const char* a3 = a2 + kstep; const char* b3 = b2 + kstep;
            unsigned x0[2], x1[2];
            x0[0] = last ? vgn0[0] : vgc0[0]; x0[1] = last ? vgn0[1] : vgc0[1]; x1[0] = last ? vgn1[0] : vgc1[0]; x1[1] = last ? vgn1[1] : vgc1[1];
            PG8_LDB(B0, 0, 0); PG8_LDB(B1, 0, 1); PG8_SCHED; PG8_LDA(At, 0, 0); PG8_STAGE(PG8_SA(1, 1), (GATHER ? a1 : a1 + hstepA), (GATHER ? vgc1 : voffA));
            PG8_WAIT_V(8); PG8_WAIT_L(0); PG8_BAR; PG8_MMA(0, 0, At, B0); PG8_MMA(0, 1, At, B1); PG8_BAR; PG8_SCHED;
            PG8_LDA(At, 0, 1); PG8_STAGE(PG8_SB(0, 0), b2, voffB); PG8_STAGE(PG8_SB(0, 1), b2 + hstepB, voffB); PG8_STAGE(PG8_SA(0, 0), a2, (GATHER ? x0 : voffA));
            PG8_WAIT_V(8); PG8_WAIT_L(0); PG8_BAR; PG8_MMA(1, 0, At, B0); PG8_MMA(1, 1, At, B1); PG8_BAR; PG8_SCHED;
            PG8_LDB(B0, 1, 0); PG8_LDB(B1, 1, 1); PG8_SCHED; PG8_LDA(At, 1, 0); PG8_STAGE(PG8_SA(0, 1), (GATHER ? a2 : a2 + hstepA), (GATHER ? x1 : voffA));
            PG8_WAIT_V(8); PG8_WAIT_L(0); PG8_BAR; PG8_MMA(0, 0, At, B0); PG8_MMA(0, 1, At, B1); PG8_BAR; PG8_SCHED;
            PG8_LDA(At, 1, 1); PG8_STAGE(PG8_SB(1, 0), b3, voffB); PG8_STAGE(PG8_SB(1, 1), b3 + hstepB, voffB); PG8_STAGE(PG8_SA(1, 0), a3, (GATHER ? x0 : voffA));
            PG8_WAIT_V(8); PG8_WAIT_L(0); PG8_BAR; PG8_MMA(1, 0, At, B0); PG8_MMA(1, 1, At, B1); PG8_BAR; PG8_SCHED;
        }
        if (wr == 0) PG8_BAR;
        E(acc, cur, wr, wc, fr, fq);
        if (!has_next) break;
#pragma unroll
        for (int a = 0; a < 2; ++a)
#pragma unroll
            for (int b = 0; b < 2; ++b)
#pragma unroll
                for (int m = 0; m < 4; ++m)
#pragma unroll
                    for (int n = 0; n < 2; ++n) acc[a][b][m][n] = (f32x4){0.f, 0.f, 0.f, 0.f};
        cur = nxt; cA = nA; cB = nB; ++ui;
        if (GATHER) { vgc0[0] = vgn0[0]; vgc0[1] = vgn0[1]; vgc1[0] = vgn1[0]; vgc1[1] = vgn1[1]; }
        if (wr == 1) PG8_BAR;
    }
    PG8_WAIT_V(0);
    PG8_BAR;
#undef PG8_GOFF
#undef PG8_SA
#undef PG8_SB
#undef PG8_STAGE
#undef PG8_LDA
#undef PG8_LDB
#undef PG8_MMA
#undef PG8_WAIT_V
#undef PG8_WAIT_L
#undef PG8_BAR
#undef PG8_SCHED
}
#else
DEV unsigned cvt_pk_bf16(float lo, float hi) { return pk2(lo, hi); }
template <class Epi, class Sched, bool GATHER = false>
DEV void gemm_phase(unsigned char*, const int tid, const Gemm g, const Sched& S, const Epi& E) {
    const int wid = tid >> 6, lane = tid & 63, wr = wid >> 2, wc = wid & 3, fr = lane & 15, fq = lane >> 4;
    Unit u;
    for (int ui = 0; S.next(ui, u); ++ui) {
        f32x4 acc[2][2][4][2];
        const bf16* Bt = (const bf16*)((const char*)g.Bt + (size_t)u.e * g.bstride);
        for (int ai = 0; ai < 2; ++ai) for (int bj = 0; bj < 2; ++bj) for (int m = 0; m < 4; ++m) for (int n = 0; n < 2; ++n) for (int j = 0; j < 4; ++j) {
            const size_t row = (size_t)u.pm * 256 + 128 * ai + 64 * wr + 16 * m + fr;
            const size_t col = (size_t)u.pn * 256 + 128 * bj + 32 * wc + (Epi::PERM ? 8 * fq + 4 * n + j : 16 * n + 4 * fq + j);
            const size_t arow = GATHER ? (size_t)g.rowmap[row] : row;
            const bf16* a = g.A + arow * g.lda + u.k0; const bf16* b = Bt + col * g.ldb + u.k0; float s = 0.f;
            for (int k = 0; k < g.K; ++k) s += bf2f(a[k]) * bf2f(b[k]);
            acc[ai][bj][m][n][j] = s; }
        E(acc, u, wr, wc, fr, fq);
    }
}
#endif
}

using pg8::Unit;
struct EpiStore {
    static constexpr bool PERM = true;
    bf16* O; int ldc; float* gates;
    DEV void operator()(const f32x4 (&acc)[2][2][4][2], const Unit& u, int wr, int wc, int fr, int fq) const {
        const int row0 = u.pm * 256 + wr * 64 + fr, col0 = u.pn * 256 + wc * 32 + 8 * fq;
        const bool dog = gates != nullptr && u.pn == C_G / 256 && wc == 0 && fq < 2;
#pragma unroll
        for (int ai = 0; ai < 2; ++ai)
#pragma unroll
            for (int m = 0; m < 4; ++m) { const int row = row0 + ai * 128 + m * 16; bf16* rowp = O + (size_t)row * ldc + col0;
#pragma unroll
                for (int bj = 0; bj < 2; ++bj) { const f32x4 v0 = acc[ai][bj][m][0], v1 = acc[ai][bj][m][1];
                    u32x4 w; w.x = pg8::cvt_pk_bf16(v0[0], v0[1]); w.y = pg8::cvt_pk_bf16(v0[2], v0[3]); w.z = pg8::cvt_pk_bf16(v1[0], v1[1]); w.w = pg8::cvt_pk_bf16(v1[2], v1[3]);
                    *(u32x4*)(rowp + bj * 128) = w;
                    if (bj == 0 && dog) { float* gp = gates + (size_t)row * 16 + 8 * fq; *(f32x4*)gp = v0; *(f32x4*)(gp + 4) = v1; } } }
    }
};
struct EpiStoreMla {
    static constexpr bool PERM = true;
    bf16* O;
    DEV void operator()(const f32x4 (&acc)[2][2][4][2], const Unit& u, int wr, int wc, int fr, int fq) const {
        const int row0 = u.pm * 256 + wr * 64 + fr, col0 = u.pn * 256 + wc * 32 + 8 * fq;
#pragma unroll
        for (int bj = 0; bj < 2; ++bj) { const int c = col0 + bj * 128;
            if (c >= 384 && c < 512) continue;
            const int hb = (c - 512) >> 7, wi = (c - 512) & 127;
            const int dst = c < 384 ? c : (wi < 64 ? 384 + 96 * hb + wi : 768 + 64 * hb + (wi - 64));
#pragma unroll
            for (int ai = 0; ai < 2; ++ai)
#pragma unroll
                for (int m = 0; m < 4; ++m) { const int row = row0 + ai * 128 + m * 16; const f32x4 v0 = acc[ai][bj][m][0], v1 = acc[ai][bj][m][1];
                    u32x4 w; w.x = pg8::cvt_pk_bf16(v0[0], v0[1]); w.y = pg8::cvt_pk_bf16(v0[2], v0[3]); w.z = pg8::cvt_pk_bf16(v1[0], v1[1]); w.w = pg8::cvt_pk_bf16(v1[2], v1[3]);
                    *(u32x4*)(O + (size_t)row * MLAP + dst) = w; } }
    }
};
template <bool from_input> struct EpiResid {
    static constexpr bool PERM = true;
    P p; int l, goff;
    DEV void operator()(const f32x4 (&acc)[2][2][4][2], const Unit& u, int wr, int wc, int fr, int fq) const {
        const int R0 = u.pm * 256, bb = R0 / TP, q0 = R0 % TP; const bool isctx = q0 < CTX;
        bf16* xb = resid_row(p, R0); constexpr size_t rs = RPITCH;
        const float* xin = isctx ? p.ctx + (size_t)(bb * CTX + q0) * D_MODEL : p.x + (size_t)(bb * SEQ + q0 - CTX) * D_MODEL;
        const float* gv = modv(p, l, R0) + goff;
        const int col0 = u.pn * 256 + wc * 32 + 8 * fq;
        constexpr int MB = from_input ? 2 : 4;
#pragma unroll
        for (int bj = 0; bj < 2; ++bj) { const int col = col0 + bj * 128; const f32x4 g0 = *(const f32x4*)(gv + col), g1 = *(const f32x4*)(gv + col + 4);
#pragma unroll
            for (int ai = 0; ai < 2; ++ai)
#pragma unroll
                for (int mb = 0; mb < 4; mb += MB) { f32x4 a0[MB], a1[MB];
#pragma unroll
                    for (int mm = 0; mm < MB; ++mm) { const size_t rl = (size_t)(wr * 64 + fr + ai * 128 + (mb + mm) * 16);
                        if (from_input) { a0[mm] = *(const f32x4*)(xin + rl * D_MODEL + col); a1[mm] = *(const f32x4*)(xin + rl * D_MODEL + col + 4); }
                        else { const u32x4 t = *(const u32x4*)(xb + rl * rs + col);
                            a0[mm] = (f32x4){bf2f((bf16)t.x), bf2f((bf16)(t.x >> 16)), bf2f((bf16)t.y), bf2f((bf16)(t.y >> 16))}; a1[mm] = (f32x4){bf2f((bf16)t.z), bf2f((bf16)(t.z >> 16)), bf2f((bf16)t.w), bf2f((bf16)(t.w >> 16))}; } }
#pragma unroll
                    for (int mm = 0; mm < MB; ++mm) { const size_t rl = (size_t)(wr * 64 + fr + ai * 128 + (mb + mm) * 16);
                        const f32x4 o0 = a0[mm] + g0 * acc[ai][bj][mb + mm][0], o1 = a1[mm] + g1 * acc[ai][bj][mb + mm][1];
                        u32x4 wv; wv.x = pg8::cvt_pk_bf16(o0[0], o0[1]); wv.y = pg8::cvt_pk_bf16(o0[2], o0[3]); wv.z = pg8::cvt_pk_bf16(o1[0], o1[1]); wv.w = pg8::cvt_pk_bf16(o1[2], o1[3]);
                        *(u32x4*)(xb + rl * rs + col) = wv; } } }
    }
};
struct EpiSwiglu {
    static constexpr bool PERM = true;
    bf16* O; int pm_base;
    DEV void operator()(const f32x4 (&acc)[2][2][4][2], const Unit& u, int wr, int wc, int fr, int fq) const {
        const int row0 = u.po * 256 + wr * 64 + fr, col0 = u.pn * 128 + wc * 32 + 8 * fq;
#pragma unroll
        for (int ai = 0; ai < 2; ++ai)
#pragma unroll
            for (int m = 0; m < 4; ++m) { float r[8];
#pragma unroll
                for (int n = 0; n < 2; ++n)
#pragma unroll
                    for (int j = 0; j < 4; ++j) r[4 * n + j] = silu_fast(acc[ai][0][m][n][j]) * acc[ai][1][m][n][j];
                u32x4 w; w.x = pg8::cvt_pk_bf16(r[0], r[1]); w.y = pg8::cvt_pk_bf16(r[2], r[3]); w.z = pg8::cvt_pk_bf16(r[4], r[5]); w.w = pg8::cvt_pk_bf16(r[6], r[7]);
                *(u32x4*)(O + (size_t)(row0 + ai * 128 + m * 16) * D_FF + col0) = w; }
    }
};
struct EpiStoreRel {
    static constexpr bool PERM = true;
    bf16* O; int ldc, pm_base;
    DEV void operator()(const f32x4 (&acc)[2][2][4][2], const Unit& u, int wr, int wc, int fr, int fq) const {
        const int row0 = u.po * 256 + wr * 64 + fr, col0 = u.pn * 256 + wc * 32 + 8 * fq;
#pragma unroll
        for (int ai = 0; ai < 2; ++ai)
#pragma unroll
            for (int m = 0; m < 4; ++m) { bf16* rowp = O + (size_t)(row0 + ai * 128 + m * 16) * ldc + col0;
#pragma unroll
                for (int bj = 0; bj < 2; ++bj) { const f32x4 v0 = acc[ai][bj][m][0], v1 = acc[ai][bj][m][1];
                    u32x4 w; w.x = pg8::cvt_pk_bf16(v0[0], v0[1]); w.y = pg8::cvt_pk_bf16(v0[2], v0[3]); w.z = pg8::cvt_pk_bf16(v1[0], v1[1]); w.w = pg8::cvt_pk_bf16(v1[2], v1[3]);
                    *(u32x4*)(rowp + bj * 128) = w; } }
    }
};
template <int mode> struct Sched {
    pg8::Order o; int pm_base; const int* seg; int nNc, kper;
    DEV bool next(int i, Unit& u) const {
        int lm, ln; if (!o.nextL(i, lm, ln)) return false;
        u.pn = ln; u.e = 0; u.k0 = 0; u.po = lm;
        if (mode == 0) u.pm = lm;
        else if (mode == 1) u.pm = (lm / NQL) * PAN_B + 1 + lm % NQL;
        else if (mode == 6) { u.pm = lm; u.k0 = (ln >= 2) ? 256 : 0; }
        else if (mode == 4) { u.pm = lm * PAN_B; u.pn = ln % nNc; u.k0 = (ln / nNc) * kper; u.po = (ln / nNc) * o.nM + lm; }
        else { const int gp = pm_base + lm; int e = 0;
#pragma unroll
            for (int k = 1; k < NEXP; ++k) e += (seg[k] <= gp) ? 1 : 0;
            u.e = e; u.pm = (mode == 2) ? gp : lm;
            if (mode == 5) { u.pn = ln % nNc; u.k0 = (ln / nNc) * kper; u.po = (ln / nNc) * o.nM + lm; } }
        return true;
    }
};

#ifndef WGM_MASK
#define WGM_MASK 0x01f
#endif
#define SITE_WGM(k) (((WGM_MASK >> (k)) & 1) ? 4 : 8)
struct TabSched {
    const int* tab; int n;
    DEV bool next(int i, Unit& u) const {
        if (i >= n) return false;
        u.pm = UNIFORM_I(tab[5 * i]); u.pn = UNIFORM_I(tab[5 * i + 1]); u.e = UNIFORM_I(tab[5 * i + 2]); u.k0 = UNIFORM_I(tab[5 * i + 3]); u.po = UNIFORM_I(tab[5 * i + 4]);
        return true;
    }
};
constexpr int MAX_UNITS = 150;
template <class S> DEV TabSched build_units(unsigned* misc, int tid, const S& sch) {
    int* tab = (int*)(misc + 256);
    __syncthreads();
    if (tid < MAX_UNITS) { Unit u; if (sch.next(tid, u)) { tab[5 * tid] = u.pm; tab[5 * tid + 1] = u.pn; tab[5 * tid + 2] = u.e; tab[5 * tid + 3] = u.k0; tab[5 * tid + 4] = u.po; } }
    __syncthreads();
    const int nwg = sch.o.nwg, c = sch.o.c, G = sch.o.G;
    TabSched t; t.tab = tab; t.n = (c < nwg) ? (nwg - c + G - 1) / G : 0;
    return t;
}

DEV void stage_rowtab(unsigned char* lds, int tid, const TabSched& T, const int* rowmap) {
    int* rt = (int*)(lds + LDS_ROWTAB); const int n = T.n < 8 ? T.n : 8;
    for (int idx = tid; idx < n * 256; idx += NTHR) rt[idx] = rowmap[T.tab[5 * (idx >> 8)] * 256 + (idx & 255)];
    __syncthreads();
}

#ifndef EMU
#define XB_TMO      128
#define XB_XCNT(j)  (256  + 64 * (j))
#define XB_XSUB(j)  (1280 + 64 * (j))
#define XB_XGEN(j)  (2304 + 64 * (j))
#define XB_TOP      3328
#define XB_TOPGEN   3392
#define XCD_BAR_WORDS 3456
#define XB_SPIN_CAP (1u << 22)
#define LAS __attribute__((address_space(3)))
__device__ __forceinline__ unsigned xb_ld(unsigned* p)              { return __hip_atomic_load(p, __ATOMIC_RELAXED, __HIP_MEMORY_SCOPE_AGENT); }
__device__ __forceinline__ unsigned xb_add(unsigned* p, unsigned v) { return __hip_atomic_fetch_add(p, v, __ATOMIC_RELAXED, __HIP_MEMORY_SCOPE_AGENT); }
__device__ __forceinline__ unsigned xb_xcc_id() { return (unsigned)__builtin_amdgcn_s_getreg((3 << 11) | 20) & 0xFu; }
#define XB_SPIN(cond, bar) do { unsigned _sp = 0; while (cond) { __builtin_amdgcn_s_sleep(1); \
    if ((++_sp & 255u) == 0u) { if (xb_ld(&(bar)[XB_TMO])) break; if (_sp > XB_SPIN_CAP) { atomicAdd(&(bar)[XB_TMO], 1u); break; } } } } while (0)
struct XcdBarrier { unsigned* bar; unsigned x; volatile LAS unsigned* st; };
__device__ __forceinline__ XcdBarrier xcd_barrier_post(unsigned* bar, volatile LAS unsigned* st) {
    XcdBarrier b; b.bar = bar; b.x = xb_xcc_id(); b.st = st;
    if (threadIdx.x == 0) (void)xb_add(&bar[XB_XCNT(b.x)], 1u);
    return b;
}
__device__ __forceinline__ void xcd_barrier_complete(unsigned* bar, unsigned x, unsigned& nloc, unsigned& nx) {
    const unsigned G = gridDim.x * gridDim.y * gridDim.z;
    unsigned sum, cnt, mine, sp = 0u;
    for (;;) {
        sum = 0u; cnt = 0u; mine = 0u;
#pragma unroll
        for (unsigned j = 0; j < 16; ++j) { const unsigned c = xb_ld(&bar[XB_XCNT(j)]); sum += c; cnt += (c > 0u) ? 1u : 0u; mine = (j == x) ? c : mine; }
        if (sum == G) break;
        __builtin_amdgcn_s_sleep(1);
        if ((++sp & 255u) == 0u) { if (xb_ld(&bar[XB_TMO])) break; if (sp > XB_SPIN_CAP) { atomicAdd(&bar[XB_TMO], 1u); break; } }
    }
    nloc = mine > 0u ? mine : 1u; nx = cnt > 0u ? cnt : 1u;
}
__device__ __forceinline__ void xcd_barrier(const XcdBarrier& b) {
    asm volatile("s_waitcnt vmcnt(0)" ::: "memory");
    __syncthreads();
    if (threadIdx.x == 0) {
        unsigned* bar = b.bar;
        __builtin_amdgcn_s_waitcnt(0);
        unsigned nloc = b.st[0], nx = b.st[1];
        if (nloc == 0u) { xcd_barrier_complete(bar, b.x, nloc, nx); b.st[0] = nloc; b.st[1] = nx; }
        const unsigned old = xb_add(&bar[XB_XSUB(b.x)], 1u);
        const unsigned gen = old / nloc;
        if (old + 1u == (gen + 1u) * nloc) {
            __builtin_amdgcn_fence(__ATOMIC_RELEASE, "agent");
            asm volatile("s_waitcnt vmcnt(0)" ::: "memory");
            const unsigned og = xb_add(&bar[XB_TOP], 1u);
            const unsigned tg = og / nx;
            if (og + 1u == (tg + 1u) * nx) xb_add(&bar[XB_TOPGEN], 1u);
            else XB_SPIN(xb_ld(&bar[XB_TOPGEN]) == tg, bar);
            __builtin_amdgcn_fence(__ATOMIC_ACQUIRE, "agent");
            xb_add(&bar[XB_XGEN(b.x)], 1u);
            asm volatile("s_waitcnt vmcnt(0)" ::: "memory");
        } else {
            XB_SPIN(xb_ld(&bar[XB_XGEN(b.x)]) == gen, bar);
            __builtin_amdgcn_fence(__ATOMIC_ACQUIRE, "agent");
            asm volatile("s_waitcnt vmcnt(0)" ::: "memory");
        }
    }
    __syncthreads();
}
#endif

struct Wg { int tid, lane, wave, G, wg, gw, NGW; unsigned char* lds; unsigned* misc; };
DEV void q_issue(const Wg& w, unsigned* ctr, unsigned& ticket) { if (w.tid == 0) ticket = atomicAdd(ctr, 1u); }
DEV int q_take(Wg& w, unsigned ticket) {
    if (w.tid == 0) w.misc[2] = ticket;
    __syncthreads();
    const int v = (int)w.misc[2];
    __syncthreads();
    return v;
}
DEV int q_next(Wg& w, unsigned* ctr) {
    if (w.tid == 0) w.misc[2] = atomicAdd(ctr, 1u);
    __syncthreads();
    const int v = (int)w.misc[2];
    __syncthreads();
    return v;
}

struct ConvJob { const float* src; int K, N, Npad; bf16* dst; int ldk, kdst0, rowofs, mode; };
struct ConvTile { const float* src; int N, k0, n0; bf16* dst; int ldk, kdst0, rowofs, mode; bool valid; };
DEV bool conv_job_pick(const ConvJob& j, int& it, ConvTile& t) {
    const int nkb = j.K / 64, nnb = j.Npad / 128, tot = nkb * nnb;
    if (it >= tot) { it -= tot; return false; }
    t.src = j.src; t.N = j.N; t.k0 = (it / nnb) * 64; t.n0 = (it % nnb) * 128; t.dst = j.dst; t.ldk = j.ldk; t.kdst0 = j.kdst0; t.rowofs = j.rowofs; t.mode = j.mode; t.valid = true;
    return true;
}
DEV void conv_load(const ConvTile& t, f32x4 (&v)[4], int tid) {
#pragma unroll
    for (int i = 0; i < 4; ++i) { const int kk = i * 16 + (tid >> 5), c4 = tid & 31; v[i] = (t.valid && t.n0 + 4 * c4 < t.N) ? *(const f32x4*)(t.src + (size_t)(t.k0 + kk) * t.N + t.n0 + 4 * c4) : (f32x4){0.f, 0.f, 0.f, 0.f}; }
}
DEV void conv_store(const ConvTile& t, const f32x4 (&v)[4], float* scr, int tid) {
#pragma unroll
    for (int i = 0; i < 4; ++i) { const int kk = i * 16 + (tid >> 5), c4 = tid & 31; *(f32x4*)(scr + kk * 132 + 4 * c4) = v[i]; }
    __syncthreads();
#pragma unroll
    for (int i = 0; i < 2; ++i) { const int idx = tid + NTHR * i, n = idx >> 3, c = idx & 7, ng = t.n0 + n; const float* s = scr + (8 * c) * 132 + n;
      const int row = t.rowofs + (t.mode == 0 ? ng : (ng / 128) * 256 + (ng % 128) + (t.mode == 2 ? 128 : 0));
      u32x4 o; o.x = pk2(s[0], s[132]); o.y = pk2(s[2 * 132], s[3 * 132]); o.z = pk2(s[4 * 132], s[5 * 132]); o.w = pk2(s[6 * 132], s[7 * 132]);
      *(u32x4*)(t.dst + (size_t)row * t.ldk + t.kdst0 + t.k0 + 8 * c) = o; }
    __syncthreads();
}
DEV void zero_rect(bf16* dst, int ld, int r0, int r1, int c0, int c1, int gtid, int gn) {
    const int cw = (c1 - c0) / 8; const long tot = (long)(r1 - r0) * cw;
    for (long i = gtid; i < tot; i += gn) { const int r = r0 + (int)(i / cw), c = c0 + 8 * (int)(i % cw); *(u32x4*)(dst + (size_t)r * ld + c) = (u32x4){0u, 0u, 0u, 0u}; }
}
DEV void phase0(const P& p, Wg& w) {
    float* scr = (float*)w.lds;
    {
        bf16* WIN = (bf16*)(p.ws + WS_WIN_T); bf16* WOUT = (bf16*)(p.ws + WS_WOUT_T); bf16* MLT = (bf16*)(p.ws + WS_MLA_T);
#define JOB_WIN(l) ConvJob{p.w_in + (size_t)(l) * D_MODEL * IN_W, D_MODEL, IN_W, PROJ_W, WIN + (size_t)(l) * PROJ_W * D_MODEL, D_MODEL, 0, 0, 0}
#define JOB_WOUT(l) ConvJob{p.w_out + (size_t)(l) * MIXW * D_MODEL, MIXW, D_MODEL, D_MODEL, WOUT + (size_t)(l) * D_MODEL * MIXW, MIXW, 0, 0, 0}
#define JOB_WUQ(l) ConvJob{p.l_wuq + (size_t)(l) * 256 * 384, 256, 384, 384, MLT + (size_t)(l) * 1024 * 512, 512, 0, 0, 0}
#define JOB_WUKV(l) ConvJob{p.l_wukv + (size_t)(l) * 128 * 512, 128, 512, 512, MLT + (size_t)(l) * 1024 * 512, 512, 256, 512, 0}
        constexpr int total = (D_MODEL / 64) * (PROJ_W / 128) + (MIXW / 64) * (D_MODEL / 128) + 4 * 3 + 2 * 4;
        ConvTile cur, nxt; f32x4 vc[4], vn[4]; cur.valid = false;
#define PICK0(it0_, T) do { int it = (it0_); T.valid = false; if ((it0_) < total) { \
            if (!conv_job_pick(JOB_WIN(0), it, T)) if (!conv_job_pick(JOB_WOUT(0), it, T)) if (!conv_job_pick(JOB_WUQ(0), it, T)) conv_job_pick(JOB_WUKV(0), it, T); } } while (0)
        const int nitem0 = 2 * (6 * D_MODEL / 64), off0 = w.G > nitem0 ? w.G - nitem0 : 0, TA = (3 * off0 < total) ? 3 * off0 : total;
#define NEXT0(it_) ((it_) < TA ? ((it_) + off0 < TA ? (it_) + off0 : TA + w.wg) : (it_) + w.G)
        const int first0 = w.wg < off0 && w.wg < TA ? w.wg : TA + w.wg;
        PICK0(first0, cur); if (cur.valid) conv_load(cur, vc, w.tid);
        for (int it0 = first0; it0 < total; it0 = NEXT0(it0)) {
            const int itn = NEXT0(it0);
            PICK0(itn, nxt); if (nxt.valid) conv_load(nxt, vn, w.tid);
            conv_store(cur, vc, scr, w.tid);
            cur = nxt;
#pragma unroll
            for (int i = 0; i < 4; ++i) vc[i] = vn[i];
        }
#undef PICK0
#undef NEXT0
    }
    for (int l = 0; l < 2; ++l) { bf16* mt = (bf16*)(p.ws + WS_MLA_T) + (size_t)l * 1024 * 512; const int gt = w.wg * NTHR + w.tid, gn = w.G * NTHR;
        zero_rect(mt, 512, 384, 512, 0, 256, gt, gn); zero_rect(mt, 512, 512, 1024, 384, 512, gt, gn); }
    if (w.wg == w.G - 1) for (int i = w.tid; i < NPOS * 24; i += NTHR) { const int pos = i / 24, f = i % 24;
        const float inv = f < 16 ? exp2f(-(float)f * (13.287712379549449f / 16.0f)) : exp2f(-(float)(f - 16) * (13.287712379549449f / 8.0f));
        float sn, cs; sincosf((float)pos * inv, &sn, &cs); float* rt = (float*)(p.ws + WS_ROPE) + 2 * i; rt[0] = cs; rt[1] = sn; }
    {
        float* sS = (float*)w.lds;
        float* part = sS + NV * D_MODEL;
        const int nitem = 2 * (6 * D_MODEL / 64);
        bool loaded = false;
        const int off = w.G > nitem ? w.G - nitem : 0;
        for (int it = w.wg - off; it < nitem; it += w.G) {
            if (it < 0) continue;
            if (!loaded) { for (int i = w.tid; i < NV * D_MODEL; i += NTHR) { const int v = i / D_MODEL, k = i % D_MODEL; sS[i] = silu_f(v < BATCH ? p.c[v * D_MODEL + k] : p.c_ctx[k]); } loaded = true; __syncthreads(); }
            const int l = it / (6 * D_MODEL / 64), cb = it % (6 * D_MODEL / 64);
            constexpr int RW = D_MODEL / 8, KU = (RW >= 64) ? 16 : RW / 4;
            static_assert(RW % (4 * KU) == 0, "modvec k blocking");
            const int lg = w.lane >> 4, lc = w.lane & 15;
            f32x4 acc[NV];
#pragma unroll
            for (int v = 0; v < NV; ++v) acc[v] = (f32x4){0.f, 0.f, 0.f, 0.f};
            const float* mw = p.mod_w + (size_t)l * D_MODEL * 6 * D_MODEL + cb * 64 + 4 * lc;
            for (int k0 = w.wave * RW; k0 < (w.wave + 1) * RW; k0 += 4 * KU) { f32x4 wv[KU];
#pragma unroll
                for (int kk = 0; kk < KU; ++kk) wv[kk] = *(const f32x4*)(mw + (size_t)(k0 + 4 * kk + lg) * 6 * D_MODEL);
#pragma unroll
                for (int kk = 0; kk < KU; ++kk)
#pragma unroll
                    for (int v = 0; v < NV; ++v) { const float sv = sS[v * D_MODEL + k0 + 4 * kk + lg]; acc[v] = acc[v] + sv * wv[kk]; } }
#pragma unroll
            for (int v = 0; v < NV; ++v) {
#pragma unroll
                for (int c = 0; c < 4; ++c) { float t = acc[v][c]; t += SHX(t, 16, w.lane); t += SHX(t, 32, w.lane); acc[v][c] = t; }
                if (lg == 0) *(f32x4*)(part + (w.wave * NV + v) * 64 + 4 * lc) = acc[v]; }
            __syncthreads();
            for (int i = w.tid; i < NV * 64; i += NTHR) { const int v = i / 64, cc = i % 64; float s = p.mod_b[(size_t)l * 6 * D_MODEL + cb * 64 + cc];
#pragma unroll
                for (int ww = 0; ww < 8; ++ww) s += part[(ww * NV + v) * 64 + cc];
                ((float*)(p.ws + WS_MODV))[(size_t)(l * NV + v) * 6 * D_MODEL + cb * 64 + cc] = s; }
            __syncthreads();
        }
    }
}
DEV void phase_moe_weights(const P& p, Wg& w) {
    float* scr = (float*)w.lds;
    const int t_gu = (D_MODEL / 64) * (D_FF / 128), t_d = (D_FF / 64) * (D_MODEL / 128), per_e = 2 * t_gu + t_d;
    ConvTile cur, nxt; f32x4 vc[4], vn[4];
#define PICKM(it0_, T) do { T.valid = false; if ((it0_) < NEXP * per_e) { const int e = (it0_) / per_e; int it = (it0_) % per_e; bf16* base = (bf16*)(p.ws + WS_MOEW + (size_t)e * MOEW_E); \
        if (!conv_job_pick(ConvJob{p.moe_wg + (size_t)e * D_MODEL * D_FF, D_MODEL, D_FF, D_FF, base, D_MODEL, 0, 0, 1}, it, T)) \
        if (!conv_job_pick(ConvJob{p.moe_wu + (size_t)e * D_MODEL * D_FF, D_MODEL, D_FF, D_FF, base, D_MODEL, 0, 0, 2}, it, T)) \
        conv_job_pick(ConvJob{p.moe_wd + (size_t)e * D_FF * D_MODEL, D_FF, D_MODEL, D_MODEL, base + (size_t)2 * D_FF * D_MODEL, D_FF, 0, 0, 0}, it, T); } } while (0)
    PICKM(w.wg, cur); if (cur.valid) conv_load(cur, vc, w.tid);
    for (int it0 = w.wg; it0 < NEXP * per_e; it0 += w.G) {
        PICKM(it0 + w.G, nxt); if (nxt.valid) conv_load(nxt, vn, w.tid);
        conv_store(cur, vc, scr, w.tid);
        cur = nxt;
#pragma unroll
        for (int i = 0; i < 4; ++i) vc[i] = vn[i];
    }
#undef PICKM
}

DEV void conv_ffn_tiles(const P& p, Wg& w, int first, int stride) {
    float* scr = (float*)w.lds;
    bf16* WIN = (bf16*)(p.ws + WS_WIN_T); bf16* WOUT = (bf16*)(p.ws + WS_WOUT_T); bf16* MLT = (bf16*)(p.ws + WS_MLA_T);
    constexpr int total = 2 * (D_MODEL / 64) * (D_FF / 128) + (D_FF / 64) * (D_MODEL / 128) + (D_MODEL / 64) * (PROJ_W / 128) + (MIXW / 64) * (D_MODEL / 128) + 4 * 3 + 2 * 4;
    ConvTile cur, nxt; f32x4 vc[4], vn[4];
#define PICKF(it0_, T) do { int it = (it0_); T.valid = false; if ((it0_) < total) { \
        if (!conv_job_pick(ConvJob{p.ffn_wg, D_MODEL, D_FF, D_FF, (bf16*)(p.ws + WS_WGU_T), D_MODEL, 0, 0, 1}, it, T)) \
        if (!conv_job_pick(ConvJob{p.ffn_wu, D_MODEL, D_FF, D_FF, (bf16*)(p.ws + WS_WGU_T), D_MODEL, 0, 0, 2}, it, T)) \
        if (!conv_job_pick(ConvJob{p.ffn_wd, D_FF, D_MODEL, D_MODEL, (bf16*)(p.ws + WS_WD_T), D_FF, 0, 0, 0}, it, T)) \
        if (!conv_job_pick(JOB_WIN(1), it, T)) if (!conv_job_pick(JOB_WOUT(1), it, T)) if (!conv_job_pick(JOB_WUQ(1), it, T)) conv_job_pick(JOB_WUKV(1), it, T); } } while (0)
    PICKF(first, cur); if (cur.valid) conv_load(cur, vc, w.tid);
    for (int it0 = first; it0 < total; it0 += stride) {
        PICKF(it0 + stride, nxt); if (nxt.valid) conv_load(nxt, vn, w.tid);
        conv_store(cur, vc, scr, w.tid);
        cur = nxt;
#pragma unroll
        for (int i = 0; i < 4; ++i) vc[i] = vn[i];
    }
#undef PICKF
}

template <int NB> DEV void phase_modulate(const P& p, Wg& w, int l, int which, bool first, bool skip_ctx, bool moe, bool ctx_part) {
    constexpr int NJ = D_MODEL / 256;
    bf16* H = (bf16*)(p.ws + WS_H);
    const float* gn = (which ? p.norm_ffn : p.norm_mix) + (size_t)l * D_MODEL;
    int cnt[NEXP];
#pragma unroll
    for (int e = 0; e < NEXP; ++e) cnt[e] = 0;
    f32x4 rw[NJ * 4][2];
    if (moe) {
#pragma unroll
        for (int j = 0; j < NJ; ++j)
#pragma unroll
            for (int k = 0; k < 4; ++k) { const float* rr = p.moe_router + (size_t)(4 * w.lane + 256 * j + k) * NEXP; rw[4 * j + k][0] = *(const f32x4*)rr; rw[4 * j + k][1] = *(const f32x4*)(rr + 4); } }
    f32x4 gnv[NJ];
#pragma unroll
    for (int j = 0; j < NJ; ++j) gnv[j] = *(const f32x4*)(gn + 4 * w.lane + 256 * j);
    static_assert(TP % NB == 0 && CTX % NB == 0 && M_ALL % NB == 0, "a group of NB consecutive rows never straddles a batch / context boundary");
    const int RPWm = (M_ALL + w.NGW - 1) / w.NGW;
    const int Rbeg = moe ? (w.gw * RPWm < M_ALL ? w.gw * RPWm : M_ALL) : NB * w.gw;
    const int Rend = moe ? (Rbeg + RPWm < M_ALL ? Rbeg + RPWm : M_ALL) : M_ALL;
    const int step = moe ? NB : NB * w.NGW;
    u32x2 nraw[NB][NJ];
#define MOD_PF(Rg_) do { _Pragma("unroll") for (int qq = 0; qq < NB; ++qq) { const bf16* xr_ = resid_row(p, (Rg_) + qq); \
        _Pragma("unroll") for (int j = 0; j < NJ; ++j) nraw[qq][j] = *(const u32x2*)(xr_ + 4 * w.lane + 256 * j); } } while (0)
    f32x4 nrawf[NB][NJ];
#define MOD_PFF(Rg_) do { _Pragma("unroll") for (int qq = 0; qq < NB; ++qq) { const int R_ = (Rg_) + qq, b_ = R_ / TP, q_ = R_ % TP; \
        const float* src_ = q_ < CTX ? p.ctx + (size_t)(b_ * CTX + q_) * D_MODEL : p.x + (size_t)(b_ * SEQ + q_ - CTX) * D_MODEL; \
        _Pragma("unroll") for (int j = 0; j < NJ; ++j) nrawf[qq][j] = *(const f32x4*)(src_ + 4 * w.lane + 256 * j); } } while (0)
    if (Rbeg < Rend) { if (first) MOD_PFF(Rbeg); else MOD_PF(Rbeg); }
    for (int Rb = Rbeg; Rb < Rend; Rb += step) {
        f32x4 vv[NB][NJ];
        if (first) {
#pragma unroll
            for (int qq = 0; qq < NB; ++qq)
#pragma unroll
                for (int j = 0; j < NJ; ++j) vv[qq][j] = nrawf[qq][j]; }
        else {
#pragma unroll
            for (int qq = 0; qq < NB; ++qq)
#pragma unroll
                for (int j = 0; j < NJ; ++j) { const u32x2 t = nraw[qq][j]; vv[qq][j] = (f32x4){bf2f((bf16)t.x), bf2f((bf16)(t.x >> 16)), bf2f((bf16)t.y), bf2f((bf16)(t.y >> 16))}; } }
        f32x4 gs[NJ], s0v[NJ];
        { const float* mv = modv(p, l, Rb); const float* sh = mv + (which ? 3 : 0) * D_MODEL; const float* sc = mv + (which ? 4 : 1) * D_MODEL;
#pragma unroll
          for (int j = 0; j < NJ; ++j) { gs[j] = *(const f32x4*)(sc + 4 * w.lane + 256 * j); s0v[j] = *(const f32x4*)(sh + 4 * w.lane + 256 * j); } }
        if (Rb + step < Rend) { if (first) MOD_PFF(Rb + step); else MOD_PF(Rb + step); }
        if (skip_ctx && (Rb % TP) < CTX) continue;
#pragma unroll
        for (int j = 0; j < NJ; ++j) gs[j] = gnv[j] * (1.0f + gs[j]);
#pragma unroll
        for (int qq = 0; qq < NB; ++qq) {
        const int R = Rb + qq; const int b = R / TP, q = R % TP;
        bf16* xr = resid_row(p, R);
        f32x4 v[NJ]; float ss = 0.f;
#pragma unroll
        for (int j = 0; j < NJ; ++j) { v[j] = vv[qq][j]; ss += v[j][0] * v[j][0] + v[j][1] * v[j][1] + v[j][2] * v[j][2] + v[j][3] * v[j][3]; }
        if (ctx_part && q < CTX) {
            const bf16* cp = (const bf16*)(p.ws + WS_MLAQ) + (size_t)(b * CTX + q) * D_MODEL; const float* gf = (const float*)(p.ws + WS_MODV) + (size_t)((l - 1) * NV + BATCH) * 6 * D_MODEL + 5 * D_MODEL;
            ss = 0.f;
#pragma unroll
            for (int j = 0; j < NJ; ++j) { const int col = 4 * w.lane + 256 * j; f32x4 a = (f32x4){0.f, 0.f, 0.f, 0.f};
                for (int ks = 0; ks < NSPLIT; ++ks) { const u32x2 t = *(const u32x2*)(cp + (size_t)ks * BATCH * CTX * D_MODEL + col);
                    a[0] += bf2f((bf16)t.x); a[1] += bf2f((bf16)(t.x >> 16)); a[2] += bf2f((bf16)t.y); a[3] += bf2f((bf16)(t.y >> 16)); }
                const f32x4 g = *(const f32x4*)(gf + col); v[j] = v[j] + g * a; { u32x2 wb; wb.x = pk2(v[j][0], v[j][1]); wb.y = pk2(v[j][2], v[j][3]); *(u32x2*)(xr + col) = wb; }
                ss += v[j][0] * v[j][0] + v[j][1] * v[j][1] + v[j][2] * v[j][2] + v[j][3] * v[j][3]; } }
        ss = wave_sum(ss, w.lane);
        const float rstd = rsqrt_fast(ss * (1.0f / D_MODEL) + EPS);
        float lg[NEXP];
#pragma unroll
        for (int e = 0; e < NEXP; ++e) lg[e] = 0.f;
#pragma unroll
        for (int j = 0; j < NJ; ++j) { const int col = 4 * w.lane + 256 * j;
            f32x4 h;
#pragma unroll
            for (int k = 0; k < 4; ++k) h[k] = v[j][k] * rstd * gs[j][k] + s0v[j][k];
            u32x2 o; o.x = pk2(h[0], h[1]); o.y = pk2(h[2], h[3]);
            *(u32x2*)(H + (size_t)R * D_MODEL + col) = o;
            if (moe) {
#pragma unroll
                for (int k = 0; k < 4; ++k) {
#pragma unroll
                    for (int e = 0; e < NEXP; ++e) lg[e] += h[k] * rw[4 * j + k][e >> 2][e & 3]; } } }
        if (moe) {
            {
              static_assert(NEXP == 8, "transpose-reduce layout");
              const bool h32 = (w.lane & 32) != 0, h16 = (w.lane & 16) != 0, h8 = (w.lane & 8) != 0; float r4[4], r2[2], r1;
#pragma unroll
              for (int e = 0; e < 4; ++e) { const float snd = h32 ? lg[e] : lg[e + 4], kp = h32 ? lg[e + 4] : lg[e]; r4[e] = kp + SHX(snd, 32, w.lane); }
#pragma unroll
              for (int e = 0; e < 2; ++e) { const float snd = h16 ? r4[e] : r4[e + 2], kp = h16 ? r4[e + 2] : r4[e]; r2[e] = kp + SHX(snd, 16, w.lane); }
              { const float snd = h8 ? r2[0] : r2[1], kp = h8 ? r2[1] : r2[0]; r1 = kp + SHX(snd, 8, w.lane); }
              r1 += SHX(r1, 4, w.lane); r1 += SHX(r1, 2, w.lane); r1 += SHX(r1, 1, w.lane);
#pragma unroll
              for (int e = 0; e < NEXP; ++e) lg[e] = __shfl(r1, 8 * e); }
            int i1 = 0; float v1 = lg[0];
#pragma unroll
            for (int e = 1; e < NEXP; ++e) if (lg[e] > v1) { v1 = lg[e]; i1 = e; }
            int i2 = -1; float v2 = -3.0e38f;
#pragma unroll
            for (int e = 0; e < NEXP; ++e) if (e != i1 && lg[e] > v2) { v2 = lg[e]; i2 = e; }
            const float w1 = 1.0f / (1.0f + expf(v2 - v1)), w2 = 1.0f - w1;
            const int tok = b * SEQ + q - CTX;
            if (w.lane == 0) { int* ti = (int*)(p.ws + WS_TOPI) + 2 * tok; float* tw = (float*)(p.ws + WS_TOPW) + 2 * tok; ti[0] = i1; ti[1] = i2; tw[0] = w1; tw[1] = w2; }
#pragma unroll
            for (int e = 0; e < NEXP; ++e) cnt[e] += (e == i1 || e == i2) ? 1 : 0;
        }
        }
    }
    if (moe) {
        int* lc = (int*)w.lds;
        if (w.lane == 0) {
#pragma unroll
            for (int e = 0; e < NEXP; ++e) lc[w.wave * NEXP + e] = cnt[e]; }
        __syncthreads();
        if (w.tid < NEXP) { int s = 0; for (int ww = 0; ww < NWAVE; ++ww) s += lc[ww * NEXP + w.tid]; ((int*)(p.ws + WS_CNTG))[w.wg * NEXP + w.tid] = s; }
        __syncthreads();
    }
}

#undef MOD_PF
#undef MOD_PFF
DEV void phase_prep(const P& p, Wg& w, int l) {
    bf16* PROJ = (bf16*)(p.ws + WS_PROJ); bf16* MQK = (bf16*)(p.ws + WS_MQK);
    const float* cw = p.m_conv + (size_t)l * 3 * 768;
    const int lane = w.lane;
    const float gkr = p.l_knorm[l * 96 + 64 + (lane & 31)];
    const f32x4 gcq = *(const f32x4*)(p.l_cq_norm + l * 256 + 4 * lane); const float gkv0 = p.l_ckv_norm[l * 128 + 2 * lane], gkv1 = p.l_ckv_norm[l * 128 + 2 * lane + 1];
    const int hq = lane >> 3, hi8 = lane & 7, hbase = (hq < 6 ? C_AQ + hq * 64 : C_AK + (hq - 6) * 64) + 8 * hi8;
    f32x4 cwv[3][3];
#pragma unroll
    for (int j = 0; j < 3; ++j)
#pragma unroll
        for (int tp = 0; tp < 3; ++tp) cwv[j][tp] = *(const f32x4*)(cw + tp * 768 + 4 * lane + 256 * j);
    float gh[8];
    { const float* gp = (hq < 6 ? p.a_qnorm : p.a_knorm) + l * 64 + 8 * hi8;
#pragma unroll
      for (int j = 0; j < 8; ++j) gh[j] = gp[j] * (hq < 6 ? QSCALE_A : 1.0f); }
    float* rtab = (float*)w.lds;
    { const float* rg = (const float*)(p.ws + WS_ROPE); for (int i = w.tid; i < NPOS * 48; i += NTHR) rtab[i] = rg[i]; }
    __syncthreads();
    constexpr int NB = 2;
    const int RPW = (M_ALL + w.NGW - 1) / w.NGW, Rbeg = w.gw * RPW, Rend = ((w.gw + 1) * RPW < M_ALL) ? (w.gw + 1) * RPW : M_ALL;
    u32x2 n0[NB][3], nnext[3]; u32x4 nh[NB]; u32x2 ncq[NB]; unsigned nckv[NB]; bf16 nkr[NB];
#define PREP_LD(R0_) do { const bool hnv_ = (R0_) + NB < M_ALL; \
        _Pragma("unroll") for (int j = 0; j < 3; ++j) nnext[j] = hnv_ ? *(const u32x2*)(PROJ + (size_t)((R0_) + NB) * PROJ_W + 4 * lane + 256 * j) : (u32x2){0u, 0u}; \
        _Pragma("unroll") for (int q = 0; q < NB; ++q) { const int R_ = (R0_) + q; const int Rr_ = R_ < M_ALL ? R_ : (R0_); const bf16* pr_ = PROJ + (size_t)Rr_ * PROJ_W; \
            _Pragma("unroll") for (int j = 0; j < 3; ++j) n0[q][j] = *(const u32x2*)(pr_ + 4 * lane + 256 * j); \
            nh[q] = *(const u32x4*)(pr_ + hbase); ncq[q] = *(const u32x2*)(pr_ + C_CQ + 4 * lane); nckv[q] = *(const unsigned*)(pr_ + C_CKV + 2 * lane); nkr[q] = pr_[C_KR + (lane & 31)]; } } while (0)
    u32x2 cprev[3];
#pragma unroll
    for (int j = 0; j < 3; ++j) cprev[j] = (Rbeg > 0 && Rbeg < Rend) ? *(const u32x2*)(PROJ + (size_t)(Rbeg - 1) * PROJ_W + 4 * lane + 256 * j) : (u32x2){0u, 0u};
    if (Rbeg < Rend) PREP_LD(Rbeg);
    for (int R0 = Rbeg; R0 < Rend; R0 += NB) {
        u32x2 c0[NB][3], cp[NB][3], cn[NB][3], cnext[3]; u32x4 hraw[NB]; u32x2 cqv[NB]; unsigned ckvv[NB]; bf16 krv[NB]; bool ok[NB];
#pragma unroll
        for (int q = 0; q < NB; ++q) { ok[q] = R0 + q < Rend; hraw[q] = nh[q]; cqv[q] = ncq[q]; ckvv[q] = nckv[q]; krv[q] = nkr[q];
#pragma unroll
            for (int j = 0; j < 3; ++j) c0[q][j] = n0[q][j]; }
#pragma unroll
        for (int j = 0; j < 3; ++j) cnext[j] = nnext[j];
        if (R0 + NB < Rend) PREP_LD(R0 + NB);
#pragma unroll
        for (int q = 0; q < NB; ++q) { const int qq = (R0 + q) % TP; const bool hp = !(qq == 0 || qq == CTX), hn = !(qq == CTX - 1 || qq == TP - 1);
#pragma unroll
            for (int j = 0; j < 3; ++j) { const u32x2 a = (q == 0) ? cprev[j] : c0[q > 0 ? q - 1 : 0][j], n = (q == NB - 1) ? cnext[j] : c0[q < NB - 1 ? q + 1 : 0][j];
                cp[q][j] = hp ? a : (u32x2){0u, 0u}; cn[q][j] = hn ? n : (u32x2){0u, 0u}; } }
#pragma unroll
        for (int j = 0; j < 3; ++j) cprev[j] = c0[NB - 1][j];
#pragma unroll
        for (int q = 0; q < NB; ++q) { const int Rr = (R0 + q < M_ALL) ? R0 + q : R0; const int qq = Rr % TP; const bool lat = qq >= CTX; const int t = qq - CTX;
            bf16* pr = PROJ + (size_t)Rr * PROJ_W;
            u32x2 ov[3];
#pragma unroll
            for (int j = 0; j < 3; ++j) { const int col = 4 * lane + 256 * j; float o[4];
#pragma unroll
                for (int k = 0; k < 4; ++k) { const unsigned sh = (k & 1) * 16; const unsigned a = (k < 2 ? cp[q][j].x : cp[q][j].y) >> sh, c = (k < 2 ? c0[q][j].x : c0[q][j].y) >> sh, n = (k < 2 ? cn[q][j].x : cn[q][j].y) >> sh;
                    const float sv = bf2f((bf16)a) * cwv[j][0][k] + bf2f((bf16)c) * cwv[j][1][k] + bf2f((bf16)n) * cwv[j][2][k]; o[k] = silu_fast(sv) * (col >= 384 ? KSCALE_M : 1.0f); }
                ov[j].x = pk2(o[0], o[1]); ov[j].y = pk2(o[2], o[3]); }
            u32x4 oh;
            { float x[8], ss = 0.f;
#pragma unroll
              for (int j = 0; j < 8; ++j) { x[j] = bf2f((bf16)(hraw[q][j >> 1] >> ((j & 1) * 16))); ss += x[j] * x[j]; }
              ss += SHX(ss, 1, lane); ss += SHX(ss, 2, lane); ss += SHX(ss, 4, lane);
              const float rs = rsqrt_fast(ss * (1.0f / 64.0f) + EPS);
#pragma unroll
              for (int j = 0; j < 8; ++j) x[j] *= rs * gh[j];
              const float* ct = rtab + ((size_t)(lat ? (hi8 < 4 ? t / GRID_W : t % GRID_W) : 0) * 24 + 8 * (hi8 & 1)) * 2;
              const f32x4 t0 = *(const f32x4*)ct, t1 = *(const f32x4*)(ct + 4), t2 = *(const f32x4*)(ct + 8), t3 = *(const f32x4*)(ct + 12);
              const float csv[8] = {t0[0], t0[2], t1[0], t1[2], t2[0], t2[2], t3[0], t3[2]}, snv[8] = {t0[1], t0[3], t1[1], t1[3], t2[1], t2[3], t3[1], t3[3]};
#pragma unroll
              for (int j = 0; j < 8; ++j) { const float pt = SHX(x[j], 2, lane);
                  if (lat) x[j] = (hi8 & 2) ? x[j] * csv[j] + pt * snv[j] : x[j] * csv[j] - pt * snv[j]; }
              oh.x = pk2(x[0], x[1]); oh.y = pk2(x[2], x[3]); oh.z = pk2(x[4], x[5]); oh.w = pk2(x[6], x[7]); }
            float csL = 1.f, snL = 0.f;
            if (lat) { const int d = lane & 31; const float* ct = rtab + ((size_t)(d < 16 ? t / GRID_W : t % GRID_W) * 24 + 16 + (d & 7)) * 2; csL = ct[0]; snL = ct[1]; }
            u32x2 ocq; unsigned ockv; float ykr;
            { float x[4] = {bf2f((bf16)cqv[q].x), bf2f((bf16)(cqv[q].x >> 16)), bf2f((bf16)cqv[q].y), bf2f((bf16)(cqv[q].y >> 16))};
              const float x0 = bf2f((bf16)ckvv[q]), x1 = bf2f((bf16)(ckvv[q] >> 16)); const float vk = lane < 32 ? bf2f(krv[q]) : 0.f;
              float s1 = x[0] * x[0] + x[1] * x[1] + x[2] * x[2] + x[3] * x[3], s2 = x0 * x0 + x1 * x1, s3 = vk * vk;
#pragma unroll
              for (int o = 1; o < 64; o <<= 1) { s1 += SHX(s1, o, lane); s2 += SHX(s2, o, lane); s3 += SHX(s3, o, lane); }
              const float r1 = rsqrt_fast(s1 * (1.0f / 256.0f) + EPS), r2 = rsqrt_fast(s2 * (1.0f / 128.0f) + EPS), r3 = rsqrt_fast(s3 * (1.0f / 32.0f) + EPS);
              ocq.x = pk2(x[0] * r1 * gcq[0], x[1] * r1 * gcq[1]); ocq.y = pk2(x[2] * r1 * gcq[2], x[3] * r1 * gcq[3]);
              ockv = pk2(x0 * r2 * gkv0, x1 * r2 * gkv1);
              float y = vk * r3 * gkr; const float pt = SHX(y, 8, lane);
              if (lat) y = (lane & 8) ? y * csL + pt * snL : y * csL - pt * snL;
              ykr = y; }
            if (ok[q]) {
#pragma unroll
                for (int j = 0; j < 3; ++j) *(u32x2*)(MQK + (size_t)Rr * 768 + 4 * lane + 256 * j) = ov[j];
                *(u32x4*)(pr + hbase) = oh;
                *(u32x2*)(pr + C_CQ + 4 * lane) = ocq; *(unsigned*)(pr + C_CKV + 2 * lane) = ockv;
                if (lane < 32) pr[C_KR + lane] = f2bf(ykr); }
        }
    }
}
#undef PREP_LD

DEV float scan_add(float v, int lane) {
#pragma unroll
    for (int d = 1; d < 64; d <<= 1) { const float t = __shfl(v, lane >= d ? lane - d : lane); if (lane >= d) v += t; }
    return v;
}
DEV float scan_max(float v, int lane) {
#pragma unroll
    for (int d = 1; d < 64; d <<= 1) { const float t = __shfl(v, lane >= d ? lane - d : lane); if (lane >= d) v = fmaxf(v, t); }
    return v;
}
DEV int chain_step(int dir, int cl) { return dir == 0 ? cl : (cl < NC_CTX ? NC_CTX - 1 - cl : NCH + NC_CTX - 1 - cl); }
DEV void gate_load(const P& p, int l, int R0, int hh, int dir, int lane, float (&g4)[4]) {
    const float* gb = p.m_gate_b + l * 16;
#pragma unroll
    for (int e = 0; e < 2; ++e) { const int j = 2 * lane + e, o = dir ? MCH - 1 - j : j;
        const float* G = (const float*)(p.ws + WS_GATES) + (size_t)(R0 + o) * 16;
        g4[2 * e] = G[dir * 8 + hh] + gb[dir * 8 + hh]; g4[2 * e + 1] = G[dir * 8 + 4 + hh] + gb[dir * 8 + 4 + hh]; }
}
DEV void gate_scan_core(const float (&g4)[4], int dir, int lane, float* al, float* pm, float* bcl, float& F, float& pml) {
    static_assert(MCH == 128, "two positions per lane");
    const float gi0 = g4[0], gi1 = g4[2], lf0 = log_sigmoid_f(g4[1]), lf1 = log_sigmoid_f(g4[3]);
    const float incl = scan_add(lf0 + lf1, lane);
    const float up1 = __shfl(incl, lane ? lane - 1 : 0), excl = lane ? up1 : 0.f;
    const float bc0 = excl + lf0, bc1 = incl, a0 = gi0 - bc0, a1 = gi1 - bc1;
    const float pin = scan_max(fmaxf(a0, a1), lane);
    const float pu = __shfl(pin, lane ? lane - 1 : 0), px0 = lane ? fmaxf(pu, a0) : a0;
    F = __shfl(incl, 63); pml = __shfl(pin, 63);
    { const int o0 = dir ? MCH - 1 - 2 * lane : 2 * lane, o1 = dir ? o0 - 1 : o0 + 1;
      al[o0] = a0; pm[o0] = px0; bcl[o0] = bc0; al[o1] = a1; pm[o1] = pin; bcl[o1] = bc1; }
}
DEV void gate_scan2(const P& p, int l, int R0, int hh, int dir, int lane, float* al, float* pm, float* bcl, float& F, float& pml) {
    float g4[4]; gate_load(p, l, R0, hh, dir, lane, g4); gate_scan_core(g4, dir, lane, al, pm, bcl, F, pml);
}
DEV void ml1_prefetch(const P& p, const Wg& w, int l, int item, u32x4 (&pkq)[3], u32x4 (&pvq)[3], float (&pg4)[4]) {
    const int b = item / (4 * NCH), hh = (item / NCH) % 4, cl = item % NCH, R0 = b * TP + cl * MCH;
    const bf16* MQK = (const bf16*)(p.ws + WS_MQK); const bf16* PROJ = (const bf16*)(p.ws + WS_PROJ);
    if (w.wave < 2) gate_load(p, l, R0, hh, w.wave, w.lane, pg4);
    (void)MQK; (void)PROJ; (void)pkq; (void)pvq;
}
DEV void ml1_item(const P& p, Wg& w, int l, int item, u32x4 (&pkq)[3], u32x4 (&pvq)[3], float (&pg4)[4], int next_item) {
    const int b = item / (4 * NCH), hh = (item / NCH) % 4, cl = item % NCH, R0 = b * TP + cl * MCH;
    float* wgt = (float*)w.lds;
    float* scr = wgt + 2 * MCH;
    bf16* Ks = (bf16*)(w.lds + 4096);
    bf16* Vw = Ks + MCH * 104;
    const bf16* MQK = (const bf16*)(p.ws + WS_MQK); const bf16* PROJ = (const bf16*)(p.ws + WS_PROJ);
    bf16* UC = (bf16*)(p.ws + WS_UC); float* NL = (float*)(p.ws + WS_NL);
    const int lane = w.lane, r = lane & 31, h = lane >> 5;
    static_assert(MCH * 12 == 3 * NTHR, "three k/v vectors per thread");
#pragma unroll
    for (int q = 0; q < 3; ++q) { const int idx = w.tid + q * NTHR, s = idx / 12, c = idx % 12;
        pkq[q] = *(const u32x4*)(MQK + (size_t)(R0 + s) * 768 + 384 + hh * 96 + 8 * c); pvq[q] = *(const u32x4*)(PROJ + (size_t)(R0 + s) * PROJ_W + C_MV + hh * 96 + 8 * c); }
    if (w.wave < 2) { const int dir = w.wave; float F, pml; float* sc = scr + dir * 3 * MCH;
        gate_scan_core(pg4, dir, lane, sc, sc + MCH, sc + 2 * MCH, F, pml);
        wave_sync();
#pragma unroll
        for (int hf = 0; hf < 2; ++hf) wgt[dir * MCH + lane + 64 * hf] = __expf(sc[lane + 64 * hf] - pml);
        const int ci = ((b * 4 + hh) * 2 + dir) * NCH + chain_step(dir, cl);
        if (lane == 0) { ((float*)(p.ws + WS_FS))[ci] = F; ((float*)(p.ws + WS_PML))[ci] = pml; } }
    __syncthreads();
#pragma unroll
    for (int q = 0; q < 3; ++q) { const int idx = w.tid + q * NTHR, s = idx / 12, c = idx % 12;
        const u32x4 kr = pkq[q], vr = pvq[q];
        *(u32x4*)(Ks + s * 104 + 8 * c) = kr;
#pragma unroll
        for (int dir = 0; dir < 2; ++dir) { const float wd = wgt[dir * MCH + s]; u32x4 o;
            o.x = pk2(wd * bf2f((bf16)vr.x), wd * bf2f((bf16)(vr.x >> 16))); o.y = pk2(wd * bf2f((bf16)vr.y), wd * bf2f((bf16)(vr.y >> 16)));
            o.z = pk2(wd * bf2f((bf16)vr.z), wd * bf2f((bf16)(vr.z >> 16))); o.w = pk2(wd * bf2f((bf16)vr.w), wd * bf2f((bf16)(vr.w >> 16)));
            *(u32x4*)(Vw + (dir * MCH + s) * 104 + 8 * c) = o;
            if (c == 0) Vw[(dir * MCH + s) * 104 + 96] = f2bf(wd); } }
    __syncthreads();
    if (next_item >= 0) ml1_prefetch(p, w, l, next_item, pkq, pvq, pg4);
    const int toff = (8 * h + ((lane & 15) >> 2)) * 104 + 16 * ((lane >> 4) & 1) + 4 * (lane & 3);
    for (int task = w.wave; task < 24; task += NWAVE) {
        const bool nt = task >= 18; const int tt = nt ? task - 18 : task;
        const int dir = nt ? tt / 3 : tt / 9, dt = nt ? tt % 3 : (tt % 9) / 3, et = nt ? 3 : tt % 3;
        f32x16 acc;
#pragma unroll
        for (int i = 0; i < 16; ++i) acc[i] = 0.f;
#pragma unroll
        for (int ks = 0; ks < MCH / 16; ++ks) { const bf16* ap = Ks + (16 * ks) * 104 + 32 * dt + toff; const bf16* bp = Vw + (dir * MCH + 16 * ks) * 104 + 32 * et + toff;
            const s16x4 al = lds_tr_read(ap), ah = lds_tr_read(ap + 4 * 104), bl = lds_tr_read(bp), bh = lds_tr_read(bp + 4 * 104);
            const bf16x8 af = (bf16x8){al[0], al[1], al[2], al[3], ah[0], ah[1], ah[2], ah[3]}, bfr = (bf16x8){bl[0], bl[1], bl[2], bl[3], bh[0], bh[1], bh[2], bh[3]};
            acc = mfma32(af, bfr, acc); }
        const int ci = ((b * 4 + hh) * 2 + dir) * NCH + chain_step(dir, cl);
        if (!nt) { bf16* up = UC + (size_t)ci * 9216 + (32 * et + r) * 96 + 32 * dt + 4 * h;
#pragma unroll
            for (int g = 0; g < 4; ++g) { u32x2 o; o.x = pk2(acc[4 * g], acc[4 * g + 1]); o.y = pk2(acc[4 * g + 2], acc[4 * g + 3]); *(u32x2*)(up + 8 * g) = o; } }
        else if (r == 0) { float* np = NL + (size_t)ci * 96 + 32 * dt + 4 * h;
#pragma unroll
            for (int g = 0; g < 4; ++g) *(f32x4*)(np + 8 * g) = (f32x4){acc[4 * g], acc[4 * g + 1], acc[4 * g + 2], acc[4 * g + 3]}; } }
    __syncthreads();
}
DEV void phase_ml2(const P& p, Wg& w) {
    constexpr int GPC = 1152 + 24;
    bf16* UC = (bf16*)(p.ws + WS_UC); float* NL = (float*)(p.ws + WS_NL);
    const float* FS = (const float*)(p.ws + WS_FS); const float* PML = (const float*)(p.ws + WS_PML); float* MST = (float*)(p.ws + WS_MST);
    int per = (((NCHAIN * GPC + w.G - 1) / w.G) + 63) & ~63; if (per > NTHR) per = NTHR;
    for (int j = w.wg * per + w.tid; w.tid < per && j < NCHAIN * GPC; j += w.G * per) {
        const int chain = j / GPC, g = j % GPC;
        float C[8], m = 0.f;
#pragma unroll
        for (int i = 0; i < 8; ++i) C[i] = 0.f;
        for (int k0 = 0; k0 < NCH; k0 += ML2_U) {
            float Fv[ML2_U], pv[ML2_U];
#pragma unroll
            for (int q = 0; q < ML2_U; ++q) { Fv[q] = FS[chain * NCH + k0 + q]; pv[q] = PML[chain * NCH + k0 + q]; }
            if (g < 1152) { u32x4 raw[ML2_U];
#pragma unroll
                for (int q = 0; q < ML2_U; ++q) raw[q] = *(const u32x4*)(UC + (size_t)(chain * NCH + k0 + q) * 9216 + 8 * g);
#pragma unroll
                for (int q = 0; q < ML2_U; ++q) { const int ci = chain * NCH + k0 + q; const float mx = fmaxf(m, pv[q]), dec = __expf(m - mx), sc = __expf(pv[q] - mx);
                    u32x4 st; st.x = pk2(C[0], C[1]); st.y = pk2(C[2], C[3]); st.z = pk2(C[4], C[5]); st.w = pk2(C[6], C[7]); *(u32x4*)(UC + (size_t)ci * 9216 + 8 * g) = st;
#pragma unroll
                    for (int i = 0; i < 8; ++i) C[i] = dec * C[i] + sc * bf2f((bf16)(raw[q][i >> 1] >> ((i & 1) * 16)));
                    if (g == 0) MST[ci] = m;
                    m = Fv[q] + mx; } }
            else { f32x4 rr[ML2_U];
#pragma unroll
                for (int q = 0; q < ML2_U; ++q) rr[q] = *(const f32x4*)(NL + (size_t)(chain * NCH + k0 + q) * 96 + 4 * (g - 1152));
#pragma unroll
                for (int q = 0; q < ML2_U; ++q) { float* nl = NL + (size_t)(chain * NCH + k0 + q) * 96 + 4 * (g - 1152);
                    const float mx = fmaxf(m, pv[q]), dec = __expf(m - mx), sc = __expf(pv[q] - mx);
                    *(f32x4*)nl = (f32x4){C[0], C[1], C[2], C[3]};
#pragma unroll
                    for (int i = 0; i < 4; ++i) C[i] = dec * C[i] + sc * rr[q][i];
                    m = Fv[q] + mx; } }
        }
    }
}
DEV void ml3_item(const P& p, Wg& w, int l, int item) {
    const int lane = w.lane, r = lane & 31, h = lane >> 5, dir = w.wave >> 2, tq = w.wave & 3;
    const int b = item / (4 * NCH), hh = (item / NCH) % 4, cl = item % NCH, R0 = b * TP + cl * MCH;
    const int ci = ((b * 4 + hh) * 2 + dir) * NCH + chain_step(dir, cl);
    bf16* Qs = (bf16*)w.lds;
    bf16* Ksm = Qs + MCH * 104;
    bf16* Vs = Ksm + MCH * 104;
    float* nls = (float*)(w.lds + 3 * MCH * 104 * 2);
    float* scn = nls + 192;
    float* hx = (float*)w.lds;
    const bf16* MQK = (const bf16*)(p.ws + WS_MQK); const bf16* PROJ = (const bf16*)(p.ws + WS_PROJ);
    const bf16* UCi = (const bf16*)(p.ws + WS_UC) + (size_t)ci * 9216;
    { u32x4 qv[3], kv[3], vv[3];
#pragma unroll
      for (int q = 0; q < 3; ++q) { const int idx = w.tid + q * NTHR, s = idx / 12, c = idx % 12;
          qv[q] = *(const u32x4*)(MQK + (size_t)(R0 + s) * 768 + hh * 96 + 8 * c); kv[q] = *(const u32x4*)(MQK + (size_t)(R0 + s) * 768 + 384 + hh * 96 + 8 * c);
          vv[q] = *(const u32x4*)(PROJ + (size_t)(R0 + s) * PROJ_W + C_MV + hh * 96 + 8 * c); }
#pragma unroll
      for (int q = 0; q < 3; ++q) { const int idx = w.tid + q * NTHR, s = idx / 12, c = idx % 12;
          *(u32x4*)(Qs + s * 104 + 8 * c) = qv[q]; *(u32x4*)(Ksm + s * 104 + 8 * c) = kv[q]; *(u32x4*)(Vs + s * 104 + 8 * c) = vv[q]; } }
    if (w.tid < 192) { const int dd = w.tid / 96; nls[w.tid] = ((const float*)(p.ws + WS_NL))[(size_t)(((b * 4 + hh) * 2 + dd) * NCH + chain_step(dd, cl)) * 96 + w.tid % 96]; }
    if (tq == 0) { float F, pml; float* sc = scn + dir * 3 * MCH; gate_scan2(p, l, R0, hh, dir, lane, sc, sc + MCH, sc + 2 * MCH, F, pml); }
    const float m_st = ((const float*)(p.ws + WS_MST))[ci];
    __syncthreads();
    const float* al = scn + dir * 3 * MCH; const float* pmv = al + MCH; const float* bcl = al + 2 * MCH;
    const int t = 32 * tq + r;
    const float mx_t = fmaxf(m_st, pmv[t]), bc_t = bcl[t];
    bf16x8 qf[6]; float qn = 0.f;
#pragma unroll
    for (int ks = 0; ks < 6; ++ks) { qf[ks] = *(const bf16x8*)(Qs + t * 104 + 16 * ks + 8 * h);
        const f32x4 n0 = *(const f32x4*)(nls + dir * 96 + 16 * ks + 8 * h), n1 = *(const f32x4*)(nls + dir * 96 + 16 * ks + 8 * h + 4);
#pragma unroll
        for (int j = 0; j < 4; ++j) { qn += bf2f((bf16)qf[ks][j]) * n0[j]; qn += bf2f((bf16)qf[ks][4 + j]) * n1[j]; } }
    qn += SHX(qn, 32, lane);
    f32x16 o[3]; float rs = 0.f;
#pragma unroll
    for (int et = 0; et < 3; ++et)
#pragma unroll
        for (int i = 0; i < 16; ++i) o[et][i] = 0.f;
    for (int kb = dir ? tq : 0; kb < (dir ? NQB : tq + 1); ++kb) {
        f32x16 pw;
#pragma unroll
        for (int i = 0; i < 16; ++i) pw[i] = 0.f;
#pragma unroll
        for (int ks = 0; ks < 6; ++ks) { const bf16x8 kf = *(const bf16x8*)(Ksm + (32 * kb + r) * 104 + 16 * ks + 8 * h); pw = mfma32(kf, qf[ks], pw); }
#pragma unroll
        for (int g = 0; g < 4; ++g) { const int s0 = 32 * kb + 8 * g + 4 * h; const f32x4 av = *(const f32x4*)(al + s0);
#pragma unroll
            for (int j = 0; j < 4; ++j) { const int sidx = s0 + j; const bool okk = dir ? (sidx >= t) : (sidx <= t);
                const float wv = okk ? __expf(av[j] - mx_t) * pw[4 * g + j] : 0.f; pw[4 * g + j] = wv; rs += wv; } }
        bf16x8 pb[2];
#pragma unroll
        for (int sp = 0; sp < 2; ++sp) { u32x4 u; u.x = pk2(pw[8 * sp], pw[8 * sp + 1]); u.y = pk2(pw[8 * sp + 2], pw[8 * sp + 3]); u.z = pk2(pw[8 * sp + 4], pw[8 * sp + 5]); u.w = pk2(pw[8 * sp + 6], pw[8 * sp + 7]);
            pb[sp] = __builtin_bit_cast(bf16x8, u); }
#pragma unroll
        for (int et = 0; et < 3; ++et)
#pragma unroll
            for (int sp = 0; sp < 2; ++sp) { const bf16* vp = Vs + (32 * kb + 16 * sp + 4 * h + ((lane & 15) >> 2)) * 104 + 32 * et + 16 * ((lane >> 4) & 1) + 4 * (lane & 3);
                const s16x4 lo = lds_tr_read(vp), hi = lds_tr_read(vp + 8 * 104);
                const bf16x8 vf = (bf16x8){lo[0], lo[1], lo[2], lo[3], hi[0], hi[1], hi[2], hi[3]};
                o[et] = mfma32(vf, pb[sp], o[et]); }
    }
    rs += SHX(rs, 32, lane);
    const float a_int = __expf(m_st - mx_t), den = a_int * qn + rs, inv = 1.0f / fmaxf(fabsf(den), __expf(-(bc_t + mx_t)));
#pragma unroll
    for (int et = 0; et < 3; ++et) { f32x16 oi;
#pragma unroll
        for (int i = 0; i < 16; ++i) oi[i] = 0.f;
#pragma unroll
        for (int ks = 0; ks < 6; ++ks) { const bf16x8 cf = *(const bf16x8*)(UCi + (32 * et + r) * 96 + 16 * ks + 8 * h); oi = mfma32(cf, qf[ks], oi); }
#pragma unroll
        for (int i = 0; i < 16; ++i) o[et][i] = (a_int * oi[i] + o[et][i]) * inv; }
    __syncthreads();
    if (dir == 1) {
#pragma unroll
        for (int et = 0; et < 3; ++et)
#pragma unroll
            for (int i = 0; i < 16; ++i) hx[t * 97 + 32 * et + crow(i, h)] = o[et][i]; }
    __syncthreads();
    if (dir == 0) { float ss = 0.f;
#pragma unroll
        for (int et = 0; et < 3; ++et)
#pragma unroll
            for (int i = 0; i < 16; ++i) { o[et][i] += hx[t * 97 + 32 * et + crow(i, h)]; ss += o[et][i] * o[et][i]; }
        ss += SHX(ss, 32, lane);
        const float rstd = rsqrt_fast(ss * (1.0f / 96.0f) + EPS);
        bf16* MIX = (bf16*)(p.ws + WS_H);
#pragma unroll
        for (int et = 0; et < 3; ++et)
#pragma unroll
            for (int g = 0; g < 4; ++g) { const int e = 32 * et + 8 * g + 4 * h;
                const u32x2 og = *(const u32x2*)(PROJ + (size_t)(R0 + t) * PROJ_W + C_MO + hh * 96 + e); const f32x4 mn = *(const f32x4*)(p.m_norm + l * 384 + hh * 96 + e);
                float o4[4];
#pragma unroll
                for (int j = 0; j < 4; ++j) { const float gate = bf2f((bf16)((j < 2 ? og.x : og.y) >> ((j & 1) * 16))); o4[j] = o[et][4 * g + j] * rstd * mn[j] * sigmoid_f(gate); }
                u32x2 ov; ov.x = pk2(o4[0], o4[1]); ov.y = pk2(o4[2], o4[3]);
                *(u32x2*)(MIX + (size_t)(R0 + t) * MIXW + hh * 96 + e) = ov; } }
    __syncthreads();
}

DEV void phase_mla_post(const P& p, Wg& w, int l) {
    bf16* MLAQ = (bf16*)(p.ws + WS_MLAQ); const bf16* PROJ = (const bf16*)(p.ws + WS_PROJ);
    const int lane = w.lane;
    int baseA = 0, nA = 8, dstA = 8 * lane; bool normA = true, ropeA = false; const float* gA = p.l_qnorm + l * 96;
    if (lane < 48) { const int hh = lane / 12, o = lane % 12;
        if (o < 8) { baseA = 12 * hh; nA = 8; gA = p.l_qnorm + l * 96 + 8 * o; }
        else { baseA = 12 * hh + 8; nA = 4; gA = p.l_qnorm + l * 96 + 64 + 8 * (o - 8); ropeA = true; } }
    else { normA = false; }
    const int hb = (lane & 31) / 8, ob = lane % 8; const bool normB = lane < 32;
    const int baseB = 8 * hb;
    const int dstB = 384 + 96 * hb + 8 * ob;
    const float* gB = p.l_knorm + l * 96 + 8 * ob;
    float gAv[8], gBv[8];
#pragma unroll
    for (int j = 0; j < 8; ++j) { gAv[j] = gA[j]; gBv[j] = gB[j]; }
    const int cidx = (lane % 12) - 8;
    constexpr int NB = 2;
    u32x4 na[NB], nb[NB], nk[NB];
#define POST_PF(R0_) do { _Pragma("unroll") for (int q = 0; q < NB; ++q) { const int R_ = (R0_) + q * w.NGW; const int Rr_ = R_ < M_ALL ? R_ : (R0_); const bf16* row_ = MLAQ + (size_t)Rr_ * MLAP; \
        na[q] = (lane < 48) ? *(const u32x4*)(row_ + 8 * lane) : (u32x4){0u, 0u, 0u, 0u}; nb[q] = normB ? *(const u32x4*)(row_ + dstB) : (u32x4){0u, 0u, 0u, 0u}; \
        nk[q] = (lane >= 48) ? *(const u32x4*)(PROJ + (size_t)Rr_ * PROJ_W + C_KR + 8 * ((lane - 48) & 3)) : (u32x4){0u, 0u, 0u, 0u}; } } while (0)
    POST_PF(w.gw);
    for (int R0 = w.gw; R0 < M_ALL; R0 += NB * w.NGW) {
        u32x4 ra[NB], rb[NB], kr[NB]; bool ok[NB]; f32x4 tb[NB][4];
#pragma unroll
        for (int q = 0; q < NB; ++q) { ok[q] = R0 + q * w.NGW < M_ALL; ra[q] = na[q]; rb[q] = nb[q]; kr[q] = nk[q];
            const int Rr = ok[q] ? R0 + q * w.NGW : R0; const int qq = Rr % TP; const bool lat = qq >= CTX; const int t = qq - CTX;
            const float* ct = (const float*)(p.ws + WS_ROPE) + ((size_t)(lat ? ((cidx & 3) < 2 ? t / GRID_W : t % GRID_W) : 0) * 24 + 16) * 2;
            tb[q][0] = *(const f32x4*)ct; tb[q][1] = *(const f32x4*)(ct + 4); tb[q][2] = *(const f32x4*)(ct + 8); tb[q][3] = *(const f32x4*)(ct + 12); }
        if (R0 + NB * w.NGW < M_ALL) POST_PF(R0 + NB * w.NGW);
        u32x4 oa[NB], obv[NB];
#pragma unroll
        for (int q = 0; q < NB; ++q) { const int Rr = ok[q] ? R0 + q * w.NGW : R0; const int qq = Rr % TP; const bool lat = qq >= CTX;
            float xa[8], xb[8], ssA = 0.f, ssB = 0.f;
#pragma unroll
            for (int j = 0; j < 8; ++j) { xa[j] = bf2f((bf16)(ra[q][j >> 1] >> ((j & 1) * 16))); xb[j] = bf2f((bf16)(rb[q][j >> 1] >> ((j & 1) * 16))); ssA += xa[j] * xa[j]; ssB += xb[j] * xb[j]; }
            float sA = 0.f, sB = 0.f;
#pragma unroll
            for (int i = 0; i < 8; ++i) { const float v = __shfl(ssA, (baseA + i) & 63); if (i < nA) sA += v; sB += __shfl(ssB, (baseB + i) & 63); }
            const float rsA = normA ? rsqrt_fast(sA / (float)(8 * nA) + EPS) : 1.0f, rsB = normB ? rsqrt_fast(sB * (1.0f / 64.0f) + EPS) : 1.0f;
#pragma unroll
            for (int j = 0; j < 8; ++j) { xa[j] = normA ? xa[j] * rsA * gAv[j] : xa[j]; xb[j] = normB ? xb[j] * rsB * gBv[j] : xb[j]; }
            const f32x4 t0 = tb[q][0], t1 = tb[q][1], t2 = tb[q][2], t3 = tb[q][3];
            const float csv[8] = {t0[0], t0[2], t1[0], t1[2], t2[0], t2[2], t3[0], t3[2]}, snv[8] = {t0[1], t0[3], t1[1], t1[3], t2[1], t2[3], t3[1], t3[3]};
#pragma unroll
            for (int j = 0; j < 8; ++j) { const float pt = SHX(xa[j], 1, lane);
                if (ropeA && lat) xa[j] = (cidx & 1) ? xa[j] * csv[j] + pt * snv[j] : xa[j] * csv[j] - pt * snv[j]; }
            if (lane < 48) {
#pragma unroll
                for (int j = 0; j < 8; ++j) xa[j] *= QSCALE_L; }
            oa[q].x = pk2(xa[0], xa[1]); oa[q].y = pk2(xa[2], xa[3]); oa[q].z = pk2(xa[4], xa[5]); oa[q].w = pk2(xa[6], xa[7]);
            obv[q].x = pk2(xb[0], xb[1]); obv[q].y = pk2(xb[2], xb[3]); obv[q].z = pk2(xb[4], xb[5]); obv[q].w = pk2(xb[6], xb[7]); }
        wave_sync();
#pragma unroll
        for (int q = 0; q < NB; ++q) if (ok[q]) { bf16* row = MLAQ + (size_t)(R0 + q * w.NGW) * MLAP;
            if (lane < 48) *(u32x4*)(row + dstA) = oa[q];
            else { const int i = lane - 48; *(u32x4*)(row + 384 + 96 * (i >> 2) + 64 + 8 * (i & 3)) = kr[q]; }
            if (normB) *(u32x4*)(row + dstB) = obv[q]; }
        wave_sync();
    }
}

#undef POST_PF
template <int DQK>
DEV void attn_unit(const bf16* Q, int ldq, const bf16* K, int ldk, const bf16* V, int ldv, bf16* O, int ldo, int nkeys, Wg& w) {
    constexpr int KS = DQK + 8, NKD = DQK / 16, CPR = DQK / 8, NKC = 64 * CPR, VS = 72;
    bf16* Ks = (bf16*)w.lds;
    bf16* Vs = (bf16*)(w.lds + 2 * 64 * KS * 2);
    const int tid = w.tid, lane = w.lane, r = lane & 31, h = lane >> 5;
    bf16x8 qr[NKD];
    { const bf16* qp = Q + (size_t)(w.wave * 32 + r) * ldq + 8 * h;
#pragma unroll
      for (int d0 = 0; d0 < NKD; ++d0) qr[d0] = *(const bf16x8*)(qp + 16 * d0); }
    const int kr0 = tid / CPR, kc0 = tid % CPR, kr1 = (tid + NTHR) / CPR, kc1 = (tid + NTHR) % CPR; const bool k1 = (tid + NTHR) < NKC;
    const int vr = tid >> 3, vc = tid & 7;
    u32x4 rk0, rk1 = (u32x4){0u, 0u, 0u, 0u}, rv;
    const int NT = nkeys / 64;
    const int vtr_off = (4 * h + ((lane & 15) >> 2)) * VS + 16 * ((lane >> 4) & 1) + 4 * (lane & 3);
#define AT_LOAD(kt) do { rk0 = *(const u32x4*)(K + (size_t)((kt) * 64 + kr0) * ldk + 8 * kc0); if (k1) rk1 = *(const u32x4*)(K + (size_t)((kt) * 64 + kr1) * ldk + 8 * kc1); \
        rv = *(const u32x4*)(V + (size_t)((kt) * 64 + vr) * ldv + 8 * vc); } while (0)
#define AT_STORE(buf) do { *(u32x4*)(Ks + ((buf) * 64 + kr0) * KS + 8 * kc0) = rk0; if (k1) *(u32x4*)(Ks + ((buf) * 64 + kr1) * KS + 8 * kc1) = rk1; \
        *(u32x4*)(Vs + ((buf) * 64 + vr) * VS + 8 * vc) = rv; } while (0)
    AT_LOAD(0); AT_STORE(0);
    __syncthreads();
    float m_run = 0.f, l_run = 0.f; f32x16 o[2], negm;
#pragma unroll
    for (int i = 0; i < 16; ++i) { o[0][i] = 0.f; o[1][i] = 0.f; negm[i] = 0.f; }
    for (int kt = 0; kt < NT; ++kt) {
        const int buf = kt & 1;
        if (kt + 1 < NT) AT_LOAD(kt + 1);
        f32x16 pt[2];
        { bf16x8 kf[2][NKD];
#pragma unroll
          for (int kh = 0; kh < 2; ++kh)
#pragma unroll
              for (int d0 = 0; d0 < NKD; ++d0) kf[kh][d0] = *(const bf16x8*)(Ks + (buf * 64 + 32 * kh + r) * KS + 16 * d0 + 8 * h);
          SCHED_FENCE();
          pt[0] = negm; pt[1] = negm;
#pragma unroll
          for (int d0 = 0; d0 < NKD; ++d0) { pt[0] = mfma32(kf[0][d0], qr[d0], pt[0]); pt[1] = mfma32(kf[1][d0], qr[d0], pt[1]); } }
        bf16x8 vf[2][2][2];
#pragma unroll
        for (int et = 0; et < 2; ++et)
#pragma unroll
            for (int kh = 0; kh < 2; ++kh)
#pragma unroll
                for (int sp = 0; sp < 2; ++sp) { const bf16* vp = Vs + (buf * 64 + 32 * kh + 16 * sp) * VS + 32 * et + vtr_off;
                    const s16x4 lo = lds_tr_read(vp), hi = lds_tr_read(vp + 8 * VS);
                    vf[et][kh][sp] = (bf16x8){lo[0], lo[1], lo[2], lo[3], hi[0], hi[1], hi[2], hi[3]}; }
        SCHED_FENCE();
        float mq[4];
#pragma unroll
        for (int c = 0; c < 4; ++c) mq[c] = fmaxf(pt[0][c], pt[1][c]);
#pragma unroll
        for (int i = 4; i < 16; ++i) mq[i & 3] = fmaxf(mq[i & 3], fmaxf(pt[0][i], pt[1][i]));
        float mt = fmaxf(fmaxf(mq[0], mq[1]), fmaxf(mq[2], mq[3]));
        if (__any(kt == 0 || mt > 8.0f)) {
            mt = fmaxf(mt, SHX(mt, 32, lane));
            const float dl = (kt == 0) ? mt : fmaxf(mt, 0.f), alpha = exp2_fast(-dl);
            m_run += dl; l_run *= alpha;
#pragma unroll
            for (int i = 0; i < 16; ++i) { pt[0][i] -= dl; pt[1][i] -= dl; o[0][i] *= alpha; o[1][i] *= alpha; negm[i] = -m_run; }
        }
        float rq[4] = {0.f, 0.f, 0.f, 0.f};
#pragma unroll
        for (int kh = 0; kh < 2; ++kh)
#pragma unroll
            for (int i = 0; i < 16; ++i) { const float e = exp2_fast(pt[kh][i]); pt[kh][i] = e; rq[i & 3] += e; }
        l_run += (rq[0] + rq[1]) + (rq[2] + rq[3]);
        bf16x8 pb[2][2];
#pragma unroll
        for (int kh = 0; kh < 2; ++kh)
#pragma unroll
            for (int sp = 0; sp < 2; ++sp) { u32x4 u; u.x = pk2(pt[kh][8 * sp], pt[kh][8 * sp + 1]); u.y = pk2(pt[kh][8 * sp + 2], pt[kh][8 * sp + 3]); u.z = pk2(pt[kh][8 * sp + 4], pt[kh][8 * sp + 5]); u.w = pk2(pt[kh][8 * sp + 6], pt[kh][8 * sp + 7]);
                pb[kh][sp] = __builtin_bit_cast(bf16x8, u); }
        SCHED_FENCE();
#pragma unroll
        for (int kh = 0; kh < 2; ++kh)
#pragma unroll
            for (int sp = 0; sp < 2; ++sp)
#pragma unroll
                for (int et = 0; et < 2; ++et) o[et] = mfma32(vf[et][kh][sp], pb[kh][sp], o[et]);
        if (kt + 1 < NT) AT_STORE(buf ^ 1);
        __syncthreads();
    }
#undef AT_LOAD
#undef AT_STORE
    l_run += SHX(l_run, 32, lane);
    const float inv = 1.0f / l_run;
    bf16* op = O + (size_t)(w.wave * 32 + r) * ldo + 4 * h;
#pragma unroll
    for (int et = 0; et < 2; ++et)
#pragma unroll
        for (int g = 0; g < 4; ++g) { u32x2 ov; ov.x = pk2(o[et][4 * g] * inv, o[et][4 * g + 1] * inv); ov.y = pk2(o[et][4 * g + 2] * inv, o[et][4 * g + 3] * inv); *(u32x2*)(op + 32 * et + 8 * g) = ov; }
}
#ifndef REP_ATT
#define REP_ATT 1
#endif
#ifndef REP_ML3
#define REP_ML3 1
#endif
DEV void relaunder(Wg& w) { int t_ = w.tid; OPAQUE_V(t_); w.tid = t_; w.lane = t_ & 63; }
DEV void phase_mix(const P& p, Wg& w, int l) {
    const bf16* PROJ = (const bf16*)(p.ws + WS_PROJ); const bf16* MLAQ = (const bf16*)(p.ws + WS_MLAQ); bf16* MIX = (bf16*)(p.ws + WS_H);
    unsigned* ctr = (unsigned*)(p.ws + WS_CTL) + CW_Q + 1024 * l;
    const int n_ml3 = BATCH * 4 * NCH;
    for (int rep = 0; rep < REP_ATT; ++rep) {
        { const int n_lat = BATCH * 4 * NQL, n_all = n_lat + ((l == 0) ? BATCH * 4 : 0);
          for (int idx = q_next(w, ctr + 64 * rep), nxt_; idx < n_all; idx = nxt_) {
            unsigned tk_ = 0u; q_issue(w, ctr + 64 * rep, tk_);
            int b, head, qb, nkeys;
            if (idx < n_lat) { b = idx / (4 * NQL); head = (idx / NQL) % 4; qb = 1 + idx % NQL; nkeys = TP; }
            else { idx -= n_lat; b = idx / 4; head = idx % 4; qb = 0; nkeys = CTX; }
            const size_t Rq = (size_t)b * TP + qb * 256, Rk = (size_t)b * TP;
            attn_unit<96>(MLAQ + Rq * MLAP + head * 96, MLAP, MLAQ + Rk * MLAP + 384 + head * 96, MLAP, MLAQ + Rk * MLAP + 768 + head * 64, MLAP, MIX + Rq * MIXW + 768 + head * 64, MIXW, nkeys, w);
            nxt_ = q_take(w, tk_);
          } }
        relaunder(w);
        { const int n_lat = BATCH * 6 * NQL, n_all = n_lat + ((l == 0) ? BATCH * 6 : 0);
          for (int idx = q_next(w, ctr + 256 + 64 * rep), nxt_; idx < n_all; idx = nxt_) {
            unsigned tk_ = 0u; q_issue(w, ctr + 256 + 64 * rep, tk_);
            int b, head, qb, nkeys;
            if (idx < n_lat) { b = idx / (6 * NQL); const int rem = idx % (6 * NQL); head = (rem / (3 * NQL)) * 3 + rem % 3; qb = 1 + (rem % (3 * NQL)) / 3; nkeys = TP; }
            else { idx -= n_lat; b = idx / 6; head = idx % 6; qb = 0; nkeys = CTX; }
            const size_t Rq = (size_t)b * TP + qb * 256, Rk = (size_t)b * TP;
            attn_unit<64>(PROJ + Rq * PROJ_W + C_AQ + head * 64, PROJ_W, PROJ + Rk * PROJ_W + C_AK + (head / 3) * 64, PROJ_W, PROJ + Rk * PROJ_W + C_AV + (head / 3) * 64, PROJ_W, MIX + Rq * MIXW + 384 + head * 64, MIXW, nkeys, w);
            nxt_ = q_take(w, tk_);
          } }
        relaunder(w);
    }
    for (int rep = 0; rep < REP_ML3; ++rep)
    for (int idx = q_next(w, ctr + 512 + 64 * rep), nxt_; idx < n_ml3; idx = nxt_) {
        unsigned tk_ = 0u; q_issue(w, ctr + 512 + 64 * rep, tk_);
        if (!(l == 1 && idx % NCH < NC_CTX)) ml3_item(p, w, l, idx);
        nxt_ = q_take(w, tk_);
    }
}

DEV void moe_seg_table(const P& p, Wg& w) {
    const int* cntg = (const int*)(p.ws + WS_CNTG); int* part = (int*)w.lds;
    { const int e = w.tid & 7; int tot = 0, pre = 0;
      for (int g = w.tid >> 3; g < w.G; g += NTHR / 8) { const int c = cntg[g * NEXP + e]; tot += c; pre += (g < w.wg) ? c : 0; }
      part[2 * w.tid] = tot; part[2 * w.tid + 1] = pre; }
    __syncthreads();
    if (w.tid < NEXP) { int tot = 0, pre = 0; for (int i = 0; i < NTHR / 8; ++i) { tot += part[2 * (8 * i + w.tid)]; pre += part[2 * (8 * i + w.tid) + 1]; } w.misc[32 + w.tid] = (unsigned)tot; w.misc[48 + w.tid] = (unsigned)pre; }
    __syncthreads();
    if (w.tid == 0) { int s = 0; for (int e = 0; e < NEXP; ++e) { w.misc[16 + e] = (unsigned)s; s += ((int)w.misc[32 + e] + 255) / 256; } w.misc[16 + NEXP] = (unsigned)s; }
    __syncthreads();
}
#ifndef EMU
DEV unsigned long long ballot64(bool pr) { return __ballot(pr); }
#else
inline unsigned long long ballot64(bool pr) { unsigned long long m = 0; for (int i = 0; i < 64; ++i) m |= (unsigned long long)(__shfl((int)pr, i) & 1) << i; return m; }
#endif
DEV void moe_row_range(const Wg& w, int& Rbeg, int& Rend) {
    const int RPWm = (M_ALL + w.NGW - 1) / w.NGW; Rbeg = w.gw * RPWm < M_ALL ? w.gw * RPWm : M_ALL; Rend = Rbeg + RPWm < M_ALL ? Rbeg + RPWm : M_ALL;
}
DEV void gather_choice(const int* topi, const Wg& w, int i0, int& e0, int& e1, int& tok) {
    int Rbeg, Rend; moe_row_range(w, Rbeg, Rend);
    const int R = Rbeg + i0 + w.lane; e0 = -1; e1 = -1; tok = 0;
    if (R < Rend) { const int q = R % TP; if (q >= CTX) { tok = (R / TP) * SEQ + q - CTX; e0 = topi[2 * tok]; e1 = topi[2 * tok + 1]; } }
}
DEV void phase_gather(const P& p, Wg& w) {
    moe_seg_table(p, w);
    const int* topi = (const int*)(p.ws + WS_TOPI); const float* topw = (const float*)(p.ws + WS_TOPW);
    int* stok = (int*)(p.ws + WS_STOK); float* sw = (float*)(p.ws + WS_SW);
    int* rowmap = (int*)(p.ws + WS_ROWMAP);
    int* lc = (int*)w.lds;
    int Rbeg_, Rend_; moe_row_range(w, Rbeg_, Rend_); const int nrow = Rend_ - Rbeg_;
    { int c[NEXP];
#pragma unroll
      for (int e = 0; e < NEXP; ++e) c[e] = 0;
      for (int i0 = 0; i0 < nrow; i0 += 64) { int e0, e1, tok; gather_choice(topi, w, i0, e0, e1, tok);
#pragma unroll
          for (int e = 0; e < NEXP; ++e) c[e] += __builtin_popcountll(ballot64(e0 == e)) + __builtin_popcountll(ballot64(e1 == e)); }
      if (w.lane == 0) {
#pragma unroll
          for (int e = 0; e < NEXP; ++e) lc[w.wave * NEXP + e] = c[e]; } }
    __syncthreads();
    if (w.tid < NEXP) { int s = (int)w.misc[16 + w.tid] * 256 + (int)w.misc[48 + w.tid]; for (int ww = 0; ww < NWAVE; ++ww) { const int c = lc[ww * NEXP + w.tid]; lc[ww * NEXP + w.tid] = s; s += c; } }
    __syncthreads();
    int base[NEXP];
#pragma unroll
    for (int e = 0; e < NEXP; ++e) base[e] = lc[w.wave * NEXP + e];
    for (int i0 = 0; i0 < nrow; i0 += 64) {
        int e0, e1, tok; gather_choice(topi, w, i0, e0, e1, tok);
        unsigned long long m0 = 0ull, m1 = 0ull; int b0 = 0, b1 = 0;
#pragma unroll
        for (int e = 0; e < NEXP; ++e) { const unsigned long long me = ballot64(e0 == e) | ballot64(e1 == e);
            if (e0 == e) { m0 = me; b0 = base[e]; } if (e1 == e) { m1 = me; b1 = base[e]; } base[e] += __builtin_popcountll(me); }
        const unsigned long long lt = (1ull << w.lane) - 1ull;
        const int a0 = b0 + __builtin_popcountll(m0 & lt), a1 = b1 + __builtin_popcountll(m1 & lt);
        if (e0 >= 0) { const int R = Rbeg_ + i0 + w.lane; stok[a0] = tok; stok[a1] = tok; rowmap[a0] = R; rowmap[a1] = R; sw[a0] = topw[2 * tok]; sw[a1] = topw[2 * tok + 1]; int* tsl = (int*)(p.ws + WS_TSL) + 2 * tok; tsl[0] = a0; tsl[1] = a1; }
    }
    for (int e = w.wg; e < NEXP; e += w.G) { const int lo = (int)w.misc[16 + e] * 256 + (int)w.misc[32 + e], hi = (int)w.misc[16 + e + 1] * 256;
        for (int s = lo + w.tid; s < hi; s += NTHR) { stok[s] = -1; sw[s] = 0.f; rowmap[s] = CTX; } }
}

DEV void phase_moe_combine(const P& p, Wg& w, int c) {
    const int* tsl = (const int*)(p.ws + WS_TSL); const float* topw = (const float*)(p.ws + WS_TOPW); const bf16* YC = (const bf16*)(p.ws + WS_YC);
    const int lo = c * MOE_PCH * 256, hi = lo + MOE_PCH * 256;
    const int ptot = (int)w.misc[16 + NEXP], np = (ptot - c * MOE_PCH) < MOE_PCH ? (ptot - c * MOE_PCH) : MOE_PCH;
    if (np <= 0) return;
    const int nsp = (np * NSPLIT > MOE_PCH) ? 1 : NSPLIT; const size_t pstr = (size_t)np * 256 * D_MODEL;
    constexpr int NJ = D_MODEL / 256;
    for (int i0 = 0; w.gw + i0 * w.NGW < NTOK; i0 += 64) {
        const int tokl = w.gw + (i0 + w.lane) * w.NGW; const bool okl = tokl < NTOK; const int tk = okl ? tokl : 0;
        const int s0l = tsl[2 * tk], s1l = tsl[2 * tk + 1];
        const bool in0 = okl && s0l >= lo && s0l < hi, in1 = okl && s1l >= lo && s1l < hi;
        const float w0l = in0 ? topw[2 * tk] : 0.f, w1l = in1 ? topw[2 * tk + 1] : 0.f;
        const int y0l = in0 ? s0l - lo : 0, y1l = in1 ? s1l - lo : 0;
        unsigned long long m = ballot64(in0 || in1);
        while (m) {
            int ii[2]; ii[0] = __builtin_ctzll(m); m &= m - 1ull; const bool two = m != 0ull; ii[1] = two ? __builtin_ctzll(m) : ii[0]; if (two) m &= m - 1ull;
            u32x2 x[2][NJ], ya[2][NJ], yb[2][NJ]; f32x4 g[2][NJ]; float w0[2], w1[2]; bf16* xr[2]; const bf16* y0[2]; const bf16* y1[2];
#pragma unroll
            for (int q = 0; q < 2; ++q) { const int tok = w.gw + (i0 + ii[q]) * w.NGW;
                w0[q] = __shfl(w0l, ii[q]); w1[q] = __shfl(w1l, ii[q]); y0[q] = YC + (size_t)__shfl(y0l, ii[q]) * D_MODEL; y1[q] = YC + (size_t)__shfl(y1l, ii[q]) * D_MODEL;
                xr[q] = (bf16*)(p.out + (size_t)tok * D_MODEL); const float* gv = (const float*)(p.ws + WS_MODV) + (size_t)(1 * NV + tok / SEQ) * 6 * D_MODEL + 5 * D_MODEL;
#pragma unroll
                for (int j = 0; j < NJ; ++j) { const int col = 4 * w.lane + 256 * j;
                    x[q][j] = *(const u32x2*)(xr[q] + col); ya[q][j] = *(const u32x2*)(y0[q] + col); yb[q][j] = *(const u32x2*)(y1[q] + col); g[q][j] = *(const f32x4*)(gv + col); } }
#pragma unroll
            for (int q = 0; q < 2; ++q) {
#pragma unroll
                for (int j = 0; j < NJ; ++j) { const int col = 4 * w.lane + 256 * j; const u32x2 a = ya[q][j], bq = yb[q][j]; f32x4 acc;
                    acc[0] = w0[q] * bf2f((bf16)a.x) + w1[q] * bf2f((bf16)bq.x); acc[1] = w0[q] * bf2f((bf16)(a.x >> 16)) + w1[q] * bf2f((bf16)(bq.x >> 16));
                    acc[2] = w0[q] * bf2f((bf16)a.y) + w1[q] * bf2f((bf16)bq.y); acc[3] = w0[q] * bf2f((bf16)(a.y >> 16)) + w1[q] * bf2f((bf16)(bq.y >> 16));
                    for (int ks = 1; ks < nsp; ++ks) { const u32x2 a2 = *(const u32x2*)(y0[q] + ks * pstr + col), b2 = *(const u32x2*)(y1[q] + ks * pstr + col);
                        acc[0] += w0[q] * bf2f((bf16)a2.x) + w1[q] * bf2f((bf16)b2.x); acc[1] += w0[q] * bf2f((bf16)(a2.x >> 16)) + w1[q] * bf2f((bf16)(b2.x >> 16));
                        acc[2] += w0[q] * bf2f((bf16)a2.y) + w1[q] * bf2f((bf16)b2.y); acc[3] += w0[q] * bf2f((bf16)(a2.y >> 16)) + w1[q] * bf2f((bf16)(b2.y >> 16)); }
                    u32x2 o; const u32x2 xv = x[q][j];
                    o.x = pk2(bf2f((bf16)xv.x) + g[q][j][0] * acc[0], bf2f((bf16)(xv.x >> 16)) + g[q][j][1] * acc[1]); o.y = pk2(bf2f((bf16)xv.y) + g[q][j][2] * acc[2], bf2f((bf16)(xv.y >> 16)) + g[q][j][3] * acc[3]);
                    if (q == 0 || two) *(u32x2*)(xr[q] + col) = o; } }
        }
    }
}
DEV void phase_moe_final(const P& p, Wg& w) {
    constexpr int c = MOE_NCH - 1, NJ = D_MODEL / 256;
    const int* tsl = (const int*)(p.ws + WS_TSL); const float* topw = (const float*)(p.ws + WS_TOPW); const bf16* YC = (const bf16*)(p.ws + WS_YC);
    const int lo = c * MOE_PCH * 256, hi = lo + MOE_PCH * 256;
    const int ptot = (int)w.misc[16 + NEXP], np = (ptot - c * MOE_PCH) < MOE_PCH ? (ptot - c * MOE_PCH) : MOE_PCH;
    const int nsp = (np * NSPLIT > MOE_PCH) ? 1 : NSPLIT; const size_t pstr = (size_t)(np > 0 ? np : 0) * 256 * D_MODEL;
    const int ntw = (NTOK - w.gw + w.NGW - 1) / w.NGW;
    for (int i0 = 0; i0 < ntw; i0 += 64) {
        const int tokl = w.gw + (i0 + w.lane) * w.NGW; const bool okl = tokl < NTOK; const int tk = okl ? tokl : 0;
        const int s0l = tsl[2 * tk], s1l = tsl[2 * tk + 1];
        const bool in0 = okl && np > 0 && s0l >= lo && s0l < hi, in1 = okl && np > 0 && s1l >= lo && s1l < hi;
        const float w0l = in0 ? topw[2 * tk] : 0.f, w1l = in1 ? topw[2 * tk + 1] : 0.f;
        const int y0l = in0 ? s0l - lo : 0, y1l = in1 ? s1l - lo : 0;
        const unsigned long long m = ballot64(in0 || in1);
        const int nb = (ntw - i0) < 64 ? (ntw - i0) : 64;
        u32x2 nx[2][NJ];
#define FIN_PF(k_) do { _Pragma("unroll") for (int q = 0; q < 2; ++q) { const int i_ = 2 * (k_) + q; const int t_ = w.gw + (i0 + (i_ < nb ? i_ : 0)) * w.NGW; const bf16* xr_ = (const bf16*)(p.out + (size_t)t_ * D_MODEL); \
            _Pragma("unroll") for (int j = 0; j < NJ; ++j) nx[q][j] = *(const u32x2*)(xr_ + 4 * w.lane + 256 * j); } } while (0)
        FIN_PF(0);
        for (int k = 0; 2 * k < nb; ++k) {
            f32x4 xo[2][NJ];
#pragma unroll
            for (int q = 0; q < 2; ++q)
#pragma unroll
                for (int j = 0; j < NJ; ++j) { const u32x2 t = nx[q][j]; xo[q][j] = (f32x4){bf2f((bf16)t.x), bf2f((bf16)(t.x >> 16)), bf2f((bf16)t.y), bf2f((bf16)(t.y >> 16))}; }
            if (2 * (k + 1) < nb) FIN_PF(k + 1);
#pragma unroll
            for (int q = 0; q < 2; ++q) { const int i = 2 * k + q;
                if (i < nb && ((m >> i) & 1ull)) {
                    const int tok = w.gw + (i0 + i) * w.NGW; const float w0 = __shfl(w0l, i), w1 = __shfl(w1l, i);
                    const bf16* y0 = YC + (size_t)__shfl(y0l, i) * D_MODEL; const bf16* y1 = YC + (size_t)__shfl(y1l, i) * D_MODEL;
                    const float* gv = (const float*)(p.ws + WS_MODV) + (size_t)(1 * NV + tok / SEQ) * 6 * D_MODEL + 5 * D_MODEL;
#pragma unroll
                    for (int j = 0; j < NJ; ++j) { const int col = 4 * w.lane + 256 * j; f32x4 ya = (f32x4){0.f, 0.f, 0.f, 0.f};
                        for (int ks = 0; ks < nsp; ++ks) { const u32x2 a = *(const u32x2*)(y0 + ks * pstr + col), bq = *(const u32x2*)(y1 + ks * pstr + col);
                            ya[0] += w0 * bf2f((bf16)a.x) + w1 * bf2f((bf16)bq.x); ya[1] += w0 * bf2f((bf16)(a.x >> 16)) + w1 * bf2f((bf16)(bq.x >> 16));
                            ya[2] += w0 * bf2f((bf16)a.y) + w1 * bf2f((bf16)bq.y); ya[3] += w0 * bf2f((bf16)(a.y >> 16)) + w1 * bf2f((bf16)(bq.y >> 16)); }
                        xo[q][j] = xo[q][j] + *(const f32x4*)(gv + col) * ya; } } }
            wave_sync();
#pragma unroll
            for (int q = 0; q < 2; ++q) { const int i = 2 * k + q; if (i < nb) { float* orow = p.out + (size_t)(w.gw + (i0 + i) * w.NGW) * D_MODEL;
#pragma unroll
                for (int j = 0; j < NJ; ++j) *(f32x4*)(orow + 4 * w.lane + 256 * j) = xo[q][j]; } }
        }
#undef FIN_PF
    }
}

#ifndef MK_PER_PHASE
#define MK_PER_PHASE 0
#endif
#if defined(EMU) || MK_PER_PHASE
#define SEG_TABLE() moe_seg_table(p, w)
#else
#define SEG_TABLE() do {} while (0)
#endif
constexpr int PH_L = 24;
constexpr int N_PHASES = 1 + 2 * PH_L;
#ifndef PROBE_MUL
#define PROBE_MUL 1
#endif
#ifdef EMU
#define GRID_BAR() do {} while (0)
#define DYN_LDS() unsigned char* lds = EMU_DYN_LDS()
#else
#define GRID_BAR() xcd_barrier(bar)
#define DYN_LDS() extern __shared__ __attribute__((aligned(16))) unsigned char lds[]
#endif
__global__ void __launch_bounds__(NTHR, 2) fwd(P p_in) {
    DYN_LDS();
    Wg w; w.tid = threadIdx.x; w.lane = w.tid & 63;
#ifndef EMU
    w.wave = __builtin_amdgcn_readfirstlane(w.tid >> 6);
#else
    w.wave = w.tid >> 6;
#endif
    w.G = gridDim.x; w.wg = blockIdx.x; w.gw = w.wg * NWAVE + w.wave; w.NGW = w.G * NWAVE; w.lds = lds; w.misc = (unsigned*)(lds + LDS_MISC);
    if (w.tid < 64) w.misc[w.tid] = 0u;
    __syncthreads();
#ifndef EMU
    XcdBarrier bar = xcd_barrier_post((unsigned*)(p_in.ws + WS_CTL) + CW_BAR, (volatile LAS unsigned*)(w.misc));
#endif
    const int lo = p_in.ph_lo, hi = p_in.ph_hi; const int wave_s = w.wave; (void)wave_s;
#ifndef PH_MASK
#define PH_MASK 0xffffffffu
#endif
#if defined(PROBE_SET) && !defined(EMU)
#define PROBE_T0(k) if (blockIdx.x == 0 && threadIdx.x == 0) { ((unsigned*)(lds + LDS_MISC))[64 + 2 * (k)] = (unsigned)wall_clock64(); }
#define PROBE_T1(k) if (blockIdx.x == 0 && threadIdx.x == 0) { ((unsigned*)(lds + LDS_MISC))[65 + 2 * (k)] = (unsigned)wall_clock64(); }
#define PROBE_SPLIT(k, vk) { GRID_BAR(); if (blockIdx.x == 0 && threadIdx.x == 0) { unsigned* m_ = (unsigned*)(lds + LDS_MISC); m_[64 + 2 * (vk)] = m_[64 + 2 * (k)]; m_[65 + 2 * (vk)] = (unsigned)wall_clock64(); } }
#else
#define PROBE_T0(k)
#define PROBE_T1(k)
#define PROBE_SPLIT(k, vk)
#endif
#ifndef EMU
#define TID_NOW() (wave_s * 64 + lane_fresh())
#define WAVE_OF(t) __builtin_amdgcn_readfirstlane((t) >> 6)
#else
#define TID_NOW() ((int)threadIdx.x)
#define WAVE_OF(t) ((t) >> 6)
#endif
#ifndef EMU
#define LOAD_P() const __attribute__((address_space(4))) P* pq_ = (const __attribute__((address_space(4))) P*)__builtin_amdgcn_kernarg_segment_ptr(); asm volatile("" : "+s"(pq_)); const P p = *(const P*)pq_;
#else
#define LOAD_P() const P& p = p_in;
#endif
#define PH_BEGIN(k) if (((PH_MASK >> ((k) - pb_)) & 1u) && lo <= (k) && (k) < hi) { LOAD_P() { int t_ = TID_NOW(); OPAQUE_V(t_); w.tid = t_; w.lane = t_ & 63; w.wave = WAVE_OF(t_); w.gw = w.wg * NWAVE + w.wave; } PROBE_T0(k)
#define PH_END(k) if ((k) + 1 < hi) GRID_BAR(); PROBE_T1(k) }
    { const int pb_ = -31; PH_BEGIN(0) phase0(p, w); PH_END(0) }
    for (int l = 0; l < 2; ++l) {
        const int pb = 1 + PH_L * l, pb_ = pb;
        PH_BEGIN(pb + 0) if (l == 0) phase_modulate<2>(p, w, 0, 0, true, false, false, false); else phase_modulate<4>(p, w, 1, 0, false, false, false, true); PH_END(pb + 0)
        PH_BEGIN(pb + 1) {
            pg8::Gemm g{(const bf16*)(p.ws + WS_H), (const bf16*)(p.ws + WS_WIN_T) + (size_t)l * PROJ_W * D_MODEL, D_MODEL, D_MODEL, D_MODEL, 0};
            Sched<0> S; S.o.init(NPAN, PROJ_W / 256, w.G, w.wg, SITE_WGM(0)); S.pm_base = 0; S.seg = nullptr; S.nNc = 0; S.kper = 0;
            EpiStore E{(bf16*)(p.ws + WS_PROJ), PROJ_W, (float*)(p.ws + WS_GATES)};
            { const TabSched T_ = build_units(w.misc, w.tid, S); pg8::gemm_phase<EpiStore, TabSched>(w.lds, w.tid, g, T_, E); } } PH_END(pb + 1)
        PH_BEGIN(pb + 2) phase_prep(p, w, l); PH_END(pb + 2)
        PH_BEGIN(pb + 3) {
            pg8::Gemm g{(const bf16*)(p.ws + WS_PROJ) + C_CQ, (const bf16*)(p.ws + WS_MLA_T) + (size_t)l * 1024 * 512, PROJ_W, 512, 256, 0};
            Sched<6> S; S.o.init(NPAN, 4, w.G, w.wg, SITE_WGM(1)); S.pm_base = 0; S.seg = nullptr; S.nNc = 0; S.kper = 0;
            EpiStoreMla E{(bf16*)(p.ws + WS_MLAQ)};
            { const TabSched T_ = build_units(w.misc, w.tid, S); pg8::gemm_phase<EpiStoreMla, TabSched>(w.lds, w.tid, g, T_, E); }
            __syncthreads();
            PROBE_SPLIT(pb + 3, 49 + 3 * l)
#ifndef NO_ML1
            { u32x4 kq_[3], vq_[3]; float g4_[4] = {0.f, 0.f, 0.f, 0.f}; const int it0_ = w.G - 1 - w.wg; if (it0_ < BATCH * 4 * NCH) ml1_prefetch(p, w, l, it0_, kq_, vq_, g4_);
              for (int it = it0_; it < BATCH * 4 * NCH; it += w.G) ml1_item(p, w, l, it, kq_, vq_, g4_, it + w.G < BATCH * 4 * NCH ? it + w.G : -1); }
#endif
            } PH_END(pb + 3)
        PH_BEGIN(pb + 4) phase_mla_post(p, w, l); PROBE_SPLIT(pb + 4, 50 + 3 * l) phase_ml2(p, w); PH_END(pb + 4)
        PH_BEGIN(pb + 5) phase_mix(p, w, l); PH_END(pb + 5)
        PH_BEGIN(pb + 6) {
            pg8::Gemm g{(const bf16*)(p.ws + WS_H), (const bf16*)(p.ws + WS_WOUT_T) + (size_t)l * D_MODEL * MIXW, MIXW, MIXW, MIXW, 0};
            Sched<0> S0; Sched<1> S1; S0.o.init(NPAN, D_MODEL / 256, w.G, w.wg, SITE_WGM(2)); S1.o.init(BATCH * NQL, D_MODEL / 256, w.G, w.wg, SITE_WGM(3)); S0.pm_base = 0; S0.seg = nullptr; S0.nNc = 0; S0.kper = 0; S1.pm_base = 0; S1.seg = nullptr; S1.nNc = 0; S1.kper = 0;
            if (l == 0) { EpiResid<true> E{p, l, 2 * D_MODEL}; const TabSched T_ = build_units(w.misc, w.tid, S0); pg8::gemm_phase<EpiResid<true>, TabSched>(w.lds, w.tid, g, T_, E);
                const int units_ = NPAN * (D_MODEL / 256), rounds_ = (units_ + w.G - 1) / w.G, extra_ = units_ - (rounds_ - 1) * w.G;
                __syncthreads();
                if (extra_ >= w.G) conv_ffn_tiles(p, w, w.wg, w.G); else if (w.wg >= extra_) conv_ffn_tiles(p, w, w.wg - extra_, w.G - extra_); }
            else { EpiResid<false> E{p, l, 2 * D_MODEL}; const TabSched T_ = build_units(w.misc, w.tid, S1); pg8::gemm_phase<EpiResid<false>, TabSched>(w.lds, w.tid, g, T_, E); } } PH_END(pb + 6)
        if (l == 0) {
            PH_BEGIN(pb + 7) phase_modulate<4>(p, w, 0, 1, false, false, false, false); PH_END(pb + 7)
            PH_BEGIN(pb + 8) {
                pg8::Gemm g{(const bf16*)(p.ws + WS_H), (const bf16*)(p.ws + WS_WGU_T), D_MODEL, D_MODEL, D_MODEL, 0};
                Sched<0> S; S.o.init(NPAN, 2 * D_FF / 256, w.G, w.wg, SITE_WGM(4)); S.pm_base = 0; S.seg = nullptr; S.nNc = 0; S.kper = 0;
                EpiSwiglu E{(bf16*)(p.ws + WS_ACT), 0};
                { const TabSched T_ = build_units(w.misc, w.tid, S); pg8::gemm_phase<EpiSwiglu, TabSched>(w.lds, w.tid, g, T_, E); } } PH_END(pb + 8)
            PH_BEGIN(pb + 9) {
                { pg8::Gemm g{(const bf16*)(p.ws + WS_ACT), (const bf16*)(p.ws + WS_WD_T), D_FF, D_FF, D_FF, 0};
                  Sched<1> S; S.o.init(BATCH * NQL, D_MODEL / 256, w.G, w.wg, SITE_WGM(5)); S.pm_base = 0; S.seg = nullptr; S.nNc = 0; S.kper = 0;
                  EpiResid<false> E{p, 0, 5 * D_MODEL};
                  { const TabSched T_ = build_units(w.misc, w.tid, S); pg8::gemm_phase<EpiResid<false>, TabSched>(w.lds, w.tid, g, T_, E); } }
                __syncthreads();
                { pg8::Gemm g{(const bf16*)(p.ws + WS_ACT), (const bf16*)(p.ws + WS_WD_T), D_FF, D_FF, KSPLIT, 0};
                  Sched<4> S; S.o.init(BATCH, (D_MODEL / 256) * NSPLIT, w.G, w.wg, SITE_WGM(6)); S.pm_base = 0; S.seg = nullptr; S.nNc = D_MODEL / 256; S.kper = KSPLIT;
                  EpiStoreRel E{(bf16*)(p.ws + WS_MLAQ), D_MODEL, 0};
                  { const TabSched T_ = build_units(w.misc, w.tid, S); pg8::gemm_phase<EpiStoreRel, TabSched>(w.lds, w.tid, g, T_, E); } } } PH_END(pb + 9)
        } else {
            PH_BEGIN(pb + 7) phase_moe_weights(p, w); PROBE_SPLIT(pb + 7, 51 + 3 * l) phase_modulate<1>(p, w, 1, 1, false, true, true, false); PH_END(pb + 7)
            PH_BEGIN(pb + 8) phase_gather(p, w); PH_END(pb + 8)
            for (int c = 0; c < MOE_NCH; ++c) {
                PH_BEGIN(pb + 9 + 2 * c) {
                    SEG_TABLE();
                    const int ptot = (int)w.misc[16 + NEXP], pm0 = c * MOE_PCH, np = (ptot - pm0) < MOE_PCH ? (ptot - pm0) : MOE_PCH;
                    if (c > 0 && (w.wg & 1)) phase_moe_combine(p, w, c - 1);
                    if (np > 0) {
                        pg8::Gemm g{(const bf16*)(p.ws + WS_H), (const bf16*)(p.ws + WS_MOEW), D_MODEL, D_MODEL, D_MODEL, MOEW_E, (const int*)(p.ws + WS_ROWMAP)};
                        Sched<2> S; S.o.init(np, 2 * D_FF / 256, w.G, w.wg, SITE_WGM(7)); S.pm_base = pm0; S.seg = (const int*)(w.misc + 16); S.nNc = 0; S.kper = 0;
                        EpiSwiglu E{(bf16*)(p.ws + WS_ACT2), pm0};
                        { const TabSched T_ = build_units(w.misc, w.tid, S);
#ifndef EMU
                          stage_rowtab(w.lds, w.tid, T_, g.rowmap);
#endif
                          pg8::gemm_phase<EpiSwiglu, TabSched, true>(w.lds, w.tid, g, T_, E); } }
                    if (c > 0 && !(w.wg & 1)) phase_moe_combine(p, w, c - 1); } PH_END(pb + 9 + 2 * c)
                PH_BEGIN(pb + 10 + 2 * c) {
                    SEG_TABLE();
                    const int ptot = (int)w.misc[16 + NEXP], pm0 = c * MOE_PCH, np = (ptot - pm0) < MOE_PCH ? (ptot - pm0) : MOE_PCH;
                    if (np > 0 && np * NSPLIT > MOE_PCH) {
                        pg8::Gemm g{(const bf16*)(p.ws + WS_ACT2), (const bf16*)(p.ws + WS_MOEW) + (size_t)2 * D_FF * D_MODEL, D_FF, D_FF, D_FF, MOEW_E};
                        Sched<3> S; S.o.init(np, D_MODEL / 256, w.G, w.wg, SITE_WGM(8)); S.pm_base = pm0; S.seg = (const int*)(w.misc + 16); S.nNc = 0; S.kper = 0;
                        EpiStoreRel E{(bf16*)(p.ws + WS_YC), D_MODEL, 0};
                        { const TabSched T_ = build_units(w.misc, w.tid, S); pg8::gemm_phase<EpiStoreRel, TabSched>(w.lds, w.tid, g, T_, E); } }
                    else if (np > 0) {
                        pg8::Gemm g{(const bf16*)(p.ws + WS_ACT2), (const bf16*)(p.ws + WS_MOEW) + (size_t)2 * D_FF * D_MODEL, D_FF, D_FF, KSPLIT, MOEW_E};
                        Sched<5> S; S.o.init(np, (D_MODEL / 256) * NSPLIT, w.G, w.wg, SITE_WGM(9)); S.pm_base = pm0; S.seg = (const int*)(w.misc + 16); S.nNc = D_MODEL / 256; S.kper = KSPLIT;
                        EpiStoreRel E{(bf16*)(p.ws + WS_YC), D_MODEL, 0};
                        { const TabSched T_ = build_units(w.misc, w.tid, S); pg8::gemm_phase<EpiStoreRel, TabSched>(w.lds, w.tid, g, T_, E); } } } PH_END(pb + 10 + 2 * c)
            }
            PH_BEGIN(pb + 9 + 2 * MOE_NCH) SEG_TABLE(); phase_moe_final(p, w); PH_END(pb + 9 + 2 * MOE_NCH)
        }
    }
#if defined(PROBE_SET) && !defined(EMU)
    if (blockIdx.x == 0 && threadIdx.x == 0) {
        unsigned tot = 0; for (int k = 0; k < 56; ++k) if ((PROBE_SET >> k) & 1ull) tot += ((unsigned*)(lds + LDS_MISC))[65 + 2 * k] - ((unsigned*)(lds + LDS_MISC))[64 + 2 * k];
        const unsigned long long t0 = wall_clock64(); while (wall_clock64() - t0 < (unsigned long long)tot * PROBE_MUL) __builtin_amdgcn_s_sleep(8);
    }
#endif
}

#ifndef MK_PER_PHASE
#define MK_PER_PHASE 0
#endif
extern "C" void kernel_launch(void* const* d_in, const int* in_sizes, int n_in, void* d_out, int out_size, void* d_ws, size_t ws_size, hipStream_t stream) {
    static int grid = 0;
    if (grid == 0) {
        if (n_in != 28 || in_sizes[0] != BATCH * SEQ * D_MODEL || out_size != BATCH * SEQ * D_MODEL || ws_size < WS_TOTAL) {
            fprintf(stderr, "kernel_launch: unexpected problem (n_in %d, x %d, out %d, ws %zu < %zu)\n", n_in, n_in > 0 ? in_sizes[0] : -1, out_size, ws_size, (size_t)WS_TOTAL); grid = -1; return; }
#ifndef EMU
        int dev = 0, cus = 0;
        if (hipGetDevice(&dev) != hipSuccess || hipDeviceGetAttribute(&cus, hipDeviceAttributeMultiprocessorCount, dev) != hipSuccess) { grid = -1; return; }
        if (hipFuncSetAttribute((const void*)fwd, hipFuncAttributeMaxDynamicSharedMemorySize, LDS_BYTES) != hipSuccess) { fprintf(stderr, "kernel_launch: hipFuncSetAttribute failed\n"); grid = -1; return; }
        int per_cu = 0;
        if (hipOccupancyMaxActiveBlocksPerMultiprocessor(&per_cu, (const void*)fwd, NTHR, LDS_BYTES) != hipSuccess || per_cu < 1) { fprintf(stderr, "kernel_launch: occupancy query says %d\n", per_cu); (void)hipGetLastError(); }
        grid = cus;
#else
        grid = 8;
#endif
    }
    if (grid < 0) return;
    (void)hipMemsetAsync((char*)d_ws + WS_CTL, 0, CTL_BYTES, stream);
    P p{};
    const float** pp = (const float**)&p;
    for (int i = 0; i < 28; ++i) pp[i] = (const float*)d_in[i];
    p.out = (float*)d_out; p.ws = (unsigned char*)d_ws;
#if MK_PER_PHASE
    for (int k = 0; k < N_PHASES; ++k) {
        if (k >= 1 + 10 && k < 1 + PH_L) continue;
        if (k >= 1 + PH_L + 10 + 2 * MOE_NCH) continue;
        p.ph_lo = k; p.ph_hi = k + 1;
        hipLaunchKernelGGL(fwd, dim3(grid), dim3(NTHR), LDS_BYTES, stream, p);
    }
#else
    p.ph_lo = 0; p.ph_hi = N_PHASES;
    hipLaunchKernelGGL(fwd, dim3(grid), dim3(NTHR), LDS_BYTES, stream, p);
#endif
}
```
